# Optimizing an MI355X kernel written in HIP

```python
import jax, jax.numpy as jnp
from jax import lax
import numpy as np

D_MODEL = 1024
BATCH = 2
SEQ = 16384
DEPTH = 4
DEC_BATCH = 8
DEC_SEQ = 2048
PAST_LEN = 128

N_MIXERS = 2
N_SG_LAYERS = (DEPTH + 1) // 2
N_TM_LAYERS = DEPTH // 2
CHUNK = 128
SG_HALF = 2 * D_MODEL
SG_GROUPS = 8
SG_GROUP_DIM = SG_HALF // SG_GROUPS
HEAD_SIZE = 64
N_HEADS = D_MODEL // HEAD_SIZE
DECAY_LORA = 64
AAA_LORA = 64
GATE_LORA = 160
N_SHIFT_MIX = 6
GN_EPS = 64e-5
D_FF = ((8 * D_MODEL // 3 + 255) // 256) * 256
CONV_WIDTH = 3
RMS_EPS = 1e-6
L2_EPS = 1e-12

kernel_name = 'hybrid_sgu_rwkv7_bidir_encoder'


def rms_norm(x, g):
    xf = x.astype(jnp.float32)
    y = xf * lax.rsqrt(jnp.mean(xf * xf, axis=-1, keepdims=True) + RMS_EPS)
    return (y * g.astype(jnp.float32)).astype(x.dtype)


def spatial_gating_mixer(x, w_in, b_in, norm_g, w_s, b_s, w_out):
    B, S, _ = x.shape
    z = jax.nn.gelu(x @ w_in + b_in, approximate=False)
    u, v = jnp.split(z, 2, axis=-1)
    v = rms_norm(v, norm_g)
    v = v.reshape(B, S // CHUNK, CHUNK, SG_GROUPS, SG_GROUP_DIM)
    v = jnp.einsum('gqp,bcpgd->bcqgd', w_s, v) + b_s.T[None, None, :, :, None]
    v = v.reshape(B, S, SG_HALF)
    return (u * v) @ w_out


def centred_shift_delta(x):
    prev = jnp.pad(x[:, :-1], ((0, 0), (1, 0), (0, 0)))
    nxt = jnp.pad(x[:, 1:], ((0, 0), (0, 1), (0, 0)))
    return 0.5 * (prev + nxt) - x


def wkv_scan(r, w, k, v, kk, a, reverse):
    B, S, H, N = r.shape
    xs = tuple(jnp.moveaxis(t, 1, 0) for t in (r, w, k, v, kk, a))

    def step(state, inp):
        r_t, w_t, k_t, v_t, kk_t, a_t = inp
        sa = jnp.einsum('bhij,bhj->bhi', state, -kk_t)
        state = (state * w_t[:, :, None, :]
                 + sa[..., None] * (kk_t * a_t)[:, :, None, :]
                 + v_t[..., None] * k_t[:, :, None, :])
        y_t = jnp.einsum('bhij,bhj->bhi', state, r_t)
        return state, y_t

    init = jnp.zeros((B, H, N, N), jnp.float32)
    _, y = lax.scan(step, init, xs, reverse=reverse)
    return jnp.moveaxis(y, 0, 1)


def heads(t):
    return t.reshape(t.shape[:-1] + (N_HEADS, HEAD_SIZE))


def rwkv7_bidir_mixer(x, mu, w_r, w_k, w_v, w0, w1, w2, a0, a1, a2, g1, g2,
                      k_k, k_a, r_k, ln_g, ln_b, w_o):
    B, S, D = x.shape
    f32 = jnp.float32
    xx = centred_shift_delta(x)
    xr, xw, xk, xv, xa, xg = (x + xx * mu[n] for n in range(N_SHIFT_MIX))
    r = xr @ w_r
    k = xk @ w_k
    v = xv @ w_v
    g = jax.nn.sigmoid(xg @ g1) @ g2
    w_pre = jnp.einsum('ebsr,erd->ebsd', jnp.tanh(jnp.einsum('bsd,edr->ebsr', xw, w1)), w2) + w0[:, None, None, :]
    w_log = -jax.nn.softplus(-w_pre.astype(f32)) - 0.5
    decay = jnp.exp(-jnp.exp(w_log))
    a_pre = jnp.einsum('ebsr,erd->ebsd', jnp.einsum('bsd,edr->ebsr', xa, a1), a2) + a0[:, None, None, :]
    a = jax.nn.sigmoid(a_pre.astype(f32))
    kf = k.astype(f32)
    kd = kf[None] * (1.0 + (a - 1.0) * k_a.astype(f32))
    kk = heads(kf * k_k.astype(f32))
    kk = kk / jnp.maximum(jnp.sqrt(jnp.sum(kk * kk, axis=-1, keepdims=True)), L2_EPS)
    rh = heads(r.astype(f32))
    vh = heads(v.astype(f32))
    kdh = heads(kd)
    ah = heads(a)
    dh = heads(decay)
    y = (wkv_scan(rh, dh[0], kdh[0], vh, kk, ah[0], False)
         + wkv_scan(rh, dh[1], kdh[1], vh, kk, ah[1], True))
    mean = jnp.mean(y, axis=-1, keepdims=True)
    var = jnp.mean(jnp.square(y - mean), axis=-1, keepdims=True)
    yn = ((y - mean) * lax.rsqrt(var + GN_EPS)).reshape(B, S, D) * ln_g.astype(f32) + ln_b.astype(f32)
    bonus = jnp.sum(rh[None] * kdh * r_k.astype(f32), axis=(0, -1))[..., None] * vh
    out = (yn + bonus.reshape(B, S, D)).astype(x.dtype) * g
    return out @ w_o


def conv_glu_ffn(x, w_gate, w_up, conv_w, conv_b, w_down):
    S = x.shape[1]
    gate = x @ w_gate
    up = x @ w_up
    half = CONV_WIDTH // 2
    padded = jnp.pad(gate, ((0, 0), (half, CONV_WIDTH - 1 - half), (0, 0)))
    conv = sum(padded[:, t:t + S] * conv_w[t] for t in range(CONV_WIDTH)) + conv_b
    h = jax.nn.gelu(conv, approximate=False) * up
    return h @ w_down


def trunk(x, norm_mix_g, norm_ffn_g, final_norm_g,
          sg_w_in, sg_b_in, sg_norm_g, sg_w_s, sg_b_s, sg_w_out,
          tm_mu, tm_w_r, tm_w_k, tm_w_v, tm_w0, tm_w1, tm_w2, tm_a0, tm_a1, tm_a2,
          tm_g1, tm_g2, tm_k_k, tm_k_a, tm_r_k, tm_ln_g, tm_ln_b, tm_w_o,
          ff_w_gate, ff_w_up, ff_conv_w, ff_conv_b, ff_w_down):
    for i in range(DEPTH):
        h = rms_norm(x, norm_mix_g[i])
        j = i // N_MIXERS
        if i % N_MIXERS == 0:
            x = x + spatial_gating_mixer(h, sg_w_in[j], sg_b_in[j], sg_norm_g[j],
                                         sg_w_s[j], sg_b_s[j], sg_w_out[j])
        else:
            x = x + rwkv7_bidir_mixer(h, tm_mu[j], tm_w_r[j], tm_w_k[j], tm_w_v[j],
                                      tm_w0[j], tm_w1[j], tm_w2[j], tm_a0[j], tm_a1[j], tm_a2[j],
                                      tm_g1[j], tm_g2[j], tm_k_k[j], tm_k_a[j], tm_r_k[j],
                                      tm_ln_g[j], tm_ln_b[j], tm_w_o[j])
        h = rms_norm(x, norm_ffn_g[i])
        x = x + conv_glu_ffn(h, ff_w_gate[i], ff_w_up[i], ff_conv_w[i], ff_conv_b[i], ff_w_down[i])
    return rms_norm(x, final_norm_g)


def setup_inputs(seed: int = 0) -> dict:
    key = jax.random.key(seed)
    ks = iter(jax.random.split(key, 64))

    def nrm(shape, scale):
        return scale * jax.random.normal(next(ks), shape, jnp.float32)

    def gain(shape):
        return 1.0 + nrm(shape, 0.02)

    D, E, F = D_MODEL, SG_HALF, D_FF
    NA, NB = N_SG_LAYERS, N_TM_LAYERS
    decay_base = jnp.linspace(-6.0, -1.0, D, dtype=jnp.float32)
    return {
        'x_prompt': nrm((BATCH, SEQ, D), 1.0),
        'x_sample': nrm((DEC_BATCH, DEC_SEQ, D), 1.0),
        'norm_mix_g': gain((DEPTH, D)),
        'norm_ffn_g': gain((DEPTH, D)),
        'final_norm_g': gain((D,)),
        'sg_w_in': nrm((NA, D, 2 * E), D ** -0.5),
        'sg_b_in': nrm((NA, 2 * E), 0.02),
        'sg_norm_g': gain((NA, E)),
        'sg_w_s': nrm((NA, SG_GROUPS, CHUNK, CHUNK), CHUNK ** -0.5),
        'sg_b_s': gain((NA, SG_GROUPS, CHUNK)),
        'sg_w_out': nrm((NA, E, D), E ** -0.5),
        'tm_mu': jax.random.uniform(next(ks), (NB, N_SHIFT_MIX, D), jnp.float32),
        'tm_w_r': nrm((NB, D, D), D ** -0.5),
        'tm_w_k': nrm((NB, D, D), D ** -0.5),
        'tm_w_v': nrm((NB, D, D), D ** -0.5),
        'tm_w0': decay_base + nrm((NB, 2, D), 0.1),
        'tm_w1': nrm((NB, 2, D, DECAY_LORA), D ** -0.5),
        'tm_w2': nrm((NB, 2, DECAY_LORA, D), 0.1 * DECAY_LORA ** -0.5),
        'tm_a0': nrm((NB, 2, D), 0.1),
        'tm_a1': nrm((NB, 2, D, AAA_LORA), D ** -0.5),
        'tm_a2': nrm((NB, 2, AAA_LORA, D), 0.5 * AAA_LORA ** -0.5),
        'tm_g1': nrm((NB, D, GATE_LORA), D ** -0.5),
        'tm_g2': nrm((NB, GATE_LORA, D), GATE_LORA ** -0.5),
        'tm_k_k': 0.85 + nrm((NB, D), 0.02),
        'tm_k_a': gain((NB, D)),
        'tm_r_k': nrm((NB, N_HEADS, HEAD_SIZE), 0.1),
        'tm_ln_g': gain((NB, D)),
        'tm_ln_b': nrm((NB, D), 0.02),
        'tm_w_o': nrm((NB, D, D), D ** -0.5),
        'ff_w_gate': nrm((DEPTH, D, F), D ** -0.5),
        'ff_w_up': nrm((DEPTH, D, F), D ** -0.5),
        'ff_conv_w': nrm((DEPTH, CONV_WIDTH, F), CONV_WIDTH ** -0.5),
        'ff_conv_b': nrm((DEPTH, F), 0.02),
        'ff_w_down': nrm((DEPTH, F, D), F ** -0.5),
    }


def reference(x_prompt, x_sample, norm_mix_g, norm_ffn_g, final_norm_g,
              sg_w_in, sg_b_in, sg_norm_g, sg_w_s, sg_b_s, sg_w_out,
              tm_mu, tm_w_r, tm_w_k, tm_w_v, tm_w0, tm_w1, tm_w2, tm_a0, tm_a1, tm_a2,
              tm_g1, tm_g2, tm_k_k, tm_k_a, tm_r_k, tm_ln_g, tm_ln_b, tm_w_o,
              ff_w_gate, ff_w_up, ff_conv_w, ff_conv_b, ff_w_down):
    params = (norm_mix_g, norm_ffn_g, final_norm_g,
              sg_w_in, sg_b_in, sg_norm_g, sg_w_s, sg_b_s, sg_w_out,
              tm_mu, tm_w_r, tm_w_k, tm_w_v, tm_w0, tm_w1, tm_w2, tm_a0, tm_a1, tm_a2,
              tm_g1, tm_g2, tm_k_k, tm_k_a, tm_r_k, tm_ln_g, tm_ln_b, tm_w_o,
              ff_w_gate, ff_w_up, ff_conv_w, ff_conv_b, ff_w_down)
    y_prompt = trunk(x_prompt, *params)
    y_sample = trunk(x_sample, *params)
    return (y_prompt, y_sample)
```

```cpp
#include <hip/hip_runtime.h>
#include <hip/hip_cooperative_groups.h>
#include <cstdio>
namespace cg = cooperative_groups;

#define DEV __device__ __forceinline__
typedef unsigned short bf16_t;
typedef short bf16x8 __attribute__((ext_vector_type(8)));
typedef float f32x4 __attribute__((ext_vector_type(4)));

extern __shared__ __attribute__((aligned(16))) char g_shm[];

constexpr int NT = 49152, SLAB = 16384;
constexpr int SHM_BYTES = 131072;
constexpr size_t MiB = 1u << 20;
constexpr size_t OFF_W = 0;
constexpr size_t OFF_H = 24 * MiB;
constexpr size_t OFF_H0 = OFF_H + 256 * 2048;
constexpr size_t OFF_U = 122 * MiB, OFF_SSQ = 250 * MiB;
constexpr size_t OFF_HMID = 122 * MiB;
constexpr size_t OFF_HX = 24 * MiB, OFF_YLF = 24 * MiB, OFF_YLB = 56 * MiB, OFF_R = 88 * MiB, OFF_K = 120 * MiB, OFF_V = 152 * MiB,
                 OFF_HL = 184 * MiB, OFF_E0 = 200 * MiB, OFF_E1 = 232 * MiB, OFF_A0 = 264 * MiB, OFF_A1 = 296 * MiB, OFF_G = 328 * MiB,
                 OFF_QF = 360 * MiB, OFF_QB = 392 * MiB, OFF_LB = 424 * MiB, OFF_PB = 440 * MiB, OFF_SI = 456 * MiB;
constexpr size_t W_SG_IN = 0, W_SG_OUT = 8 * MiB;
constexpr size_t W_FF_A = 0, W_FF_D = 12 * MiB;
constexpr size_t W_TM_P = 0, W_TM_O = 14 * MiB, W_TM_W2 = 16 * MiB, W_TM_A2 = 16 * MiB + 512 * 1024, W_TM_G2 = 17 * MiB;

struct Params {
  const float* in[34];
  float* x;
  char* ws;
};


typedef const __attribute__((address_space(4))) char* karg_t;
DEV int opaque0() { int z = 0; asm volatile("" : "+s"(z)); return z; }
DEV const float* kin(int i) { karg_t kp = (karg_t)__builtin_amdgcn_kernarg_segment_ptr(); return *(const float* const __attribute__((address_space(4)))*)(kp + (i + opaque0()) * 8); }
DEV float* kx() { karg_t kp = (karg_t)__builtin_amdgcn_kernarg_segment_ptr(); return *(float* const __attribute__((address_space(4)))*)(kp + (34 + opaque0()) * 8); }
DEV char* kws() { karg_t kp = (karg_t)__builtin_amdgcn_kernarg_segment_ptr(); return *(char* const __attribute__((address_space(4)))*)(kp + (35 + opaque0()) * 8); }

DEV int opaque_tid() { int z = 0; asm volatile("" : "+v"(z)); return (int)threadIdx.x + z; }
DEV float bf2f(bf16_t u) { return __uint_as_float(((unsigned)u) << 16); }
DEV bf16_t f2bf(float f) { unsigned u = __float_as_uint(f); u += 0x7fffu + ((u >> 16) & 1u); return (bf16_t)(u >> 16); }
DEV unsigned pack2(float a, float b) { return (unsigned)f2bf(a) | ((unsigned)f2bf(b) << 16); }
DEV float wave_sum(float v) {
#pragma unroll
  for (int o = 32; o > 0; o >>= 1) v += __shfl_xor(v, o);
  return v;
}
DEV float sigmoidf_(float x) { return 1.0f / (1.0f + __expf(-x)); }
DEV float gelu_exact(float x) { return 0.5f * x * (1.0f + erff(x * 0.70710678118654752f)); }

DEV void phase_init(const Params& p) {
  const int TIDX = opaque_tid();
  const float4* xp = (const float4*)kin(0);
  const float4* xs = (const float4*)kin(1);
  float4* x = (float4*)kx();
  const size_t n0 = (size_t)32768 * 256, n1 = (size_t)16384 * 256;
  for (size_t i = (size_t)blockIdx.x * 512 + TIDX; i < n0 + n1; i += (size_t)gridDim.x * 512) x[i] = i < n0 ? xp[i] : xs[i - n0];
}

DEV void phase_norm(const Params& p, const float* g, bf16_t* h0) {
  const int TIDX = opaque_tid();
  const int wid = TIDX >> 6, lane = TIDX & 63;
  float4 gv[4];
#pragma unroll
  for (int i = 0; i < 4; ++i) gv[i] = ((const float4*)g)[lane + 64 * i];
  for (int t = blockIdx.x * 8 + wid; t < NT; t += gridDim.x * 8) {
    const float4* xr = (const float4*)(kx() + (size_t)t * 1024);
    float4 v[4]; float ss = 0.f;
#pragma unroll
    for (int i = 0; i < 4; ++i) { v[i] = xr[lane + 64 * i]; ss += v[i].x * v[i].x + v[i].y * v[i].y + v[i].z * v[i].z + v[i].w * v[i].w; }
    ss = wave_sum(ss);
    const float rs = rsqrtf(ss * (1.0f / 1024.f) + 1e-6f);
    uint2* hr = (uint2*)(h0 + (size_t)t * 1024);
#pragma unroll
    for (int i = 0; i < 4; ++i) {
      uint2 o; o.x = pack2(v[i].x * rs * gv[i].x, v[i].y * rs * gv[i].y); o.y = pack2(v[i].z * rs * gv[i].z, v[i].w * rs * gv[i].w);
      hr[lane + 64 * i] = o;
    }
  }
}

DEV void phase_norm_tm(const Params& p, const float* g, bf16_t* hx, int slab) {
  const int TIDX = opaque_tid();
  const int wid = TIDX >> 6, lane = TIDX & 63;
  const int L = slab < 2 ? 16384 : 2048;
  float4 gv[4];
#pragma unroll
  for (int i = 0; i < 4; ++i) gv[i] = ((const float4*)g)[lane + 64 * i];
  for (int ts = blockIdx.x * 8 + wid; ts < SLAB; ts += gridDim.x * 8) {
    const int t = slab * SLAB + ts, pos = ts & (L - 1);
    float4 hv[3][4];
#pragma unroll
    for (int d = 0; d < 3; ++d) {
      const bool valid = !((d == 0 && pos == 0) || (d == 2 && pos == L - 1));
      const int tt = valid ? t + d - 1 : t;
      const float4* xr = (const float4*)(kx() + (size_t)tt * 1024);
      float ss = 0.f;
#pragma unroll
      for (int i = 0; i < 4; ++i) { float4 v = xr[lane + 64 * i]; hv[d][i] = v; ss += v.x * v.x + v.y * v.y + v.z * v.z + v.w * v.w; }
      ss = wave_sum(ss);
      const float rs = valid ? rsqrtf(ss * (1.0f / 1024.f) + 1e-6f) : 0.f;
#pragma unroll
      for (int i = 0; i < 4; ++i) { hv[d][i].x *= rs * gv[i].x; hv[d][i].y *= rs * gv[i].y; hv[d][i].z *= rs * gv[i].z; hv[d][i].w *= rs * gv[i].w; }
    }
    uint2* hr = (uint2*)(hx + (size_t)ts * 2048);
#pragma unroll
    for (int i = 0; i < 4; ++i) {
      uint2 o; o.x = pack2(hv[1][i].x, hv[1][i].y); o.y = pack2(hv[1][i].z, hv[1][i].w);
      hr[lane + 64 * i] = o;
      uint2 q;
      q.x = pack2(0.5f * (hv[0][i].x + hv[2][i].x) - hv[1][i].x, 0.5f * (hv[0][i].y + hv[2][i].y) - hv[1][i].y);
      q.y = pack2(0.5f * (hv[0][i].z + hv[2][i].z) - hv[1][i].z, 0.5f * (hv[0][i].w + hv[2][i].w) - hv[1][i].w);
      hr[256 + lane + 64 * i] = q;
    }
  }
}

DEV void phase_final(const Params& p) {
  const int TIDX = opaque_tid();
  const int wid = TIDX >> 6, lane = TIDX & 63;
  const float* g = kin(4);
  float4 gv[4];
#pragma unroll
  for (int i = 0; i < 4; ++i) gv[i] = ((const float4*)g)[lane + 64 * i];
  for (int t = blockIdx.x * 8 + wid; t < NT; t += gridDim.x * 8) {
    float4* xr = (float4*)(kx() + (size_t)t * 1024);
    float4 v[4]; float ss = 0.f;
#pragma unroll
    for (int i = 0; i < 4; ++i) { v[i] = xr[lane + 64 * i]; ss += v[i].x * v[i].x + v[i].y * v[i].y + v[i].z * v[i].z + v[i].w * v[i].w; }
    ss = wave_sum(ss);
    const float rs = rsqrtf(ss * (1.0f / 1024.f) + 1e-6f);
#pragma unroll
    for (int i = 0; i < 4; ++i) {
      float4 o; o.x = v[i].x * rs * gv[i].x; o.y = v[i].y * rs * gv[i].y; o.z = v[i].z * rs * gv[i].z; o.w = v[i].w * rs * gv[i].w;
      xr[lane + 64 * i] = o;
    }
  }
}

DEV void wprep_T(bf16_t* dst, int ldd, int koff, const float* src, int Ks, int Ns, const float* scale, int rs, int roff) {
  const int TIDX = opaque_tid();
  float (*tile)[33] = (float (*)[33])g_shm;
  const int tx = TIDX & 31, ty = TIDX >> 5;
  const int nkt = Ks / 32, nnt = Ns / 32;
  for (int tIdx = blockIdx.x; tIdx < nkt * nnt; tIdx += gridDim.x) {
    const int k0 = (tIdx / nnt) * 32, n0 = (tIdx % nnt) * 32;
    __syncthreads();
#pragma unroll
    for (int i = 0; i < 2; ++i) tile[ty + 16 * i][tx] = src[(size_t)(k0 + ty + 16 * i) * Ns + n0 + tx];
    __syncthreads();
    const float sc = scale ? scale[k0 + tx] : 1.0f;
#pragma unroll
    for (int i = 0; i < 2; ++i) {
      const int n = n0 + ty + 16 * i;
      const int drow = (n >> 7) * rs + (n & 127) + roff;
      dst[(size_t)drow * ldd + koff + k0 + tx] = f2bf(tile[tx][ty + 16 * i] * sc);
    }
  }
  __syncthreads();
}

constexpr int BM = 256, BK = 64, HALF = 128, HT = HALF * BK;
DEV int lds_byte(int r, int c) {
  int st = (r >> 4) * 2 + (c >> 5), rr = r & 15, cc = c & 31, ob = rr * 64 + cc * 2;
  return st * 1024 + (ob ^ (((ob >> 9) & 1) << 5));
}
DEV void stage_rc(int b, int& R, int& C) {
  int st = b / 1024, sb = b % 1024, swz = sb ^ (((sb >> 9) & 1) << 5);
  R = (st >> 1) * 16 + swz / 64; C = (st & 1) * 32 + (swz % 64) / 2;
}

typedef __attribute__((address_space(3))) unsigned char lds_u8;
DEV void gemm_big(const bf16_t* A, long lda, const bf16_t* Bt, long ldb, int K, long brow, long bcol, f32x4 (&acc)[2][2][4][2]) {
  const int TIDX = opaque_tid();
  lds_u8* lds = (lds_u8*)g_shm;
  constexpr int HTB = HT * 2;
#define SA(b, h) (((b) * 2 + (h)) * HTB)
#define SB(b, h) ((4 + (b) * 2 + (h)) * HTB)
#define STAGE(bufoff, gbase, VO, kt) do { const char* _gp = (gbase) + (size_t)(kt) * (BK * 2); \
    __builtin_amdgcn_global_load_lds((const unsigned*)(_gp + VO##0), (__attribute__((address_space(3))) unsigned*)(lds + (bufoff) + ldsw), 16, 0, 0); \
    __builtin_amdgcn_global_load_lds((const unsigned*)(_gp + VO##1), (__attribute__((address_space(3))) unsigned*)(lds + (bufoff) + ldsw + 8192), 16, 0, 0); } while (0)
#define LDA(dst, b, h) for (int m = 0; m < 4; ++m) for (int k = 0; k < 2; ++k) \
    dst[m][k] = *(const __attribute__((address_space(3))) bf16x8*)(lds + SA(b, h) + aoff + m * 2048 + k * 1024)
#define LDB(dst, b, h) for (int n = 0; n < 2; ++n) for (int k = 0; k < 2; ++k) \
    dst[n][k] = *(const __attribute__((address_space(3))) bf16x8*)(lds + SB(b, h) + boff + n * 2048 + k * 1024)
#define MMA(ai, bj, At, Bt_) do { __builtin_amdgcn_s_setprio(1); \
    for (int m = 0; m < 4; ++m) for (int n = 0; n < 2; ++n) for (int k = 0; k < 2; ++k) \
      acc[ai][bj][m][n] = __builtin_amdgcn_mfma_f32_16x16x32_bf16(At[m][k], Bt_[n][k], acc[ai][bj][m][n], 0, 0, 0); \
    __builtin_amdgcn_s_setprio(0); } while (0)
#define WAIT_V(n) asm volatile("s_waitcnt vmcnt(" #n ")" ::: "memory")
#define WAIT_L(n) asm volatile("s_waitcnt lgkmcnt(" #n ")" ::: "memory")
#define BAR __builtin_amdgcn_s_barrier()
#define SCHED __builtin_amdgcn_sched_barrier(0)
  const int tid = TIDX, wid = __builtin_amdgcn_readfirstlane(tid >> 6), lane = tid & 63, wr = wid >> 2, wc = wid & 3, fr = lane & 15, fq = lane >> 4;
  unsigned va0, va1, vb0, vb1;
  { int r_, c_; stage_rc(tid * 16, r_, c_); va0 = (unsigned)((r_ * lda + c_) * 2); vb0 = (unsigned)((r_ * ldb + c_) * 2);
    stage_rc(tid * 16 + 8192, r_, c_); va1 = (unsigned)((r_ * lda + c_) * 2); vb1 = (unsigned)((r_ * ldb + c_) * 2); }
  const unsigned ldsw = (unsigned)wid * 1024u;
  const int aoff = lds_byte(wr * 64 + fr, fq * 8), boff = lds_byte(wc * 32 + fr, fq * 8);
  const char* cA0 = (const char*)(A + brow * lda); const char* cA1 = cA0 + (size_t)HALF * lda * 2;
  const char* cB0 = (const char*)(Bt + bcol * ldb); const char* cB1 = cB0 + (size_t)HALF * ldb * 2;
#pragma unroll
  for (int a = 0; a < 2; ++a)
#pragma unroll
    for (int b = 0; b < 2; ++b)
#pragma unroll
      for (int m = 0; m < 4; ++m)
#pragma unroll
        for (int n = 0; n < 2; ++n) acc[a][b][m][n] = (f32x4){0.f, 0.f, 0.f, 0.f};
  bf16x8 At[4][2], B0[2][2], B1[2][2];
  const int nt = K / BK;
  STAGE(SB(0, 0), cB0, vb, 0); STAGE(SA(0, 0), cA0, va, 0);
  STAGE(SB(0, 1), cB1, vb, 0); STAGE(SA(0, 1), cA1, va, 0);
  if (wr == 1) BAR;
  WAIT_V(4); BAR;
  STAGE(SB(1, 0), cB0, vb, 1); STAGE(SA(1, 0), cA0, va, 1); STAGE(SB(1, 1), cB1, vb, 1);
  WAIT_V(6); BAR;
  for (int t = 0; t < nt - 2; t += 2) {
    LDB(B0, 0, 0); SCHED; LDA(At, 0, 0); STAGE(SA(1, 1), cA1, va, t + 1);
    WAIT_L(8); BAR; WAIT_L(0); MMA(0, 0, At, B0); BAR; SCHED;
    LDB(B1, 0, 1); STAGE(SB(0, 0), cB0, vb, t + 2);
    BAR; WAIT_L(0); MMA(0, 1, At, B1); BAR;
    LDA(At, 0, 1); STAGE(SA(0, 0), cA0, va, t + 2);
    BAR; WAIT_L(0); MMA(1, 0, At, B0); BAR; SCHED;
    STAGE(SB(0, 1), cB1, vb, t + 2);
    WAIT_V(6); BAR; MMA(1, 1, At, B1); BAR;
    LDB(B0, 1, 0); SCHED; LDA(At, 1, 0); STAGE(SA(0, 1), cA1, va, t + 2);
    WAIT_L(8); BAR; WAIT_L(0); MMA(0, 0, At, B0); BAR; SCHED;
    LDB(B1, 1, 1); STAGE(SB(1, 0), cB0, vb, t + 3);
    BAR; WAIT_L(0); MMA(0, 1, At, B1); BAR;
    LDA(At, 1, 1); STAGE(SA(1, 0), cA0, va, t + 3);
    BAR; WAIT_L(0); MMA(1, 0, At, B0); BAR; SCHED;
    STAGE(SB(1, 1), cB1, vb, t + 3);
    WAIT_V(6); BAR; MMA(1, 1, At, B1); BAR;
  }
  { LDB(B0, 0, 0); LDA(At, 0, 0); STAGE(SA(1, 1), cA1, va, nt - 1);
    BAR; WAIT_L(0); MMA(0, 0, At, B0); BAR;
    LDB(B1, 0, 1); BAR; WAIT_L(0); MMA(0, 1, At, B1); BAR;
    LDA(At, 0, 1); WAIT_V(4); BAR; WAIT_L(0); MMA(1, 0, At, B0); MMA(1, 1, At, B1); BAR; }
  { LDB(B0, 1, 0); LDA(At, 1, 0); WAIT_V(2); BAR; WAIT_L(0); MMA(0, 0, At, B0); BAR;
    LDB(B1, 1, 1); WAIT_V(0); BAR; WAIT_L(0); MMA(0, 1, At, B1); BAR;
    LDA(At, 1, 1); BAR; WAIT_L(0); MMA(1, 0, At, B0); MMA(1, 1, At, B1); BAR; }
  if (wr == 0) BAR;
}
DEV void dump_half(const f32x4 (&acc)[2][2][4][2], int ai, int tid) {
  float* T = (float*)g_shm;
  const int wid = tid >> 6, lane = tid & 63, wr = wid >> 2, wc = wid & 3, fr = lane & 15, fq = lane >> 4;
#pragma unroll
  for (int bj = 0; bj < 2; ++bj)
#pragma unroll
    for (int m = 0; m < 4; ++m)
#pragma unroll
      for (int n = 0; n < 2; ++n)
#pragma unroll
        for (int jj = 0; jj < 4; ++jj) {
          const int r = wr * 64 + m * 16 + fq * 4 + jj, c = bj * 128 + wc * 32 + n * 16 + fr;
          T[r * 256 + (c ^ (fq << 4))] = (ai == 0) ? acc[0][bj][m][n][jj] : acc[1][bj][m][n][jj];
        }
}
DEV float4 tile_ld4(int r, int c4) { return *(const float4*)((const float*)g_shm + r * 256 + (c4 ^ (((r >> 2) & 3) << 4))); }
DEV float tile_ld(int r, int c) { return ((const float*)g_shm)[r * 256 + (c ^ (((r >> 2) & 3) << 4))]; }

DEV int vblock() { return (blockIdx.x & 7) * (gridDim.x >> 3) + (blockIdx.x >> 3); }

DEV void phase_gemm_res(const Params& p, const bf16_t* A, long lda, const bf16_t* Bt, int K, int mtiles, long xrow0) {
  float* X = kx();
  for (int tile = vblock(); tile < mtiles * 4; tile += gridDim.x) {
    const int pm = tile >> 2, pn = tile & 3;
    f32x4 acc[2][2][4][2];
    gemm_big(A, lda, Bt, K, K, (long)pm * 256, (long)pn * 256, acc);
    const int tid = opaque_tid();
#pragma unroll
    for (int ai = 0; ai < 2; ++ai) {
      __syncthreads();
      dump_half(acc, ai, tid);
      __syncthreads();
      for (int e = tid; e < 128 * 64; e += 512) {
        const int r = e >> 6, c4 = (e & 63) * 4;
        const float4 v = tile_ld4(r, c4);
        float4* q = (float4*)(X + (xrow0 + pm * 256 + ai * 128 + r) * 1024 + pn * 256 + c4);
        float4 o = *q; o.x += v.x; o.y += v.y; o.z += v.z; o.w += v.w; *q = o;
      }
    }
    __syncthreads();
  }
}

DEV void phase_sgu_in(const Params& p, int j, int slab) {
  const bf16_t* A = (const bf16_t*)(kws() + OFF_H0) + (size_t)slab * SLAB * 1024;
  const bf16_t* Bt = (const bf16_t*)(kws() + OFF_W + W_SG_IN);
  const float* bin = kin(6) + (size_t)j * 4096;
  bf16_t* Z = (bf16_t*)(kws() + OFF_U);
  float* SSQ = (float*)(kws() + OFF_SSQ);
  for (int tile = vblock(); tile < 64 * 16; tile += gridDim.x) {
    const int pm = tile >> 4, pn = tile & 15;
    f32x4 acc[2][2][4][2];
    gemm_big(A, 1024, Bt, 1024, 1024, (long)pm * 256, (long)pn * 256, acc);
    const int tid = opaque_tid(), wid = tid >> 6, lane = tid & 63;
    const float4 b4 = *(const float4*)(bin + pn * 256 + lane * 4);
#pragma unroll
    for (int ai = 0; ai < 2; ++ai) {
      __syncthreads();
      dump_half(acc, ai, tid);
      __syncthreads();
      for (int rr = 0; rr < 16; ++rr) {
        const int r = wid * 16 + rr;
        const float4 v = tile_ld4(r, lane * 4);
        const float z0 = gelu_exact(v.x + b4.x), z1 = gelu_exact(v.y + b4.y), z2 = gelu_exact(v.z + b4.z), z3 = gelu_exact(v.w + b4.w);
        const int row = pm * 256 + ai * 128 + r;
        uint2 o; o.x = pack2(z0, z1); o.y = pack2(z2, z3);
        *(uint2*)(Z + (size_t)row * 4096 + pn * 256 + lane * 4) = o;
        if (pn >= 8) {
          const float ss = wave_sum(z0 * z0 + z1 * z1 + z2 * z2 + z3 * z3);
          if (lane == 0) SSQ[(size_t)row * 8 + (pn - 8)] = ss;
        }
      }
    }
    __syncthreads();
  }
}

DEV void phase_tm_proj(const Params& p) {
  const bf16_t* A = (const bf16_t*)(kws() + OFF_HX);
  const bf16_t* Bt = (const bf16_t*)(kws() + OFF_W + W_TM_P);
  for (int tile = vblock(); tile < 64 * 14; tile += gridDim.x) {
    const int pm = tile / 14, pn = tile % 14;
    f32x4 acc[2][2][4][2];
    gemm_big(A, 2048, Bt, 2048, 2048, (long)pm * 256, (long)pn * 256, acc);
    const int tid = opaque_tid(), wid = tid >> 6, lane = tid & 63;
    bf16_t* O; int ld, cb;
    if (pn < 12) { O = (bf16_t*)(kws() + (pn < 4 ? OFF_R : (pn < 8 ? OFF_K : OFF_V))); ld = 1024; cb = (pn & 3) * 256; }
    else { O = (bf16_t*)(kws() + OFF_HL); ld = 512; cb = (pn - 12) * 256; }
    const int act = pn < 12 ? 0 : (pn == 12 ? (lane < 32 ? 1 : 0) : 2);
#pragma unroll
    for (int ai = 0; ai < 2; ++ai) {
      __syncthreads();
      dump_half(acc, ai, tid);
      __syncthreads();
      for (int rr = 0; rr < 16; ++rr) {
        const int r = wid * 16 + rr;
        float4 v = tile_ld4(r, lane * 4);
        if (act == 1) { v.x = tanhf(v.x); v.y = tanhf(v.y); v.z = tanhf(v.z); v.w = tanhf(v.w); }
        else if (act == 2) { v.x = sigmoidf_(v.x); v.y = sigmoidf_(v.y); v.z = sigmoidf_(v.z); v.w = sigmoidf_(v.w); }
        uint2 o; o.x = pack2(v.x, v.y); o.y = pack2(v.z, v.w);
        *(uint2*)(O + (size_t)(pm * 256 + ai * 128 + r) * ld + cb + lane * 4) = o;
      }
    }
    __syncthreads();
  }
}

DEV void phase_ffn_a(const Params& p, int layer) {
  const bf16_t* A = (const bf16_t*)(kws() + OFF_H0);
  const bf16_t* Bt = (const bf16_t*)(kws() + OFF_W + W_FF_A);
  bf16_t* HM = (bf16_t*)(kws() + OFF_HMID);
  const float* cw = kin(31) + (size_t)layer * 3 * 2816;
  const float* cb = kin(32) + (size_t)layer * 2816;
  float* UP = (float*)g_shm;
  bf16_t* gl = (bf16_t*)(g_shm + 65536);
  for (int tile = vblock(); tile < 202 * 22; tile += gridDim.x) {
    const int mi = tile / 22, pn = tile % 22;
    int base, L, i;
    if (mi < 130) { base = (mi / 65) * 16384; L = 16384; i = mi % 65; }
    else { const int m2 = mi - 130; base = 32768 + (m2 / 9) * 2048; L = 2048; i = m2 % 9; }
    const int s0 = 254 * i - 1;
    f32x4 acc[2][2][4][2];
    gemm_big(A, 1024, Bt, 1024, 1024, (long)base + s0, (long)pn * 256, acc);
    const int tid = opaque_tid(), wid = tid >> 6, lane = tid & 63, wr = wid >> 2, wc = wid & 3, fr = lane & 15, fq = lane >> 4;
    __syncthreads();
#pragma unroll
    for (int ai = 0; ai < 2; ++ai)
#pragma unroll
      for (int m = 0; m < 4; ++m)
#pragma unroll
        for (int n = 0; n < 2; ++n)
#pragma unroll
          for (int jj = 0; jj < 4; ++jj) {
            const int r = ai * 128 + wr * 64 + m * 16 + fq * 4 + jj, c = wc * 32 + n * 16 + fr;
            const int s = s0 + r;
            gl[r * 128 + c] = (s >= 0 && s < L) ? f2bf(acc[ai][0][m][n][jj]) : (bf16_t)0;
          }
    const int c4 = (lane & 31) * 4, f = pn * 128 + c4;
    const float4 w0 = *(const float4*)(cw + f), w1 = *(const float4*)(cw + 2816 + f), w2 = *(const float4*)(cw + 2 * 2816 + f), bb = *(const float4*)(cb + f);
#pragma unroll
    for (int ai = 0; ai < 2; ++ai) {
      __syncthreads();
#pragma unroll
      for (int m = 0; m < 4; ++m)
#pragma unroll
        for (int n = 0; n < 2; ++n)
#pragma unroll
          for (int jj = 0; jj < 4; ++jj) {
            const int r = wr * 64 + m * 16 + fq * 4 + jj, c = wc * 32 + n * 16 + fr;
            UP[r * 128 + (c ^ (fq << 4))] = (ai == 0) ? acc[0][1][m][n][jj] : acc[1][1][m][n][jj];
          }
      __syncthreads();
      for (int e = tid; e < 128 * 32; e += 512) {
        const int rl = e >> 5, r = ai * 128 + rl, s = s0 + r;
        if (r >= 1 && r <= 254 && s < L) {
          const float4 u = *(const float4*)(UP + rl * 128 + (c4 ^ (((rl >> 2) & 3) << 4)));
          const uint2 g0 = *(const uint2*)(gl + (r - 1) * 128 + c4), g1 = *(const uint2*)(gl + r * 128 + c4), g2 = *(const uint2*)(gl + (r + 1) * 128 + c4);
          const float c0 = w0.x * __uint_as_float(g0.x << 16) + w1.x * __uint_as_float(g1.x << 16) + w2.x * __uint_as_float(g2.x << 16) + bb.x;
          const float c1 = w0.y * __uint_as_float(g0.x & 0xffff0000u) + w1.y * __uint_as_float(g1.x & 0xffff0000u) + w2.y * __uint_as_float(g2.x & 0xffff0000u) + bb.y;
          const float c2 = w0.z * __uint_as_float(g0.y << 16) + w1.z * __uint_as_float(g1.y << 16) + w2.z * __uint_as_float(g2.y << 16) + bb.z;
          const float c3 = w0.w * __uint_as_float(g0.y & 0xffff0000u) + w1.w * __uint_as_float(g1.y & 0xffff0000u) + w2.w * __uint_as_float(g2.y & 0xffff0000u) + bb.w;
          uint2 o; o.x = pack2(gelu_exact(c0) * u.x, gelu_exact(c1) * u.y); o.y = pack2(gelu_exact(c2) * u.z, gelu_exact(c3) * u.w);
          *(uint2*)(HM + (size_t)(base + s) * 2816 + f) = o;
        }
      }
    }
    __syncthreads();
  }
}

template <int KP>
DEV void small_mma(f32x4 (&acc)[4][4]) {
  const int TIDX = opaque_tid();
  constexpr int LD = KP + 8;
  const bf16_t* sA = (const bf16_t*)g_shm;
  const bf16_t* sB = sA + 128 * LD;
  const int wid = TIDX >> 6, lane = TIDX & 63, wr = wid >> 2, wc = wid & 3, fr = lane & 15, fq = lane >> 4;
#pragma unroll
  for (int m = 0; m < 4; ++m)
#pragma unroll
    for (int n = 0; n < 4; ++n) acc[m][n] = (f32x4){0.f, 0.f, 0.f, 0.f};
#pragma unroll
  for (int kk = 0; kk < KP / 32; ++kk) {
    bf16x8 a[4], b[4];
#pragma unroll
    for (int m = 0; m < 4; ++m) a[m] = *(const bf16x8*)(sA + (wr * 64 + m * 16 + fr) * LD + kk * 32 + fq * 8);
#pragma unroll
    for (int n = 0; n < 4; ++n) b[n] = *(const bf16x8*)(sB + (wc * 64 + n * 16 + fr) * LD + kk * 32 + fq * 8);
#pragma unroll
    for (int m = 0; m < 4; ++m)
#pragma unroll
      for (int n = 0; n < 4; ++n) acc[m][n] = __builtin_amdgcn_mfma_f32_16x16x32_bf16(a[m], b[n], acc[m][n], 0, 0, 0);
  }
}
template <int KP>
DEV void small_load(bf16_t* s, const bf16_t* g, long ld, int rows) {
  const int TIDX = opaque_tid();
  constexpr int LD = KP + 8, CPR = KP / 8;
  for (int c = TIDX; c < rows * CPR; c += 512) {
    const int r = c / CPR, k8 = (c % CPR) * 8;
    *(uint4*)(s + r * LD + k8) = *(const uint4*)(g + (long)r * ld + k8);
  }
}

DEV void phase_sgu_mix(const Params& p, int j) {
  const int TIDX = opaque_tid();
  constexpr int KP = 128, LD = KP + 8;
  const int wid = TIDX >> 6, lane = TIDX & 63, wr = wid >> 2, wc = wid & 3, fr = lane & 15, fq = lane >> 4;
  bf16_t* sA = (bf16_t*)g_shm;
  bf16_t* sB = sA + 128 * LD;
  float* rsv = (float*)(g_shm + (128 + 256) * LD * 2);
  bf16_t* Z = (bf16_t*)(kws() + OFF_U);
  const float* SSQ = (const float*)(kws() + OFF_SSQ);
  const float* ws_ = kin(8) + (size_t)j * 8 * 128 * 128;
  const float* bs = kin(9) + (size_t)j * 8 * 128;
  const float* ng = kin(7) + (size_t)j * 2048;
  for (int unit = blockIdx.x; unit < 128 * 8; unit += gridDim.x) {
    const int chunk = unit >> 3, g = unit & 7;
    __syncthreads();
    if (TIDX < 128) {
      const float* sp = SSQ + (size_t)(chunk * 128 + TIDX) * 8;
      float s = 0.f;
      for (int i = 0; i < 8; ++i) s += sp[i];
      rsv[TIDX] = rsqrtf(s * (1.0f / 2048.f) + 1e-6f);
    }
    for (int e = TIDX; e < 128 * 32; e += 512) {
      const int pp = e >> 5, c8 = (e & 31) * 8;
      const uint4 v = *(const uint4*)(Z + (size_t)(chunk * 128 + pp) * 4096 + 2048 + g * 256 + c8);
      sB[(c8 + 0) * LD + pp] = (bf16_t)(v.x & 0xffff); sB[(c8 + 1) * LD + pp] = (bf16_t)(v.x >> 16);
      sB[(c8 + 2) * LD + pp] = (bf16_t)(v.y & 0xffff); sB[(c8 + 3) * LD + pp] = (bf16_t)(v.y >> 16);
      sB[(c8 + 4) * LD + pp] = (bf16_t)(v.z & 0xffff); sB[(c8 + 5) * LD + pp] = (bf16_t)(v.z >> 16);
      sB[(c8 + 6) * LD + pp] = (bf16_t)(v.w & 0xffff); sB[(c8 + 7) * LD + pp] = (bf16_t)(v.w >> 16);
    }
    __syncthreads();
    for (int c = TIDX; c < 128 * 16; c += 512) {
      const int q = c >> 4, p8 = (c & 15) * 8;
      const float4* wp = (const float4*)(ws_ + ((size_t)g * 128 + q) * 128 + p8);
      const float4 w0 = wp[0], w1 = wp[1];
      uint4 o;
      o.x = pack2(w0.x * rsv[p8 + 0], w0.y * rsv[p8 + 1]); o.y = pack2(w0.z * rsv[p8 + 2], w0.w * rsv[p8 + 3]);
      o.z = pack2(w1.x * rsv[p8 + 4], w1.y * rsv[p8 + 5]); o.w = pack2(w1.z * rsv[p8 + 6], w1.w * rsv[p8 + 7]);
      *(uint4*)(sA + q * LD + p8) = o;
    }
    __syncthreads();
    f32x4 acc[4][4];
    small_mma<KP>(acc);
#pragma unroll
    for (int m = 0; m < 4; ++m)
#pragma unroll
      for (int n = 0; n < 4; ++n) {
        const int c = g * 256 + wc * 64 + n * 16 + fr;
        const float gg = ng[c];
#pragma unroll
        for (int jj = 0; jj < 4; ++jj) {
          const int q = wr * 64 + m * 16 + fq * 4 + jj;
          const float mix = acc[m][n][jj] * gg + bs[g * 128 + q];
          bf16_t* up = Z + (size_t)(chunk * 128 + q) * 4096 + c;
          *up = f2bf(bf2f(*up) * mix);
        }
      }
  }
  __syncthreads();
}

template <int KP>
DEV void lora_out_unit(const Params& p, int j, int kind, int mt, int ntile) {
  const int TIDX = opaque_tid();
  constexpr int LD = KP + 8;
  const int wid = TIDX >> 6, lane = TIDX & 63, wr = wid >> 2, wc = wid & 3, fr = lane & 15, fq = lane >> 4;
  bf16_t* sA = (bf16_t*)g_shm;
  bf16_t* sB = sA + 128 * LD;
  const bf16_t* HL = (const bf16_t*)(kws() + OFF_HL);
  const int koff = kind < 4 ? kind * 64 : 256;
  const bf16_t* Bt = (const bf16_t*)(kws() + OFF_W + (kind < 2 ? W_TM_W2 + (size_t)kind * 1024 * 64 * 2 : (kind < 4 ? W_TM_A2 + (size_t)(kind - 2) * 1024 * 64 * 2 : W_TM_G2)));
  bf16_t* O = (bf16_t*)(kws() + (kind == 0 ? OFF_E0 : kind == 1 ? OFF_E1 : kind == 2 ? OFF_A0 : kind == 3 ? OFF_A1 : OFF_G));
  const float* bias = kind < 2 ? kin(15) + ((size_t)j * 2 + kind) * 1024 : (kind < 4 ? kin(18) + ((size_t)j * 2 + kind - 2) * 1024 : nullptr);
  __syncthreads();
  small_load<KP>(sA, HL + (size_t)mt * 128 * 512 + koff, 512, 128);
  small_load<KP>(sB, Bt + (size_t)ntile * 256 * KP, KP, 256);
  __syncthreads();
  f32x4 acc[4][4];
  small_mma<KP>(acc);
#pragma unroll
  for (int m = 0; m < 4; ++m)
#pragma unroll
    for (int n = 0; n < 4; ++n) {
      const int col = ntile * 256 + wc * 64 + n * 16 + fr;
      const float b = bias ? bias[col] : 0.f;
#pragma unroll
      for (int jj = 0; jj < 4; ++jj) {
        const int row = mt * 128 + wr * 64 + m * 16 + fq * 4 + jj;
        float v = acc[m][n][jj] + b;
        if (kind < 2) v = 0.6065306597126334f * sigmoidf_(v); else if (kind < 4) v = sigmoidf_(v);
        O[(size_t)row * 1024 + col] = f2bf(v);
      }
    }
}
DEV void phase_tm_lora_out(const Params& p, int j) {
  for (int unit = blockIdx.x; unit < 5 * 512; unit += gridDim.x) {
    const int kind = unit / 512, r = unit % 512, mt = r >> 2, ntile = r & 3;
    if (kind < 4) lora_out_unit<64>(p, j, kind, mt, ntile); else lora_out_unit<160>(p, j, kind, mt, ntile);
  }
  __syncthreads();
}

template <int C> DEV void fmac_bc(float& acc, float op, float s) {
  asm volatile("v_fmac_f32_dpp %0, %1, %2 row_newbcast:%3 row_mask:0xf bank_mask:0xf" : "+v"(acc) : "v"(op), "v"(s), "n"(C));
}
template <int C> DEV float mul_bc(float op, float s) {
  float r;
  asm volatile("v_mul_f32_dpp %0, %1, %2 row_newbcast:%3 row_mask:0xf bank_mask:0xf" : "=v"(r) : "v"(op), "v"(s), "n"(C));
  return r;
}
#define LAUNDER4(a) asm volatile("s_nop 1" : "+v"(a[0]), "+v"(a[1]), "+v"(a[2]), "+v"(a[3]))
#define REP4(M, J) M(J) M(J + 1) M(J + 2) M(J + 3)
#define REP16(M, J) REP4(M, J) REP4(M, J + 4) REP4(M, J + 8) REP4(M, J + 12)
#define REP64(M) REP16(M, 0) REP16(M, 16) REP16(M, 32) REP16(M, 48)

DEV float row_sum16(float v) { v += __shfl_xor(v, 1); v += __shfl_xor(v, 2); v += __shfl_xor(v, 4); v += __shfl_xor(v, 8); return v; }

struct ScanRaw { uint2 r, k, a, e; bf16_t v; };

DEV void phase_scan(const Params& p, int j, int slab) {
  const int TIDX = opaque_tid();
  const int wid = TIDX >> 6, lane = TIDX & 63, c16 = lane & 15;
  const bf16_t* Rb = (const bf16_t*)(kws() + OFF_R);
  const bf16_t* Kb = (const bf16_t*)(kws() + OFF_K);
  const bf16_t* Vb = (const bf16_t*)(kws() + OFF_V);
  for (int item = blockIdx.x * 8 + wid; item < 2048; item += gridDim.x * 8) {
    const int kind = item & 1, dir = (item >> 1) & 1, hd = (item >> 2) & 15, seg = item >> 6;
    const bf16_t* Ab = (const bf16_t*)(kws() + (dir ? OFF_A1 : OFF_A0));
    const bf16_t* Eb = (const bf16_t*)(kws() + (dir ? OFF_E1 : OFF_E0));
    bf16_t* Yo = (bf16_t*)(kws() + (kind ? (dir ? OFF_QB : OFF_QF) : (dir ? OFF_YLB : OFF_YLF)));
    float* Fo = (float*)(kws() + (kind ? OFF_PB : OFF_LB)) + (size_t)((seg * 16 + hd) * 2 + dir) * 4096;
    float kkw[4], kaw[4];
#pragma unroll
    for (int m = 0; m < 4; ++m) { kkw[m] = kin(23)[(size_t)j * 1024 + hd * 64 + 4 * c16 + m]; kaw[m] = kin(24)[(size_t)j * 1024 + hd * 64 + 4 * c16 + m]; }
    float S[64];
#pragma unroll
    for (int q = 0; q < 64; ++q) S[q] = (kind && q == lane) ? 1.f : 0.f;
    const int t0 = seg * 512, tstep = dir ? -1 : 1, tfirst = dir ? t0 + 511 : t0;
    const size_t hoff = (size_t)hd * 64;
    auto load_raw = [&](int step, ScanRaw& w) {
      const int st = step < 512 ? step : 511;
      const size_t o = (size_t)(tfirst + tstep * st) * 1024 + hoff;
      w.r = *(const uint2*)(Rb + o + 4 * c16); w.k = *(const uint2*)(Kb + o + 4 * c16);
      w.a = *(const uint2*)(Ab + o + 4 * c16); w.e = *(const uint2*)(Eb + o + 4 * c16);
      w.v = Vb[o + lane];
    };
    float nkk[4], bb[4], kd[4], ww[4], rr[4], vv;
    auto prep = [&](const ScanRaw& w) {
      float kf[4], af[4], ef[4], kr[4];
      kf[0] = __uint_as_float(w.k.x << 16); kf[1] = __uint_as_float(w.k.x & 0xffff0000u); kf[2] = __uint_as_float(w.k.y << 16); kf[3] = __uint_as_float(w.k.y & 0xffff0000u);
      af[0] = __uint_as_float(w.a.x << 16); af[1] = __uint_as_float(w.a.x & 0xffff0000u); af[2] = __uint_as_float(w.a.y << 16); af[3] = __uint_as_float(w.a.y & 0xffff0000u);
      ef[0] = __uint_as_float(w.e.x << 16); ef[1] = __uint_as_float(w.e.x & 0xffff0000u); ef[2] = __uint_as_float(w.e.y << 16); ef[3] = __uint_as_float(w.e.y & 0xffff0000u);
      rr[0] = __uint_as_float(w.r.x << 16); rr[1] = __uint_as_float(w.r.x & 0xffff0000u); rr[2] = __uint_as_float(w.r.y << 16); rr[3] = __uint_as_float(w.r.y & 0xffff0000u);
      float ss = 0.f;
#pragma unroll
      for (int m = 0; m < 4; ++m) { kr[m] = kf[m] * kkw[m]; ss += kr[m] * kr[m]; }
      ss = row_sum16(ss);
      const float inv = 1.0f / fmaxf(sqrtf(ss), 1e-12f);
#pragma unroll
      for (int m = 0; m < 4; ++m) {
        const float kk = kr[m] * inv;
        nkk[m] = -kk; bb[m] = kk * af[m]; kd[m] = kf[m] * (1.0f + (af[m] - 1.0f) * kaw[m]);
        ww[m] = __builtin_amdgcn_exp2f(-1.4426950408889634f * ef[m]);
      }
      vv = bf2f(w.v);
    };
    ScanRaw w0, w1;
    load_raw(0, w0); load_raw(1, w1);
    prep(w0);
    for (int step = 0; step < 512; ++step) {
      ScanRaw w2; load_raw(step + 2, w2);
      LAUNDER4(nkk); LAUNDER4(bb); LAUNDER4(kd); LAUNDER4(ww); LAUNDER4(rr);
      float sa0 = 0.f, sa1 = 0.f;
#define SA_EL(J) fmac_bc<((J) >> 2)>(((J) & 1) ? sa1 : sa0, nkk[(J) & 3], S[J]);
      REP64(SA_EL)
      const float sa = sa0 + sa1;
      float y0 = 0.f, y1 = 0.f;
      if (kind == 0) {
#define UP_EL(J) { float t_ = mul_bc<((J) >> 2)>(kd[(J) & 3], vv); fmac_bc<((J) >> 2)>(t_, bb[(J) & 3], sa); fmac_bc<((J) >> 2)>(t_, ww[(J) & 3], S[J]); S[J] = t_; fmac_bc<((J) >> 2)>(((J) & 1) ? y1 : y0, rr[(J) & 3], t_); }
        REP64(UP_EL)
      } else {
#define UP_ID(J) { float t_ = mul_bc<((J) >> 2)>(bb[(J) & 3], sa); fmac_bc<((J) >> 2)>(t_, ww[(J) & 3], S[J]); S[J] = t_; fmac_bc<((J) >> 2)>(((J) & 1) ? y1 : y0, rr[(J) & 3], t_); }
        REP64(UP_ID)
      }
      Yo[(size_t)(tfirst + tstep * step) * 1024 + hoff + lane] = f2bf(y0 + y1);
      prep(w1);
      w1 = w2;
    }
#pragma unroll
    for (int q = 0; q < 16; ++q) {
      float4 o; o.x = S[4 * q]; o.y = S[4 * q + 1]; o.z = S[4 * q + 2]; o.w = S[4 * q + 3];
      *(float4*)(Fo + (size_t)lane * 64 + 4 * q) = o;
    }
  }
}

DEV void phase_combine(const Params& p, int slab) {
  const int TIDX = opaque_tid();
  float* ST = (float*)g_shm;
  float* PL = ST + 4096;
  const float* Lb = (const float*)(kws() + OFF_LB);
  const float* Pb = (const float*)(kws() + OFF_PB);
  float* SI = (float*)(kws() + OFF_SI);
  const int nseq = slab < 2 ? 1 : 8, sps = 32 / nseq;
  const int i = TIDX & 63, cgp = TIDX >> 6;
  for (int chain = blockIdx.x; chain < nseq * 32; chain += gridDim.x) {
    const int dir = chain & 1, hd = (chain >> 1) & 15, sq = chain >> 5;
    __syncthreads();
    for (int e = TIDX; e < 4096; e += 512) ST[e] = 0.f;
    __syncthreads();
    for (int s = 0; s < sps; ++s) {
      const int sg = sq * sps + (dir ? sps - 1 - s : s);
      const size_t cb = (size_t)((sg * 16 + hd) * 2 + dir) * 4096;
#pragma unroll
      for (int c = 0; c < 8; ++c) SI[cb + (size_t)i * 64 + cgp * 8 + c] = ST[(cgp * 8 + c) * 64 + i];
      for (int e = TIDX; e < 4096; e += 512) PL[e] = Pb[cb + e];
      __syncthreads();
      float acc[8];
#pragma unroll
      for (int c = 0; c < 8; ++c) acc[c] = Lb[cb + (size_t)i * 64 + cgp * 8 + c];
      for (int r = 0; r < 64; ++r) {
        const float sv = ST[r * 64 + i];
        const float4 p0 = *(const float4*)(PL + r * 64 + cgp * 8), p1 = *(const float4*)(PL + r * 64 + cgp * 8 + 4);
        acc[0] += sv * p0.x; acc[1] += sv * p0.y; acc[2] += sv * p0.z; acc[3] += sv * p0.w;
        acc[4] += sv * p1.x; acc[5] += sv * p1.y; acc[6] += sv * p1.z; acc[7] += sv * p1.w;
      }
      __syncthreads();
#pragma unroll
      for (int c = 0; c < 8; ++c) ST[(cgp * 8 + c) * 64 + i] = acc[c];
      __syncthreads();
    }
  }
  __syncthreads();
}

DEV void phase_tm_post(const Params& p, int j) {
  const int TIDX = opaque_tid();
  const int wid = TIDX >> 6, lane = TIDX & 63, c16 = lane & 15;
  bf16_t* Rb = (bf16_t*)(kws() + OFF_R);
  const bf16_t* Kb = (const bf16_t*)(kws() + OFF_K);
  const bf16_t* Vb = (const bf16_t*)(kws() + OFF_V);
  const bf16_t* A0 = (const bf16_t*)(kws() + OFF_A0);
  const bf16_t* A1 = (const bf16_t*)(kws() + OFF_A1);
  const bf16_t* Gb = (const bf16_t*)(kws() + OFF_G);
  const bf16_t* YF = (const bf16_t*)(kws() + OFF_YLF);
  const bf16_t* YB = (const bf16_t*)(kws() + OFF_YLB);
  const bf16_t* QF = (const bf16_t*)(kws() + OFF_QF);
  const bf16_t* QB = (const bf16_t*)(kws() + OFF_QB);
  const float* SI = (const float*)(kws() + OFF_SI);
  for (int item = blockIdx.x * 8 + wid; item < 2048; item += gridDim.x * 8) {
    const int quarter = item & 3, hd = (item >> 2) & 15, seg = item >> 6;
    const int cch = hd * 64 + lane;
    const float rk = kin(25)[(size_t)j * 1024 + cch], ka = kin(24)[(size_t)j * 1024 + cch];
    const float lg = kin(26)[(size_t)j * 1024 + cch], lb = kin(27)[(size_t)j * 1024 + cch];
    float SF[64], SBk[64];
    {
      const float* sf = SI + (size_t)((seg * 16 + hd) * 2 + 0) * 4096 + (size_t)lane * 64;
      const float* sb = SI + (size_t)((seg * 16 + hd) * 2 + 1) * 4096 + (size_t)lane * 64;
#pragma unroll
      for (int q = 0; q < 16; ++q) {
        const float4 a = *(const float4*)(sf + 4 * q), b = *(const float4*)(sb + 4 * q);
        SF[4 * q] = a.x; SF[4 * q + 1] = a.y; SF[4 * q + 2] = a.z; SF[4 * q + 3] = a.w;
        SBk[4 * q] = b.x; SBk[4 * q + 1] = b.y; SBk[4 * q + 2] = b.z; SBk[4 * q + 3] = b.w;
      }
    }
    for (int tt = 0; tt < 128; ++tt) {
      const size_t o = (size_t)(seg * 512 + quarter * 128 + tt) * 1024 + hd * 64;
      const uint2 qfr = *(const uint2*)(QF + o + 4 * c16), qbr = *(const uint2*)(QB + o + 4 * c16);
      float qf[4], qb[4];
      qf[0] = __uint_as_float(qfr.x << 16); qf[1] = __uint_as_float(qfr.x & 0xffff0000u); qf[2] = __uint_as_float(qfr.y << 16); qf[3] = __uint_as_float(qfr.y & 0xffff0000u);
      qb[0] = __uint_as_float(qbr.x << 16); qb[1] = __uint_as_float(qbr.x & 0xffff0000u); qb[2] = __uint_as_float(qbr.y << 16); qb[3] = __uint_as_float(qbr.y & 0xffff0000u);
      float y0 = bf2f(YF[o + lane]), y1 = bf2f(YB[o + lane]);
      const float rj = bf2f(Rb[o + lane]), kj = bf2f(Kb[o + lane]), vj = bf2f(Vb[o + lane]), gj = bf2f(Gb[o + lane]);
      const float a0 = bf2f(A0[o + lane]), a1 = bf2f(A1[o + lane]);
      LAUNDER4(qf); LAUNDER4(qb);
#define PF_EL(J) fmac_bc<((J) >> 2)>(y0, qf[(J) & 3], SF[J]); fmac_bc<((J) >> 2)>(y1, qb[(J) & 3], SBk[J]);
      REP64(PF_EL)
      const float y = y0 + y1;
      const float mean = wave_sum(y) * (1.0f / 64.f);
      const float dy = y - mean;
      const float var = wave_sum(dy * dy) * (1.0f / 64.f);
      const float yn = dy * rsqrtf(var + 64e-5f) * lg + lb;
      const float bon = wave_sum(rj * rk * kj * ((1.0f + (a0 - 1.0f) * ka) + (1.0f + (a1 - 1.0f) * ka)));
      Rb[o + lane] = f2bf((yn + bon * vj) * gj);
    }
  }
}

DEV void wprep_sgu(const Params& p, int j) {
  wprep_T((bf16_t*)(kws() + OFF_W + W_SG_IN), 1024, 0, kin(5) + (size_t)j * 1024 * 4096, 1024, 4096, nullptr, 128, 0);
  wprep_T((bf16_t*)(kws() + OFF_W + W_SG_OUT), 2048, 0, kin(10) + (size_t)j * 2048 * 1024, 2048, 1024, nullptr, 128, 0);
}
DEV void wprep_ffn(const Params& p, int layer) {
  wprep_T((bf16_t*)(kws() + OFF_W + W_FF_A), 1024, 0, kin(29) + (size_t)layer * 1024 * 2816, 1024, 2816, nullptr, 256, 0);
  wprep_T((bf16_t*)(kws() + OFF_W + W_FF_A), 1024, 0, kin(30) + (size_t)layer * 1024 * 2816, 1024, 2816, nullptr, 256, 128);
  wprep_T((bf16_t*)(kws() + OFF_W + W_FF_D), 2816, 0, kin(33) + (size_t)layer * 2816 * 1024, 2816, 1024, nullptr, 128, 0);
}
DEV void wprep_tm(const Params& p, int j) {
  const int TIDX = opaque_tid();
  bf16_t* WP = (bf16_t*)(kws() + OFF_W + W_TM_P);
  const float* mu = kin(11) + (size_t)j * 6 * 1024;
  const float* srcs[3] = {kin(12) + (size_t)j * 1048576, kin(13) + (size_t)j * 1048576, kin(14) + (size_t)j * 1048576};
  const int mus[3] = {0, 2, 3};
#pragma unroll
  for (int i = 0; i < 3; ++i) {
    wprep_T(WP, 2048, 0, srcs[i], 1024, 1024, nullptr, 128, i * 1024);
    wprep_T(WP, 2048, 1024, srcs[i], 1024, 1024, mu + mus[i] * 1024, 128, i * 1024);
  }
#pragma unroll
  for (int e = 0; e < 2; ++e) {
    const float* w1 = kin(16) + ((size_t)j * 2 + e) * 1024 * 64;
    wprep_T(WP, 2048, 0, w1, 1024, 64, nullptr, 128, 3072 + 64 * e);
    wprep_T(WP, 2048, 1024, w1, 1024, 64, mu + 1 * 1024, 128, 3072 + 64 * e);
    const float* a1 = kin(19) + ((size_t)j * 2 + e) * 1024 * 64;
    wprep_T(WP, 2048, 0, a1, 1024, 64, nullptr, 128, 3200 + 64 * e);
    wprep_T(WP, 2048, 1024, a1, 1024, 64, mu + 4 * 1024, 128, 3200 + 64 * e);
    wprep_T((bf16_t*)(kws() + OFF_W + W_TM_W2) + (size_t)e * 1024 * 64, 64, 0, kin(17) + ((size_t)j * 2 + e) * 64 * 1024, 64, 1024, nullptr, 128, 0);
    wprep_T((bf16_t*)(kws() + OFF_W + W_TM_A2) + (size_t)e * 1024 * 64, 64, 0, kin(20) + ((size_t)j * 2 + e) * 64 * 1024, 64, 1024, nullptr, 128, 0);
  }
  const float* g1 = kin(21) + (size_t)j * 1024 * 160;
  wprep_T(WP, 2048, 0, g1, 1024, 160, nullptr, 128, 3328);
  wprep_T(WP, 2048, 1024, g1, 1024, 160, mu + 5 * 1024, 128, 3328);
  for (size_t i = (size_t)blockIdx.x * 512 + TIDX; i < (size_t)96 * 2048 / 2; i += (size_t)gridDim.x * 512) ((unsigned*)(WP + (size_t)3488 * 2048))[i] = 0u;
  wprep_T((bf16_t*)(kws() + OFF_W + W_TM_G2), 160, 0, kin(22) + (size_t)j * 160 * 1024, 160, 1024, nullptr, 128, 0);
  wprep_T((bf16_t*)(kws() + OFF_W + W_TM_O), 1024, 0, kin(28) + (size_t)j * 1048576, 1024, 1024, nullptr, 128, 0);
}

constexpr int PH_SGU = 10, PH_FFN = 3, PH_TM = 21;
constexpr int N_PHASES = 1 + 2 * (PH_SGU + PH_FFN) + 2 * (PH_TM + PH_FFN) + 1;

DEV void run_phase(const Params& p, int ph) {
  if (ph == 0) { phase_init(p); return; }
  if (ph == N_PHASES - 1) { phase_final(p); return; }
  int q = ph - 1, layer = 0;
  for (;;) {
    const int len = (layer & 1) ? PH_TM + PH_FFN : PH_SGU + PH_FFN;
    if (q < len) break;
    q -= len; ++layer;
  }
  const int j = layer >> 1;
  bf16_t* H0 = (bf16_t*)(kws() + OFF_H0);
  const int nmix = (layer & 1) ? PH_TM : PH_SGU;
  if (q >= nmix) {
    const int f = q - nmix;
    if (f == 0) { phase_norm(p, kin(3) + (size_t)layer * 1024, H0); wprep_ffn(p, layer); }
    else if (f == 1) phase_ffn_a(p, layer);
    else phase_gemm_res(p, (const bf16_t*)(kws() + OFF_HMID), 2816, (const bf16_t*)(kws() + OFF_W + W_FF_D), 2816, 192, 0);
    return;
  }
  if (!(layer & 1)) {
    if (q == 0) { phase_norm(p, kin(2) + (size_t)layer * 1024, H0); wprep_sgu(p, j); return; }
    const int slab = (q - 1) / 3, s = (q - 1) % 3;
    if (s == 0) phase_sgu_in(p, j, slab);
    else if (s == 1) phase_sgu_mix(p, j);
    else phase_gemm_res(p, (const bf16_t*)(kws() + OFF_U), 4096, (const bf16_t*)(kws() + OFF_W + W_SG_OUT), 2048, 64, (long)slab * SLAB);
    return;
  }
  {
    const int slab = q / 7, s = q % 7;
    switch (s) {
      case 0: phase_norm_tm(p, kin(2) + (size_t)layer * 1024, (bf16_t*)(kws() + OFF_HX), slab); if (slab == 0) wprep_tm(p, j); break;
      case 1: phase_tm_proj(p); break;
      case 2: phase_tm_lora_out(p, j); break;
      case 3: phase_scan(p, j, slab); break;
      case 4: phase_combine(p, slab); break;
      case 5: phase_tm_post(p, j); break;
      default: phase_gemm_res(p, (const bf16_t*)(kws() + OFF_R), 1024, (const bf16_t*)(kws() + OFF_W + W_TM_O), 1024, 64, (long)slab * SLAB); break;
    }
  }
}

__global__ void __launch_bounds__(512, 2) mega(Params p, int ph_lo, int ph_hi, int coop) {
  for (int ph = ph_lo; ph < ph_hi; ++ph) {
    run_phase(p, ph);
    if (coop && ph + 1 < ph_hi) cg::this_grid().sync();
  }
}

extern "C" void kernel_launch(void* const* d_in, const int* in_sizes, int n_in, void* d_out, int out_size, void* d_ws, size_t ws_size, hipStream_t stream) {
  static int grid = 0;
  if (!grid) {
    int dev = 0, cus = 0, per_cu = 0;
    (void)hipFuncSetAttribute((const void*)mega, hipFuncAttributeMaxDynamicSharedMemorySize, SHM_BYTES);
    (void)hipGetDevice(&dev);
    (void)hipDeviceGetAttribute(&cus, hipDeviceAttributeMultiprocessorCount, dev);
    (void)hipOccupancyMaxActiveBlocksPerMultiprocessor(&per_cu, (const void*)mega, 512, SHM_BYTES);
    if (per_cu < 1) per_cu = 1;
    grid = cus * per_cu;
    if (grid > 256) grid = 256;
    if (grid & 7) grid &= ~7;
  }
  Params p{};
  for (int i = 0; i < 34; ++i) p.in[i] = (const float*)d_in[i];
  p.x = (float*)d_out;
  p.ws = (char*)d_ws;
  int ph_lo = 0, ph_hi = N_PHASES, coop = 1;
  void* args[] = {&p, &ph_lo, &ph_hi, &coop};
  hipError_t e = hipLaunchCooperativeKernel((const void*)mega, dim3(grid), dim3(512), args, SHM_BYTES, stream);
  if (e != hipSuccess) fprintf(stderr, "cooperative launch failed: %s (grid %d)\n", hipGetErrorString(e), grid);
}
```

```cpp
#include <hip/hip_runtime.h>
#include <hip/hip_cooperative_groups.h>
#include <cstdio>
namespace cg = cooperative_groups;

#define DEV __device__ __forceinline__
typedef unsigned short bf16_t;
typedef short bf16x8 __attribute__((ext_vector_type(8)));
typedef float f32x4 __attribute__((ext_vector_type(4)));

extern __shared__ __attribute__((aligned(16))) char g_shm[];

constexpr int NT = 49152, SLAB = 16384;
constexpr int SHM_BYTES = 131072;
constexpr size_t MiB = 1u << 20;
constexpr size_t OFF_W = 0;
constexpr size_t OFF_H = 24 * MiB;
constexpr size_t OFF_H0 = OFF_H + 256 * 2048;
constexpr size_t OFF_U = 122 * MiB, OFF_SSQ = 250 * MiB;
constexpr size_t OFF_HMID = 122 * MiB;
constexpr size_t OFF_HX = 24 * MiB, OFF_YLF = 24 * MiB, OFF_YLB = 56 * MiB, OFF_R = 88 * MiB, OFF_K = 120 * MiB, OFF_V = 152 * MiB,
                 OFF_HL = 184 * MiB, OFF_E0 = 200 * MiB, OFF_E1 = 232 * MiB, OFF_A0 = 264 * MiB, OFF_A1 = 296 * MiB, OFF_G = 328 * MiB,
                 OFF_QF = 360 * MiB, OFF_QB = 392 * MiB, OFF_LB = 424 * MiB, OFF_PB = 440 * MiB, OFF_SI = 456 * MiB;
constexpr size_t W_SG_IN = 0, W_SG_OUT = 8 * MiB;
constexpr size_t W_FF_A = 0, W_FF_D = 12 * MiB;
constexpr size_t W_TM_P = 0, W_TM_O = 14 * MiB, W_TM_W2 = 16 * MiB, W_TM_A2 = 16 * MiB + 512 * 1024, W_TM_G2 = 17 * MiB;

struct Params {
  const float* in[34];
  float* x;
  char* ws;
};


typedef const __attribute__((address_space(4))) char* karg_t;
DEV int opaque0() { int z = 0; asm volatile("" : "+s"(z)); return z; }
DEV const float* kin(int i) { karg_t kp = (karg_t)__builtin_amdgcn_kernarg_segment_ptr(); return *(const float* const __attribute__((address_space(4)))*)(kp + (i + opaque0()) * 8); }
DEV float* kx() { karg_t kp = (karg_t)__builtin_amdgcn_kernarg_segment_ptr(); return *(float* const __attribute__((address_space(4)))*)(kp + (34 + opaque0()) * 8); }
DEV char* kws() { karg_t kp = (karg_t)__builtin_amdgcn_kernarg_segment_ptr(); return *(char* const __attribute__((address_space(4)))*)(kp + (35 + opaque0()) * 8); }

DEV int opaque_tid() { int z = 0; asm volatile("" : "+v"(z)); return (int)threadIdx.x + z; }
DEV float bf2f(bf16_t u) { return __uint_as_float(((unsigned)u) << 16); }
DEV bf16_t f2bf(float f) { unsigned u = __float_as_uint(f); u += 0x7fffu + ((u >> 16) & 1u); return (bf16_t)(u >> 16); }
DEV unsigned pack2(float a, float b) { return (unsigned)f2bf(a) | ((unsigned)f2bf(b) << 16); }
DEV float wave_sum(float v) {
#pragma unroll
  for (int o = 32; o > 0; o >>= 1) v += __shfl_xor(v, o);
  return v;
}
DEV float sigmoidf_(float x) { return 1.0f / (1.0f + __expf(-x)); }
DEV float gelu_exact(float v) {
  const float av = fabsf(v), d = av * 0.2316418882f + 1.0f;
  const float t = __builtin_amdgcn_rcpf(d);
  float q = t * 0.5307027145f + (-0.7265760135f); q = q * t + 0.7107068705f; q = q * t + (-0.142248368f); q = q * t + 0.127414796f; q = q * t;
  const float e = __builtin_amdgcn_exp2f((v * v) * (-0.72134752044f));
  const float m = v * (q * e), r = v - m;
  return v < 0.f ? m : r;
}

DEV void phase_init(const Params& p) {
  const int TIDX = opaque_tid();
  const float4* xp = (const float4*)kin(0);
  const float4* xs = (const float4*)kin(1);
  float4* x = (float4*)kx();
  const size_t n0 = (size_t)32768 * 256, n1 = (size_t)16384 * 256;
  for (size_t i = (size_t)blockIdx.x * 512 + TIDX; i < n0 + n1; i += (size_t)gridDim.x * 512) x[i] = i < n0 ? xp[i] : xs[i - n0];
}

DEV void phase_norm(const Params& p, const float* g, bf16_t* h0) {
  const int TIDX = opaque_tid();
  const int wid = TIDX >> 6, lane = TIDX & 63;
  float4 gv[4];
#pragma unroll
  for (int i = 0; i < 4; ++i) gv[i] = ((const float4*)g)[lane + 64 * i];
  for (int t = blockIdx.x * 8 + wid; t < NT; t += gridDim.x * 8) {
    const float4* xr = (const float4*)(kx() + (size_t)t * 1024);
    float4 v[4]; float ss = 0.f;
#pragma unroll
    for (int i = 0; i < 4; ++i) { v[i] = xr[lane + 64 * i]; ss += v[i].x * v[i].x + v[i].y * v[i].y + v[i].z * v[i].z + v[i].w * v[i].w; }
    ss = wave_sum(ss);
    const float rs = rsqrtf(ss * (1.0f / 1024.f) + 1e-6f);
    uint2* hr = (uint2*)(h0 + (size_t)t * 1024);
#pragma unroll
    for (int i = 0; i < 4; ++i) {
      uint2 o; o.x = pack2(v[i].x * rs * gv[i].x, v[i].y * rs * gv[i].y); o.y = pack2(v[i].z * rs * gv[i].z, v[i].w * rs * gv[i].w);
      hr[lane + 64 * i] = o;
    }
  }
}

DEV void phase_norm_tm(const Params& p, const float* g, bf16_t* hx, int slab) {
  const int TIDX = opaque_tid();
  const int wid = TIDX >> 6, lane = TIDX & 63;
  const int L = slab < 2 ? 16384 : 2048;
  float4 gv[4];
#pragma unroll
  for (int i = 0; i < 4; ++i) gv[i] = ((const float4*)g)[lane + 64 * i];
  for (int ts = blockIdx.x * 8 + wid; ts < SLAB; ts += gridDim.x * 8) {
    const int t = slab * SLAB + ts, pos = ts & (L - 1);
    float4 hv[3][4];
#pragma unroll
    for (int d = 0; d < 3; ++d) {
      const bool valid = !((d == 0 && pos == 0) || (d == 2 && pos == L - 1));
      const int tt = valid ? t + d - 1 : t;
      const float4* xr = (const float4*)(kx() + (size_t)tt * 1024);
      float ss = 0.f;
#pragma unroll
      for (int i = 0; i < 4; ++i) { float4 v = xr[lane + 64 * i]; hv[d][i] = v; ss += v.x * v.x + v.y * v.y + v.z * v.z + v.w * v.w; }
      ss = wave_sum(ss);
      const float rs = valid ? rsqrtf(ss * (1.0f / 1024.f) + 1e-6f) : 0.f;
#pragma unroll
      for (int i = 0; i < 4; ++i) { hv[d][i].x *= rs * gv[i].x; hv[d][i].y *= rs * gv[i].y; hv[d][i].z *= rs * gv[i].z; hv[d][i].w *= rs * gv[i].w; }
    }
    uint2* hr = (uint2*)(hx + (size_t)ts * 2048);
#pragma unroll
    for (int i = 0; i < 4; ++i) {
      uint2 o; o.x = pack2(hv[1][i].x, hv[1][i].y); o.y = pack2(hv[1][i].z, hv[1][i].w);
      hr[lane + 64 * i] = o;
      uint2 q;
      q.x = pack2(0.5f * (hv[0][i].x + hv[2][i].x) - hv[1][i].x, 0.5f * (hv[0][i].y + hv[2][i].y) - hv[1][i].y);
      q.y = pack2(0.5f * (hv[0][i].z + hv[2][i].z) - hv[1][i].z, 0.5f * (hv[0][i].w + hv[2][i].w) - hv[1][i].w);
      hr[256 + lane + 64 * i] = q;
    }
  }
}

DEV void phase_final(const Params& p) {
  const int TIDX = opaque_tid();
  const int wid = TIDX >> 6, lane = TIDX & 63;
  const float* g = kin(4);
  float4 gv[4];
#pragma unroll
  for (int i = 0; i < 4; ++i) gv[i] = ((const float4*)g)[lane + 64 * i];
  for (int t = blockIdx.x * 8 + wid; t < NT; t += gridDim.x * 8) {
    float4* xr = (float4*)(kx() + (size_t)t * 1024);
    float4 v[4]; float ss = 0.f;
#pragma unroll
    for (int i = 0; i < 4; ++i) { v[i] = xr[lane + 64 * i]; ss += v[i].x * v[i].x + v[i].y * v[i].y + v[i].z * v[i].z + v[i].w * v[i].w; }
    ss = wave_sum(ss);
    const float rs = rsqrtf(ss * (1.0f / 1024.f) + 1e-6f);
#pragma unroll
    for (int i = 0; i < 4; ++i) {
      float4 o; o.x = v[i].x * rs * gv[i].x; o.y = v[i].y * rs * gv[i].y; o.z = v[i].z * rs * gv[i].z; o.w = v[i].w * rs * gv[i].w;
      xr[lane + 64 * i] = o;
    }
  }
}

DEV void wprep_T(bf16_t* dst, int ldd, int koff, const float* src, int Ks, int Ns, const float* scale, int rs, int roff) {
  const int TIDX = opaque_tid();
  float (*tile)[33] = (float (*)[33])g_shm;
  const int tx = TIDX & 31, ty = TIDX >> 5;
  const int nkt = Ks / 32, nnt = Ns / 32;
  for (int tIdx = blockIdx.x; tIdx < nkt * nnt; tIdx += gridDim.x) {
    const int k0 = (tIdx / nnt) * 32, n0 = (tIdx % nnt) * 32;
    __syncthreads();
#pragma unroll
    for (int i = 0; i < 2; ++i) tile[ty + 16 * i][tx] = src[(size_t)(k0 + ty + 16 * i) * Ns + n0 + tx];
    __syncthreads();
    const float sc = scale ? scale[k0 + tx] : 1.0f;
#pragma unroll
    for (int i = 0; i < 2; ++i) {
      const int n = n0 + ty + 16 * i;
      const int drow = (n >> 7) * rs + (n & 127) + roff;
      dst[(size_t)drow * ldd + koff + k0 + tx] = f2bf(tile[tx][ty + 16 * i] * sc);
    }
  }
  __syncthreads();
}


DEV void wprep_T2(bf16_t* dst, int ldd, int koff, const float* src, int Ks, int Ns, const float* scale, int rs, int roff) {
  const int TIDX = opaque_tid();
  float* tile = (float*)g_shm;
  const int nkt = Ks / 64, nnt = Ns / 128;
  const int lc = TIDX & 127, lr = TIDX >> 7;
  const int wk = TIDX & 63, wn = TIDX >> 6;
  for (int tIdx = blockIdx.x; tIdx < nkt * nnt; tIdx += gridDim.x) {
    const int k0 = (tIdx / nnt) * 64, n0 = (tIdx % nnt) * 128;
    float v[16];
#pragma unroll
    for (int i = 0; i < 16; ++i) v[i] = src[(size_t)(k0 + i * 4 + lr) * Ns + n0 + lc];
    __syncthreads();
#pragma unroll
    for (int i = 0; i < 16; ++i) tile[(i * 4 + lr) * 129 + lc] = v[i];
    __syncthreads();
    const float sc = scale ? scale[k0 + wk] : 1.0f;
#pragma unroll
    for (int i = 0; i < 16; ++i) {
      const int n = n0 + i * 8 + wn;
      const int drow = (n >> 7) * rs + (n & 127) + roff;
      dst[(size_t)drow * ldd + koff + k0 + wk] = f2bf(tile[wk * 129 + i * 8 + wn] * sc);
    }
  }
  __syncthreads();
}

constexpr int BM = 256, BK = 64, HALF = 128, HT = HALF * BK;
DEV int lds_byte(int r, int c) {
  int st = (r >> 4) * 2 + (c >> 5), rr = r & 15, cc = c & 31, ob = rr * 64 + cc * 2;
  return st * 1024 + (ob ^ (((ob >> 9) & 1) << 5));
}
DEV void stage_rc(int b, int& R, int& C) {
  int st = b / 1024, sb = b % 1024, swz = sb ^ (((sb >> 9) & 1) << 5);
  R = (st >> 1) * 16 + swz / 64; C = (st & 1) * 32 + (swz % 64) / 2;
}

typedef __attribute__((address_space(3))) unsigned char lds_u8;
DEV void gemm_big(const bf16_t* A, long lda, const bf16_t* Bt, long ldb, int K, long brow, long bcol, f32x4 (&acc)[2][2][4][2]) {
  const int TIDX = opaque_tid();
  lds_u8* lds = (lds_u8*)g_shm;
  constexpr int HTB = HT * 2;
#define SA(b, h) (((b) * 2 + (h)) * HTB)
#define SB(b, h) ((4 + (b) * 2 + (h)) * HTB)
#define STAGE(bufoff, gbase, VO, kt) do { const char* _gp = (gbase) + (size_t)(kt) * (BK * 2); \
    __builtin_amdgcn_global_load_lds((const unsigned*)(_gp + VO##0), (__attribute__((address_space(3))) unsigned*)(lds + (bufoff) + ldsw), 16, 0, 0); \
    __builtin_amdgcn_global_load_lds((const unsigned*)(_gp + VO##1), (__attribute__((address_space(3))) unsigned*)(lds + (bufoff) + ldsw + 8192), 16, 0, 0); } while (0)
#define LDA(dst, b, h) for (int m = 0; m < 4; ++m) for (int k = 0; k < 2; ++k) \
    dst[m][k] = *(const __attribute__((address_space(3))) bf16x8*)(lds + SA(b, h) + aoff + m * 2048 + k * 1024)
#define LDB(dst, b, h) for (int n = 0; n < 2; ++n) for (int k = 0; k < 2; ++k) \
    dst[n][k] = *(const __attribute__((address_space(3))) bf16x8*)(lds + SB(b, h) + boff + n * 2048 + k * 1024)
#define MMA(ai, bj, At, Bt_) do { __builtin_amdgcn_s_setprio(1); \
    for (int m = 0; m < 4; ++m) for (int n = 0; n < 2; ++n) for (int k = 0; k < 2; ++k) \
      acc[ai][bj][m][n] = __builtin_amdgcn_mfma_f32_16x16x32_bf16(At[m][k], Bt_[n][k], acc[ai][bj][m][n], 0, 0, 0); \
    __builtin_amdgcn_s_setprio(0); } while (0)
#define WAIT_V(n) asm volatile("s_waitcnt vmcnt(" #n ")" ::: "memory")
#define WAIT_L(n) asm volatile("s_waitcnt lgkmcnt(" #n ")" ::: "memory")
#define BAR __builtin_amdgcn_s_barrier()
#define SCHED __builtin_amdgcn_sched_barrier(0)
  const int tid = TIDX, wid = __builtin_amdgcn_readfirstlane(tid >> 6), lane = tid & 63, wr = wid >> 2, wc = wid & 3, fr = lane & 15, fq = lane >> 4;
  unsigned va0, va1, vb0, vb1;
  { int r_, c_; stage_rc(tid * 16, r_, c_); va0 = (unsigned)((r_ * lda + c_) * 2); vb0 = (unsigned)((r_ * ldb + c_) * 2);
    stage_rc(tid * 16 + 8192, r_, c_); va1 = (unsigned)((r_ * lda + c_) * 2); vb1 = (unsigned)((r_ * ldb + c_) * 2); }
  const unsigned ldsw = (unsigned)wid * 1024u;
  const int aoff = lds_byte(wr * 64 + fr, fq * 8), boff = lds_byte(wc * 32 + fr, fq * 8);
  const char* cA0 = (const char*)(A + brow * lda); const char* cA1 = cA0 + (size_t)HALF * lda * 2;
  const char* cB0 = (const char*)(Bt + bcol * ldb); const char* cB1 = cB0 + (size_t)HALF * ldb * 2;
#pragma unroll
  for (int a = 0; a < 2; ++a)
#pragma unroll
    for (int b = 0; b < 2; ++b)
#pragma unroll
      for (int m = 0; m < 4; ++m)
#pragma unroll
        for (int n = 0; n < 2; ++n) acc[a][b][m][n] = (f32x4){0.f, 0.f, 0.f, 0.f};
  bf16x8 At[4][2], B0[2][2], B1[2][2];
  const int nt = K / BK;
  STAGE(SB(0, 0), cB0, vb, 0); STAGE(SA(0, 0), cA0, va, 0);
  STAGE(SB(0, 1), cB1, vb, 0); STAGE(SA(0, 1), cA1, va, 0);
  if (wr == 1) BAR;
  WAIT_V(4); BAR;
  STAGE(SB(1, 0), cB0, vb, 1); STAGE(SA(1, 0), cA0, va, 1); STAGE(SB(1, 1), cB1, vb, 1);
  WAIT_V(6); BAR;
  for (int t = 0; t < nt - 2; t += 2) {
    LDB(B0, 0, 0); SCHED; LDA(At, 0, 0); STAGE(SA(1, 1), cA1, va, t + 1);
    WAIT_L(8); BAR; WAIT_L(0); MMA(0, 0, At, B0); BAR; SCHED;
    LDB(B1, 0, 1); STAGE(SB(0, 0), cB0, vb, t + 2);
    BAR; WAIT_L(0); MMA(0, 1, At, B1); BAR;
    LDA(At, 0, 1); STAGE(SA(0, 0), cA0, va, t + 2);
    BAR; WAIT_L(0); MMA(1, 0, At, B0); BAR; SCHED;
    STAGE(SB(0, 1), cB1, vb, t + 2);
    WAIT_V(6); BAR; MMA(1, 1, At, B1); BAR;
    LDB(B0, 1, 0); SCHED; LDA(At, 1, 0); STAGE(SA(0, 1), cA1, va, t + 2);
    WAIT_L(8); BAR; WAIT_L(0); MMA(0, 0, At, B0); BAR; SCHED;
    LDB(B1, 1, 1); STAGE(SB(1, 0), cB0, vb, t + 3);
    BAR; WAIT_L(0); MMA(0, 1, At, B1); BAR;
    LDA(At, 1, 1); STAGE(SA(1, 0), cA0, va, t + 3);
    BAR; WAIT_L(0); MMA(1, 0, At, B0); BAR; SCHED;
    STAGE(SB(1, 1), cB1, vb, t + 3);
    WAIT_V(6); BAR; MMA(1, 1, At, B1); BAR;
  }
  { LDB(B0, 0, 0); LDA(At, 0, 0); STAGE(SA(1, 1), cA1, va, nt - 1);
    BAR; WAIT_L(0); MMA(0, 0, At, B0); BAR;
    LDB(B1, 0, 1); BAR; WAIT_L(0); MMA(0, 1, At, B1); BAR;
    LDA(At, 0, 1); WAIT_V(4); BAR; WAIT_L(0); MMA(1, 0, At, B0); MMA(1, 1, At, B1); BAR; }
  { LDB(B0, 1, 0); LDA(At, 1, 0); WAIT_V(2); BAR; WAIT_L(0); MMA(0, 0, At, B0); BAR;
    LDB(B1, 1, 1); WAIT_V(0); BAR; WAIT_L(0); MMA(0, 1, At, B1); BAR;
    LDA(At, 1, 1); BAR; WAIT_L(0); MMA(1, 0, At, B0); MMA(1, 1, At, B1); BAR; }
  if (wr == 0) BAR;
}
DEV void dump_half(const f32x4 (&acc)[2][2][4][2], int ai, int tid) {
  float* T = (float*)g_shm;
  const int wid = tid >> 6, lane = tid & 63, wr = wid >> 2, wc = wid & 3, fr = lane & 15, fq = lane >> 4;
#pragma unroll
  for (int bj = 0; bj < 2; ++bj)
#pragma unroll
    for (int m = 0; m < 4; ++m)
#pragma unroll
      for (int n = 0; n < 2; ++n)
#pragma unroll
        for (int jj = 0; jj < 4; ++jj) {
          const int r = wr * 64 + m * 16 + fq * 4 + jj, c = bj * 128 + wc * 32 + n * 16 + fr;
          T[r * 256 + (c ^ (fq << 4))] = (ai == 0) ? acc[0][bj][m][n][jj] : acc[1][bj][m][n][jj];
        }
}
DEV float4 tile_ld4(int r, int c4) { return *(const float4*)((const float*)g_shm + r * 256 + (c4 ^ (((r >> 2) & 3) << 4))); }
DEV float tile_ld(int r, int c) { return ((const float*)g_shm)[r * 256 + (c ^ (((r >> 2) & 3) << 4))]; }

DEV int vblock() { return (blockIdx.x & 7) * (gridDim.x >> 3) + (blockIdx.x >> 3); }

DEV void phase_gemm_res(const Params& p, const bf16_t* A, long lda, const bf16_t* Bt, int K, int mtiles, long xrow0) {
  float* X = kx();
  for (int tile = vblock(); tile < mtiles * 4; tile += gridDim.x) {
    const int pm = tile >> 2, pn = tile & 3;
    f32x4 acc[2][2][4][2];
    gemm_big(A, lda, Bt, K, K, (long)pm * 256, (long)pn * 256, acc);
    const int tid = opaque_tid();
#pragma unroll
    for (int ai = 0; ai < 2; ++ai) {
      __syncthreads();
      dump_half(acc, ai, tid);
      __syncthreads();
      for (int e = tid; e < 128 * 64; e += 512) {
        const int r = e >> 6, c4 = (e & 63) * 4;
        const float4 v = tile_ld4(r, c4);
        float4* q = (float4*)(X + (xrow0 + pm * 256 + ai * 128 + r) * 1024 + pn * 256 + c4);
        float4 o = *q; o.x += v.x; o.y += v.y; o.z += v.z; o.w += v.w; *q = o;
      }
    }
    __syncthreads();
  }
}

DEV void phase_sgu_in(const Params& p, int j, int slab) {
  const bf16_t* A = (const bf16_t*)(kws() + OFF_H0) + (size_t)slab * SLAB * 1024;
  const bf16_t* Bt = (const bf16_t*)(kws() + OFF_W + W_SG_IN);
  const float* bin = kin(6) + (size_t)j * 4096;
  bf16_t* Z = (bf16_t*)(kws() + OFF_U);
  float* SSQ = (float*)(kws() + OFF_SSQ);
  for (int tile = vblock(); tile < 64 * 16; tile += gridDim.x) {
    const int pm = tile >> 4, pn = tile & 15;
    f32x4 acc[2][2][4][2];
    gemm_big(A, 1024, Bt, 1024, 1024, (long)pm * 256, (long)pn * 256, acc);
    const int tid = opaque_tid(), wid = tid >> 6, lane = tid & 63;
    const float4 b4 = *(const float4*)(bin + pn * 256 + lane * 4);
#pragma unroll
    for (int ai = 0; ai < 2; ++ai) {
      __syncthreads();
      dump_half(acc, ai, tid);
      __syncthreads();
      for (int rr = 0; rr < 16; ++rr) {
        const int r = wid * 16 + rr;
        const float4 v = tile_ld4(r, lane * 4);
        const float z0 = gelu_exact(v.x + b4.x), z1 = gelu_exact(v.y + b4.y), z2 = gelu_exact(v.z + b4.z), z3 = gelu_exact(v.w + b4.w);
        const int row = pm * 256 + ai * 128 + r;
        uint2 o; o.x = pack2(z0, z1); o.y = pack2(z2, z3);
        *(uint2*)(Z + (size_t)row * 4096 + pn * 256 + lane * 4) = o;
        if (pn >= 8) {
          const float ss = wave_sum(z0 * z0 + z1 * z1 + z2 * z2 + z3 * z3);
          if (lane == 0) SSQ[(size_t)row * 8 + (pn - 8)] = ss;
        }
      }
    }
    __syncthreads();
  }
}

DEV void phase_tm_proj(const Params& p) {
  const bf16_t* A = (const bf16_t*)(kws() + OFF_HX);
  const bf16_t* Bt = (const bf16_t*)(kws() + OFF_W + W_TM_P);
  for (int tile = vblock(); tile < 64 * 14; tile += gridDim.x) {
    const int pm = tile / 14, pn = tile % 14;
    f32x4 acc[2][2][4][2];
    gemm_big(A, 2048, Bt, 2048, 2048, (long)pm * 256, (long)pn * 256, acc);
    const int tid = opaque_tid(), wid = tid >> 6, lane = tid & 63;
    bf16_t* O; int ld, cb;
    if (pn < 12) { O = (bf16_t*)(kws() + (pn < 4 ? OFF_R : (pn < 8 ? OFF_K : OFF_V))); ld = 1024; cb = (pn & 3) * 256; }
    else { O = (bf16_t*)(kws() + OFF_HL); ld = 512; cb = (pn - 12) * 256; }
    const int act = pn < 12 ? 0 : (pn == 12 ? (lane < 32 ? 1 : 0) : 2);
#pragma unroll
    for (int ai = 0; ai < 2; ++ai) {
      __syncthreads();
      dump_half(acc, ai, tid);
      __syncthreads();
      for (int rr = 0; rr < 16; ++rr) {
        const int r = wid * 16 + rr;
        float4 v = tile_ld4(r, lane * 4);
        if (act == 1) { v.x = tanhf(v.x); v.y = tanhf(v.y); v.z = tanhf(v.z); v.w = tanhf(v.w); }
        else if (act == 2) { v.x = sigmoidf_(v.x); v.y = sigmoidf_(v.y); v.z = sigmoidf_(v.z); v.w = sigmoidf_(v.w); }
        uint2 o; o.x = pack2(v.x, v.y); o.y = pack2(v.z, v.w);
        *(uint2*)(O + (size_t)(pm * 256 + ai * 128 + r) * ld + cb + lane * 4) = o;
      }
    }
    __syncthreads();
  }
}

DEV void phase_ffn_a(const Params& p, int layer) {
  const bf16_t* A = (const bf16_t*)(kws() + OFF_H0);
  const bf16_t* Bt = (const bf16_t*)(kws() + OFF_W + W_FF_A);
  bf16_t* HM = (bf16_t*)(kws() + OFF_HMID);
  const float* cw = kin(31) + (size_t)layer * 3 * 2816;
  const float* cb = kin(32) + (size_t)layer * 2816;
  float* UP = (float*)g_shm;
  bf16_t* gl = (bf16_t*)(g_shm + 65536);
  for (int tile = vblock(); tile < 202 * 22; tile += gridDim.x) {
    const int mi = tile / 22, pn = tile % 22;
    int base, L, i;
    if (mi < 130) { base = (mi / 65) * 16384; L = 16384; i = mi % 65; }
    else { const int m2 = mi - 130; base = 32768 + (m2 / 9) * 2048; L = 2048; i = m2 % 9; }
    const int s0 = 254 * i - 1;
    f32x4 acc[2][2][4][2];
    gemm_big(A, 1024, Bt, 1024, 1024, (long)base + s0, (long)pn * 256, acc);
    const int tid = opaque_tid(), wid = tid >> 6, lane = tid & 63, wr = wid >> 2, wc = wid & 3, fr = lane & 15, fq = lane >> 4;
    __syncthreads();
#pragma unroll
    for (int ai = 0; ai < 2; ++ai)
#pragma unroll
      for (int m = 0; m < 4; ++m)
#pragma unroll
        for (int n = 0; n < 2; ++n)
#pragma unroll
          for (int jj = 0; jj < 4; ++jj) {
            const int r = ai * 128 + wr * 64 + m * 16 + fq * 4 + jj, c = wc * 32 + n * 16 + fr;
            const int s = s0 + r;
            gl[r * 128 + c] = (s >= 0 && s < L) ? f2bf(acc[ai][0][m][n][jj]) : (bf16_t)0;
          }
    const int c4 = (lane & 31) * 4, f = pn * 128 + c4;
    const float4 w0 = *(const float4*)(cw + f), w1 = *(const float4*)(cw + 2816 + f), w2 = *(const float4*)(cw + 2 * 2816 + f), bb = *(const float4*)(cb + f);
#pragma unroll
    for (int ai = 0; ai < 2; ++ai) {
      __syncthreads();
#pragma unroll
      for (int m = 0; m < 4; ++m)
#pragma unroll
        for (int n = 0; n < 2; ++n)
#pragma unroll
          for (int jj = 0; jj < 4; ++jj) {
            const int r = wr * 64 + m * 16 + fq * 4 + jj, c = wc * 32 + n * 16 + fr;
            UP[r * 128 + (c ^ (fq << 4))] = (ai == 0) ? acc[0][1][m][n][jj] : acc[1][1][m][n][jj];
          }
      __syncthreads();
      for (int e = tid; e < 128 * 32; e += 512) {
        const int rl = e >> 5, r = ai * 128 + rl, s = s0 + r;
        if (r >= 1 && r <= 254 && s < L) {
          const float4 u = *(const float4*)(UP + rl * 128 + (c4 ^ (((rl >> 2) & 3) << 4)));
          const uint2 g0 = *(const uint2*)(gl + (r - 1) * 128 + c4), g1 = *(const uint2*)(gl + r * 128 + c4), g2 = *(const uint2*)(gl + (r + 1) * 128 + c4);
          const float c0 = w0.x * __uint_as_float(g0.x << 16) + w1.x * __uint_as_float(g1.x << 16) + w2.x * __uint_as_float(g2.x << 16) + bb.x;
          const float c1 = w0.y * __uint_as_float(g0.x & 0xffff0000u) + w1.y * __uint_as_float(g1.x & 0xffff0000u) + w2.y * __uint_as_float(g2.x & 0xffff0000u) + bb.y;
          const float c2 = w0.z * __uint_as_float(g0.y << 16) + w1.z * __uint_as_float(g1.y << 16) + w2.z * __uint_as_float(g2.y << 16) + bb.z;
          const float c3 = w0.w * __uint_as_float(g0.y & 0xffff0000u) + w1.w * __uint_as_float(g1.y & 0xffff0000u) + w2.w * __uint_as_float(g2.y & 0xffff0000u) + bb.w;
          uint2 o; o.x = pack2(gelu_exact(c0) * u.x, gelu_exact(c1) * u.y); o.y = pack2(gelu_exact(c2) * u.z, gelu_exact(c3) * u.w);
          *(uint2*)(HM + (size_t)(base + s) * 2816 + f) = o;
        }
      }
    }
    __syncthreads();
  }
}

template <int KP>
DEV void small_mma(f32x4 (&acc)[4][4]) {
  const int TIDX = opaque_tid();
  constexpr int LD = KP + 8;
  const bf16_t* sA = (const bf16_t*)g_shm;
  const bf16_t* sB = sA + 128 * LD;
  const int wid = TIDX >> 6, lane = TIDX & 63, wr = wid >> 2, wc = wid & 3, fr = lane & 15, fq = lane >> 4;
#pragma unroll
  for (int m = 0; m < 4; ++m)
#pragma unroll
    for (int n = 0; n < 4; ++n) acc[m][n] = (f32x4){0.f, 0.f, 0.f, 0.f};
#pragma unroll
  for (int kk = 0; kk < KP / 32; ++kk) {
    bf16x8 a[4], b[4];
#pragma unroll
    for (int m = 0; m < 4; ++m) a[m] = *(const bf16x8*)(sA + (wr * 64 + m * 16 + fr) * LD + kk * 32 + fq * 8);
#pragma unroll
    for (int n = 0; n < 4; ++n) b[n] = *(const bf16x8*)(sB + (wc * 64 + n * 16 + fr) * LD + kk * 32 + fq * 8);
#pragma unroll
    for (int m = 0; m < 4; ++m)
#pragma unroll
      for (int n = 0; n < 4; ++n) acc[m][n] = __builtin_amdgcn_mfma_f32_16x16x32_bf16(a[m], b[n], acc[m][n], 0, 0, 0);
  }
}
template <int KP>
DEV void small_load(bf16_t* s, const bf16_t* g, long ld, int rows) {
  const int TIDX = opaque_tid();
  constexpr int LD = KP + 8, CPR = KP / 8;
  for (int c = TIDX; c < rows * CPR; c += 512) {
    const int r = c / CPR, k8 = (c % CPR) * 8;
    *(uint4*)(s + r * LD + k8) = *(const uint4*)(g + (long)r * ld + k8);
  }
}

DEV void phase_sgu_mix(const Params& p, int j) {
  const int TIDX = opaque_tid();
  constexpr int KP = 128, LD = KP + 8;
  const int wid = TIDX >> 6, lane = TIDX & 63, wr = wid >> 2, wc = wid & 3, fr = lane & 15, fq = lane >> 4;
  bf16_t* sA = (bf16_t*)g_shm;
  bf16_t* sB = sA + 128 * LD;
  float* rsv = (float*)(g_shm + (128 + 256) * LD * 2);
  bf16_t* Z = (bf16_t*)(kws() + OFF_U);
  const float* SSQ = (const float*)(kws() + OFF_SSQ);
  const float* ws_ = kin(8) + (size_t)j * 8 * 128 * 128;
  const float* bs = kin(9) + (size_t)j * 8 * 128;
  const float* ng = kin(7) + (size_t)j * 2048;
  for (int unit = blockIdx.x; unit < 128 * 8; unit += gridDim.x) {
    const int chunk = unit >> 3, g = unit & 7;
    __syncthreads();
    if (TIDX < 128) {
      const float* sp = SSQ + (size_t)(chunk * 128 + TIDX) * 8;
      float s = 0.f;
      for (int i = 0; i < 8; ++i) s += sp[i];
      rsv[TIDX] = rsqrtf(s * (1.0f / 2048.f) + 1e-6f);
    }
    for (int e = TIDX; e < 128 * 32; e += 512) {
      const int pp = e >> 5, c8 = (e & 31) * 8;
      const uint4 v = *(const uint4*)(Z + (size_t)(chunk * 128 + pp) * 4096 + 2048 + g * 256 + c8);
      sB[(c8 + 0) * LD + pp] = (bf16_t)(v.x & 0xffff); sB[(c8 + 1) * LD + pp] = (bf16_t)(v.x >> 16);
      sB[(c8 + 2) * LD + pp] = (bf16_t)(v.y & 0xffff); sB[(c8 + 3) * LD + pp] = (bf16_t)(v.y >> 16);
      sB[(c8 + 4) * LD + pp] = (bf16_t)(v.z & 0xffff); sB[(c8 + 5) * LD + pp] = (bf16_t)(v.z >> 16);
      sB[(c8 + 6) * LD + pp] = (bf16_t)(v.w & 0xffff); sB[(c8 + 7) * LD + pp] = (bf16_t)(v.w >> 16);
    }
    __syncthreads();
    for (int c = TIDX; c < 128 * 16; c += 512) {
      const int q = c >> 4, p8 = (c & 15) * 8;
      const float4* wp = (const float4*)(ws_ + ((size_t)g * 128 + q) * 128 + p8);
      const float4 w0 = wp[0], w1 = wp[1];
      uint4 o;
      o.x = pack2(w0.x * rsv[p8 + 0], w0.y * rsv[p8 + 1]); o.y = pack2(w0.z * rsv[p8 + 2], w0.w * rsv[p8 + 3]);
      o.z = pack2(w1.x * rsv[p8 + 4], w1.y * rsv[p8 + 5]); o.w = pack2(w1.z * rsv[p8 + 6], w1.w * rsv[p8 + 7]);
      *(uint4*)(sA + q * LD + p8) = o;
    }
    __syncthreads();
    f32x4 acc[4][4];
    small_mma<KP>(acc);
#pragma unroll
    for (int m = 0; m < 4; ++m)
#pragma unroll
      for (int n = 0; n < 4; ++n) {
        const int c = g * 256 + wc * 64 + n * 16 + fr;
        const float gg = ng[c];
#pragma unroll
        for (int jj = 0; jj < 4; ++jj) {
          const int q = wr * 64 + m * 16 + fq * 4 + jj;
          const float mix = acc[m][n][jj] * gg + bs[g * 128 + q];
          bf16_t* up = Z + (size_t)(chunk * 128 + q) * 4096 + c;
          *up = f2bf(bf2f(*up) * mix);
        }
      }
  }
  __syncthreads();
}

template <int KP>
DEV void lora_out_unit(const Params& p, int j, int kind, int mt, int ntile) {
  const int TIDX = opaque_tid();
  constexpr int LD = KP + 8;
  const int wid = TIDX >> 6, lane = TIDX & 63, wr = wid >> 2, wc = wid & 3, fr = lane & 15, fq = lane >> 4;
  bf16_t* sA = (bf16_t*)g_shm;
  bf16_t* sB = sA + 128 * LD;
  const bf16_t* HL = (const bf16_t*)(kws() + OFF_HL);
  const int koff = kind < 4 ? kind * 64 : 256;
  const bf16_t* Bt = (const bf16_t*)(kws() + OFF_W + (kind < 2 ? W_TM_W2 + (size_t)kind * 1024 * 64 * 2 : (kind < 4 ? W_TM_A2 + (size_t)(kind - 2) * 1024 * 64 * 2 : W_TM_G2)));
  bf16_t* O = (bf16_t*)(kws() + (kind == 0 ? OFF_E0 : kind == 1 ? OFF_E1 : kind == 2 ? OFF_A0 : kind == 3 ? OFF_A1 : OFF_G));
  const float* bias = kind < 2 ? kin(15) + ((size_t)j * 2 + kind) * 1024 : (kind < 4 ? kin(18) + ((size_t)j * 2 + kind - 2) * 1024 : nullptr);
  __syncthreads();
  small_load<KP>(sA, HL + (size_t)mt * 128 * 512 + koff, 512, 128);
  small_load<KP>(sB, Bt + (size_t)ntile * 256 * KP, KP, 256);
  __syncthreads();
  f32x4 acc[4][4];
  small_mma<KP>(acc);
#pragma unroll
  for (int m = 0; m < 4; ++m)
#pragma unroll
    for (int n = 0; n < 4; ++n) {
      const int col = ntile * 256 + wc * 64 + n * 16 + fr;
      const float b = bias ? bias[col] : 0.f;
#pragma unroll
      for (int jj = 0; jj < 4; ++jj) {
        const int row = mt * 128 + wr * 64 + m * 16 + fq * 4 + jj;
        float v = acc[m][n][jj] + b;
        if (kind < 2) v = 0.6065306597126334f * sigmoidf_(v); else if (kind < 4) v = sigmoidf_(v);
        O[(size_t)row * 1024 + col] = f2bf(v);
      }
    }
}
DEV void phase_tm_lora_out(const Params& p, int j) {
  for (int unit = blockIdx.x; unit < 5 * 512; unit += gridDim.x) {
    const int kind = unit / 512, r = unit % 512, mt = r >> 2, ntile = r & 3;
    if (kind < 4) lora_out_unit<64>(p, j, kind, mt, ntile); else lora_out_unit<160>(p, j, kind, mt, ntile);
  }
  __syncthreads();
}

template <int C> DEV void fmac_bc(float& acc, float op, float s) {
  asm volatile("v_fmac_f32_dpp %0, %1, %2 row_newbcast:%3 row_mask:0xf bank_mask:0xf" : "+v"(acc) : "v"(op), "v"(s), "n"(C));
}
template <int C> DEV float mul_bc(float op, float s) {
  float r;
  asm volatile("v_mul_f32_dpp %0, %1, %2 row_newbcast:%3 row_mask:0xf bank_mask:0xf" : "=v"(r) : "v"(op), "v"(s), "n"(C));
  return r;
}
#define LAUNDER4(a) asm volatile("s_nop 1" : "+v"(a[0]), "+v"(a[1]), "+v"(a[2]), "+v"(a[3]))
#define REP4(M, J) M(J) M(J + 1) M(J + 2) M(J + 3)
#define REP16(M, J) REP4(M, J) REP4(M, J + 4) REP4(M, J + 8) REP4(M, J + 12)
#define REP64(M) REP16(M, 0) REP16(M, 16) REP16(M, 32) REP16(M, 48)

DEV float row_sum16(float v) { v += __shfl_xor(v, 1); v += __shfl_xor(v, 2); v += __shfl_xor(v, 4); v += __shfl_xor(v, 8); return v; }

struct ScanRaw { uint2 r, k, a, e; bf16_t v; };

DEV void phase_scan(const Params& p, int j, int slab) {
  const int TIDX = opaque_tid();
  const int wid = TIDX >> 6, lane = TIDX & 63, c16 = lane & 15;
  const bf16_t* Rb = (const bf16_t*)(kws() + OFF_R);
  const bf16_t* Kb = (const bf16_t*)(kws() + OFF_K);
  const bf16_t* Vb = (const bf16_t*)(kws() + OFF_V);
  for (int item = blockIdx.x * 8 + wid; item < 2048; item += gridDim.x * 8) {
    const int kind = item & 1, dir = (item >> 1) & 1, hd = (item >> 2) & 15, seg = item >> 6;
    const bf16_t* Ab = (const bf16_t*)(kws() + (dir ? OFF_A1 : OFF_A0));
    const bf16_t* Eb = (const bf16_t*)(kws() + (dir ? OFF_E1 : OFF_E0));
    bf16_t* Yo = (bf16_t*)(kws() + (kind ? (dir ? OFF_QB : OFF_QF) : (dir ? OFF_YLB : OFF_YLF)));
    float* Fo = (float*)(kws() + (kind ? OFF_PB : OFF_LB)) + (size_t)((seg * 16 + hd) * 2 + dir) * 4096;
    float kkw[4], kaw[4];
#pragma unroll
    for (int m = 0; m < 4; ++m) { kkw[m] = kin(23)[(size_t)j * 1024 + hd * 64 + 4 * c16 + m]; kaw[m] = kin(24)[(size_t)j * 1024 + hd * 64 + 4 * c16 + m]; }
    float S[64];
#pragma unroll
    for (int q = 0; q < 64; ++q) S[q] = (kind && q == lane) ? 1.f : 0.f;
    const int t0 = seg * 512, tstep = dir ? -1 : 1, tfirst = dir ? t0 + 511 : t0;
    const size_t hoff = (size_t)hd * 64;
    auto load_raw = [&](int step, ScanRaw& w) {
      const int st = step < 512 ? step : 511;
      const size_t o = (size_t)(tfirst + tstep * st) * 1024 + hoff;
      w.r = *(const uint2*)(Rb + o + 4 * c16); w.k = *(const uint2*)(Kb + o + 4 * c16);
      w.a = *(const uint2*)(Ab + o + 4 * c16); w.e = *(const uint2*)(Eb + o + 4 * c16);
      w.v = Vb[o + lane];
    };
    float nkk[4], bb[4], kd[4], ww[4], rr[4], vv;
    auto prep = [&](const ScanRaw& w) {
      float kf[4], af[4], ef[4], kr[4];
      kf[0] = __uint_as_float(w.k.x << 16); kf[1] = __uint_as_float(w.k.x & 0xffff0000u); kf[2] = __uint_as_float(w.k.y << 16); kf[3] = __uint_as_float(w.k.y & 0xffff0000u);
      af[0] = __uint_as_float(w.a.x << 16); af[1] = __uint_as_float(w.a.x & 0xffff0000u); af[2] = __uint_as_float(w.a.y << 16); af[3] = __uint_as_float(w.a.y & 0xffff0000u);
      ef[0] = __uint_as_float(w.e.x << 16); ef[1] = __uint_as_float(w.e.x & 0xffff0000u); ef[2] = __uint_as_float(w.e.y << 16); ef[3] = __uint_as_float(w.e.y & 0xffff0000u);
      rr[0] = __uint_as_float(w.r.x << 16); rr[1] = __uint_as_float(w.r.x & 0xffff0000u); rr[2] = __uint_as_float(w.r.y << 16); rr[3] = __uint_as_float(w.r.y & 0xffff0000u);
      float ss = 0.f;
#pragma unroll
      for (int m = 0; m < 4; ++m) { kr[m] = kf[m] * kkw[m]; ss += kr[m] * kr[m]; }
      ss = row_sum16(ss);
      const float inv = 1.0f / fmaxf(sqrtf(ss), 1e-12f);
#pragma unroll
      for (int m = 0; m < 4; ++m) {
        const float kk = kr[m] * inv;
        nkk[m] = -kk; bb[m] = kk * af[m]; kd[m] = kf[m] * (1.0f + (af[m] - 1.0f) * kaw[m]);
        ww[m] = __builtin_amdgcn_exp2f(-1.4426950408889634f * ef[m]);
      }
      vv = bf2f(w.v);
    };
    ScanRaw w0, w1;
    load_raw(0, w0); load_raw(1, w1);
    prep(w0);
    for (int step = 0; step < 512; ++step) {
      ScanRaw w2; load_raw(step + 2, w2);
      LAUNDER4(nkk); LAUNDER4(bb); LAUNDER4(kd); LAUNDER4(ww); LAUNDER4(rr);
      float sa0 = 0.f, sa1 = 0.f;
#define SA_EL(J) fmac_bc<((J) >> 2)>(((J) & 1) ? sa1 : sa0, nkk[(J) & 3], S[J]);
      REP64(SA_EL)
      const float sa = sa0 + sa1;
      float y0 = 0.f, y1 = 0.f;
      if (kind == 0) {
#define UP_EL(J) { float t_ = mul_bc<((J) >> 2)>(kd[(J) & 3], vv); fmac_bc<((J) >> 2)>(t_, bb[(J) & 3], sa); fmac_bc<((J) >> 2)>(t_, ww[(J) & 3], S[J]); S[J] = t_; fmac_bc<((J) >> 2)>(((J) & 1) ? y1 : y0, rr[(J) & 3], t_); }
        REP64(UP_EL)
      } else {
#define UP_ID(J) { float t_ = mul_bc<((J) >> 2)>(bb[(J) & 3], sa); fmac_bc<((J) >> 2)>(t_, ww[(J) & 3], S[J]); S[J] = t_; fmac_bc<((J) >> 2)>(((J) & 1) ? y1 : y0, rr[(J) & 3], t_); }
        REP64(UP_ID)
      }
      Yo[(size_t)(tfirst + tstep * step) * 1024 + hoff + lane] = f2bf(y0 + y1);
      prep(w1);
      w1 = w2;
    }
#pragma unroll
    for (int q = 0; q < 16; ++q) {
      float4 o; o.x = S[4 * q]; o.y = S[4 * q + 1]; o.z = S[4 * q + 2]; o.w = S[4 * q + 3];
      *(float4*)(Fo + (size_t)lane * 64 + 4 * q) = o;
    }
  }
}

DEV void phase_combine(const Params& p, int slab) {
  const int TIDX = opaque_tid();
  float* ST = (float*)g_shm;
  float* PL = ST + 4096;
  const float* Lb = (const float*)(kws() + OFF_LB);
  const float* Pb = (const float*)(kws() + OFF_PB);
  float* SI = (float*)(kws() + OFF_SI);
  const int nseq = slab < 2 ? 1 : 8, sps = 32 / nseq;
  const int i = TIDX & 63, cgp = TIDX >> 6;
  for (int chain = blockIdx.x; chain < nseq * 32; chain += gridDim.x) {
    const int dir = chain & 1, hd = (chain >> 1) & 15, sq = chain >> 5;
    __syncthreads();
    for (int e = TIDX; e < 4096; e += 512) ST[e] = 0.f;
    float4 pr0, pr1, lr0, lr1;
    {
      const int sg = sq * sps + (dir ? sps - 1 : 0);
      const size_t cb = (size_t)((sg * 16 + hd) * 2 + dir) * 4096;
      pr0 = *(const float4*)(Pb + cb + TIDX * 8); pr1 = *(const float4*)(Pb + cb + TIDX * 8 + 4);
      lr0 = *(const float4*)(Lb + cb + (size_t)i * 64 + cgp * 8); lr1 = *(const float4*)(Lb + cb + (size_t)i * 64 + cgp * 8 + 4);
    }
    __syncthreads();
    for (int s = 0; s < sps; ++s) {
      const int sg = sq * sps + (dir ? sps - 1 - s : s);
      const size_t cb = (size_t)((sg * 16 + hd) * 2 + dir) * 4096;
      {
        float4 o0, o1;
        o0.x = ST[(cgp * 8 + 0) * 64 + i]; o0.y = ST[(cgp * 8 + 1) * 64 + i]; o0.z = ST[(cgp * 8 + 2) * 64 + i]; o0.w = ST[(cgp * 8 + 3) * 64 + i];
        o1.x = ST[(cgp * 8 + 4) * 64 + i]; o1.y = ST[(cgp * 8 + 5) * 64 + i]; o1.z = ST[(cgp * 8 + 6) * 64 + i]; o1.w = ST[(cgp * 8 + 7) * 64 + i];
        *(float4*)(SI + cb + (size_t)i * 64 + cgp * 8) = o0; *(float4*)(SI + cb + (size_t)i * 64 + cgp * 8 + 4) = o1;
      }
      *(float4*)(PL + TIDX * 8) = pr0; *(float4*)(PL + TIDX * 8 + 4) = pr1;
      float acc[8] = {lr0.x, lr0.y, lr0.z, lr0.w, lr1.x, lr1.y, lr1.z, lr1.w};
      __syncthreads();
      if (s + 1 < sps) {
        const int sg2 = sq * sps + (dir ? sps - 2 - s : s + 1);
        const size_t cb2 = (size_t)((sg2 * 16 + hd) * 2 + dir) * 4096;
        pr0 = *(const float4*)(Pb + cb2 + TIDX * 8); pr1 = *(const float4*)(Pb + cb2 + TIDX * 8 + 4);
        lr0 = *(const float4*)(Lb + cb2 + (size_t)i * 64 + cgp * 8); lr1 = *(const float4*)(Lb + cb2 + (size_t)i * 64 + cgp * 8 + 4);
      }
#pragma unroll 8
      for (int r = 0; r < 64; ++r) {
        const float sv = ST[r * 64 + i];
        const float4 p0 = *(const float4*)(PL + r * 64 + cgp * 8), p1 = *(const float4*)(PL + r * 64 + cgp * 8 + 4);
        acc[0] += sv * p0.x; acc[1] += sv * p0.y; acc[2] += sv * p0.z; acc[3] += sv * p0.w;
        acc[4] += sv * p1.x; acc[5] += sv * p1.y; acc[6] += sv * p1.z; acc[7] += sv * p1.w;
      }
      __syncthreads();
#pragma unroll
      for (int c = 0; c < 8; ++c) ST[(cgp * 8 + c) * 64 + i] = acc[c];
      __syncthreads();
    }
  }
  __syncthreads();
}

DEV void phase_tm_post(const Params& p, int j) {
  const int TIDX = opaque_tid();
  const int wid = TIDX >> 6, lane = TIDX & 63, c16 = lane & 15;
  bf16_t* Rb = (bf16_t*)(kws() + OFF_R);
  const bf16_t* Kb = (const bf16_t*)(kws() + OFF_K);
  const bf16_t* Vb = (const bf16_t*)(kws() + OFF_V);
  const bf16_t* A0 = (const bf16_t*)(kws() + OFF_A0);
  const bf16_t* A1 = (const bf16_t*)(kws() + OFF_A1);
  const bf16_t* Gb = (const bf16_t*)(kws() + OFF_G);
  const bf16_t* YF = (const bf16_t*)(kws() + OFF_YLF);
  const bf16_t* YB = (const bf16_t*)(kws() + OFF_YLB);
  const bf16_t* QF = (const bf16_t*)(kws() + OFF_QF);
  const bf16_t* QB = (const bf16_t*)(kws() + OFF_QB);
  const float* SI = (const float*)(kws() + OFF_SI);
  for (int item = blockIdx.x * 8 + wid; item < 2048; item += gridDim.x * 8) {
    const int quarter = item & 3, hd = (item >> 2) & 15, seg = item >> 6;
    const int cch = hd * 64 + lane;
    const float rk = kin(25)[(size_t)j * 1024 + cch], ka = kin(24)[(size_t)j * 1024 + cch];
    const float lg = kin(26)[(size_t)j * 1024 + cch], lb = kin(27)[(size_t)j * 1024 + cch];
    float SF[64], SBk[64];
    {
      const float* sf = SI + (size_t)((seg * 16 + hd) * 2 + 0) * 4096 + (size_t)lane * 64;
      const float* sb = SI + (size_t)((seg * 16 + hd) * 2 + 1) * 4096 + (size_t)lane * 64;
#pragma unroll
      for (int q = 0; q < 16; ++q) {
        const float4 a = *(const float4*)(sf + 4 * q), b = *(const float4*)(sb + 4 * q);
        SF[4 * q] = a.x; SF[4 * q + 1] = a.y; SF[4 * q + 2] = a.z; SF[4 * q + 3] = a.w;
        SBk[4 * q] = b.x; SBk[4 * q + 1] = b.y; SBk[4 * q + 2] = b.z; SBk[4 * q + 3] = b.w;
      }
    }
    for (int tt = 0; tt < 128; ++tt) {
      const size_t o = (size_t)(seg * 512 + quarter * 128 + tt) * 1024 + hd * 64;
      const uint2 qfr = *(const uint2*)(QF + o + 4 * c16), qbr = *(const uint2*)(QB + o + 4 * c16);
      float qf[4], qb[4];
      qf[0] = __uint_as_float(qfr.x << 16); qf[1] = __uint_as_float(qfr.x & 0xffff0000u); qf[2] = __uint_as_float(qfr.y << 16); qf[3] = __uint_as_float(qfr.y & 0xffff0000u);
      qb[0] = __uint_as_float(qbr.x << 16); qb[1] = __uint_as_float(qbr.x & 0xffff0000u); qb[2] = __uint_as_float(qbr.y << 16); qb[3] = __uint_as_float(qbr.y & 0xffff0000u);
      float y0 = bf2f(YF[o + lane]), y1 = bf2f(YB[o + lane]);
      const float rj = bf2f(Rb[o + lane]), kj = bf2f(Kb[o + lane]), vj = bf2f(Vb[o + lane]), gj = bf2f(Gb[o + lane]);
      const float a0 = bf2f(A0[o + lane]), a1 = bf2f(A1[o + lane]);
      LAUNDER4(qf); LAUNDER4(qb);
#define PF_EL(J) fmac_bc<((J) >> 2)>(y0, qf[(J) & 3], SF[J]); fmac_bc<((J) >> 2)>(y1, qb[(J) & 3], SBk[J]);
      REP64(PF_EL)
      const float y = y0 + y1;
      const float mean = wave_sum(y) * (1.0f / 64.f);
      const float dy = y - mean;
      const float var = wave_sum(dy * dy) * (1.0f / 64.f);
      const float yn = dy * rsqrtf(var + 64e-5f) * lg + lb;
      const float bon = wave_sum(rj * rk * kj * ((1.0f + (a0 - 1.0f) * ka) + (1.0f + (a1 - 1.0f) * ka)));
      Rb[o + lane] = f2bf((yn + bon * vj) * gj);
    }
  }
}

DEV void wprep_sgu(const Params& p, int j) {
  wprep_T2((bf16_t*)(kws() + OFF_W + W_SG_IN), 1024, 0, kin(5) + (size_t)j * 1024 * 4096, 1024, 4096, nullptr, 128, 0);
  wprep_T2((bf16_t*)(kws() + OFF_W + W_SG_OUT), 2048, 0, kin(10) + (size_t)j * 2048 * 1024, 2048, 1024, nullptr, 128, 0);
}
DEV void wprep_ffn(const Params& p, int layer) {
  wprep_T2((bf16_t*)(kws() + OFF_W + W_FF_A), 1024, 0, kin(29) + (size_t)layer * 1024 * 2816, 1024, 2816, nullptr, 256, 0);
  wprep_T2((bf16_t*)(kws() + OFF_W + W_FF_A), 1024, 0, kin(30) + (size_t)layer * 1024 * 2816, 1024, 2816, nullptr, 256, 128);
  wprep_T2((bf16_t*)(kws() + OFF_W + W_FF_D), 2816, 0, kin(33) + (size_t)layer * 2816 * 1024, 2816, 1024, nullptr, 128, 0);
}
DEV void wprep_tm(const Params& p, int j) {
  const int TIDX = opaque_tid();
  bf16_t* WP = (bf16_t*)(kws() + OFF_W + W_TM_P);
  const float* mu = kin(11) + (size_t)j * 6 * 1024;
  const float* srcs[3] = {kin(12) + (size_t)j * 1048576, kin(13) + (size_t)j * 1048576, kin(14) + (size_t)j * 1048576};
  const int mus[3] = {0, 2, 3};
#pragma unroll
  for (int i = 0; i < 3; ++i) {
    wprep_T2(WP, 2048, 0, srcs[i], 1024, 1024, nullptr, 128, i * 1024);
    wprep_T2(WP, 2048, 1024, srcs[i], 1024, 1024, mu + mus[i] * 1024, 128, i * 1024);
  }
#pragma unroll
  for (int e = 0; e < 2; ++e) {
    const float* w1 = kin(16) + ((size_t)j * 2 + e) * 1024 * 64;
    wprep_T(WP, 2048, 0, w1, 1024, 64, nullptr, 128, 3072 + 64 * e);
    wprep_T(WP, 2048, 1024, w1, 1024, 64, mu + 1 * 1024, 128, 3072 + 64 * e);
    const float* a1 = kin(19) + ((size_t)j * 2 + e) * 1024 * 64;
    wprep_T(WP, 2048, 0, a1, 1024, 64, nullptr, 128, 3200 + 64 * e);
    wprep_T(WP, 2048, 1024, a1, 1024, 64, mu + 4 * 1024, 128, 3200 + 64 * e);
    wprep_T2((bf16_t*)(kws() + OFF_W + W_TM_W2) + (size_t)e * 1024 * 64, 64, 0, kin(17) + ((size_t)j * 2 + e) * 64 * 1024, 64, 1024, nullptr, 128, 0);
    wprep_T2((bf16_t*)(kws() + OFF_W + W_TM_A2) + (size_t)e * 1024 * 64, 64, 0, kin(20) + ((size_t)j * 2 + e) * 64 * 1024, 64, 1024, nullptr, 128, 0);
  }
  const float* g1 = kin(21) + (size_t)j * 1024 * 160;
  wprep_T(WP, 2048, 0, g1, 1024, 160, nullptr, 128, 3328);
  wprep_T(WP, 2048, 1024, g1, 1024, 160, mu + 5 * 1024, 128, 3328);
  for (size_t i = (size_t)blockIdx.x * 512 + TIDX; i < (size_t)96 * 2048 / 2; i += (size_t)gridDim.x * 512) ((unsigned*)(WP + (size_t)3488 * 2048))[i] = 0u;
  wprep_T((bf16_t*)(kws() + OFF_W + W_TM_G2), 160, 0, kin(22) + (size_t)j * 160 * 1024, 160, 1024, nullptr, 128, 0);
  wprep_T2((bf16_t*)(kws() + OFF_W + W_TM_O), 1024, 0, kin(28) + (size_t)j * 1048576, 1024, 1024, nullptr, 128, 0);
}

constexpr int PH_SGU = 10, PH_FFN = 3, PH_TM = 21;
constexpr int N_PHASES = 1 + 2 * (PH_SGU + PH_FFN) + 2 * (PH_TM + PH_FFN) + 1;

DEV void run_phase(const Params& p, int ph) {
  if (ph == 0) { phase_init(p); return; }
  if (ph == N_PHASES - 1) { phase_final(p); return; }
  int q = ph - 1, layer = 0;
  for (;;) {
    const int len = (layer & 1) ? PH_TM + PH_FFN : PH_SGU + PH_FFN;
    if (q < len) break;
    q -= len; ++layer;
  }
  const int j = layer >> 1;
  bf16_t* H0 = (bf16_t*)(kws() + OFF_H0);
  const int nmix = (layer & 1) ? PH_TM : PH_SGU;
  if (q >= nmix) {
    const int f = q - nmix;
    if (f == 0) { phase_norm(p, kin(3) + (size_t)layer * 1024, H0); wprep_ffn(p, layer); }
    else if (f == 1) phase_ffn_a(p, layer);
    else phase_gemm_res(p, (const bf16_t*)(kws() + OFF_HMID), 2816, (const bf16_t*)(kws() + OFF_W + W_FF_D), 2816, 192, 0);
    return;
  }
  if (!(layer & 1)) {
    if (q == 0) { phase_norm(p, kin(2) + (size_t)layer * 1024, H0); wprep_sgu(p, j); return; }
    const int slab = (q - 1) / 3, s = (q - 1) % 3;
    if (s == 0) phase_sgu_in(p, j, slab);
    else if (s == 1) phase_sgu_mix(p, j);
    else phase_gemm_res(p, (const bf16_t*)(kws() + OFF_U), 4096, (const bf16_t*)(kws() + OFF_W + W_SG_OUT), 2048, 64, (long)slab * SLAB);
    return;
  }
  {
    const int slab = q / 7, s = q % 7;
    switch (s) {
      case 0: phase_norm_tm(p, kin(2) + (size_t)layer * 1024, (bf16_t*)(kws() + OFF_HX), slab); if (slab == 0) wprep_tm(p, j); break;
      case 1: phase_tm_proj(p); break;
      case 2: phase_tm_lora_out(p, j); break;
      case 3: phase_scan(p, j, slab); break;
      case 4: phase_combine(p, slab); break;
      case 5: phase_tm_post(p, j); break;
      default: phase_gemm_res(p, (const bf16_t*)(kws() + OFF_R), 1024, (const bf16_t*)(kws() + OFF_W + W_TM_O), 1024, 64, (long)slab * SLAB); break;
    }
  }
}

__global__ void __launch_bounds__(512, 2) mega(Params p, int ph_lo, int ph_hi, int coop) {
  for (int ph = ph_lo; ph < ph_hi; ++ph) {
    run_phase(p, ph);
    if (coop && ph + 1 < ph_hi) cg::this_grid().sync();
  }
}

extern "C" void kernel_launch(void* const* d_in, const int* in_sizes, int n_in, void* d_out, int out_size, void* d_ws, size_t ws_size, hipStream_t stream) {
  static int grid = 0;
  if (!grid) {
    int dev = 0, cus = 0, per_cu = 0;
    (void)hipFuncSetAttribute((const void*)mega, hipFuncAttributeMaxDynamicSharedMemorySize, SHM_BYTES);
    (void)hipGetDevice(&dev);
    (void)hipDeviceGetAttribute(&cus, hipDeviceAttributeMultiprocessorCount, dev);
    (void)hipOccupancyMaxActiveBlocksPerMultiprocessor(&per_cu, (const void*)mega, 512, SHM_BYTES);
    if (per_cu < 1) per_cu = 1;
    grid = cus * per_cu;
    if (grid > 256) grid = 256;
    if (grid & 7) grid &= ~7;
  }
  Params p{};
  for (int i = 0; i < 34; ++i) p.in[i] = (const float*)d_in[i];
  p.x = (float*)d_out;
  p.ws = (char*)d_ws;
  int ph_lo = 0, ph_hi = N_PHASES, coop = 1;
  void* args[] = {&p, &ph_lo, &ph_hi, &coop};
  hipError_t e = hipLaunchCooperativeKernel((const void*)mega, dim3(grid), dim3(512), args, SHM_BYTES, stream);
  if (e != hipSuccess) fprintf(stderr, "cooperative launch failed: %s (grid %d)\n", hipGetErrorString(e), grid);
}
```

```cpp
#define PROBE_CAT -1
#include <hip/hip_runtime.h>
#include <hip/hip_cooperative_groups.h>
#include <cstdio>
namespace cg = cooperative_groups;

#define DEV __device__ __forceinline__
typedef unsigned short bf16_t;
typedef short bf16x8 __attribute__((ext_vector_type(8)));
typedef float f32x4 __attribute__((ext_vector_type(4)));

extern __shared__ __attribute__((aligned(16))) char g_shm[];

constexpr int NT = 49152, SLAB = 16384;
constexpr int SHM_BYTES = 131072;
constexpr size_t MiB = 1u << 20;
constexpr size_t OFF_W = 0;
constexpr size_t OFF_H = 24 * MiB;
constexpr size_t OFF_H0 = OFF_H + 256 * 2048;
constexpr size_t OFF_U = 122 * MiB, OFF_SSQ = 250 * MiB;
constexpr size_t OFF_HMID = 122 * MiB;
constexpr size_t OFF_HX = 24 * MiB, OFF_YLF = 24 * MiB, OFF_YLB = 56 * MiB, OFF_R = 88 * MiB, OFF_K = 120 * MiB, OFF_V = 152 * MiB,
                 OFF_HL = 184 * MiB, OFF_E0 = 200 * MiB, OFF_E1 = 232 * MiB, OFF_A0 = 264 * MiB, OFF_A1 = 296 * MiB, OFF_G = 328 * MiB,
                 OFF_QF = 360 * MiB, OFF_QB = 392 * MiB, OFF_LB = 424 * MiB, OFF_PB = 440 * MiB, OFF_SI = 456 * MiB;
constexpr size_t W_SG_IN = 0, W_SG_OUT = 8 * MiB;
constexpr size_t W_FF_A = 0, W_FF_D = 12 * MiB;
constexpr size_t W_TM_P = 0, W_TM_O = 14 * MiB, W_TM_W2 = 16 * MiB, W_TM_A2 = 16 * MiB + 512 * 1024, W_TM_G2 = 17 * MiB;

struct Params {
  const float* in[34];
  float* x;
  char* ws;
};


typedef const __attribute__((address_space(4))) char* karg_t;
DEV int opaque0() { int z = 0; asm volatile("" : "+s"(z)); return z; }
DEV const float* kin(int i) { karg_t kp = (karg_t)__builtin_amdgcn_kernarg_segment_ptr(); return *(const float* const __attribute__((address_space(4)))*)(kp + (i + opaque0()) * 8); }
DEV float* kx() { karg_t kp = (karg_t)__builtin_amdgcn_kernarg_segment_ptr(); return *(float* const __attribute__((address_space(4)))*)(kp + (34 + opaque0()) * 8); }
DEV char* kws() { karg_t kp = (karg_t)__builtin_amdgcn_kernarg_segment_ptr(); return *(char* const __attribute__((address_space(4)))*)(kp + (35 + opaque0()) * 8); }

DEV int opaque_tid() { int z = 0; asm volatile("" : "+v"(z)); return (int)threadIdx.x + z; }
DEV float bf2f(bf16_t u) { return __uint_as_float(((unsigned)u) << 16); }
DEV bf16_t f2bf(float f) { unsigned u = __float_as_uint(f); u += 0x7fffu + ((u >> 16) & 1u); return (bf16_t)(u >> 16); }
DEV unsigned pack2(float a, float b) { return (unsigned)f2bf(a) | ((unsigned)f2bf(b) << 16); }
template <int CTRL> DEV float dppmov(float v) { return __int_as_float(__builtin_amdgcn_update_dpp(0, __float_as_int(v), CTRL, 0xf, 0xf, true)); }
DEV float row_sum16(float v) {
  v += dppmov<0xB1>(v); v += dppmov<0x4E>(v); v += dppmov<0x141>(v); v += dppmov<0x140>(v);
  return v;
}
DEV float wave_sum(float v) {
  const int r = __float_as_int(row_sum16(v));
  return (__int_as_float(__builtin_amdgcn_readlane(r, 0)) + __int_as_float(__builtin_amdgcn_readlane(r, 16))) +
         (__int_as_float(__builtin_amdgcn_readlane(r, 32)) + __int_as_float(__builtin_amdgcn_readlane(r, 48)));
}
DEV float sigmoidf_(float x) { return 1.0f / (1.0f + __expf(-x)); }
DEV float gelu_exact(float v) {
  const float av = fabsf(v), d = av * 0.2316418882f + 1.0f;
  const float t = __builtin_amdgcn_rcpf(d);
  float q = t * 0.5307027145f + (-0.7265760135f); q = q * t + 0.7107068705f; q = q * t + (-0.142248368f); q = q * t + 0.127414796f; q = q * t;
  const float e = __builtin_amdgcn_exp2f((v * v) * (-0.72134752044f));
  const float m = v * (q * e), r = v - m;
  return v < 0.f ? m : r;
}

DEV void phase_init(const Params& p) {
  const int TIDX = opaque_tid();
  const float4* xp = (const float4*)kin(0);
  const float4* xs = (const float4*)kin(1);
  float4* x = (float4*)kx();
  const size_t n0 = (size_t)32768 * 256, n1 = (size_t)16384 * 256;
  for (size_t i = (size_t)blockIdx.x * 512 + TIDX; i < n0 + n1; i += (size_t)gridDim.x * 512) x[i] = i < n0 ? xp[i] : xs[i - n0];
}

DEV void phase_norm(const Params& p, const float* g, bf16_t* h0) {
  const int TIDX = opaque_tid();
  const int wid = TIDX >> 6, lane = TIDX & 63;
  float4 gv[4];
#pragma unroll
  for (int i = 0; i < 4; ++i) gv[i] = ((const float4*)g)[lane + 64 * i];
  for (int t = blockIdx.x * 8 + wid; t < NT; t += gridDim.x * 8) {
    const float4* xr = (const float4*)(kx() + (size_t)t * 1024);
    float4 v[4]; float ss = 0.f;
#pragma unroll
    for (int i = 0; i < 4; ++i) { v[i] = xr[lane + 64 * i]; ss += v[i].x * v[i].x + v[i].y * v[i].y + v[i].z * v[i].z + v[i].w * v[i].w; }
    ss = wave_sum(ss);
    const float rs = rsqrtf(ss * (1.0f / 1024.f) + 1e-6f);
    uint2* hr = (uint2*)(h0 + (size_t)t * 1024);
#pragma unroll
    for (int i = 0; i < 4; ++i) {
      uint2 o; o.x = pack2(v[i].x * rs * gv[i].x, v[i].y * rs * gv[i].y); o.y = pack2(v[i].z * rs * gv[i].z, v[i].w * rs * gv[i].w);
      hr[lane + 64 * i] = o;
    }
  }
}

DEV void phase_norm_tm(const Params& p, const float* g, bf16_t* hx, int slab) {
  const int TIDX = opaque_tid();
  const int wid = TIDX >> 6, lane = TIDX & 63;
  const int L = slab < 2 ? 16384 : 2048;
  float4 gv[4];
#pragma unroll
  for (int i = 0; i < 4; ++i) gv[i] = ((const float4*)g)[lane + 64 * i];
  for (int ts = blockIdx.x * 8 + wid; ts < SLAB; ts += gridDim.x * 8) {
    const int t = slab * SLAB + ts, pos = ts & (L - 1);
    float4 hv[3][4];
#pragma unroll
    for (int d = 0; d < 3; ++d) {
      const bool valid = !((d == 0 && pos == 0) || (d == 2 && pos == L - 1));
      const int tt = valid ? t + d - 1 : t;
      const float4* xr = (const float4*)(kx() + (size_t)tt * 1024);
      float ss = 0.f;
#pragma unroll
      for (int i = 0; i < 4; ++i) { float4 v = xr[lane + 64 * i]; hv[d][i] = v; ss += v.x * v.x + v.y * v.y + v.z * v.z + v.w * v.w; }
      ss = wave_sum(ss);
      const float rs = valid ? rsqrtf(ss * (1.0f / 1024.f) + 1e-6f) : 0.f;
#pragma unroll
      for (int i = 0; i < 4; ++i) { hv[d][i].x *= rs * gv[i].x; hv[d][i].y *= rs * gv[i].y; hv[d][i].z *= rs * gv[i].z; hv[d][i].w *= rs * gv[i].w; }
    }
    uint2* hr = (uint2*)(hx + (size_t)ts * 2048);
#pragma unroll
    for (int i = 0; i < 4; ++i) {
      uint2 o; o.x = pack2(hv[1][i].x, hv[1][i].y); o.y = pack2(hv[1][i].z, hv[1][i].w);
      hr[lane + 64 * i] = o;
      uint2 q;
      q.x = pack2(0.5f * (hv[0][i].x + hv[2][i].x) - hv[1][i].x, 0.5f * (hv[0][i].y + hv[2][i].y) - hv[1][i].y);
      q.y = pack2(0.5f * (hv[0][i].z + hv[2][i].z) - hv[1][i].z, 0.5f * (hv[0][i].w + hv[2][i].w) - hv[1][i].w);
      hr[256 + lane + 64 * i] = q;
    }
  }
}

DEV void phase_final(const Params& p) {
  const int TIDX = opaque_tid();
  const int wid = TIDX >> 6, lane = TIDX & 63;
  const float* g = kin(4);
  float4 gv[4];
#pragma unroll
  for (int i = 0; i < 4; ++i) gv[i] = ((const float4*)g)[lane + 64 * i];
  for (int t = blockIdx.x * 8 + wid; t < NT; t += gridDim.x * 8) {
    float4* xr = (float4*)(kx() + (size_t)t * 1024);
    float4 v[4]; float ss = 0.f;
#pragma unroll
    for (int i = 0; i < 4; ++i) { v[i] = xr[lane + 64 * i]; ss += v[i].x * v[i].x + v[i].y * v[i].y + v[i].z * v[i].z + v[i].w * v[i].w; }
    ss = wave_sum(ss);
    const float rs = rsqrtf(ss * (1.0f / 1024.f) + 1e-6f);
#pragma unroll
    for (int i = 0; i < 4; ++i) {
      float4 o; o.x = v[i].x * rs * gv[i].x; o.y = v[i].y * rs * gv[i].y; o.z = v[i].z * rs * gv[i].z; o.w = v[i].w * rs * gv[i].w;
      xr[lane + 64 * i] = o;
    }
  }
}

DEV void wprep_T(bf16_t* dst, int ldd, int koff, const float* src, int Ks, int Ns, const float* scale, int rs, int roff) {
  const int TIDX = opaque_tid();
  float (*tile)[33] = (float (*)[33])g_shm;
  const int tx = TIDX & 31, ty = TIDX >> 5;
  const int nkt = Ks / 32, nnt = Ns / 32;
  for (int tIdx = blockIdx.x; tIdx < nkt * nnt; tIdx += gridDim.x) {
    const int k0 = (tIdx / nnt) * 32, n0 = (tIdx % nnt) * 32;
    __syncthreads();
#pragma unroll
    for (int i = 0; i < 2; ++i) tile[ty + 16 * i][tx] = src[(size_t)(k0 + ty + 16 * i) * Ns + n0 + tx];
    __syncthreads();
    const float sc = scale ? scale[k0 + tx] : 1.0f;
#pragma unroll
    for (int i = 0; i < 2; ++i) {
      const int n = n0 + ty + 16 * i;
      const int drow = (n >> 7) * rs + (n & 127) + roff;
      dst[(size_t)drow * ldd + koff + k0 + tx] = f2bf(tile[tx][ty + 16 * i] * sc);
    }
  }
  __syncthreads();
}


DEV void wprep_T2(bf16_t* dst, int ldd, int koff, const float* src, int Ks, int Ns, const float* scale, int rs, int roff) {
  const int TIDX = opaque_tid();
  float* tile = (float*)g_shm;
  const int nkt = Ks / 64, nnt = Ns / 128;
  const int lc = TIDX & 127, lr = TIDX >> 7;
  const int wk = TIDX & 63, wn = TIDX >> 6;
  for (int tIdx = blockIdx.x; tIdx < nkt * nnt; tIdx += gridDim.x) {
    const int k0 = (tIdx / nnt) * 64, n0 = (tIdx % nnt) * 128;
    float v[16];
#pragma unroll
    for (int i = 0; i < 16; ++i) v[i] = src[(size_t)(k0 + i * 4 + lr) * Ns + n0 + lc];
    __syncthreads();
#pragma unroll
    for (int i = 0; i < 16; ++i) tile[(i * 4 + lr) * 129 + lc] = v[i];
    __syncthreads();
    const float sc = scale ? scale[k0 + wk] : 1.0f;
#pragma unroll
    for (int i = 0; i < 16; ++i) {
      const int n = n0 + i * 8 + wn;
      const int drow = (n >> 7) * rs + (n & 127) + roff;
      dst[(size_t)drow * ldd + koff + k0 + wk] = f2bf(tile[wk * 129 + i * 8 + wn] * sc);
    }
  }
  __syncthreads();
}

constexpr int BM = 256, BK = 64, HALF = 128, HT = HALF * BK;
DEV int lds_byte(int r, int c) {
  int st = (r >> 4) * 2 + (c >> 5), rr = r & 15, cc = c & 31, ob = rr * 64 + cc * 2;
  return st * 1024 + (ob ^ (((ob >> 9) & 1) << 5));
}
DEV void stage_rc(int b, int& R, int& C) {
  int st = b / 1024, sb = b % 1024, swz = sb ^ (((sb >> 9) & 1) << 5);
  R = (st >> 1) * 16 + swz / 64; C = (st & 1) * 32 + (swz % 64) / 2;
}

typedef __attribute__((address_space(3))) unsigned char lds_u8;
DEV void gemm_big(const bf16_t* A, long lda, const bf16_t* Bt, long ldb, int K, long brow, long bcol, f32x4 (&acc)[2][2][4][2]) {
  const int TIDX = opaque_tid();
  lds_u8* lds = (lds_u8*)g_shm;
  constexpr int HTB = HT * 2;
#define SA(b, h) (((b) * 2 + (h)) * HTB)
#define SB(b, h) ((4 + (b) * 2 + (h)) * HTB)
#define STAGE(bufoff, gbase, VO, kt) do { const char* _gp = (gbase) + (size_t)(kt) * (BK * 2); \
    __builtin_amdgcn_global_load_lds((const unsigned*)(_gp + VO##0), (__attribute__((address_space(3))) unsigned*)(lds + (bufoff) + ldsw), 16, 0, 0); \
    __builtin_amdgcn_global_load_lds((const unsigned*)(_gp + VO##1), (__attribute__((address_space(3))) unsigned*)(lds + (bufoff) + ldsw + 8192), 16, 0, 0); } while (0)
#define LDA(dst, b, h) for (int m = 0; m < 4; ++m) for (int k = 0; k < 2; ++k) \
    dst[m][k] = *(const __attribute__((address_space(3))) bf16x8*)(lds + SA(b, h) + aoff + m * 2048 + k * 1024)
#define LDB(dst, b, h) for (int n = 0; n < 2; ++n) for (int k = 0; k < 2; ++k) \
    dst[n][k] = *(const __attribute__((address_space(3))) bf16x8*)(lds + SB(b, h) + boff + n * 2048 + k * 1024)
#define MMA(ai, bj, At, Bt_) do { __builtin_amdgcn_s_setprio(1); \
    for (int m = 0; m < 4; ++m) for (int n = 0; n < 2; ++n) for (int k = 0; k < 2; ++k) \
      acc[ai][bj][m][n] = __builtin_amdgcn_mfma_f32_16x16x32_bf16(At[m][k], Bt_[n][k], acc[ai][bj][m][n], 0, 0, 0); \
    __builtin_amdgcn_s_setprio(0); } while (0)
#define WAIT_V(n) asm volatile("s_waitcnt vmcnt(" #n ")" ::: "memory")
#define WAIT_L(n) asm volatile("s_waitcnt lgkmcnt(" #n ")" ::: "memory")
#define BAR __builtin_amdgcn_s_barrier()
#define SCHED __builtin_amdgcn_sched_barrier(0)
  const int tid = TIDX, wid = __builtin_amdgcn_readfirstlane(tid >> 6), lane = tid & 63, wr = wid >> 2, wc = wid & 3, fr = lane & 15, fq = lane >> 4;
  unsigned va0, va1, vb0, vb1;
  { int r_, c_; stage_rc(tid * 16, r_, c_); va0 = (unsigned)((r_ * lda + c_) * 2); vb0 = (unsigned)((r_ * ldb + c_) * 2);
    stage_rc(tid * 16 + 8192, r_, c_); va1 = (unsigned)((r_ * lda + c_) * 2); vb1 = (unsigned)((r_ * ldb + c_) * 2); }
  const unsigned ldsw = (unsigned)wid * 1024u;
  const int aoff = lds_byte(wr * 64 + fr, fq * 8), boff = lds_byte(wc * 32 + fr, fq * 8);
  const char* cA0 = (const char*)(A + brow * lda); const char* cA1 = cA0 + (size_t)HALF * lda * 2;
  const char* cB0 = (const char*)(Bt + bcol * ldb); const char* cB1 = cB0 + (size_t)HALF * ldb * 2;
#pragma unroll
  for (int a = 0; a < 2; ++a)
#pragma unroll
    for (int b = 0; b < 2; ++b)
#pragma unroll
      for (int m = 0; m < 4; ++m)
#pragma unroll
        for (int n = 0; n < 2; ++n) acc[a][b][m][n] = (f32x4){0.f, 0.f, 0.f, 0.f};
  bf16x8 At[4][2], B0[2][2], B1[2][2];
  const int nt = K / BK;
  STAGE(SB(0, 0), cB0, vb, 0); STAGE(SA(0, 0), cA0, va, 0);
  STAGE(SB(0, 1), cB1, vb, 0); STAGE(SA(0, 1), cA1, va, 0);
  if (wr == 1) BAR;
  WAIT_V(4); BAR;
  STAGE(SB(1, 0), cB0, vb, 1); STAGE(SA(1, 0), cA0, va, 1); STAGE(SB(1, 1), cB1, vb, 1);
  WAIT_V(6); BAR;
  for (int t = 0; t < nt - 2; t += 2) {
    LDB(B0, 0, 0); SCHED; LDA(At, 0, 0); STAGE(SA(1, 1), cA1, va, t + 1);
    WAIT_L(8); BAR; WAIT_L(0); MMA(0, 0, At, B0); BAR; SCHED;
    LDB(B1, 0, 1); STAGE(SB(0, 0), cB0, vb, t + 2);
    BAR; WAIT_L(0); MMA(0, 1, At, B1); BAR;
    LDA(At, 0, 1); STAGE(SA(0, 0), cA0, va, t + 2);
    BAR; WAIT_L(0); MMA(1, 0, At, B0); BAR; SCHED;
    STAGE(SB(0, 1), cB1, vb, t + 2);
    WAIT_V(6); BAR; MMA(1, 1, At, B1); BAR;
    LDB(B0, 1, 0); SCHED; LDA(At, 1, 0); STAGE(SA(0, 1), cA1, va, t + 2);
    WAIT_L(8); BAR; WAIT_L(0); MMA(0, 0, At, B0); BAR; SCHED;
    LDB(B1, 1, 1); STAGE(SB(1, 0), cB0, vb, t + 3);
    BAR; WAIT_L(0); MMA(0, 1, At, B1); BAR;
    LDA(At, 1, 1); STAGE(SA(1, 0), cA0, va, t + 3);
    BAR; WAIT_L(0); MMA(1, 0, At, B0); BAR; SCHED;
    STAGE(SB(1, 1), cB1, vb, t + 3);
    WAIT_V(6); BAR; MMA(1, 1, At, B1); BAR;
  }
  { LDB(B0, 0, 0); LDA(At, 0, 0); STAGE(SA(1, 1), cA1, va, nt - 1);
    BAR; WAIT_L(0); MMA(0, 0, At, B0); BAR;
    LDB(B1, 0, 1); BAR; WAIT_L(0); MMA(0, 1, At, B1); BAR;
    LDA(At, 0, 1); WAIT_V(4); BAR; WAIT_L(0); MMA(1, 0, At, B0); MMA(1, 1, At, B1); BAR; }
  { LDB(B0, 1, 0); LDA(At, 1, 0); WAIT_V(2); BAR; WAIT_L(0); MMA(0, 0, At, B0); BAR;
    LDB(B1, 1, 1); WAIT_V(0); BAR; WAIT_L(0); MMA(0, 1, At, B1); BAR;
    LDA(At, 1, 1); BAR; WAIT_L(0); MMA(1, 0, At, B0); MMA(1, 1, At, B1); BAR; }
  if (wr == 0) BAR;
}
DEV void dump_half(const f32x4 (&acc)[2][2][4][2], int ai, int tid) {
  float* T = (float*)g_shm;
  const int wid = tid >> 6, lane = tid & 63, wr = wid >> 2, wc = wid & 3, fr = lane & 15, fq = lane >> 4;
#pragma unroll
  for (int bj = 0; bj < 2; ++bj)
#pragma unroll
    for (int m = 0; m < 4; ++m)
#pragma unroll
      for (int n = 0; n < 2; ++n)
#pragma unroll
        for (int jj = 0; jj < 4; ++jj) {
          const int r = wr * 64 + m * 16 + fq * 4 + jj, c = bj * 128 + wc * 32 + n * 16 + fr;
          T[r * 256 + (c ^ (fq << 4))] = (ai == 0) ? acc[0][bj][m][n][jj] : acc[1][bj][m][n][jj];
        }
}
DEV float4 tile_ld4(int r, int c4) { return *(const float4*)((const float*)g_shm + r * 256 + (c4 ^ (((r >> 2) & 3) << 4))); }
DEV float tile_ld(int r, int c) { return ((const float*)g_shm)[r * 256 + (c ^ (((r >> 2) & 3) << 4))]; }

DEV int vblock() { return (blockIdx.x & 7) * (gridDim.x >> 3) + (blockIdx.x >> 3); }

DEV void phase_gemm_res(const Params& p, const bf16_t* A, long lda, const bf16_t* Bt, int K, int mtiles, long xrow0) {
  float* X = kx();
  for (int tile = vblock(); tile < mtiles * 4; tile += gridDim.x) {
    const int pm = tile >> 2, pn = tile & 3;
    f32x4 acc[2][2][4][2];
    gemm_big(A, lda, Bt, K, K, (long)pm * 256, (long)pn * 256, acc);
    const int tid = opaque_tid();
#pragma unroll
    for (int ai = 0; ai < 2; ++ai) {
      __syncthreads();
      dump_half(acc, ai, tid);
      __syncthreads();
      for (int e = tid; e < 128 * 64; e += 512) {
        const int r = e >> 6, c4 = (e & 63) * 4;
        const float4 v = tile_ld4(r, c4);
        float4* q = (float4*)(X + (xrow0 + pm * 256 + ai * 128 + r) * 1024 + pn * 256 + c4);
        float4 o = *q; o.x += v.x; o.y += v.y; o.z += v.z; o.w += v.w; *q = o;
      }
    }
    __syncthreads();
  }
}

DEV void phase_sgu_in(const Params& p, int j, int slab) {
  const bf16_t* A = (const bf16_t*)(kws() + OFF_H0) + (size_t)slab * SLAB * 1024;
  const bf16_t* Bt = (const bf16_t*)(kws() + OFF_W + W_SG_IN);
  const float* bin = kin(6) + (size_t)j * 4096;
  bf16_t* Z = (bf16_t*)(kws() + OFF_U);
  float* SSQ = (float*)(kws() + OFF_SSQ);
  for (int tile = vblock(); tile < 64 * 16; tile += gridDim.x) {
    const int pm = tile >> 4, pn = tile & 15;
    f32x4 acc[2][2][4][2];
    gemm_big(A, 1024, Bt, 1024, 1024, (long)pm * 256, (long)pn * 256, acc);
    const int tid = opaque_tid(), wid = tid >> 6, lane = tid & 63;
    const float4 b4 = *(const float4*)(bin + pn * 256 + lane * 4);
#pragma unroll
    for (int ai = 0; ai < 2; ++ai) {
      __syncthreads();
      dump_half(acc, ai, tid);
      __syncthreads();
      for (int rr = 0; rr < 16; ++rr) {
        const int r = wid * 16 + rr;
        const float4 v = tile_ld4(r, lane * 4);
        const float z0 = gelu_exact(v.x + b4.x), z1 = gelu_exact(v.y + b4.y), z2 = gelu_exact(v.z + b4.z), z3 = gelu_exact(v.w + b4.w);
        const int row = pm * 256 + ai * 128 + r;
        uint2 o; o.x = pack2(z0, z1); o.y = pack2(z2, z3);
        *(uint2*)(Z + (size_t)row * 4096 + pn * 256 + lane * 4) = o;
        if (pn >= 8) {
          const float ss = wave_sum(z0 * z0 + z1 * z1 + z2 * z2 + z3 * z3);
          if (lane == 0) SSQ[(size_t)row * 8 + (pn - 8)] = ss;
        }
      }
    }
    __syncthreads();
  }
}

DEV void phase_tm_proj(const Params& p) {
  const bf16_t* A = (const bf16_t*)(kws() + OFF_HX);
  const bf16_t* Bt = (const bf16_t*)(kws() + OFF_W + W_TM_P);
  for (int tile = vblock(); tile < 64 * 14; tile += gridDim.x) {
    const int pm = tile / 14, pn = tile % 14;
    f32x4 acc[2][2][4][2];
    gemm_big(A, 2048, Bt, 2048, 2048, (long)pm * 256, (long)pn * 256, acc);
    const int tid = opaque_tid(), wid = tid >> 6, lane = tid & 63;
    bf16_t* O; int ld, cb;
    if (pn < 12) { O = (bf16_t*)(kws() + (pn < 4 ? OFF_R : (pn < 8 ? OFF_K : OFF_V))); ld = 1024; cb = (pn & 3) * 256; }
    else { O = (bf16_t*)(kws() + OFF_HL); ld = 512; cb = (pn - 12) * 256; }
    const int act = pn < 12 ? 0 : (pn == 12 ? (lane < 32 ? 1 : 0) : 2);
#pragma unroll
    for (int ai = 0; ai < 2; ++ai) {
      __syncthreads();
      dump_half(acc, ai, tid);
      __syncthreads();
      for (int rr = 0; rr < 16; ++rr) {
        const int r = wid * 16 + rr;
        float4 v = tile_ld4(r, lane * 4);
        if (act == 1) { v.x = tanhf(v.x); v.y = tanhf(v.y); v.z = tanhf(v.z); v.w = tanhf(v.w); }
        else if (act == 2) { v.x = sigmoidf_(v.x); v.y = sigmoidf_(v.y); v.z = sigmoidf_(v.z); v.w = sigmoidf_(v.w); }
        uint2 o; o.x = pack2(v.x, v.y); o.y = pack2(v.z, v.w);
        *(uint2*)(O + (size_t)(pm * 256 + ai * 128 + r) * ld + cb + lane * 4) = o;
      }
    }
    __syncthreads();
  }
}

DEV void phase_ffn_a(const Params& p, int layer) {
  const bf16_t* A = (const bf16_t*)(kws() + OFF_H0);
  const bf16_t* Bt = (const bf16_t*)(kws() + OFF_W + W_FF_A);
  bf16_t* HM = (bf16_t*)(kws() + OFF_HMID);
  const float* cw = kin(31) + (size_t)layer * 3 * 2816;
  const float* cb = kin(32) + (size_t)layer * 2816;
  float* UP = (float*)g_shm;
  bf16_t* gl = (bf16_t*)(g_shm + 65536);
  for (int tile = vblock(); tile < 202 * 22; tile += gridDim.x) {
    const int mi = tile / 22, pn = tile % 22;
    int base, L, i;
    if (mi < 130) { base = (mi / 65) * 16384; L = 16384; i = mi % 65; }
    else { const int m2 = mi - 130; base = 32768 + (m2 / 9) * 2048; L = 2048; i = m2 % 9; }
    const int s0 = 254 * i - 1;
    f32x4 acc[2][2][4][2];
    gemm_big(A, 1024, Bt, 1024, 1024, (long)base + s0, (long)pn * 256, acc);
    const int tid = opaque_tid(), wid = tid >> 6, lane = tid & 63, wr = wid >> 2, wc = wid & 3, fr = lane & 15, fq = lane >> 4;
    __syncthreads();
#pragma unroll
    for (int ai = 0; ai < 2; ++ai)
#pragma unroll
      for (int m = 0; m < 4; ++m)
#pragma unroll
        for (int n = 0; n < 2; ++n)
#pragma unroll
          for (int jj = 0; jj < 4; ++jj) {
            const int r = ai * 128 + wr * 64 + m * 16 + fq * 4 + jj, c = wc * 32 + n * 16 + fr;
            const int s = s0 + r;
            gl[r * 128 + c] = (s >= 0 && s < L) ? f2bf(acc[ai][0][m][n][jj]) : (bf16_t)0;
          }
    const int c4 = (lane & 31) * 4, f = pn * 128 + c4;
    const float4 w0 = *(const float4*)(cw + f), w1 = *(const float4*)(cw + 2816 + f), w2 = *(const float4*)(cw + 2 * 2816 + f), bb = *(const float4*)(cb + f);
#pragma unroll
    for (int ai = 0; ai < 2; ++ai) {
      __syncthreads();
#pragma unroll
      for (int m = 0; m < 4; ++m)
#pragma unroll
        for (int n = 0; n < 2; ++n)
#pragma unroll
          for (int jj = 0; jj < 4; ++jj) {
            const int r = wr * 64 + m * 16 + fq * 4 + jj, c = wc * 32 + n * 16 + fr;
            UP[r * 128 + (c ^ (fq << 4))] = (ai == 0) ? acc[0][1][m][n][jj] : acc[1][1][m][n][jj];
          }
      __syncthreads();
      for (int e = tid; e < 128 * 32; e += 512) {
        const int rl = e >> 5, r = ai * 128 + rl, s = s0 + r;
        if (r >= 1 && r <= 254 && s < L) {
          const float4 u = *(const float4*)(UP + rl * 128 + (c4 ^ (((rl >> 2) & 3) << 4)));
          const uint2 g0 = *(const uint2*)(gl + (r - 1) * 128 + c4), g1 = *(const uint2*)(gl + r * 128 + c4), g2 = *(const uint2*)(gl + (r + 1) * 128 + c4);
          const float c0 = w0.x * __uint_as_float(g0.x << 16) + w1.x * __uint_as_float(g1.x << 16) + w2.x * __uint_as_float(g2.x << 16) + bb.x;
          const float c1 = w0.y * __uint_as_float(g0.x & 0xffff0000u) + w1.y * __uint_as_float(g1.x & 0xffff0000u) + w2.y * __uint_as_float(g2.x & 0xffff0000u) + bb.y;
          const float c2 = w0.z * __uint_as_float(g0.y << 16) + w1.z * __uint_as_float(g1.y << 16) + w2.z * __uint_as_float(g2.y << 16) + bb.z;
          const float c3 = w0.w * __uint_as_float(g0.y & 0xffff0000u) + w1.w * __uint_as_float(g1.y & 0xffff0000u) + w2.w * __uint_as_float(g2.y & 0xffff0000u) + bb.w;
          uint2 o; o.x = pack2(gelu_exact(c0) * u.x, gelu_exact(c1) * u.y); o.y = pack2(gelu_exact(c2) * u.z, gelu_exact(c3) * u.w);
          *(uint2*)(HM + (size_t)(base + s) * 2816 + f) = o;
        }
      }
    }
    __syncthreads();
  }
}

template <int KP>
DEV void small_mma(f32x4 (&acc)[4][4]) {
  const int TIDX = opaque_tid();
  constexpr int LD = KP + 8;
  const bf16_t* sA = (const bf16_t*)g_shm;
  const bf16_t* sB = sA + 128 * LD;
  const int wid = TIDX >> 6, lane = TIDX & 63, wr = wid >> 2, wc = wid & 3, fr = lane & 15, fq = lane >> 4;
#pragma unroll
  for (int m = 0; m < 4; ++m)
#pragma unroll
    for (int n = 0; n < 4; ++n) acc[m][n] = (f32x4){0.f, 0.f, 0.f, 0.f};
#pragma unroll
  for (int kk = 0; kk < KP / 32; ++kk) {
    bf16x8 a[4], b[4];
#pragma unroll
    for (int m = 0; m < 4; ++m) a[m] = *(const bf16x8*)(sA + (wr * 64 + m * 16 + fr) * LD + kk * 32 + fq * 8);
#pragma unroll
    for (int n = 0; n < 4; ++n) b[n] = *(const bf16x8*)(sB + (wc * 64 + n * 16 + fr) * LD + kk * 32 + fq * 8);
#pragma unroll
    for (int m = 0; m < 4; ++m)
#pragma unroll
      for (int n = 0; n < 4; ++n) acc[m][n] = __builtin_amdgcn_mfma_f32_16x16x32_bf16(a[m], b[n], acc[m][n], 0, 0, 0);
  }
}
template <int KP>
DEV void small_load(bf16_t* s, const bf16_t* g, long ld, int rows) {
  const int TIDX = opaque_tid();
  constexpr int LD = KP + 8, CPR = KP / 8;
  for (int c = TIDX; c < rows * CPR; c += 512) {
    const int r = c / CPR, k8 = (c % CPR) * 8;
    *(uint4*)(s + r * LD + k8) = *(const uint4*)(g + (long)r * ld + k8);
  }
}

DEV void phase_sgu_mix(const Params& p, int j) {
  const int TIDX = opaque_tid();
  constexpr int KP = 128, LD = KP + 8;
  const int wid = TIDX >> 6, lane = TIDX & 63, wr = wid >> 2, wc = wid & 3, fr = lane & 15, fq = lane >> 4;
  bf16_t* sA = (bf16_t*)g_shm;
  bf16_t* sB = sA + 128 * LD;
  float* rsv = (float*)(g_shm + (128 + 256) * LD * 2);
  bf16_t* Z = (bf16_t*)(kws() + OFF_U);
  const float* SSQ = (const float*)(kws() + OFF_SSQ);
  const float* ws_ = kin(8) + (size_t)j * 8 * 128 * 128;
  const float* bs = kin(9) + (size_t)j * 8 * 128;
  const float* ng = kin(7) + (size_t)j * 2048;
  for (int unit = blockIdx.x; unit < 128 * 8; unit += gridDim.x) {
    const int chunk = unit >> 3, g = unit & 7;
    __syncthreads();
    if (TIDX < 128) {
      const float* sp = SSQ + (size_t)(chunk * 128 + TIDX) * 8;
      float s = 0.f;
      for (int i = 0; i < 8; ++i) s += sp[i];
      rsv[TIDX] = rsqrtf(s * (1.0f / 2048.f) + 1e-6f);
    }
    for (int e = TIDX; e < 128 * 32; e += 512) {
      const int pp = e >> 5, c8 = (e & 31) * 8;
      const uint4 v = *(const uint4*)(Z + (size_t)(chunk * 128 + pp) * 4096 + 2048 + g * 256 + c8);
      sB[(c8 + 0) * LD + pp] = (bf16_t)(v.x & 0xffff); sB[(c8 + 1) * LD + pp] = (bf16_t)(v.x >> 16);
      sB[(c8 + 2) * LD + pp] = (bf16_t)(v.y & 0xffff); sB[(c8 + 3) * LD + pp] = (bf16_t)(v.y >> 16);
      sB[(c8 + 4) * LD + pp] = (bf16_t)(v.z & 0xffff); sB[(c8 + 5) * LD + pp] = (bf16_t)(v.z >> 16);
      sB[(c8 + 6) * LD + pp] = (bf16_t)(v.w & 0xffff); sB[(c8 + 7) * LD + pp] = (bf16_t)(v.w >> 16);
    }
    __syncthreads();
    for (int c = TIDX; c < 128 * 16; c += 512) {
      const int q = c >> 4, p8 = (c & 15) * 8;
      const float4* wp = (const float4*)(ws_ + ((size_t)g * 128 + q) * 128 + p8);
      const float4 w0 = wp[0], w1 = wp[1];
      uint4 o;
      o.x = pack2(w0.x * rsv[p8 + 0], w0.y * rsv[p8 + 1]); o.y = pack2(w0.z * rsv[p8 + 2], w0.w * rsv[p8 + 3]);
      o.z = pack2(w1.x * rsv[p8 + 4], w1.y * rsv[p8 + 5]); o.w = pack2(w1.z * rsv[p8 + 6], w1.w * rsv[p8 + 7]);
      *(uint4*)(sA + q * LD + p8) = o;
    }
    __syncthreads();
    f32x4 acc[4][4];
    small_mma<KP>(acc);
#pragma unroll
    for (int m = 0; m < 4; ++m)
#pragma unroll
      for (int n = 0; n < 4; ++n) {
        const int c = g * 256 + wc * 64 + n * 16 + fr;
        const float gg = ng[c];
#pragma unroll
        for (int jj = 0; jj < 4; ++jj) {
          const int q = wr * 64 + m * 16 + fq * 4 + jj;
          const float mix = acc[m][n][jj] * gg + bs[g * 128 + q];
          bf16_t* up = Z + (size_t)(chunk * 128 + q) * 4096 + c;
          *up = f2bf(bf2f(*up) * mix);
        }
      }
  }
  __syncthreads();
}

template <int KP>
DEV void lora_out_unit(const Params& p, int j, int kind, int mt, int ntile) {
  const int TIDX = opaque_tid();
  constexpr int LD = KP + 8;
  const int wid = TIDX >> 6, lane = TIDX & 63, wr = wid >> 2, wc = wid & 3, fr = lane & 15, fq = lane >> 4;
  bf16_t* sA = (bf16_t*)g_shm;
  bf16_t* sB = sA + 128 * LD;
  const bf16_t* HL = (const bf16_t*)(kws() + OFF_HL);
  const int koff = kind < 4 ? kind * 64 : 256;
  const bf16_t* Bt = (const bf16_t*)(kws() + OFF_W + (kind < 2 ? W_TM_W2 + (size_t)kind * 1024 * 64 * 2 : (kind < 4 ? W_TM_A2 + (size_t)(kind - 2) * 1024 * 64 * 2 : W_TM_G2)));
  bf16_t* O = (bf16_t*)(kws() + (kind == 0 ? OFF_E0 : kind == 1 ? OFF_E1 : kind == 2 ? OFF_A0 : kind == 3 ? OFF_A1 : OFF_G));
  const float* bias = kind < 2 ? kin(15) + ((size_t)j * 2 + kind) * 1024 : (kind < 4 ? kin(18) + ((size_t)j * 2 + kind - 2) * 1024 : nullptr);
  __syncthreads();
  small_load<KP>(sA, HL + (size_t)mt * 128 * 512 + koff, 512, 128);
  small_load<KP>(sB, Bt + (size_t)ntile * 256 * KP, KP, 256);
  __syncthreads();
  f32x4 acc[4][4];
  small_mma<KP>(acc);
#pragma unroll
  for (int m = 0; m < 4; ++m)
#pragma unroll
    for (int n = 0; n < 4; ++n) {
      const int col = ntile * 256 + wc * 64 + n * 16 + fr;
      const float b = bias ? bias[col] : 0.f;
#pragma unroll
      for (int jj = 0; jj < 4; ++jj) {
        const int row = mt * 128 + wr * 64 + m * 16 + fq * 4 + jj;
        float v = acc[m][n][jj] + b;
        if (kind < 2) v = 0.6065306597126334f * sigmoidf_(v); else if (kind < 4) v = sigmoidf_(v);
        O[(size_t)row * 1024 + col] = f2bf(v);
      }
    }
}
DEV void phase_tm_lora_out(const Params& p, int j) {
  for (int unit = blockIdx.x; unit < 5 * 512; unit += gridDim.x) {
    const int kind = unit / 512, r = unit % 512, mt = r >> 2, ntile = r & 3;
    if (kind < 4) lora_out_unit<64>(p, j, kind, mt, ntile); else lora_out_unit<160>(p, j, kind, mt, ntile);
  }
  __syncthreads();
}

template <int C> DEV void fmac_bc(float& acc, float op, float s) {
  asm volatile("v_fmac_f32_dpp %0, %1, %2 row_newbcast:%3 row_mask:0xf bank_mask:0xf" : "+v"(acc) : "v"(op), "v"(s), "n"(C));
}
template <int C> DEV void mulip_bc(float& s, float op) {
  asm volatile("v_mul_f32_dpp %0, %1, %0 row_newbcast:%2 row_mask:0xf bank_mask:0xf" : "+v"(s) : "v"(op), "n"(C));
}
template <int C> DEV float mul_bc(float op, float s) {
  float r;
  asm volatile("v_mul_f32_dpp %0, %1, %2 row_newbcast:%3 row_mask:0xf bank_mask:0xf" : "=v"(r) : "v"(op), "v"(s), "n"(C));
  return r;
}
#define LAUNDER4(a) asm volatile("s_nop 1" : "+v"(a[0]), "+v"(a[1]), "+v"(a[2]), "+v"(a[3]))
#define REP4(M, J) M(J) M(J + 1) M(J + 2) M(J + 3)
#define REP16(M, J) REP4(M, J) REP4(M, J + 4) REP4(M, J + 8) REP4(M, J + 12)
#define REP64(M) REP16(M, 0) REP16(M, 16) REP16(M, 32) REP16(M, 48)


struct ScanRaw { uint2 r, k, a, e; bf16_t v; };

DEV void phase_scan(const Params& p, int j, int slab) {
  const int TIDX = opaque_tid();
  const int wid = TIDX >> 6, lane = TIDX & 63, c16 = lane & 15;
  const bf16_t* Rb = (const bf16_t*)(kws() + OFF_R);
  const bf16_t* Kb = (const bf16_t*)(kws() + OFF_K);
  const bf16_t* Vb = (const bf16_t*)(kws() + OFF_V);
  for (int item = blockIdx.x * 8 + wid; item < 2048; item += gridDim.x * 8) {
    const int kind = item & 1, dir = (item >> 1) & 1, hd = (item >> 2) & 15, seg = item >> 6;
    const bf16_t* Ab = (const bf16_t*)(kws() + (dir ? OFF_A1 : OFF_A0));
    const bf16_t* Eb = (const bf16_t*)(kws() + (dir ? OFF_E1 : OFF_E0));
    bf16_t* Yo = (bf16_t*)(kws() + (kind ? (dir ? OFF_QB : OFF_QF) : (dir ? OFF_YLB : OFF_YLF)));
    float* Fo = (float*)(kws() + (kind ? OFF_PB : OFF_LB)) + (size_t)((seg * 16 + hd) * 2 + dir) * 4096;
    float kkw[4], kaw[4];
#pragma unroll
    for (int m = 0; m < 4; ++m) { kkw[m] = kin(23)[(size_t)j * 1024 + hd * 64 + 4 * c16 + m]; kaw[m] = kin(24)[(size_t)j * 1024 + hd * 64 + 4 * c16 + m]; }
    float S[64];
#pragma unroll
    for (int q = 0; q < 64; ++q) S[q] = (kind && q == lane) ? 1.f : 0.f;
    const int t0 = seg * 512, tstep = dir ? -1 : 1, tfirst = dir ? t0 + 511 : t0;
    const size_t hoff = (size_t)hd * 64;
    auto load_raw = [&](int step, ScanRaw& w) {
      const int st = step < 512 ? step : 511;
      const size_t o = (size_t)(tfirst + tstep * st) * 1024 + hoff;
      w.r = *(const uint2*)(Rb + o + 4 * c16); w.k = *(const uint2*)(Kb + o + 4 * c16);
      w.a = *(const uint2*)(Ab + o + 4 * c16); w.e = *(const uint2*)(Eb + o + 4 * c16);
      w.v = Vb[o + lane];
    };
    float nkk[4], bb[4], kd[4], ww[4], rr[4], vv;
    auto prep = [&](const ScanRaw& w) {
      float kf[4], af[4], ef[4], kr[4];
      kf[0] = __uint_as_float(w.k.x << 16); kf[1] = __uint_as_float(w.k.x & 0xffff0000u); kf[2] = __uint_as_float(w.k.y << 16); kf[3] = __uint_as_float(w.k.y & 0xffff0000u);
      af[0] = __uint_as_float(w.a.x << 16); af[1] = __uint_as_float(w.a.x & 0xffff0000u); af[2] = __uint_as_float(w.a.y << 16); af[3] = __uint_as_float(w.a.y & 0xffff0000u);
      ef[0] = __uint_as_float(w.e.x << 16); ef[1] = __uint_as_float(w.e.x & 0xffff0000u); ef[2] = __uint_as_float(w.e.y << 16); ef[3] = __uint_as_float(w.e.y & 0xffff0000u);
      rr[0] = __uint_as_float(w.r.x << 16); rr[1] = __uint_as_float(w.r.x & 0xffff0000u); rr[2] = __uint_as_float(w.r.y << 16); rr[3] = __uint_as_float(w.r.y & 0xffff0000u);
      float ss = 0.f;
#pragma unroll
      for (int m = 0; m < 4; ++m) { kr[m] = kf[m] * kkw[m]; ss += kr[m] * kr[m]; }
      ss = row_sum16(ss);
      const float inv = __builtin_amdgcn_rsqf(fmaxf(ss, 1e-24f));
#pragma unroll
      for (int m = 0; m < 4; ++m) {
        const float kk = kr[m] * inv;
        nkk[m] = -kk; bb[m] = kk * af[m]; kd[m] = kf[m] * (1.0f + (af[m] - 1.0f) * kaw[m]);
        ww[m] = __builtin_amdgcn_exp2f(-1.4426950408889634f * ef[m]);
      }
      vv = bf2f(w.v);
    };
    ScanRaw w0, w1;
    load_raw(0, w0); load_raw(1, w1);
    prep(w0);
    for (int step = 0; step < 512; ++step) {
      ScanRaw w2; load_raw(step + 2, w2);
      LAUNDER4(nkk); LAUNDER4(bb); LAUNDER4(kd); LAUNDER4(ww); LAUNDER4(rr);
      float sa0 = 0.f, sa1 = 0.f;
#define SA_EL(J) fmac_bc<((J) >> 2)>(((J) & 1) ? sa1 : sa0, nkk[(J) & 3], S[J]);
      REP64(SA_EL)
      const float sa = sa0 + sa1;
      float y0 = 0.f, y1 = 0.f;
      if (kind == 0) {
#define UP_EL(J) { mulip_bc<((J) >> 2)>(S[J], ww[(J) & 3]); fmac_bc<((J) >> 2)>(S[J], bb[(J) & 3], sa); fmac_bc<((J) >> 2)>(S[J], kd[(J) & 3], vv); fmac_bc<((J) >> 2)>(((J) & 1) ? y1 : y0, rr[(J) & 3], S[J]); }
        REP64(UP_EL)
      } else {
#define UP_ID(J) { mulip_bc<((J) >> 2)>(S[J], ww[(J) & 3]); fmac_bc<((J) >> 2)>(S[J], bb[(J) & 3], sa); fmac_bc<((J) >> 2)>(((J) & 1) ? y1 : y0, rr[(J) & 3], S[J]); }
        REP64(UP_ID)
      }
      Yo[(size_t)(tfirst + tstep * step) * 1024 + hoff + lane] = f2bf(y0 + y1);
      prep(w1);
      w1 = w2;
    }
#pragma unroll
    for (int q = 0; q < 16; ++q) {
      float4 o; o.x = S[4 * q]; o.y = S[4 * q + 1]; o.z = S[4 * q + 2]; o.w = S[4 * q + 3];
      *(float4*)(Fo + (size_t)lane * 64 + 4 * q) = o;
    }
  }
}

#define LBAR() do { asm volatile("s_waitcnt lgkmcnt(0)" ::: "memory"); __builtin_amdgcn_s_barrier(); asm volatile("" ::: "memory"); } while (0)
DEV void phase_combine(const Params& p, int slab) {
  const int TIDX = opaque_tid();
  float* ST = (float*)g_shm;
  float* PL = ST + 4096;
  const float* Lb = (const float*)(kws() + OFF_LB);
  const float* Pb = (const float*)(kws() + OFF_PB);
  float* SI = (float*)(kws() + OFF_SI);
  const int nseq = slab < 2 ? 1 : 8, sps = 32 / nseq;
  const int i = TIDX & 63, cgp = TIDX >> 6;
  for (int chain = blockIdx.x; chain < nseq * 32; chain += gridDim.x) {
    const int dir = chain & 1, hd = (chain >> 1) & 15, sq = chain >> 5;
    __syncthreads();
    for (int e = TIDX; e < 4096; e += 512) ST[e] = 0.f;
    float4 pr0, pr1, lr0, lr1;
    {
      const int sg = sq * sps + (dir ? sps - 1 : 0);
      const size_t cb = (size_t)((sg * 16 + hd) * 2 + dir) * 4096;
      pr0 = *(const float4*)(Pb + cb + TIDX * 8); pr1 = *(const float4*)(Pb + cb + TIDX * 8 + 4);
      lr0 = *(const float4*)(Lb + cb + (size_t)i * 64 + cgp * 8); lr1 = *(const float4*)(Lb + cb + (size_t)i * 64 + cgp * 8 + 4);
    }
    __syncthreads();
    for (int s = 0; s < sps; ++s) {
      const int sg = sq * sps + (dir ? sps - 1 - s : s);
      const size_t cb = (size_t)((sg * 16 + hd) * 2 + dir) * 4096;
      {
        float4 o0, o1;
        o0.x = ST[(cgp * 8 + 0) * 64 + i]; o0.y = ST[(cgp * 8 + 1) * 64 + i]; o0.z = ST[(cgp * 8 + 2) * 64 + i]; o0.w = ST[(cgp * 8 + 3) * 64 + i];
        o1.x = ST[(cgp * 8 + 4) * 64 + i]; o1.y = ST[(cgp * 8 + 5) * 64 + i]; o1.z = ST[(cgp * 8 + 6) * 64 + i]; o1.w = ST[(cgp * 8 + 7) * 64 + i];
        *(float4*)(SI + cb + (size_t)i * 64 + cgp * 8) = o0; *(float4*)(SI + cb + (size_t)i * 64 + cgp * 8 + 4) = o1;
      }
      *(float4*)(PL + TIDX * 8) = pr0; *(float4*)(PL + TIDX * 8 + 4) = pr1;
      float acc[8] = {lr0.x, lr0.y, lr0.z, lr0.w, lr1.x, lr1.y, lr1.z, lr1.w};
      LBAR();
      if (s + 1 < sps) {
        const int sg2 = sq * sps + (dir ? sps - 2 - s : s + 1);
        const size_t cb2 = (size_t)((sg2 * 16 + hd) * 2 + dir) * 4096;
        pr0 = *(const float4*)(Pb + cb2 + TIDX * 8); pr1 = *(const float4*)(Pb + cb2 + TIDX * 8 + 4);
        lr0 = *(const float4*)(Lb + cb2 + (size_t)i * 64 + cgp * 8); lr1 = *(const float4*)(Lb + cb2 + (size_t)i * 64 + cgp * 8 + 4);
      }
#pragma unroll 8
      for (int r = 0; r < 64; ++r) {
        const float sv = ST[r * 64 + i];
        const float4 p0 = *(const float4*)(PL + r * 64 + cgp * 8), p1 = *(const float4*)(PL + r * 64 + cgp * 8 + 4);
        acc[0] += sv * p0.x; acc[1] += sv * p0.y; acc[2] += sv * p0.z; acc[3] += sv * p0.w;
        acc[4] += sv * p1.x; acc[5] += sv * p1.y; acc[6] += sv * p1.z; acc[7] += sv * p1.w;
      }
      LBAR();
#pragma unroll
      for (int c = 0; c < 8; ++c) ST[(cgp * 8 + c) * 64 + i] = acc[c];
      LBAR();
    }
  }
  __syncthreads();
}

DEV void phase_tm_post(const Params& p, int j) {
  const int TIDX = opaque_tid();
  const int wid = TIDX >> 6, lane = TIDX & 63, c16 = lane & 15;
  bf16_t* Rb = (bf16_t*)(kws() + OFF_R);
  const bf16_t* Kb = (const bf16_t*)(kws() + OFF_K);
  const bf16_t* Vb = (const bf16_t*)(kws() + OFF_V);
  const bf16_t* A0 = (const bf16_t*)(kws() + OFF_A0);
  const bf16_t* A1 = (const bf16_t*)(kws() + OFF_A1);
  const bf16_t* Gb = (const bf16_t*)(kws() + OFF_G);
  const bf16_t* YF = (const bf16_t*)(kws() + OFF_YLF);
  const bf16_t* YB = (const bf16_t*)(kws() + OFF_YLB);
  const bf16_t* QF = (const bf16_t*)(kws() + OFF_QF);
  const bf16_t* QB = (const bf16_t*)(kws() + OFF_QB);
  const float* SI = (const float*)(kws() + OFF_SI);
  for (int item = blockIdx.x * 8 + wid; item < 2048; item += gridDim.x * 8) {
    const int quarter = item & 3, hd = (item >> 2) & 15, seg = item >> 6;
    const int cch = hd * 64 + lane;
    const float rk = kin(25)[(size_t)j * 1024 + cch], ka = kin(24)[(size_t)j * 1024 + cch];
    const float lg = kin(26)[(size_t)j * 1024 + cch], lb = kin(27)[(size_t)j * 1024 + cch];
    float SF[64], SBk[64];
    {
      const float* sf = SI + (size_t)((seg * 16 + hd) * 2 + 0) * 4096 + (size_t)lane * 64;
      const float* sb = SI + (size_t)((seg * 16 + hd) * 2 + 1) * 4096 + (size_t)lane * 64;
#pragma unroll
      for (int q = 0; q < 16; ++q) {
        const float4 a = *(const float4*)(sf + 4 * q), b = *(const float4*)(sb + 4 * q);
        SF[4 * q] = a.x; SF[4 * q + 1] = a.y; SF[4 * q + 2] = a.z; SF[4 * q + 3] = a.w;
        SBk[4 * q] = b.x; SBk[4 * q + 1] = b.y; SBk[4 * q + 2] = b.z; SBk[4 * q + 3] = b.w;
      }
    }
    struct PostRaw { uint2 qf, qb; bf16_t yf, yb, r, k, v, g, a0, a1; };
    const size_t obase = (size_t)(seg * 512 + quarter * 128) * 1024 + hd * 64;
    auto load_raw = [&](int tt, PostRaw& w) {
      const size_t o = obase + (size_t)(tt < 128 ? tt : 127) * 1024;
      w.qf = *(const uint2*)(QF + o + 4 * c16); w.qb = *(const uint2*)(QB + o + 4 * c16);
      w.yf = YF[o + lane]; w.yb = YB[o + lane]; w.r = Rb[o + lane]; w.k = Kb[o + lane]; w.v = Vb[o + lane]; w.g = Gb[o + lane];
      w.a0 = A0[o + lane]; w.a1 = A1[o + lane];
    };
    PostRaw w0, w1;
    load_raw(0, w0); load_raw(1, w1);
    for (int tt = 0; tt < 128; ++tt) {
      const size_t o = obase + (size_t)tt * 1024;
      PostRaw w2; load_raw(tt + 2, w2);
      const uint2 qfr = w0.qf, qbr = w0.qb;
      float qf[4], qb[4];
      qf[0] = __uint_as_float(qfr.x << 16); qf[1] = __uint_as_float(qfr.x & 0xffff0000u); qf[2] = __uint_as_float(qfr.y << 16); qf[3] = __uint_as_float(qfr.y & 0xffff0000u);
      qb[0] = __uint_as_float(qbr.x << 16); qb[1] = __uint_as_float(qbr.x & 0xffff0000u); qb[2] = __uint_as_float(qbr.y << 16); qb[3] = __uint_as_float(qbr.y & 0xffff0000u);
      float y0 = bf2f(w0.yf), y1 = bf2f(w0.yb);
      const float rj = bf2f(w0.r), kj = bf2f(w0.k), vj = bf2f(w0.v), gj = bf2f(w0.g);
      const float a0 = bf2f(w0.a0), a1 = bf2f(w0.a1);
      LAUNDER4(qf); LAUNDER4(qb);
#define PF_EL(J) fmac_bc<((J) >> 2)>(y0, qf[(J) & 3], SF[J]); fmac_bc<((J) >> 2)>(y1, qb[(J) & 3], SBk[J]);
      REP64(PF_EL)
      const float y = y0 + y1;
      const float mean = wave_sum(y) * (1.0f / 64.f);
      const float dy = y - mean;
      const float var = wave_sum(dy * dy) * (1.0f / 64.f);
      const float yn = dy * rsqrtf(var + 64e-5f) * lg + lb;
      const float bon = wave_sum(rj * rk * kj * ((1.0f + (a0 - 1.0f) * ka) + (1.0f + (a1 - 1.0f) * ka)));
      Rb[o + lane] = f2bf((yn + bon * vj) * gj);
      w0 = w1; w1 = w2;
    }
  }
}

DEV void wprep_sgu(const Params& p, int j) {
  wprep_T2((bf16_t*)(kws() + OFF_W + W_SG_IN), 1024, 0, kin(5) + (size_t)j * 1024 * 4096, 1024, 4096, nullptr, 128, 0);
  wprep_T2((bf16_t*)(kws() + OFF_W + W_SG_OUT), 2048, 0, kin(10) + (size_t)j * 2048 * 1024, 2048, 1024, nullptr, 128, 0);
}
DEV void wprep_ffn(const Params& p, int layer) {
  wprep_T2((bf16_t*)(kws() + OFF_W + W_FF_A), 1024, 0, kin(29) + (size_t)layer * 1024 * 2816, 1024, 2816, nullptr, 256, 0);
  wprep_T2((bf16_t*)(kws() + OFF_W + W_FF_A), 1024, 0, kin(30) + (size_t)layer * 1024 * 2816, 1024, 2816, nullptr, 256, 128);
  wprep_T2((bf16_t*)(kws() + OFF_W + W_FF_D), 2816, 0, kin(33) + (size_t)layer * 2816 * 1024, 2816, 1024, nullptr, 128, 0);
}
DEV void wprep_tm(const Params& p, int j) {
  const int TIDX = opaque_tid();
  bf16_t* WP = (bf16_t*)(kws() + OFF_W + W_TM_P);
  const float* mu = kin(11) + (size_t)j * 6 * 1024;
  const float* srcs[3] = {kin(12) + (size_t)j * 1048576, kin(13) + (size_t)j * 1048576, kin(14) + (size_t)j * 1048576};
  const int mus[3] = {0, 2, 3};
#pragma unroll
  for (int i = 0; i < 3; ++i) {
    wprep_T2(WP, 2048, 0, srcs[i], 1024, 1024, nullptr, 128, i * 1024);
    wprep_T2(WP, 2048, 1024, srcs[i], 1024, 1024, mu + mus[i] * 1024, 128, i * 1024);
  }
#pragma unroll
  for (int e = 0; e < 2; ++e) {
    const float* w1 = kin(16) + ((size_t)j * 2 + e) * 1024 * 64;
    wprep_T(WP, 2048, 0, w1, 1024, 64, nullptr, 128, 3072 + 64 * e);
    wprep_T(WP, 2048, 1024, w1, 1024, 64, mu + 1 * 1024, 128, 3072 + 64 * e);
    const float* a1 = kin(19) + ((size_t)j * 2 + e) * 1024 * 64;
    wprep_T(WP, 2048, 0, a1, 1024, 64, nullptr, 128, 3200 + 64 * e);
    wprep_T(WP, 2048, 1024, a1, 1024, 64, mu + 4 * 1024, 128, 3200 + 64 * e);
    wprep_T2((bf16_t*)(kws() + OFF_W + W_TM_W2) + (size_t)e * 1024 * 64, 64, 0, kin(17) + ((size_t)j * 2 + e) * 64 * 1024, 64, 1024, nullptr, 128, 0);
    wprep_T2((bf16_t*)(kws() + OFF_W + W_TM_A2) + (size_t)e * 1024 * 64, 64, 0, kin(20) + ((size_t)j * 2 + e) * 64 * 1024, 64, 1024, nullptr, 128, 0);
  }
  const float* g1 = kin(21) + (size_t)j * 1024 * 160;
  wprep_T(WP, 2048, 0, g1, 1024, 160, nullptr, 128, 3328);
  wprep_T(WP, 2048, 1024, g1, 1024, 160, mu + 5 * 1024, 128, 3328);
  for (size_t i = (size_t)blockIdx.x * 512 + TIDX; i < (size_t)96 * 2048 / 2; i += (size_t)gridDim.x * 512) ((unsigned*)(WP + (size_t)3488 * 2048))[i] = 0u;
  wprep_T((bf16_t*)(kws() + OFF_W + W_TM_G2), 160, 0, kin(22) + (size_t)j * 160 * 1024, 160, 1024, nullptr, 128, 0);
  wprep_T2((bf16_t*)(kws() + OFF_W + W_TM_O), 1024, 0, kin(28) + (size_t)j * 1048576, 1024, 1024, nullptr, 128, 0);
}

constexpr int PH_SGU = 10, PH_FFN = 3, PH_TM = 21;
constexpr int N_PHASES = 1 + 2 * (PH_SGU + PH_FFN) + 2 * (PH_TM + PH_FFN) + 1;

DEV void run_phase(const Params& p, int ph) {
  if (ph == 0) { phase_init(p); return; }
  if (ph == N_PHASES - 1) { phase_final(p); return; }
  int q = ph - 1, layer = 0;
  for (;;) {
    const int len = (layer & 1) ? PH_TM + PH_FFN : PH_SGU + PH_FFN;
    if (q < len) break;
    q -= len; ++layer;
  }
  const int j = layer >> 1;
  bf16_t* H0 = (bf16_t*)(kws() + OFF_H0);
  const int nmix = (layer & 1) ? PH_TM : PH_SGU;
  if (q >= nmix) {
    const int f = q - nmix;
    if (f == 0) { phase_norm(p, kin(3) + (size_t)layer * 1024, H0); wprep_ffn(p, layer); }
    else if (f == 1) phase_ffn_a(p, layer);
    else phase_gemm_res(p, (const bf16_t*)(kws() + OFF_HMID), 2816, (const bf16_t*)(kws() + OFF_W + W_FF_D), 2816, 192, 0);
    return;
  }
  if (!(layer & 1)) {
    if (q == 0) { phase_norm(p, kin(2) + (size_t)layer * 1024, H0); wprep_sgu(p, j); return; }
    const int slab = (q - 1) / 3, s = (q - 1) % 3;
    if (s == 0) phase_sgu_in(p, j, slab);
    else if (s == 1) phase_sgu_mix(p, j);
    else phase_gemm_res(p, (const bf16_t*)(kws() + OFF_U), 4096, (const bf16_t*)(kws() + OFF_W + W_SG_OUT), 2048, 64, (long)slab * SLAB);
    return;
  }
  {
    const int slab = q / 7, s = q % 7;
    switch (s) {
      case 0: phase_norm_tm(p, kin(2) + (size_t)layer * 1024, (bf16_t*)(kws() + OFF_HX), slab); if (slab == 0) wprep_tm(p, j); break;
      case 1: phase_tm_proj(p); break;
      case 2: phase_tm_lora_out(p, j); break;
      case 3: phase_scan(p, j, slab); break;
      case 4: phase_combine(p, slab); break;
      case 5: phase_tm_post(p, j); break;
      default: phase_gemm_res(p, (const bf16_t*)(kws() + OFF_R), 1024, (const bf16_t*)(kws() + OFF_W + W_TM_O), 1024, 64, (long)slab * SLAB); break;
    }
  }
}

#ifndef PROBE_CAT
#define PROBE_CAT -1
#endif
DEV int phase_cat(int ph) {
  if (ph == 0 || ph == N_PHASES - 1) return 2;
  int q = ph - 1, layer = 0;
  for (;;) { const int len = (layer & 1) ? PH_TM + PH_FFN : PH_SGU + PH_FFN; if (q < len) break; q -= len; ++layer; }
  const int nmix = (layer & 1) ? PH_TM : PH_SGU;
  if (q >= nmix) return (q - nmix) == 0 ? 2 : 0;
  if (!(layer & 1)) { if (q == 0) return 2; const int s = (q - 1) % 3; return s == 1 ? 3 : 0; }
  const int s = q % 7;
  return s == 0 ? 2 : (s == 1 || s == 6) ? 0 : (s == 2 ? 4 : (s == 3 ? 1 : (s == 4 ? 5 : 6)));
}
__global__ void __launch_bounds__(512, 2) mega(Params p, int ph_lo, int ph_hi, int coop) {
#if PROBE_CAT >= 0
  if (blockIdx.x == 0 && threadIdx.x == 0) ((unsigned long long*)(kws() + 480 * MiB))[0] = wall_clock64();
#endif
  for (int ph = ph_lo; ph < ph_hi; ++ph) {
    run_phase(p, ph);
    if (coop && ph + 1 < ph_hi) cg::this_grid().sync();
#if PROBE_CAT >= 0
    if (blockIdx.x == 0 && threadIdx.x == 0) ((unsigned long long*)(kws() + 480 * MiB))[ph + 1] = wall_clock64();
#endif
  }
#if PROBE_CAT >= 0
  cg::this_grid().sync();
  if (blockIdx.x == 0 && threadIdx.x == 0) {
    const unsigned long long* ts = (const unsigned long long*)(kws() + 480 * MiB);
    unsigned long long acc = 0;
    for (int ph = 0; ph < N_PHASES; ++ph) if (PROBE_CAT == 9 || phase_cat(ph) == PROBE_CAT) acc += ts[ph + 1] - ts[ph];
    kx()[0] += sqrtf((float)acc * (0.01f * 0.5f));
  }
#endif
}

extern "C" void kernel_launch(void* const* d_in, const int* in_sizes, int n_in, void* d_out, int out_size, void* d_ws, size_t ws_size, hipStream_t stream) {
  static int grid = 0;
  if (!grid) {
    int dev = 0, cus = 0, per_cu = 0;
    (void)hipFuncSetAttribute((const void*)mega, hipFuncAttributeMaxDynamicSharedMemorySize, SHM_BYTES);
    (void)hipGetDevice(&dev);
    (void)hipDeviceGetAttribute(&cus, hipDeviceAttributeMultiprocessorCount, dev);
    (void)hipOccupancyMaxActiveBlocksPerMultiprocessor(&per_cu, (const void*)mega, 512, SHM_BYTES);
    if (per_cu < 1) per_cu = 1;
    grid = cus * per_cu;
    if (grid > 256) grid = 256;
    if (grid & 7) grid &= ~7;
  }
  Params p{};
  for (int i = 0; i < 34; ++i) p.in[i] = (const float*)d_in[i];
  p.x = (float*)d_out;
  p.ws = (char*)d_ws;
  int ph_lo = 0, ph_hi = N_PHASES, coop = 1;
  void* args[] = {&p, &ph_lo, &ph_hi, &coop};
  hipError_t e = hipLaunchCooperativeKernel((const void*)mega, dim3(grid), dim3(512), args, SHM_BYTES, stream);
  if (e != hipSuccess) fprintf(stderr, "cooperative launch failed: %s (grid %d)\n", hipGetErrorString(e), grid);
}
```

```cpp
#define PROBE_CAT -1
#include <hip/hip_runtime.h>
#include <hip/hip_cooperative_groups.h>
#include <cstdio>
namespace cg = cooperative_groups;

#define DEV __device__ __forceinline__
typedef unsigned short bf16_t;
typedef short bf16x8 __attribute__((ext_vector_type(8)));
typedef float f32x4 __attribute__((ext_vector_type(4)));

extern __shared__ __attribute__((aligned(16))) char g_shm[];

constexpr int NT = 49152, SLAB = 16384;
constexpr int SHM_BYTES = 147456;
constexpr size_t MiB = 1u << 20;
constexpr size_t OFF_W = 0;
constexpr size_t OFF_H = 24 * MiB;
constexpr size_t OFF_H0 = OFF_H + 256 * 2048;
constexpr size_t OFF_U = 122 * MiB, OFF_SSQ = 250 * MiB;
constexpr size_t OFF_HMID = 122 * MiB;
constexpr size_t OFF_HX = 24 * MiB, OFF_YLF = 24 * MiB, OFF_YLB = 56 * MiB, OFF_R = 88 * MiB, OFF_K = 120 * MiB, OFF_V = 152 * MiB,
                 OFF_HL = 184 * MiB, OFF_E0 = 200 * MiB, OFF_E1 = 232 * MiB, OFF_A0 = 264 * MiB, OFF_A1 = 296 * MiB, OFF_G = 328 * MiB,
                 OFF_PSI = 360 * MiB, OFF_BON = 488 * MiB;
constexpr size_t W_SG_IN = 0, W_SG_OUT = 8 * MiB;
constexpr size_t W_FF_A = 0, W_FF_D = 12 * MiB;
constexpr size_t W_TM_P = 0, W_TM_O = 14 * MiB, W_TM_W2 = 16 * MiB, W_TM_A2 = 16 * MiB + 512 * 1024, W_TM_G2 = 17 * MiB;

struct Params {
  const float* in[34];
  float* x;
  char* ws;
};


typedef const __attribute__((address_space(4))) char* karg_t;
DEV int opaque0() { int z = 0; asm volatile("" : "+s"(z)); return z; }
DEV const float* kin(int i) { karg_t kp = (karg_t)__builtin_amdgcn_kernarg_segment_ptr(); return *(const float* const __attribute__((address_space(4)))*)(kp + (i + opaque0()) * 8); }
DEV float* kx() { karg_t kp = (karg_t)__builtin_amdgcn_kernarg_segment_ptr(); return *(float* const __attribute__((address_space(4)))*)(kp + (34 + opaque0()) * 8); }
DEV char* kws() { karg_t kp = (karg_t)__builtin_amdgcn_kernarg_segment_ptr(); return *(char* const __attribute__((address_space(4)))*)(kp + (35 + opaque0()) * 8); }

DEV int opaque_tid() { int z = 0; asm volatile("" : "+v"(z)); return (int)threadIdx.x + z; }
DEV float bf2f(bf16_t u) { return __uint_as_float(((unsigned)u) << 16); }
DEV bf16_t f2bf(float f) { unsigned u = __float_as_uint(f); u += 0x7fffu + ((u >> 16) & 1u); return (bf16_t)(u >> 16); }
DEV unsigned pack2(float a, float b) { return (unsigned)f2bf(a) | ((unsigned)f2bf(b) << 16); }
template <int CTRL> DEV float dppmov(float v) { return __int_as_float(__builtin_amdgcn_update_dpp(0, __float_as_int(v), CTRL, 0xf, 0xf, true)); }
DEV float row_sum16(float v) {
  v += dppmov<0xB1>(v); v += dppmov<0x4E>(v); v += dppmov<0x141>(v); v += dppmov<0x140>(v);
  return v;
}
DEV float wave_sum(float v) {
  const int r = __float_as_int(row_sum16(v));
  return (__int_as_float(__builtin_amdgcn_readlane(r, 0)) + __int_as_float(__builtin_amdgcn_readlane(r, 16))) +
         (__int_as_float(__builtin_amdgcn_readlane(r, 32)) + __int_as_float(__builtin_amdgcn_readlane(r, 48)));
}
DEV float sigmoidf_(float x) { return 1.0f / (1.0f + __expf(-x)); }
DEV float gelu_exact(float v) {
  const float av = fabsf(v), d = av * 0.2316418882f + 1.0f;
  const float t = __builtin_amdgcn_rcpf(d);
  float q = t * 0.5307027145f + (-0.7265760135f); q = q * t + 0.7107068705f; q = q * t + (-0.142248368f); q = q * t + 0.127414796f; q = q * t;
  const float e = __builtin_amdgcn_exp2f((v * v) * (-0.72134752044f));
  const float m = v * (q * e), r = v - m;
  return v < 0.f ? m : r;
}

DEV void phase_init(const Params& p) {
  const int TIDX = opaque_tid();
  const float4* xp = (const float4*)kin(0);
  const float4* xs = (const float4*)kin(1);
  float4* x = (float4*)kx();
  const size_t n0 = (size_t)32768 * 256, n1 = (size_t)16384 * 256;
  for (size_t i = (size_t)blockIdx.x * 512 + TIDX; i < n0 + n1; i += (size_t)gridDim.x * 512) x[i] = i < n0 ? xp[i] : xs[i - n0];
}

DEV void phase_norm(const Params& p, const float* g, bf16_t* h0) {
  const int TIDX = opaque_tid();
  const int wid = TIDX >> 6, lane = TIDX & 63;
  float4 gv[4];
#pragma unroll
  for (int i = 0; i < 4; ++i) gv[i] = ((const float4*)g)[lane + 64 * i];
  for (int t = blockIdx.x * 8 + wid; t < NT; t += gridDim.x * 8) {
    const float4* xr = (const float4*)(kx() + (size_t)t * 1024);
    float4 v[4]; float ss = 0.f;
#pragma unroll
    for (int i = 0; i < 4; ++i) { v[i] = xr[lane + 64 * i]; ss += v[i].x * v[i].x + v[i].y * v[i].y + v[i].z * v[i].z + v[i].w * v[i].w; }
    ss = wave_sum(ss);
    const float rs = rsqrtf(ss * (1.0f / 1024.f) + 1e-6f);
    uint2* hr = (uint2*)(h0 + (size_t)t * 1024);
#pragma unroll
    for (int i = 0; i < 4; ++i) {
      uint2 o; o.x = pack2(v[i].x * rs * gv[i].x, v[i].y * rs * gv[i].y); o.y = pack2(v[i].z * rs * gv[i].z, v[i].w * rs * gv[i].w);
      hr[lane + 64 * i] = o;
    }
  }
}

DEV void phase_norm_tm(const Params& p, const float* g, bf16_t* hx, int slab) {
  const int TIDX = opaque_tid();
  const int wid = TIDX >> 6, lane = TIDX & 63;
  const int L = slab < 2 ? 16384 : 2048;
  float4 gv[4];
#pragma unroll
  for (int i = 0; i < 4; ++i) gv[i] = ((const float4*)g)[lane + 64 * i];
  for (int ts = blockIdx.x * 8 + wid; ts < SLAB; ts += gridDim.x * 8) {
    const int t = slab * SLAB + ts, pos = ts & (L - 1);
    float4 hv[3][4];
#pragma unroll
    for (int d = 0; d < 3; ++d) {
      const bool valid = !((d == 0 && pos == 0) || (d == 2 && pos == L - 1));
      const int tt = valid ? t + d - 1 : t;
      const float4* xr = (const float4*)(kx() + (size_t)tt * 1024);
      float ss = 0.f;
#pragma unroll
      for (int i = 0; i < 4; ++i) { float4 v = xr[lane + 64 * i]; hv[d][i] = v; ss += v.x * v.x + v.y * v.y + v.z * v.z + v.w * v.w; }
      ss = wave_sum(ss);
      const float rs = valid ? rsqrtf(ss * (1.0f / 1024.f) + 1e-6f) : 0.f;
#pragma unroll
      for (int i = 0; i < 4; ++i) { hv[d][i].x *= rs * gv[i].x; hv[d][i].y *= rs * gv[i].y; hv[d][i].z *= rs * gv[i].z; hv[d][i].w *= rs * gv[i].w; }
    }
    uint2* hr = (uint2*)(hx + (size_t)ts * 2048);
#pragma unroll
    for (int i = 0; i < 4; ++i) {
      uint2 o; o.x = pack2(hv[1][i].x, hv[1][i].y); o.y = pack2(hv[1][i].z, hv[1][i].w);
      hr[lane + 64 * i] = o;
      uint2 q;
      q.x = pack2(0.5f * (hv[0][i].x + hv[2][i].x) - hv[1][i].x, 0.5f * (hv[0][i].y + hv[2][i].y) - hv[1][i].y);
      q.y = pack2(0.5f * (hv[0][i].z + hv[2][i].z) - hv[1][i].z, 0.5f * (hv[0][i].w + hv[2][i].w) - hv[1][i].w);
      hr[256 + lane + 64 * i] = q;
    }
  }
}

DEV void phase_final(const Params& p) {
  const int TIDX = opaque_tid();
  const int wid = TIDX >> 6, lane = TIDX & 63;
  const float* g = kin(4);
  float4 gv[4];
#pragma unroll
  for (int i = 0; i < 4; ++i) gv[i] = ((const float4*)g)[lane + 64 * i];
  for (int t = blockIdx.x * 8 + wid; t < NT; t += gridDim.x * 8) {
    float4* xr = (float4*)(kx() + (size_t)t * 1024);
    float4 v[4]; float ss = 0.f;
#pragma unroll
    for (int i = 0; i < 4; ++i) { v[i] = xr[lane + 64 * i]; ss += v[i].x * v[i].x + v[i].y * v[i].y + v[i].z * v[i].z + v[i].w * v[i].w; }
    ss = wave_sum(ss);
    const float rs = rsqrtf(ss * (1.0f / 1024.f) + 1e-6f);
#pragma unroll
    for (int i = 0; i < 4; ++i) {
      float4 o; o.x = v[i].x * rs * gv[i].x; o.y = v[i].y * rs * gv[i].y; o.z = v[i].z * rs * gv[i].z; o.w = v[i].w * rs * gv[i].w;
      xr[lane + 64 * i] = o;
    }
  }
}

DEV void wprep_T(bf16_t* dst, int ldd, int koff, const float* src, int Ks, int Ns, const float* scale, int rs, int roff) {
  const int TIDX = opaque_tid();
  float (*tile)[33] = (float (*)[33])g_shm;
  const int tx = TIDX & 31, ty = TIDX >> 5;
  const int nkt = Ks / 32, nnt = Ns / 32;
  for (int tIdx = blockIdx.x; tIdx < nkt * nnt; tIdx += gridDim.x) {
    const int k0 = (tIdx / nnt) * 32, n0 = (tIdx % nnt) * 32;
    __syncthreads();
#pragma unroll
    for (int i = 0; i < 2; ++i) tile[ty + 16 * i][tx] = src[(size_t)(k0 + ty + 16 * i) * Ns + n0 + tx];
    __syncthreads();
    const float sc = scale ? scale[k0 + tx] : 1.0f;
#pragma unroll
    for (int i = 0; i < 2; ++i) {
      const int n = n0 + ty + 16 * i;
      const int drow = (n >> 7) * rs + (n & 127) + roff;
      dst[(size_t)drow * ldd + koff + k0 + tx] = f2bf(tile[tx][ty + 16 * i] * sc);
    }
  }
  __syncthreads();
}


DEV void wprep_T2(bf16_t* dst, int ldd, int koff, const float* src, int Ks, int Ns, const float* scale, int rs, int roff) {
  const int TIDX = opaque_tid();
  float* tile = (float*)g_shm;
  const int nkt = Ks / 64, nnt = Ns / 128;
  const int lc = TIDX & 127, lr = TIDX >> 7;
  const int wk = TIDX & 63, wn = TIDX >> 6;
  for (int tIdx = blockIdx.x; tIdx < nkt * nnt; tIdx += gridDim.x) {
    const int k0 = (tIdx / nnt) * 64, n0 = (tIdx % nnt) * 128;
    float v[16];
#pragma unroll
    for (int i = 0; i < 16; ++i) v[i] = src[(size_t)(k0 + i * 4 + lr) * Ns + n0 + lc];
    __syncthreads();
#pragma unroll
    for (int i = 0; i < 16; ++i) tile[(i * 4 + lr) * 129 + lc] = v[i];
    __syncthreads();
    const float sc = scale ? scale[k0 + wk] : 1.0f;
#pragma unroll
    for (int i = 0; i < 16; ++i) {
      const int n = n0 + i * 8 + wn;
      const int drow = (n >> 7) * rs + (n & 127) + roff;
      dst[(size_t)drow * ldd + koff + k0 + wk] = f2bf(tile[wk * 129 + i * 8 + wn] * sc);
    }
  }
  __syncthreads();
}

constexpr int BM = 256, BK = 64, HALF = 128, HT = HALF * BK;
DEV int lds_byte(int r, int c) {
  int st = (r >> 4) * 2 + (c >> 5), rr = r & 15, cc = c & 31, ob = rr * 64 + cc * 2;
  return st * 1024 + (ob ^ (((ob >> 9) & 1) << 5));
}
DEV void stage_rc(int b, int& R, int& C) {
  int st = b / 1024, sb = b % 1024, swz = sb ^ (((sb >> 9) & 1) << 5);
  R = (st >> 1) * 16 + swz / 64; C = (st & 1) * 32 + (swz % 64) / 2;
}

typedef __attribute__((address_space(3))) unsigned char lds_u8;
DEV void gemm_big(const bf16_t* A, long lda, const bf16_t* Bt, long ldb, int K, long brow, long bcol, f32x4 (&acc)[2][2][4][2]) {
  const int TIDX = opaque_tid();
  lds_u8* lds = (lds_u8*)g_shm;
  constexpr int HTB = HT * 2;
#define SA(b, h) (((b) * 2 + (h)) * HTB)
#define SB(b, h) ((4 + (b) * 2 + (h)) * HTB)
#define STAGE(bufoff, gbase, VO, kt) do { const char* _gp = (gbase) + (size_t)(kt) * (BK * 2); \
    __builtin_amdgcn_global_load_lds((const unsigned*)(_gp + VO##0), (__attribute__((address_space(3))) unsigned*)(lds + (bufoff) + ldsw), 16, 0, 0); \
    __builtin_amdgcn_global_load_lds((const unsigned*)(_gp + VO##1), (__attribute__((address_space(3))) unsigned*)(lds + (bufoff) + ldsw + 8192), 16, 0, 0); } while (0)
#define LDA(dst, b, h) for (int m = 0; m < 4; ++m) for (int k = 0; k < 2; ++k) \
    dst[m][k] = *(const __attribute__((address_space(3))) bf16x8*)(lds + SA(b, h) + aoff + m * 2048 + k * 1024)
#define LDB(dst, b, h) for (int n = 0; n < 2; ++n) for (int k = 0; k < 2; ++k) \
    dst[n][k] = *(const __attribute__((address_space(3))) bf16x8*)(lds + SB(b, h) + boff + n * 2048 + k * 1024)
#define MMA(ai, bj, At, Bt_) do { __builtin_amdgcn_s_setprio(1); \
    for (int m = 0; m < 4; ++m) for (int n = 0; n < 2; ++n) for (int k = 0; k < 2; ++k) \
      acc[ai][bj][m][n] = __builtin_amdgcn_mfma_f32_16x16x32_bf16(At[m][k], Bt_[n][k], acc[ai][bj][m][n], 0, 0, 0); \
    __builtin_amdgcn_s_setprio(0); } while (0)
#define WAIT_V(n) asm volatile("s_waitcnt vmcnt(" #n ")" ::: "memory")
#define WAIT_L(n) asm volatile("s_waitcnt lgkmcnt(" #n ")" ::: "memory")
#define BAR __builtin_amdgcn_s_barrier()
#define SCHED __builtin_amdgcn_sched_barrier(0)
  const int tid = TIDX, wid = __builtin_amdgcn_readfirstlane(tid >> 6), lane = tid & 63, wr = wid >> 2, wc = wid & 3, fr = lane & 15, fq = lane >> 4;
  unsigned va0, va1, vb0, vb1;
  { int r_, c_; stage_rc(tid * 16, r_, c_); va0 = (unsigned)((r_ * lda + c_) * 2); vb0 = (unsigned)((r_ * ldb + c_) * 2);
    stage_rc(tid * 16 + 8192, r_, c_); va1 = (unsigned)((r_ * lda + c_) * 2); vb1 = (unsigned)((r_ * ldb + c_) * 2); }
  const unsigned ldsw = (unsigned)wid * 1024u;
  const int aoff = lds_byte(wr * 64 + fr, fq * 8), boff = lds_byte(wc * 32 + fr, fq * 8);
  const char* cA0 = (const char*)(A + brow * lda); const char* cA1 = cA0 + (size_t)HALF * lda * 2;
  const char* cB0 = (const char*)(Bt + bcol * ldb); const char* cB1 = cB0 + (size_t)HALF * ldb * 2;
#pragma unroll
  for (int a = 0; a < 2; ++a)
#pragma unroll
    for (int b = 0; b < 2; ++b)
#pragma unroll
      for (int m = 0; m < 4; ++m)
#pragma unroll
        for (int n = 0; n < 2; ++n) acc[a][b][m][n] = (f32x4){0.f, 0.f, 0.f, 0.f};
  bf16x8 At[4][2], B0[2][2], B1[2][2];
  const int nt = K / BK;
  STAGE(SB(0, 0), cB0, vb, 0); STAGE(SA(0, 0), cA0, va, 0);
  STAGE(SB(0, 1), cB1, vb, 0); STAGE(SA(0, 1), cA1, va, 0);
  if (wr == 1) BAR;
  WAIT_V(4); BAR;
  STAGE(SB(1, 0), cB0, vb, 1); STAGE(SA(1, 0), cA0, va, 1); STAGE(SB(1, 1), cB1, vb, 1);
  WAIT_V(6); BAR;
  for (int t = 0; t < nt - 2; t += 2) {
    LDB(B0, 0, 0); SCHED; LDA(At, 0, 0); STAGE(SA(1, 1), cA1, va, t + 1);
    WAIT_L(8); BAR; WAIT_L(0); MMA(0, 0, At, B0); BAR; SCHED;
    LDB(B1, 0, 1); STAGE(SB(0, 0), cB0, vb, t + 2);
    BAR; WAIT_L(0); MMA(0, 1, At, B1); BAR;
    LDA(At, 0, 1); STAGE(SA(0, 0), cA0, va, t + 2);
    BAR; WAIT_L(0); MMA(1, 0, At, B0); BAR; SCHED;
    STAGE(SB(0, 1), cB1, vb, t + 2);
    WAIT_V(6); BAR; MMA(1, 1, At, B1); BAR;
    LDB(B0, 1, 0); SCHED; LDA(At, 1, 0); STAGE(SA(0, 1), cA1, va, t + 2);
    WAIT_L(8); BAR; WAIT_L(0); MMA(0, 0, At, B0); BAR; SCHED;
    LDB(B1, 1, 1); STAGE(SB(1, 0), cB0, vb, t + 3);
    BAR; WAIT_L(0); MMA(0, 1, At, B1); BAR;
    LDA(At, 1, 1); STAGE(SA(1, 0), cA0, va, t + 3);
    BAR; WAIT_L(0); MMA(1, 0, At, B0); BAR; SCHED;
    STAGE(SB(1, 1), cB1, vb, t + 3);
    WAIT_V(6); BAR; MMA(1, 1, At, B1); BAR;
  }
  { LDB(B0, 0, 0); LDA(At, 0, 0); STAGE(SA(1, 1), cA1, va, nt - 1);
    BAR; WAIT_L(0); MMA(0, 0, At, B0); BAR;
    LDB(B1, 0, 1); BAR; WAIT_L(0); MMA(0, 1, At, B1); BAR;
    LDA(At, 0, 1); WAIT_V(4); BAR; WAIT_L(0); MMA(1, 0, At, B0); MMA(1, 1, At, B1); BAR; }
  { LDB(B0, 1, 0); LDA(At, 1, 0); WAIT_V(2); BAR; WAIT_L(0); MMA(0, 0, At, B0); BAR;
    LDB(B1, 1, 1); WAIT_V(0); BAR; WAIT_L(0); MMA(0, 1, At, B1); BAR;
    LDA(At, 1, 1); BAR; WAIT_L(0); MMA(1, 0, At, B0); MMA(1, 1, At, B1); BAR; }
  if (wr == 0) BAR;
}
DEV void dump_half(const f32x4 (&acc)[2][2][4][2], int ai, int tid) {
  float* T = (float*)g_shm;
  const int wid = tid >> 6, lane = tid & 63, wr = wid >> 2, wc = wid & 3, fr = lane & 15, fq = lane >> 4;
#pragma unroll
  for (int bj = 0; bj < 2; ++bj)
#pragma unroll
    for (int m = 0; m < 4; ++m)
#pragma unroll
      for (int n = 0; n < 2; ++n)
#pragma unroll
        for (int jj = 0; jj < 4; ++jj) {
          const int r = wr * 64 + m * 16 + fq * 4 + jj, c = bj * 128 + wc * 32 + n * 16 + fr;
          T[r * 256 + (c ^ (fq << 4))] = (ai == 0) ? acc[0][bj][m][n][jj] : acc[1][bj][m][n][jj];
        }
}
DEV float4 tile_ld4(int r, int c4) { return *(const float4*)((const float*)g_shm + r * 256 + (c4 ^ (((r >> 2) & 3) << 4))); }
DEV float tile_ld(int r, int c) { return ((const float*)g_shm)[r * 256 + (c ^ (((r >> 2) & 3) << 4))]; }

DEV int vblock() { return (blockIdx.x & 7) * (gridDim.x >> 3) + (blockIdx.x >> 3); }

DEV void phase_gemm_res(const Params& p, const bf16_t* A, long lda, const bf16_t* Bt, int K, int mtiles, long xrow0) {
  float* X = kx();
  for (int tile = vblock(); tile < mtiles * 4; tile += gridDim.x) {
    const int pm = tile >> 2, pn = tile & 3;
    f32x4 acc[2][2][4][2];
    gemm_big(A, lda, Bt, K, K, (long)pm * 256, (long)pn * 256, acc);
    const int tid = opaque_tid();
#pragma unroll
    for (int ai = 0; ai < 2; ++ai) {
      __syncthreads();
      dump_half(acc, ai, tid);
      __syncthreads();
      for (int e = tid; e < 128 * 64; e += 512) {
        const int r = e >> 6, c4 = (e & 63) * 4;
        const float4 v = tile_ld4(r, c4);
        float4* q = (float4*)(X + (xrow0 + pm * 256 + ai * 128 + r) * 1024 + pn * 256 + c4);
        float4 o = *q; o.x += v.x; o.y += v.y; o.z += v.z; o.w += v.w; *q = o;
      }
    }
    __syncthreads();
  }
}

DEV void phase_sgu_in(const Params& p, int j, int slab) {
  const bf16_t* A = (const bf16_t*)(kws() + OFF_H0) + (size_t)slab * SLAB * 1024;
  const bf16_t* Bt = (const bf16_t*)(kws() + OFF_W + W_SG_IN);
  const float* bin = kin(6) + (size_t)j * 4096;
  bf16_t* Z = (bf16_t*)(kws() + OFF_U);
  float* SSQ = (float*)(kws() + OFF_SSQ);
  for (int tile = vblock(); tile < 64 * 16; tile += gridDim.x) {
    const int pm = tile >> 4, pn = tile & 15;
    f32x4 acc[2][2][4][2];
    gemm_big(A, 1024, Bt, 1024, 1024, (long)pm * 256, (long)pn * 256, acc);
    const int tid = opaque_tid(), wid = tid >> 6, lane = tid & 63;
    const float4 b4 = *(const float4*)(bin + pn * 256 + lane * 4);
#pragma unroll
    for (int ai = 0; ai < 2; ++ai) {
      __syncthreads();
      dump_half(acc, ai, tid);
      __syncthreads();
      for (int rr = 0; rr < 16; ++rr) {
        const int r = wid * 16 + rr;
        const float4 v = tile_ld4(r, lane * 4);
        const float z0 = gelu_exact(v.x + b4.x), z1 = gelu_exact(v.y + b4.y), z2 = gelu_exact(v.z + b4.z), z3 = gelu_exact(v.w + b4.w);
        const int row = pm * 256 + ai * 128 + r;
        uint2 o; o.x = pack2(z0, z1); o.y = pack2(z2, z3);
        *(uint2*)(Z + (size_t)row * 4096 + pn * 256 + lane * 4) = o;
        if (pn >= 8) {
          const float ss = wave_sum(z0 * z0 + z1 * z1 + z2 * z2 + z3 * z3);
          if (lane == 0) SSQ[(size_t)row * 8 + (pn - 8)] = ss;
        }
      }
    }
    __syncthreads();
  }
}

DEV void phase_tm_proj(const Params& p) {
  const bf16_t* A = (const bf16_t*)(kws() + OFF_HX);
  const bf16_t* Bt = (const bf16_t*)(kws() + OFF_W + W_TM_P);
  for (int tile = vblock(); tile < 64 * 14; tile += gridDim.x) {
    const int pm = tile / 14, pn = tile % 14;
    f32x4 acc[2][2][4][2];
    gemm_big(A, 2048, Bt, 2048, 2048, (long)pm * 256, (long)pn * 256, acc);
    const int tid = opaque_tid(), wid = tid >> 6, lane = tid & 63;
    bf16_t* O; int ld, cb;
    if (pn < 12) { O = (bf16_t*)(kws() + (pn < 4 ? OFF_R : (pn < 8 ? OFF_K : OFF_V))); ld = 1024; cb = (pn & 3) * 256; }
    else { O = (bf16_t*)(kws() + OFF_HL); ld = 512; cb = (pn - 12) * 256; }
    const int act = pn < 12 ? 0 : (pn == 12 ? (lane < 32 ? 1 : 0) : 2);
#pragma unroll
    for (int ai = 0; ai < 2; ++ai) {
      __syncthreads();
      dump_half(acc, ai, tid);
      __syncthreads();
      for (int rr = 0; rr < 16; ++rr) {
        const int r = wid * 16 + rr;
        float4 v = tile_ld4(r, lane * 4);
        if (act == 1) { v.x = tanhf(v.x); v.y = tanhf(v.y); v.z = tanhf(v.z); v.w = tanhf(v.w); }
        else if (act == 2) { v.x = sigmoidf_(v.x); v.y = sigmoidf_(v.y); v.z = sigmoidf_(v.z); v.w = sigmoidf_(v.w); }
        uint2 o; o.x = pack2(v.x, v.y); o.y = pack2(v.z, v.w);
        *(uint2*)(O + (size_t)(pm * 256 + ai * 128 + r) * ld + cb + lane * 4) = o;
      }
    }
    __syncthreads();
  }
}

DEV void phase_ffn_a(const Params& p, int layer) {
  const bf16_t* A = (const bf16_t*)(kws() + OFF_H0);
  const bf16_t* Bt = (const bf16_t*)(kws() + OFF_W + W_FF_A);
  bf16_t* HM = (bf16_t*)(kws() + OFF_HMID);
  const float* cw = kin(31) + (size_t)layer * 3 * 2816;
  const float* cb = kin(32) + (size_t)layer * 2816;
  float* UP = (float*)g_shm;
  bf16_t* gl = (bf16_t*)(g_shm + 65536);
  for (int tile = vblock(); tile < 202 * 22; tile += gridDim.x) {
    const int mi = tile / 22, pn = tile % 22;
    int base, L, i;
    if (mi < 130) { base = (mi / 65) * 16384; L = 16384; i = mi % 65; }
    else { const int m2 = mi - 130; base = 32768 + (m2 / 9) * 2048; L = 2048; i = m2 % 9; }
    const int s0 = 254 * i - 1;
    f32x4 acc[2][2][4][2];
    gemm_big(A, 1024, Bt, 1024, 1024, (long)base + s0, (long)pn * 256, acc);
    const int tid = opaque_tid(), wid = tid >> 6, lane = tid & 63, wr = wid >> 2, wc = wid & 3, fr = lane & 15, fq = lane >> 4;
    __syncthreads();
#pragma unroll
    for (int ai = 0; ai < 2; ++ai)
#pragma unroll
      for (int m = 0; m < 4; ++m)
#pragma unroll
        for (int n = 0; n < 2; ++n)
#pragma unroll
          for (int jj = 0; jj < 4; ++jj) {
            const int r = ai * 128 + wr * 64 + m * 16 + fq * 4 + jj, c = wc * 32 + n * 16 + fr;
            const int s = s0 + r;
            gl[r * 128 + c] = (s >= 0 && s < L) ? f2bf(acc[ai][0][m][n][jj]) : (bf16_t)0;
          }
    const int c4 = (lane & 31) * 4, f = pn * 128 + c4;
    const float4 w0 = *(const float4*)(cw + f), w1 = *(const float4*)(cw + 2816 + f), w2 = *(const float4*)(cw + 2 * 2816 + f), bb = *(const float4*)(cb + f);
#pragma unroll
    for (int ai = 0; ai < 2; ++ai) {
      __syncthreads();
#pragma unroll
      for (int m = 0; m < 4; ++m)
#pragma unroll
        for (int n = 0; n < 2; ++n)
#pragma unroll
          for (int jj = 0; jj < 4; ++jj) {
            const int r = wr * 64 + m * 16 + fq * 4 + jj, c = wc * 32 + n * 16 + fr;
            UP[r * 128 + (c ^ (fq << 4))] = (ai == 0) ? acc[0][1][m][n][jj] : acc[1][1][m][n][jj];
          }
      __syncthreads();
      for (int e = tid; e < 128 * 32; e += 512) {
        const int rl = e >> 5, r = ai * 128 + rl, s = s0 + r;
        if (r >= 1 && r <= 254 && s < L) {
          const float4 u = *(const float4*)(UP + rl * 128 + (c4 ^ (((rl >> 2) & 3) << 4)));
          const uint2 g0 = *(const uint2*)(gl + (r - 1) * 128 + c4), g1 = *(const uint2*)(gl + r * 128 + c4), g2 = *(const uint2*)(gl + (r + 1) * 128 + c4);
          const float c0 = w0.x * __uint_as_float(g0.x << 16) + w1.x * __uint_as_float(g1.x << 16) + w2.x * __uint_as_float(g2.x << 16) + bb.x;
          const float c1 = w0.y * __uint_as_float(g0.x & 0xffff0000u) + w1.y * __uint_as_float(g1.x & 0xffff0000u) + w2.y * __uint_as_float(g2.x & 0xffff0000u) + bb.y;
          const float c2 = w0.z * __uint_as_float(g0.y << 16) + w1.z * __uint_as_float(g1.y << 16) + w2.z * __uint_as_float(g2.y << 16) + bb.z;
          const float c3 = w0.w * __uint_as_float(g0.y & 0xffff0000u) + w1.w * __uint_as_float(g1.y & 0xffff0000u) + w2.w * __uint_as_float(g2.y & 0xffff0000u) + bb.w;
          uint2 o; o.x = pack2(gelu_exact(c0) * u.x, gelu_exact(c1) * u.y); o.y = pack2(gelu_exact(c2) * u.z, gelu_exact(c3) * u.w);
          *(uint2*)(HM + (size_t)(base + s) * 2816 + f) = o;
        }
      }
    }
    __syncthreads();
  }
}

template <int KP>
DEV void small_mma(f32x4 (&acc)[4][4]) {
  const int TIDX = opaque_tid();
  constexpr int LD = KP + 8;
  const bf16_t* sA = (const bf16_t*)g_shm;
  const bf16_t* sB = sA + 128 * LD;
  const int wid = TIDX >> 6, lane = TIDX & 63, wr = wid >> 2, wc = wid & 3, fr = lane & 15, fq = lane >> 4;
#pragma unroll
  for (int m = 0; m < 4; ++m)
#pragma unroll
    for (int n = 0; n < 4; ++n) acc[m][n] = (f32x4){0.f, 0.f, 0.f, 0.f};
#pragma unroll
  for (int kk = 0; kk < KP / 32; ++kk) {
    bf16x8 a[4], b[4];
#pragma unroll
    for (int m = 0; m < 4; ++m) a[m] = *(const bf16x8*)(sA + (wr * 64 + m * 16 + fr) * LD + kk * 32 + fq * 8);
#pragma unroll
    for (int n = 0; n < 4; ++n) b[n] = *(const bf16x8*)(sB + (wc * 64 + n * 16 + fr) * LD + kk * 32 + fq * 8);
#pragma unroll
    for (int m = 0; m < 4; ++m)
#pragma unroll
      for (int n = 0; n < 4; ++n) acc[m][n] = __builtin_amdgcn_mfma_f32_16x16x32_bf16(a[m], b[n], acc[m][n], 0, 0, 0);
  }
}
template <int KP>
DEV void small_load(bf16_t* s, const bf16_t* g, long ld, int rows) {
  const int TIDX = opaque_tid();
  constexpr int LD = KP + 8, CPR = KP / 8;
  for (int c = TIDX; c < rows * CPR; c += 512) {
    const int r = c / CPR, k8 = (c % CPR) * 8;
    *(uint4*)(s + r * LD + k8) = *(const uint4*)(g + (long)r * ld + k8);
  }
}

DEV void phase_sgu_mix(const Params& p, int j) {
  const int TIDX = opaque_tid();
  constexpr int KP = 128, LD = KP + 8;
  const int wid = TIDX >> 6, lane = TIDX & 63, wr = wid >> 2, wc = wid & 3, fr = lane & 15, fq = lane >> 4;
  bf16_t* sA = (bf16_t*)g_shm;
  bf16_t* sB = sA + 128 * LD;
  float* rsv = (float*)(g_shm + (128 + 256) * LD * 2);
  bf16_t* Z = (bf16_t*)(kws() + OFF_U);
  const float* SSQ = (const float*)(kws() + OFF_SSQ);
  const float* ws_ = kin(8) + (size_t)j * 8 * 128 * 128;
  const float* bs = kin(9) + (size_t)j * 8 * 128;
  const float* ng = kin(7) + (size_t)j * 2048;
  for (int unit = blockIdx.x; unit < 128 * 8; unit += gridDim.x) {
    const int chunk = unit >> 3, g = unit & 7;
    __syncthreads();
    if (TIDX < 128) {
      const float* sp = SSQ + (size_t)(chunk * 128 + TIDX) * 8;
      float s = 0.f;
      for (int i = 0; i < 8; ++i) s += sp[i];
      rsv[TIDX] = rsqrtf(s * (1.0f / 2048.f) + 1e-6f);
    }
    for (int e = TIDX; e < 128 * 32; e += 512) {
      const int pp = e >> 5, c8 = (e & 31) * 8;
      const uint4 v = *(const uint4*)(Z + (size_t)(chunk * 128 + pp) * 4096 + 2048 + g * 256 + c8);
      sB[(c8 + 0) * LD + pp] = (bf16_t)(v.x & 0xffff); sB[(c8 + 1) * LD + pp] = (bf16_t)(v.x >> 16);
      sB[(c8 + 2) * LD + pp] = (bf16_t)(v.y & 0xffff); sB[(c8 + 3) * LD + pp] = (bf16_t)(v.y >> 16);
      sB[(c8 + 4) * LD + pp] = (bf16_t)(v.z & 0xffff); sB[(c8 + 5) * LD + pp] = (bf16_t)(v.z >> 16);
      sB[(c8 + 6) * LD + pp] = (bf16_t)(v.w & 0xffff); sB[(c8 + 7) * LD + pp] = (bf16_t)(v.w >> 16);
    }
    __syncthreads();
    for (int c = TIDX; c < 128 * 16; c += 512) {
      const int q = c >> 4, p8 = (c & 15) * 8;
      const float4* wp = (const float4*)(ws_ + ((size_t)g * 128 + q) * 128 + p8);
      const float4 w0 = wp[0], w1 = wp[1];
      uint4 o;
      o.x = pack2(w0.x * rsv[p8 + 0], w0.y * rsv[p8 + 1]); o.y = pack2(w0.z * rsv[p8 + 2], w0.w * rsv[p8 + 3]);
      o.z = pack2(w1.x * rsv[p8 + 4], w1.y * rsv[p8 + 5]); o.w = pack2(w1.z * rsv[p8 + 6], w1.w * rsv[p8 + 7]);
      *(uint4*)(sA + q * LD + p8) = o;
    }
    __syncthreads();
    f32x4 acc[4][4];
    small_mma<KP>(acc);
#pragma unroll
    for (int m = 0; m < 4; ++m)
#pragma unroll
      for (int n = 0; n < 4; ++n) {
        const int c = g * 256 + wc * 64 + n * 16 + fr;
        const float gg = ng[c];
#pragma unroll
        for (int jj = 0; jj < 4; ++jj) {
          const int q = wr * 64 + m * 16 + fq * 4 + jj;
          const float mix = acc[m][n][jj] * gg + bs[g * 128 + q];
          bf16_t* up = Z + (size_t)(chunk * 128 + q) * 4096 + c;
          *up = f2bf(bf2f(*up) * mix);
        }
      }
  }
  __syncthreads();
}

template <int KP>
DEV void lora_out_unit(const Params& p, int j, int kind, int mt, int ntile) {
  const int TIDX = opaque_tid();
  constexpr int LD = KP + 8;
  const int wid = TIDX >> 6, lane = TIDX & 63, wr = wid >> 2, wc = wid & 3, fr = lane & 15, fq = lane >> 4;
  bf16_t* sA = (bf16_t*)g_shm;
  bf16_t* sB = sA + 128 * LD;
  const bf16_t* HL = (const bf16_t*)(kws() + OFF_HL);
  const int koff = kind < 4 ? kind * 64 : 256;
  const bf16_t* Bt = (const bf16_t*)(kws() + OFF_W + (kind < 2 ? W_TM_W2 + (size_t)kind * 1024 * 64 * 2 : (kind < 4 ? W_TM_A2 + (size_t)(kind - 2) * 1024 * 64 * 2 : W_TM_G2)));
  bf16_t* O = (bf16_t*)(kws() + (kind == 0 ? OFF_E0 : kind == 1 ? OFF_E1 : kind == 2 ? OFF_A0 : kind == 3 ? OFF_A1 : OFF_G));
  const float* bias = kind < 2 ? kin(15) + ((size_t)j * 2 + kind) * 1024 : (kind < 4 ? kin(18) + ((size_t)j * 2 + kind - 2) * 1024 : nullptr);
  __syncthreads();
  small_load<KP>(sA, HL + (size_t)mt * 128 * 512 + koff, 512, 128);
  small_load<KP>(sB, Bt + (size_t)ntile * 256 * KP, KP, 256);
  __syncthreads();
  f32x4 acc[4][4];
  small_mma<KP>(acc);
#pragma unroll
  for (int m = 0; m < 4; ++m)
#pragma unroll
    for (int n = 0; n < 4; ++n) {
      const int col = ntile * 256 + wc * 64 + n * 16 + fr;
      const float b = bias ? bias[col] : 0.f;
#pragma unroll
      for (int jj = 0; jj < 4; ++jj) {
        const int row = mt * 128 + wr * 64 + m * 16 + fq * 4 + jj;
        float v = acc[m][n][jj] + b;
        if (kind < 2) v = 0.6065306597126334f * sigmoidf_(v); else if (kind < 4) v = sigmoidf_(v);
        O[(size_t)row * 1024 + col] = f2bf(v);
      }
    }
}
DEV void phase_tm_lora_out(const Params& p, int j) {
  for (int unit = blockIdx.x; unit < 5 * 512; unit += gridDim.x) {
    const int kind = unit / 512, r = unit % 512, mt = r >> 2, ntile = r & 3;
    if (kind < 4) lora_out_unit<64>(p, j, kind, mt, ntile); else lora_out_unit<160>(p, j, kind, mt, ntile);
  }
  __syncthreads();
}

constexpr int LDP = 72;
constexpr int MATE = 64 * LDP;
DEV bf16_t* lbuf(int i) { return (bf16_t*)g_shm + i * MATE; }
DEV void bmm(const bf16_t* A, const bf16_t* Bt, int mb, int nh, int fr, int fq, f32x4 (&acc)[2]) {
  acc[0] = (f32x4){0.f, 0.f, 0.f, 0.f}; acc[1] = (f32x4){0.f, 0.f, 0.f, 0.f};
#pragma unroll
  for (int kk = 0; kk < 2; ++kk) {
    const bf16x8 a = *(const bf16x8*)(A + (mb * 16 + fr) * LDP + kk * 32 + fq * 8);
#pragma unroll
    for (int n = 0; n < 2; ++n) {
      const bf16x8 b = *(const bf16x8*)(Bt + (nh * 32 + n * 16 + fr) * LDP + kk * 32 + fq * 8);
      acc[n] = __builtin_amdgcn_mfma_f32_16x16x32_bf16(a, b, acc[n], 0, 0, 0);
    }
  }
}
#define LBAR2() do { asm volatile("s_waitcnt lgkmcnt(0)" ::: "memory"); __builtin_amdgcn_s_barrier(); asm volatile("" ::: "memory"); } while (0)
DEV void st_rm(bf16_t* C, const f32x4 (&v)[2], int mb, int nh, int fr, int fq) {
#pragma unroll
  for (int n = 0; n < 2; ++n)
#pragma unroll
    for (int j = 0; j < 4; ++j) C[(mb * 16 + fq * 4 + j) * LDP + nh * 32 + n * 16 + fr] = f2bf(v[n][j]);
}
DEV void st_tr(bf16_t* CT, const f32x4 (&v)[2], int mb, int nh, int fr, int fq) {
#pragma unroll
  for (int n = 0; n < 2; ++n) {
    uint2 o; o.x = pack2(v[n][0], v[n][1]); o.y = pack2(v[n][2], v[n][3]);
    *(uint2*)(CT + (nh * 32 + n * 16 + fr) * LDP + mb * 16 + fq * 4) = o;
  }
}

DEV void phase_wkv_a(const Params& p, int jl, int slab) {
  const int TIDX = opaque_tid();
  const int wid = __builtin_amdgcn_readfirstlane(TIDX >> 6), lane = TIDX & 63, fr = lane & 15, fq = lane >> 4, mb = wid >> 1, nh = wid & 1;
  const bf16_t* Rb = (const bf16_t*)(kws() + OFF_R);
  const bf16_t* Kb = (const bf16_t*)(kws() + OFF_K);
  const bf16_t* Vb = (const bf16_t*)(kws() + OFF_V);
  float* PSI = (float*)(kws() + OFF_PSI);
  float* BON = (float*)(kws() + OFF_BON);
  float* segsum = (float*)(g_shm + 15 * MATE * 2);
  float* gTs = segsum + 512;
  bf16_t *mAtil = lbuf(0), *mBtil = lbuf(1), *mKtil = lbuf(2), *mRtil = lbuf(3), *mBgamT = lbuf(4), *mKgam = lbuf(5), *mAtilT = lbuf(6), *mVT = lbuf(7),
         *mMak = lbuf(10), *mMrk = lbuf(11), *mMrbT = lbuf(12);
  for (int unit = blockIdx.x; unit < 256 * 32; unit += gridDim.x) {
    const int e = unit & 1, h = (unit >> 1) & 15, c = unit >> 5;
    bf16_t* Ab = (bf16_t*)(kws() + (e ? OFF_A1 : OFF_A0));
    bf16_t* Eb = (bf16_t*)(kws() + (e ? OFF_E1 : OFF_E0));
    bf16_t* YL = (bf16_t*)(kws() + (e ? OFF_YLB : OFF_YLF));
    const size_t tile0 = (size_t)c * 64 * 1024 + h * 64;
    {
      const int jcol = lane, sg = wid;
      const float kkw = kin(23)[(size_t)jl * 1024 + h * 64 + jcol], kaw = kin(24)[(size_t)jl * 1024 + h * 64 + jcol], rkw = kin(25)[(size_t)jl * 1024 + h * 64 + jcol];
      float rv[8], kv[8], vv[8], av[8], lw[8];
#pragma unroll
      for (int q = 0; q < 8; ++q) {
        const int tau = sg * 8 + q, tok = e ? 63 - tau : tau;
        const size_t o = tile0 + (size_t)tok * 1024 + jcol;
        rv[q] = bf2f(Rb[o]); kv[q] = bf2f(Kb[o]); vv[q] = bf2f(Vb[o]); av[q] = bf2f(Ab[o]); lw[q] = -bf2f(Eb[o]);
      }
      float pre[8]; float run = 0.f;
#pragma unroll
      for (int q = 0; q < 8; ++q) { run += lw[q]; pre[q] = run; }
      segsum[sg * 64 + jcol] = run;
      LBAR2();
      float off = 0.f, tot = 0.f;
#pragma unroll
      for (int s2 = 0; s2 < 8; ++s2) { const float sv = segsum[s2 * 64 + jcol]; tot += sv; if (s2 < sg) off += sv; }
      if (sg == 0) gTs[jcol] = __expf(tot);
      float at[8], bg[8], vt[8];
#pragma unroll
      for (int q = 0; q < 8; ++q) {
        const int tau = sg * 8 + q, tok = e ? 63 - tau : tau;
        const float g = off + pre[q], gp = g - lw[q];
        const float kr = kv[q] * kkw;
        const float ss = wave_sum(kr * kr);
        const float kk = kr * __builtin_amdgcn_rsqf(fmaxf(ss, 1e-24f));
        const float b = kk * av[q], kd = kv[q] * (1.0f + (av[q] - 1.0f) * kaw);
        const float eg = __expf(g), eng = __expf(-g), egp = __expf(gp), egt = __expf(tot - g);
        const float atil = -kk * egp;
        mAtil[tau * LDP + jcol] = f2bf(atil);
        mBtil[tau * LDP + jcol] = f2bf(b * eng);
        mKtil[tau * LDP + jcol] = f2bf(kd * eng);
        mRtil[tau * LDP + jcol] = f2bf(rv[q] * eg);
        mKgam[tau * LDP + jcol] = f2bf(kd * egt);
        at[q] = atil; bg[q] = b * egt; vt[q] = vv[q];
        const float bon = wave_sum(rv[q] * kd * rkw);
        if (lane == 0) BON[((size_t)e * SLAB + c * 64 + tok) * 16 + h] = bon;
      }
      uint4 o;
      o.x = pack2(at[0], at[1]); o.y = pack2(at[2], at[3]); o.z = pack2(at[4], at[5]); o.w = pack2(at[6], at[7]);
      *(uint4*)(mAtilT + jcol * LDP + sg * 8) = o;
      o.x = pack2(bg[0], bg[1]); o.y = pack2(bg[2], bg[3]); o.z = pack2(bg[4], bg[5]); o.w = pack2(bg[6], bg[7]);
      *(uint4*)(mBgamT + jcol * LDP + sg * 8) = o;
      o.x = pack2(vt[0], vt[1]); o.y = pack2(vt[2], vt[3]); o.z = pack2(vt[4], vt[5]); o.w = pack2(vt[6], vt[7]);
      *(uint4*)(mVT + jcol * LDP + sg * 8) = o;
    }
    LBAR2();
    f32x4 acc[2], acc2[2];
    bmm(mBtil, mAtil, mb, nh, fr, fq, acc);
#pragma unroll
    for (int n = 0; n < 2; ++n)
#pragma unroll
      for (int j = 0; j < 4; ++j) { const int s = mb * 16 + fq * 4 + j, t = nh * 32 + n * 16 + fr; acc[n][j] = s < t ? acc[n][j] : 0.f; }
    st_rm(lbuf(8), acc, mb, nh, fr, fq); st_tr(lbuf(9), acc, mb, nh, fr, fq);
#pragma unroll
    for (int n = 0; n < 2; ++n)
#pragma unroll
      for (int j = 0; j < 4; ++j) { const int s = mb * 16 + fq * 4 + j, t = nh * 32 + n * 16 + fr; acc[n][j] += (s == t) ? 1.f : 0.f; }
    st_rm(lbuf(13), acc, mb, nh, fr, fq);
    bmm(mKtil, mAtil, mb, nh, fr, fq, acc);
#pragma unroll
    for (int n = 0; n < 2; ++n)
#pragma unroll
      for (int j = 0; j < 4; ++j) { const int s = mb * 16 + fq * 4 + j, t = nh * 32 + n * 16 + fr; acc[n][j] = s < t ? acc[n][j] : 0.f; }
    st_rm(mMak, acc, mb, nh, fr, fq);
    bmm(mKtil, mRtil, mb, nh, fr, fq, acc);
#pragma unroll
    for (int n = 0; n < 2; ++n)
#pragma unroll
      for (int j = 0; j < 4; ++j) { const int s = mb * 16 + fq * 4 + j, t = nh * 32 + n * 16 + fr; acc[n][j] = s <= t ? acc[n][j] : 0.f; }
    st_rm(mMrk, acc, mb, nh, fr, fq);
    bmm(mBtil, mRtil, mb, nh, fr, fq, acc);
#pragma unroll
    for (int n = 0; n < 2; ++n)
#pragma unroll
      for (int j = 0; j < 4; ++j) { const int s = mb * 16 + fq * 4 + j, t = nh * 32 + n * 16 + fr; acc[n][j] = s <= t ? acc[n][j] : 0.f; }
    st_tr(mMrbT, acc, mb, nh, fr, fq);
    LBAR2();
    bmm(lbuf(8), lbuf(9), mb, nh, fr, fq, acc);
    st_rm(lbuf(1), acc, mb, nh, fr, fq); st_tr(lbuf(2), acc, mb, nh, fr, fq);
    LBAR2();
#pragma unroll
    for (int k = 0; k < 4; ++k) {
      const int pc = (k & 1) ? 8 : 1, pn = (k & 1) ? 1 : 8, wc_ = (k & 1) ? 14 : 13, wn = (k & 1) ? 13 : 14;
      bmm(lbuf(wc_), lbuf(pc + 1), mb, nh, fr, fq, acc);
      bmm(lbuf(pc), lbuf(pc + 1), mb, nh, fr, fq, acc2);
#pragma unroll
      for (int n = 0; n < 2; ++n)
#pragma unroll
        for (int j = 0; j < 4; ++j) acc[n][j] += bf2f(lbuf(wc_)[(mb * 16 + fq * 4 + j) * LDP + nh * 32 + n * 16 + fr]);
      st_rm(lbuf(wn), acc, mb, nh, fr, fq);
      st_rm(lbuf(pn), acc2, mb, nh, fr, fq); st_tr(lbuf(pn + 1), acc2, mb, nh, fr, fq);
      LBAR2();
    }
    bmm(lbuf(13), lbuf(2), mb, nh, fr, fq, acc);
#pragma unroll
    for (int n = 0; n < 2; ++n)
#pragma unroll
      for (int j = 0; j < 4; ++j) acc[n][j] += bf2f(lbuf(13)[(mb * 16 + fq * 4 + j) * LDP + nh * 32 + n * 16 + fr]);
    st_rm(lbuf(14), acc, mb, nh, fr, fq);
    LBAR2();
    bmm(mMrbT, lbuf(14), mb, nh, fr, fq, acc);  st_rm(lbuf(8), acc, mb, nh, fr, fq);
    bmm(mBgamT, lbuf(14), mb, nh, fr, fq, acc); st_rm(lbuf(9), acc, mb, nh, fr, fq);
    LBAR2();
    bmm(lbuf(8), mMak, mb, nh, fr, fq, acc);
#pragma unroll
    for (int n = 0; n < 2; ++n)
#pragma unroll
      for (int j = 0; j < 4; ++j) { const int t = mb * 16 + fq * 4 + j, s = nh * 32 + n * 16 + fr; acc[n][j] += bf2f(mMrk[s * LDP + t]); }
    st_rm(lbuf(1), acc, mb, nh, fr, fq);
    bmm(lbuf(9), mMak, mb, nh, fr, fq, acc);
#pragma unroll
    for (int n = 0; n < 2; ++n)
#pragma unroll
      for (int j = 0; j < 4; ++j) { const int jj = mb * 16 + fq * 4 + j, s = nh * 32 + n * 16 + fr; acc[n][j] += bf2f(mKgam[s * LDP + jj]); }
    st_rm(lbuf(2), acc, mb, nh, fr, fq);
    bmm(lbuf(8), mAtilT, mb, nh, fr, fq, acc);
#pragma unroll
    for (int n = 0; n < 2; ++n)
#pragma unroll
      for (int j = 0; j < 4; ++j) {
        const int t = mb * 16 + fq * 4 + j, jj = nh * 32 + n * 16 + fr;
        Eb[tile0 + (size_t)t * 1024 + jj] = f2bf(acc[n][j] + bf2f(mRtil[t * LDP + jj]));
      }
    bmm(lbuf(9), mAtilT, mb, nh, fr, fq, acc);
#pragma unroll
    for (int n = 0; n < 2; ++n)
#pragma unroll
      for (int j = 0; j < 4; ++j) {
        const int jp = mb * 16 + fq * 4 + j, jj = nh * 32 + n * 16 + fr;
        Ab[tile0 + (size_t)jp * 1024 + jj] = f2bf(acc[n][j] + (jp == jj ? gTs[jj] : 0.f));
      }
    LBAR2();
    bmm(lbuf(1), mVT, mb, nh, fr, fq, acc);
#pragma unroll
    for (int n = 0; n < 2; ++n)
#pragma unroll
      for (int j = 0; j < 4; ++j) { const int t = mb * 16 + fq * 4 + j, i = nh * 32 + n * 16 + fr; YL[tile0 + (size_t)t * 1024 + i] = f2bf(acc[n][j]); }
    bmm(mVT, lbuf(2), mb, nh, fr, fq, acc);
#pragma unroll
    for (int n = 0; n < 2; ++n)
#pragma unroll
      for (int j = 0; j < 4; ++j) { const int i = mb * 16 + fq * 4 + j, jj = nh * 32 + n * 16 + fr; PSI[(size_t)unit * 4096 + i * 64 + jj] = acc[n][j]; }
    LBAR2();
  }
}

DEV void phase_wkv_b(const Params& p, int slab) {
  const int TIDX = opaque_tid();
  const int wid = __builtin_amdgcn_readfirstlane(TIDX >> 6), lane = TIDX & 63, fr = lane & 15, fq = lane >> 4, mb = wid >> 1, nh = wid & 1;
  const float* PSI = (const float*)(kws() + OFF_PSI);
  const int nseq = slab < 2 ? 1 : 8, cps = 256 / nseq;
  bf16_t *Sb = lbuf(0), *PhT = lbuf(1), *OmT = lbuf(2);
  const int lr = TIDX >> 3, lc8 = (TIDX & 7) * 8;
  for (int chain = blockIdx.x; chain < nseq * 32; chain += gridDim.x) {
    const int e = chain & 1, h = (chain >> 1) & 15, sq = chain >> 5;
    const bf16_t* Ab = (const bf16_t*)(kws() + (e ? OFF_A1 : OFF_A0));
    const bf16_t* Eb = (const bf16_t*)(kws() + (e ? OFF_E1 : OFF_E0));
    bf16_t* YL = (bf16_t*)(kws() + (e ? OFF_YLB : OFF_YLF));
    f32x4 S[2];
    S[0] = (f32x4){0.f, 0.f, 0.f, 0.f}; S[1] = (f32x4){0.f, 0.f, 0.f, 0.f};
    uint4 phv, omv; float psi[8]; bf16_t yl[8];
    auto prefetch = [&](int step) {
      const int st = step < cps ? step : cps - 1;
      const int c = sq * cps + (e ? cps - 1 - st : st);
      const size_t tile0 = (size_t)c * 64 * 1024 + h * 64;
      phv = *(const uint4*)(Ab + tile0 + (size_t)lr * 1024 + lc8);
      omv = *(const uint4*)(Eb + tile0 + (size_t)lr * 1024 + lc8);
      const size_t unit = ((size_t)c * 16 + h) * 2 + e;
#pragma unroll
      for (int n = 0; n < 2; ++n)
#pragma unroll
        for (int j = 0; j < 4; ++j) {
          psi[n * 4 + j] = PSI[unit * 4096 + (mb * 16 + fq * 4 + j) * 64 + nh * 32 + n * 16 + fr];
          yl[n * 4 + j] = YL[tile0 + (size_t)(mb * 16 + fq * 4 + j) * 1024 + nh * 32 + n * 16 + fr];
        }
    };
    prefetch(0);
    for (int step = 0; step < cps; ++step) {
      const int c = sq * cps + (e ? cps - 1 - step : step);
      const size_t tile0 = (size_t)c * 64 * 1024 + h * 64;
      st_rm(Sb, S, mb, nh, fr, fq);
      *(uint4*)(PhT + lr * LDP + lc8) = phv;
      *(uint4*)(OmT + lr * LDP + lc8) = omv;
      float psc[8], ylc[8];
#pragma unroll
      for (int q = 0; q < 8; ++q) { psc[q] = psi[q]; ylc[q] = bf2f(yl[q]); }
      LBAR2();
      prefetch(step + 1);
      f32x4 acc[2];
      bmm(OmT, Sb, mb, nh, fr, fq, acc);
#pragma unroll
      for (int n = 0; n < 2; ++n)
#pragma unroll
        for (int j = 0; j < 4; ++j)
          YL[tile0 + (size_t)(mb * 16 + fq * 4 + j) * 1024 + nh * 32 + n * 16 + fr] = f2bf(acc[n][j] + ylc[n * 4 + j]);
      bmm(Sb, PhT, mb, nh, fr, fq, acc);
#pragma unroll
      for (int n = 0; n < 2; ++n)
#pragma unroll
        for (int j = 0; j < 4; ++j) S[n][j] = acc[n][j] + psc[n * 4 + j];
      LBAR2();
    }
  }
}

DEV void phase_tm_post(const Params& p, int jl) {
  const int TIDX = opaque_tid();
  const int wid = TIDX >> 6, lane = TIDX & 63;
  bf16_t* Rb = (bf16_t*)(kws() + OFF_R);
  const bf16_t* Vb = (const bf16_t*)(kws() + OFF_V);
  const bf16_t* Gb = (const bf16_t*)(kws() + OFF_G);
  const bf16_t* YF = (const bf16_t*)(kws() + OFF_YLF);
  const bf16_t* YB = (const bf16_t*)(kws() + OFF_YLB);
  const float* BON = (const float*)(kws() + OFF_BON);
  for (int item = blockIdx.x * 8 + wid; item < 2048; item += gridDim.x * 8) {
    const int hd = item & 15, tb = (item >> 4) * 128;
    const int cch = hd * 64 + lane;
    const float lg = kin(26)[(size_t)jl * 1024 + cch], lb = kin(27)[(size_t)jl * 1024 + cch];
    struct PostRaw { bf16_t yf, yb, v, g; float b0, b1; };
    auto load_raw = [&](int tt, PostRaw& w) {
      const int t = tb + (tt < 128 ? tt : 127);
      const size_t o = (size_t)t * 1024 + cch;
      const size_t ob = (size_t)((t & ~63) + 63 - (t & 63)) * 1024 + cch;
      w.yf = YF[o]; w.yb = YB[ob]; w.v = Vb[o]; w.g = Gb[o];
      w.b0 = BON[(size_t)t * 16 + hd]; w.b1 = BON[((size_t)SLAB + t) * 16 + hd];
    };
    PostRaw w0, w1;
    load_raw(0, w0); load_raw(1, w1);
    for (int tt = 0; tt < 128; ++tt) {
      PostRaw w2; load_raw(tt + 2, w2);
      const float y = bf2f(w0.yf) + bf2f(w0.yb);
      const float mean = wave_sum(y) * (1.0f / 64.f);
      const float dy = y - mean;
      const float var = wave_sum(dy * dy) * (1.0f / 64.f);
      const float yn = dy * rsqrtf(var + 64e-5f) * lg + lb;
      Rb[(size_t)(tb + tt) * 1024 + cch] = f2bf((yn + (w0.b0 + w0.b1) * bf2f(w0.v)) * bf2f(w0.g));
      w0 = w1; w1 = w2;
    }
  }
}

DEV void wprep_sgu(const Params& p, int j) {
  wprep_T2((bf16_t*)(kws() + OFF_W + W_SG_IN), 1024, 0, kin(5) + (size_t)j * 1024 * 4096, 1024, 4096, nullptr, 128, 0);
  wprep_T2((bf16_t*)(kws() + OFF_W + W_SG_OUT), 2048, 0, kin(10) + (size_t)j * 2048 * 1024, 2048, 1024, nullptr, 128, 0);
}
DEV void wprep_ffn(const Params& p, int layer) {
  wprep_T2((bf16_t*)(kws() + OFF_W + W_FF_A), 1024, 0, kin(29) + (size_t)layer * 1024 * 2816, 1024, 2816, nullptr, 256, 0);
  wprep_T2((bf16_t*)(kws() + OFF_W + W_FF_A), 1024, 0, kin(30) + (size_t)layer * 1024 * 2816, 1024, 2816, nullptr, 256, 128);
  wprep_T2((bf16_t*)(kws() + OFF_W + W_FF_D), 2816, 0, kin(33) + (size_t)layer * 2816 * 1024, 2816, 1024, nullptr, 128, 0);
}
DEV void wprep_tm(const Params& p, int j) {
  const int TIDX = opaque_tid();
  bf16_t* WP = (bf16_t*)(kws() + OFF_W + W_TM_P);
  const float* mu = kin(11) + (size_t)j * 6 * 1024;
  const float* srcs[3] = {kin(12) + (size_t)j * 1048576, kin(13) + (size_t)j * 1048576, kin(14) + (size_t)j * 1048576};
  const int mus[3] = {0, 2, 3};
#pragma unroll
  for (int i = 0; i < 3; ++i) {
    wprep_T2(WP, 2048, 0, srcs[i], 1024, 1024, nullptr, 128, i * 1024);
    wprep_T2(WP, 2048, 1024, srcs[i], 1024, 1024, mu + mus[i] * 1024, 128, i * 1024);
  }
#pragma unroll
  for (int e = 0; e < 2; ++e) {
    const float* w1 = kin(16) + ((size_t)j * 2 + e) * 1024 * 64;
    wprep_T(WP, 2048, 0, w1, 1024, 64, nullptr, 128, 3072 + 64 * e);
    wprep_T(WP, 2048, 1024, w1, 1024, 64, mu + 1 * 1024, 128, 3072 + 64 * e);
    const float* a1 = kin(19) + ((size_t)j * 2 + e) * 1024 * 64;
    wprep_T(WP, 2048, 0, a1, 1024, 64, nullptr, 128, 3200 + 64 * e);
    wprep_T(WP, 2048, 1024, a1, 1024, 64, mu + 4 * 1024, 128, 3200 + 64 * e);
    wprep_T2((bf16_t*)(kws() + OFF_W + W_TM_W2) + (size_t)e * 1024 * 64, 64, 0, kin(17) + ((size_t)j * 2 + e) * 64 * 1024, 64, 1024, nullptr, 128, 0);
    wprep_T2((bf16_t*)(kws() + OFF_W + W_TM_A2) + (size_t)e * 1024 * 64, 64, 0, kin(20) + ((size_t)j * 2 + e) * 64 * 1024, 64, 1024, nullptr, 128, 0);
  }
  const float* g1 = kin(21) + (size_t)j * 1024 * 160;
  wprep_T(WP, 2048, 0, g1, 1024, 160, nullptr, 128, 3328);
  wprep_T(WP, 2048, 1024, g1, 1024, 160, mu + 5 * 1024, 128, 3328);
  for (size_t i = (size_t)blockIdx.x * 512 + TIDX; i < (size_t)96 * 2048 / 2; i += (size_t)gridDim.x * 512) ((unsigned*)(WP + (size_t)3488 * 2048))[i] = 0u;
  wprep_T((bf16_t*)(kws() + OFF_W + W_TM_G2), 160, 0, kin(22) + (size_t)j * 160 * 1024, 160, 1024, nullptr, 128, 0);
  wprep_T2((bf16_t*)(kws() + OFF_W + W_TM_O), 1024, 0, kin(28) + (size_t)j * 1048576, 1024, 1024, nullptr, 128, 0);
}

constexpr int PH_SGU = 10, PH_FFN = 3, PH_TM = 21;
constexpr int N_PHASES = 1 + 2 * (PH_SGU + PH_FFN) + 2 * (PH_TM + PH_FFN) + 1;

DEV void run_phase(const Params& p, int ph) {
  if (ph == 0) { phase_init(p); return; }
  if (ph == N_PHASES - 1) { phase_final(p); return; }
  int q = ph - 1, layer = 0;
  for (;;) {
    const int len = (layer & 1) ? PH_TM + PH_FFN : PH_SGU + PH_FFN;
    if (q < len) break;
    q -= len; ++layer;
  }
  const int j = layer >> 1;
  bf16_t* H0 = (bf16_t*)(kws() + OFF_H0);
  const int nmix = (layer & 1) ? PH_TM : PH_SGU;
  if (q >= nmix) {
    const int f = q - nmix;
    if (f == 0) { phase_norm(p, kin(3) + (size_t)layer * 1024, H0); wprep_ffn(p, layer); }
    else if (f == 1) phase_ffn_a(p, layer);
    else phase_gemm_res(p, (const bf16_t*)(kws() + OFF_HMID), 2816, (const bf16_t*)(kws() + OFF_W + W_FF_D), 2816, 192, 0);
    return;
  }
  if (!(layer & 1)) {
    if (q == 0) { phase_norm(p, kin(2) + (size_t)layer * 1024, H0); wprep_sgu(p, j); return; }
    const int slab = (q - 1) / 3, s = (q - 1) % 3;
    if (s == 0) phase_sgu_in(p, j, slab);
    else if (s == 1) phase_sgu_mix(p, j);
    else phase_gemm_res(p, (const bf16_t*)(kws() + OFF_U), 4096, (const bf16_t*)(kws() + OFF_W + W_SG_OUT), 2048, 64, (long)slab * SLAB);
    return;
  }
  {
    const int slab = q / 7, s = q % 7;
    switch (s) {
      case 0: phase_norm_tm(p, kin(2) + (size_t)layer * 1024, (bf16_t*)(kws() + OFF_HX), slab); if (slab == 0) wprep_tm(p, j); break;
      case 1: phase_tm_proj(p); break;
      case 2: phase_tm_lora_out(p, j); break;
      case 3: phase_wkv_a(p, j, slab); break;
      case 4: phase_wkv_b(p, slab); break;
      case 5: phase_tm_post(p, j); break;
      default: phase_gemm_res(p, (const bf16_t*)(kws() + OFF_R), 1024, (const bf16_t*)(kws() + OFF_W + W_TM_O), 1024, 64, (long)slab * SLAB); break;
    }
  }
}

#ifndef PROBE_CAT
#define PROBE_CAT -1
#endif
DEV int phase_cat(int ph) {
  if (ph == 0 || ph == N_PHASES - 1) return 2;
  int q = ph - 1, layer = 0;
  for (;;) { const int len = (layer & 1) ? PH_TM + PH_FFN : PH_SGU + PH_FFN; if (q < len) break; q -= len; ++layer; }
  const int nmix = (layer & 1) ? PH_TM : PH_SGU;
  if (q >= nmix) return (q - nmix) == 0 ? 2 : 0;
  if (!(layer & 1)) { if (q == 0) return 2; const int s = (q - 1) % 3; return s == 1 ? 3 : 0; }
  const int s = q % 7;
  return s == 0 ? 2 : (s == 1 || s == 6) ? 0 : (s == 2 ? 4 : (s == 3 ? 1 : (s == 4 ? 5 : 6)));
}
__global__ void __launch_bounds__(512, 2) mega(Params p, int ph_lo, int ph_hi, int coop) {
#if PROBE_CAT >= 0
  if (blockIdx.x == 0 && threadIdx.x == 0) ((unsigned long long*)(kws() + 480 * MiB))[0] = wall_clock64();
#endif
  for (int ph = ph_lo; ph < ph_hi; ++ph) {
    run_phase(p, ph);
    if (coop && ph + 1 < ph_hi) cg::this_grid().sync();
#if PROBE_CAT >= 0
    if (blockIdx.x == 0 && threadIdx.x == 0) ((unsigned long long*)(kws() + 480 * MiB))[ph + 1] = wall_clock64();
#endif
  }
#if PROBE_CAT >= 0
  cg::this_grid().sync();
  if (blockIdx.x == 0 && threadIdx.x == 0) {
    const unsigned long long* ts = (const unsigned long long*)(kws() + 480 * MiB);
    unsigned long long acc = 0;
    for (int ph = 0; ph < N_PHASES; ++ph) if (PROBE_CAT == 9 || phase_cat(ph) == PROBE_CAT) acc += ts[ph + 1] - ts[ph];
    kx()[0] += sqrtf((float)acc * (0.01f * 0.5f));
  }
#endif
}

extern "C" void kernel_launch(void* const* d_in, const int* in_sizes, int n_in, void* d_out, int out_size, void* d_ws, size_t ws_size, hipStream_t stream) {
  static int grid = 0;
  if (!grid) {
    int dev = 0, cus = 0, per_cu = 0;
    (void)hipFuncSetAttribute((const void*)mega, hipFuncAttributeMaxDynamicSharedMemorySize, SHM_BYTES);
    (void)hipGetDevice(&dev);
    (void)hipDeviceGetAttribute(&cus, hipDeviceAttributeMultiprocessorCount, dev);
    (void)hipOccupancyMaxActiveBlocksPerMultiprocessor(&per_cu, (const void*)mega, 512, SHM_BYTES);
    if (per_cu < 1) per_cu = 1;
    grid = cus * per_cu;
    if (grid > 256) grid = 256;
    if (grid & 7) grid &= ~7;
  }
  Params p{};
  for (int i = 0; i < 34; ++i) p.in[i] = (const float*)d_in[i];
  p.x = (float*)d_out;
  p.ws = (char*)d_ws;
  int ph_lo = 0, ph_hi = N_PHASES, coop = 1;
  void* args[] = {&p, &ph_lo, &ph_hi, &coop};
  hipError_t e = hipLaunchCooperativeKernel((const void*)mega, dim3(grid), dim3(512), args, SHM_BYTES, stream);
  if (e != hipSuccess) fprintf(stderr, "cooperative launch failed: %s (grid %d)\n", hipGetErrorString(e), grid);
}
```

```cpp
#define PROBE_CAT -1
#include <hip/hip_runtime.h>
#include <hip/hip_cooperative_groups.h>
#include <cstdio>
namespace cg = cooperative_groups;

#define DEV __device__ __forceinline__
typedef unsigned short bf16_t;
typedef short bf16x8 __attribute__((ext_vector_type(8)));
typedef float f32x4 __attribute__((ext_vector_type(4)));

extern __shared__ __attribute__((aligned(16))) char g_shm[];

constexpr int NT = 49152, SLAB = 16384;
constexpr int SHM_BYTES = 147456;
constexpr size_t MiB = 1u << 20;
constexpr size_t OFF_W = 0;
constexpr size_t OFF_H = 24 * MiB;
constexpr size_t OFF_H0 = OFF_H + 256 * 2048;
constexpr size_t OFF_U = 122 * MiB, OFF_SSQ = 250 * MiB;
constexpr size_t OFF_HMID = 122 * MiB;
constexpr size_t OFF_HX = 24 * MiB, OFF_YLF = 24 * MiB, OFF_YLB = 56 * MiB, OFF_R = 88 * MiB, OFF_K = 120 * MiB, OFF_V = 152 * MiB,
                 OFF_HL = 184 * MiB, OFF_E0 = 200 * MiB, OFF_E1 = 232 * MiB, OFF_A0 = 264 * MiB, OFF_A1 = 296 * MiB, OFF_G = 328 * MiB,
                 OFF_PSI = 360 * MiB, OFF_BON = 488 * MiB, OFF_PHG = 490 * MiB, OFF_PSG = 492 * MiB, OFF_SST = 496 * MiB;
constexpr size_t W_SG_IN = 0, W_SG_OUT = 8 * MiB;
constexpr size_t W_FF_A = 0, W_FF_D = 12 * MiB;
constexpr size_t W_TM_P = 0, W_TM_O = 14 * MiB, W_TM_W2 = 16 * MiB, W_TM_A2 = 16 * MiB + 512 * 1024, W_TM_G2 = 17 * MiB;

struct Params {
  const float* in[34];
  float* x;
  char* ws;
};


typedef const __attribute__((address_space(4))) char* karg_t;
DEV int opaque0() { int z = 0; asm volatile("" : "+s"(z)); return z; }
DEV const float* kin(int i) { karg_t kp = (karg_t)__builtin_amdgcn_kernarg_segment_ptr(); return *(const float* const __attribute__((address_space(4)))*)(kp + (i + opaque0()) * 8); }
DEV float* kx() { karg_t kp = (karg_t)__builtin_amdgcn_kernarg_segment_ptr(); return *(float* const __attribute__((address_space(4)))*)(kp + (34 + opaque0()) * 8); }
DEV char* kws() { karg_t kp = (karg_t)__builtin_amdgcn_kernarg_segment_ptr(); return *(char* const __attribute__((address_space(4)))*)(kp + (35 + opaque0()) * 8); }

DEV int opaque_tid() { int z = 0; asm volatile("" : "+v"(z)); return (int)threadIdx.x + z; }
DEV float bf2f(bf16_t u) { return __uint_as_float(((unsigned)u) << 16); }
DEV bf16_t f2bf(float f) { unsigned u = __float_as_uint(f); u += 0x7fffu + ((u >> 16) & 1u); return (bf16_t)(u >> 16); }
DEV unsigned pack2(float a, float b) { return (unsigned)f2bf(a) | ((unsigned)f2bf(b) << 16); }
template <int CTRL> DEV float dppmov(float v) { return __int_as_float(__builtin_amdgcn_update_dpp(0, __float_as_int(v), CTRL, 0xf, 0xf, true)); }
DEV float row_sum16(float v) {
  v += dppmov<0xB1>(v); v += dppmov<0x4E>(v); v += dppmov<0x141>(v); v += dppmov<0x140>(v);
  return v;
}
DEV float wave_sum(float v) {
  const int r = __float_as_int(row_sum16(v));
  return (__int_as_float(__builtin_amdgcn_readlane(r, 0)) + __int_as_float(__builtin_amdgcn_readlane(r, 16))) +
         (__int_as_float(__builtin_amdgcn_readlane(r, 32)) + __int_as_float(__builtin_amdgcn_readlane(r, 48)));
}
DEV float sigmoidf_(float x) { return 1.0f / (1.0f + __expf(-x)); }
DEV float gelu_exact(float v) {
  const float av = fabsf(v), d = av * 0.2316418882f + 1.0f;
  const float t = __builtin_amdgcn_rcpf(d);
  float q = t * 0.5307027145f + (-0.7265760135f); q = q * t + 0.7107068705f; q = q * t + (-0.142248368f); q = q * t + 0.127414796f; q = q * t;
  const float e = __builtin_amdgcn_exp2f((v * v) * (-0.72134752044f));
  const float m = v * (q * e), r = v - m;
  return v < 0.f ? m : r;
}

DEV void phase_init(const Params& p) {
  const int TIDX = opaque_tid();
  const float4* xp = (const float4*)kin(0);
  const float4* xs = (const float4*)kin(1);
  float4* x = (float4*)kx();
  const size_t n0 = (size_t)32768 * 256, n1 = (size_t)16384 * 256;
  for (size_t i = (size_t)blockIdx.x * 512 + TIDX; i < n0 + n1; i += (size_t)gridDim.x * 512) x[i] = i < n0 ? xp[i] : xs[i - n0];
}

DEV void phase_norm(const Params& p, const float* g, bf16_t* h0) {
  const int TIDX = opaque_tid();
  const int wid = TIDX >> 6, lane = TIDX & 63;
  float4 gv[4];
#pragma unroll
  for (int i = 0; i < 4; ++i) gv[i] = ((const float4*)g)[lane + 64 * i];
  for (int t = blockIdx.x * 8 + wid; t < NT; t += gridDim.x * 8) {
    const float4* xr = (const float4*)(kx() + (size_t)t * 1024);
    float4 v[4]; float ss = 0.f;
#pragma unroll
    for (int i = 0; i < 4; ++i) { v[i] = xr[lane + 64 * i]; ss += v[i].x * v[i].x + v[i].y * v[i].y + v[i].z * v[i].z + v[i].w * v[i].w; }
    ss = wave_sum(ss);
    const float rs = rsqrtf(ss * (1.0f / 1024.f) + 1e-6f);
    uint2* hr = (uint2*)(h0 + (size_t)t * 1024);
#pragma unroll
    for (int i = 0; i < 4; ++i) {
      uint2 o; o.x = pack2(v[i].x * rs * gv[i].x, v[i].y * rs * gv[i].y); o.y = pack2(v[i].z * rs * gv[i].z, v[i].w * rs * gv[i].w);
      hr[lane + 64 * i] = o;
    }
  }
}

DEV void phase_norm_tm(const Params& p, const float* g, bf16_t* hx, int slab) {
  const int TIDX = opaque_tid();
  const int wid = TIDX >> 6, lane = TIDX & 63;
  const int L = slab < 2 ? 16384 : 2048;
  float4 gv[4];
#pragma unroll
  for (int i = 0; i < 4; ++i) gv[i] = ((const float4*)g)[lane + 64 * i];
  for (int ts = blockIdx.x * 8 + wid; ts < SLAB; ts += gridDim.x * 8) {
    const int t = slab * SLAB + ts, pos = ts & (L - 1);
    float4 hv[3][4];
#pragma unroll
    for (int d = 0; d < 3; ++d) {
      const bool valid = !((d == 0 && pos == 0) || (d == 2 && pos == L - 1));
      const int tt = valid ? t + d - 1 : t;
      const float4* xr = (const float4*)(kx() + (size_t)tt * 1024);
      float ss = 0.f;
#pragma unroll
      for (int i = 0; i < 4; ++i) { float4 v = xr[lane + 64 * i]; hv[d][i] = v; ss += v.x * v.x + v.y * v.y + v.z * v.z + v.w * v.w; }
      ss = wave_sum(ss);
      const float rs = valid ? rsqrtf(ss * (1.0f / 1024.f) + 1e-6f) : 0.f;
#pragma unroll
      for (int i = 0; i < 4; ++i) { hv[d][i].x *= rs * gv[i].x; hv[d][i].y *= rs * gv[i].y; hv[d][i].z *= rs * gv[i].z; hv[d][i].w *= rs * gv[i].w; }
    }
    uint2* hr = (uint2*)(hx + (size_t)ts * 2048);
#pragma unroll
    for (int i = 0; i < 4; ++i) {
      uint2 o; o.x = pack2(hv[1][i].x, hv[1][i].y); o.y = pack2(hv[1][i].z, hv[1][i].w);
      hr[lane + 64 * i] = o;
      uint2 q;
      q.x = pack2(0.5f * (hv[0][i].x + hv[2][i].x) - hv[1][i].x, 0.5f * (hv[0][i].y + hv[2][i].y) - hv[1][i].y);
      q.y = pack2(0.5f * (hv[0][i].z + hv[2][i].z) - hv[1][i].z, 0.5f * (hv[0][i].w + hv[2][i].w) - hv[1][i].w);
      hr[256 + lane + 64 * i] = q;
    }
  }
}

DEV void phase_final(const Params& p) {
  const int TIDX = opaque_tid();
  const int wid = TIDX >> 6, lane = TIDX & 63;
  const float* g = kin(4);
  float4 gv[4];
#pragma unroll
  for (int i = 0; i < 4; ++i) gv[i] = ((const float4*)g)[lane + 64 * i];
  for (int t = blockIdx.x * 8 + wid; t < NT; t += gridDim.x * 8) {
    float4* xr = (float4*)(kx() + (size_t)t * 1024);
    float4 v[4]; float ss = 0.f;
#pragma unroll
    for (int i = 0; i < 4; ++i) { v[i] = xr[lane + 64 * i]; ss += v[i].x * v[i].x + v[i].y * v[i].y + v[i].z * v[i].z + v[i].w * v[i].w; }
    ss = wave_sum(ss);
    const float rs = rsqrtf(ss * (1.0f / 1024.f) + 1e-6f);
#pragma unroll
    for (int i = 0; i < 4; ++i) {
      float4 o; o.x = v[i].x * rs * gv[i].x; o.y = v[i].y * rs * gv[i].y; o.z = v[i].z * rs * gv[i].z; o.w = v[i].w * rs * gv[i].w;
      xr[lane + 64 * i] = o;
    }
  }
}

DEV void wprep_T(bf16_t* dst, int ldd, int koff, const float* src, int Ks, int Ns, const float* scale, int rs, int roff) {
  const int TIDX = opaque_tid();
  float (*tile)[33] = (float (*)[33])g_shm;
  const int tx = TIDX & 31, ty = TIDX >> 5;
  const int nkt = Ks / 32, nnt = Ns / 32;
  for (int tIdx = blockIdx.x; tIdx < nkt * nnt; tIdx += gridDim.x) {
    const int k0 = (tIdx / nnt) * 32, n0 = (tIdx % nnt) * 32;
    __syncthreads();
#pragma unroll
    for (int i = 0; i < 2; ++i) tile[ty + 16 * i][tx] = src[(size_t)(k0 + ty + 16 * i) * Ns + n0 + tx];
    __syncthreads();
    const float sc = scale ? scale[k0 + tx] : 1.0f;
#pragma unroll
    for (int i = 0; i < 2; ++i) {
      const int n = n0 + ty + 16 * i;
      const int drow = (n >> 7) * rs + (n & 127) + roff;
      dst[(size_t)drow * ldd + koff + k0 + tx] = f2bf(tile[tx][ty + 16 * i] * sc);
    }
  }
  __syncthreads();
}


DEV void wprep_T2(bf16_t* dst, int ldd, int koff, const float* src, int Ks, int Ns, const float* scale, int rs, int roff) {
  const int TIDX = opaque_tid();
  float* tile = (float*)g_shm;
  const int nkt = Ks / 64, nnt = Ns / 128;
  const int lc = TIDX & 127, lr = TIDX >> 7;
  const int wk = TIDX & 63, wn = TIDX >> 6;
  for (int tIdx = blockIdx.x; tIdx < nkt * nnt; tIdx += gridDim.x) {
    const int k0 = (tIdx / nnt) * 64, n0 = (tIdx % nnt) * 128;
    float v[16];
#pragma unroll
    for (int i = 0; i < 16; ++i) v[i] = src[(size_t)(k0 + i * 4 + lr) * Ns + n0 + lc];
    __syncthreads();
#pragma unroll
    for (int i = 0; i < 16; ++i) tile[(i * 4 + lr) * 129 + lc] = v[i];
    __syncthreads();
    const float sc = scale ? scale[k0 + wk] : 1.0f;
#pragma unroll
    for (int i = 0; i < 16; ++i) {
      const int n = n0 + i * 8 + wn;
      const int drow = (n >> 7) * rs + (n & 127) + roff;
      dst[(size_t)drow * ldd + koff + k0 + wk] = f2bf(tile[wk * 129 + i * 8 + wn] * sc);
    }
  }
  __syncthreads();
}

constexpr int BM = 256, BK = 64, HALF = 128, HT = HALF * BK;
DEV int lds_byte(int r, int c) {
  int st = (r >> 4) * 2 + (c >> 5), rr = r & 15, cc = c & 31, ob = rr * 64 + cc * 2;
  return st * 1024 + (ob ^ (((ob >> 9) & 1) << 5));
}
DEV void stage_rc(int b, int& R, int& C) {
  int st = b / 1024, sb = b % 1024, swz = sb ^ (((sb >> 9) & 1) << 5);
  R = (st >> 1) * 16 + swz / 64; C = (st & 1) * 32 + (swz % 64) / 2;
}

typedef __attribute__((address_space(3))) unsigned char lds_u8;
DEV void gemm_big(const bf16_t* A, long lda, const bf16_t* Bt, long ldb, int K, long brow, long bcol, f32x4 (&acc)[2][2][4][2]) {
  const int TIDX = opaque_tid();
  lds_u8* lds = (lds_u8*)g_shm;
  constexpr int HTB = HT * 2;
#define SA(b, h) (((b) * 2 + (h)) * HTB)
#define SB(b, h) ((4 + (b) * 2 + (h)) * HTB)
#define STAGE(bufoff, gbase, VO, kt) do { const char* _gp = (gbase) + (size_t)(kt) * (BK * 2); \
    __builtin_amdgcn_global_load_lds((const unsigned*)(_gp + VO##0), (__attribute__((address_space(3))) unsigned*)(lds + (bufoff) + ldsw), 16, 0, 0); \
    __builtin_amdgcn_global_load_lds((const unsigned*)(_gp + VO##1), (__attribute__((address_space(3))) unsigned*)(lds + (bufoff) + ldsw + 8192), 16, 0, 0); } while (0)
#define LDA(dst, b, h) for (int m = 0; m < 4; ++m) for (int k = 0; k < 2; ++k) \
    dst[m][k] = *(const __attribute__((address_space(3))) bf16x8*)(lds + SA(b, h) + aoff + m * 2048 + k * 1024)
#define LDB(dst, b, h) for (int n = 0; n < 2; ++n) for (int k = 0; k < 2; ++k) \
    dst[n][k] = *(const __attribute__((address_space(3))) bf16x8*)(lds + SB(b, h) + boff + n * 2048 + k * 1024)
#define MMA(ai, bj, At, Bt_) do { __builtin_amdgcn_s_setprio(1); \
    for (int m = 0; m < 4; ++m) for (int n = 0; n < 2; ++n) for (int k = 0; k < 2; ++k) \
      acc[ai][bj][m][n] = __builtin_amdgcn_mfma_f32_16x16x32_bf16(At[m][k], Bt_[n][k], acc[ai][bj][m][n], 0, 0, 0); \
    __builtin_amdgcn_s_setprio(0); } while (0)
#define WAIT_V(n) asm volatile("s_waitcnt vmcnt(" #n ")" ::: "memory")
#define WAIT_L(n) asm volatile("s_waitcnt lgkmcnt(" #n ")" ::: "memory")
#define BAR __builtin_amdgcn_s_barrier()
#define SCHED __builtin_amdgcn_sched_barrier(0)
  const int tid = TIDX, wid = __builtin_amdgcn_readfirstlane(tid >> 6), lane = tid & 63, wr = wid >> 2, wc = wid & 3, fr = lane & 15, fq = lane >> 4;
  unsigned va0, va1, vb0, vb1;
  { int r_, c_; stage_rc(tid * 16, r_, c_); va0 = (unsigned)((r_ * lda + c_) * 2); vb0 = (unsigned)((r_ * ldb + c_) * 2);
    stage_rc(tid * 16 + 8192, r_, c_); va1 = (unsigned)((r_ * lda + c_) * 2); vb1 = (unsigned)((r_ * ldb + c_) * 2); }
  const unsigned ldsw = (unsigned)wid * 1024u;
  const int aoff = lds_byte(wr * 64 + fr, fq * 8), boff = lds_byte(wc * 32 + fr, fq * 8);
  const char* cA0 = (const char*)(A + brow * lda); const char* cA1 = cA0 + (size_t)HALF * lda * 2;
  const char* cB0 = (const char*)(Bt + bcol * ldb); const char* cB1 = cB0 + (size_t)HALF * ldb * 2;
#pragma unroll
  for (int a = 0; a < 2; ++a)
#pragma unroll
    for (int b = 0; b < 2; ++b)
#pragma unroll
      for (int m = 0; m < 4; ++m)
#pragma unroll
        for (int n = 0; n < 2; ++n) acc[a][b][m][n] = (f32x4){0.f, 0.f, 0.f, 0.f};
  bf16x8 At[4][2], B0[2][2], B1[2][2];
  const int nt = K / BK;
  STAGE(SB(0, 0), cB0, vb, 0); STAGE(SA(0, 0), cA0, va, 0);
  STAGE(SB(0, 1), cB1, vb, 0); STAGE(SA(0, 1), cA1, va, 0);
  if (wr == 1) BAR;
  WAIT_V(4); BAR;
  STAGE(SB(1, 0), cB0, vb, 1); STAGE(SA(1, 0), cA0, va, 1); STAGE(SB(1, 1), cB1, vb, 1);
  WAIT_V(6); BAR;
  for (int t = 0; t < nt - 2; t += 2) {
    LDB(B0, 0, 0); SCHED; LDA(At, 0, 0); STAGE(SA(1, 1), cA1, va, t + 1);
    WAIT_L(8); BAR; WAIT_L(0); MMA(0, 0, At, B0); BAR; SCHED;
    LDB(B1, 0, 1); STAGE(SB(0, 0), cB0, vb, t + 2);
    BAR; WAIT_L(0); MMA(0, 1, At, B1); BAR;
    LDA(At, 0, 1); STAGE(SA(0, 0), cA0, va, t + 2);
    BAR; WAIT_L(0); MMA(1, 0, At, B0); BAR; SCHED;
    STAGE(SB(0, 1), cB1, vb, t + 2);
    WAIT_V(6); BAR; MMA(1, 1, At, B1); BAR;
    LDB(B0, 1, 0); SCHED; LDA(At, 1, 0); STAGE(SA(0, 1), cA1, va, t + 2);
    WAIT_L(8); BAR; WAIT_L(0); MMA(0, 0, At, B0); BAR; SCHED;
    LDB(B1, 1, 1); STAGE(SB(1, 0), cB0, vb, t + 3);
    BAR; WAIT_L(0); MMA(0, 1, At, B1); BAR;
    LDA(At, 1, 1); STAGE(SA(1, 0), cA0, va, t + 3);
    BAR; WAIT_L(0); MMA(1, 0, At, B0); BAR; SCHED;
    STAGE(SB(1, 1), cB1, vb, t + 3);
    WAIT_V(6); BAR; MMA(1, 1, At, B1); BAR;
  }
  { LDB(B0, 0, 0); LDA(At, 0, 0); STAGE(SA(1, 1), cA1, va, nt - 1);
    BAR; WAIT_L(0); MMA(0, 0, At, B0); BAR;
    LDB(B1, 0, 1); BAR; WAIT_L(0); MMA(0, 1, At, B1); BAR;
    LDA(At, 0, 1); WAIT_V(4); BAR; WAIT_L(0); MMA(1, 0, At, B0); MMA(1, 1, At, B1); BAR; }
  { LDB(B0, 1, 0); LDA(At, 1, 0); WAIT_V(2); BAR; WAIT_L(0); MMA(0, 0, At, B0); BAR;
    LDB(B1, 1, 1); WAIT_V(0); BAR; WAIT_L(0); MMA(0, 1, At, B1); BAR;
    LDA(At, 1, 1); BAR; WAIT_L(0); MMA(1, 0, At, B0); MMA(1, 1, At, B1); BAR; }
  if (wr == 0) BAR;
}
DEV void dump_half(const f32x4 (&acc)[2][2][4][2], int ai, int tid) {
  float* T = (float*)g_shm;
  const int wid = tid >> 6, lane = tid & 63, wr = wid >> 2, wc = wid & 3, fr = lane & 15, fq = lane >> 4;
#pragma unroll
  for (int bj = 0; bj < 2; ++bj)
#pragma unroll
    for (int m = 0; m < 4; ++m)
#pragma unroll
      for (int n = 0; n < 2; ++n)
#pragma unroll
        for (int jj = 0; jj < 4; ++jj) {
          const int r = wr * 64 + m * 16 + fq * 4 + jj, c = bj * 128 + wc * 32 + n * 16 + fr;
          T[r * 256 + (c ^ (fq << 4))] = (ai == 0) ? acc[0][bj][m][n][jj] : acc[1][bj][m][n][jj];
        }
}
DEV float4 tile_ld4(int r, int c4) { return *(const float4*)((const float*)g_shm + r * 256 + (c4 ^ (((r >> 2) & 3) << 4))); }
DEV float tile_ld(int r, int c) { return ((const float*)g_shm)[r * 256 + (c ^ (((r >> 2) & 3) << 4))]; }

DEV int vblock() { return (blockIdx.x & 7) * (gridDim.x >> 3) + (blockIdx.x >> 3); }

DEV void phase_gemm_res(const Params& p, const bf16_t* A, long lda, const bf16_t* Bt, int K, int mtiles, long xrow0) {
  float* X = kx();
  for (int tile = vblock(); tile < mtiles * 4; tile += gridDim.x) {
    const int pm = tile >> 2, pn = tile & 3;
    f32x4 acc[2][2][4][2];
    gemm_big(A, lda, Bt, K, K, (long)pm * 256, (long)pn * 256, acc);
    const int tid = opaque_tid();
#pragma unroll
    for (int ai = 0; ai < 2; ++ai) {
      __syncthreads();
      dump_half(acc, ai, tid);
      __syncthreads();
      for (int e = tid; e < 128 * 64; e += 512) {
        const int r = e >> 6, c4 = (e & 63) * 4;
        const float4 v = tile_ld4(r, c4);
        float4* q = (float4*)(X + (xrow0 + pm * 256 + ai * 128 + r) * 1024 + pn * 256 + c4);
        float4 o = *q; o.x += v.x; o.y += v.y; o.z += v.z; o.w += v.w; *q = o;
      }
    }
    __syncthreads();
  }
}

DEV void phase_sgu_in(const Params& p, int j, int slab) {
  const bf16_t* A = (const bf16_t*)(kws() + OFF_H0) + (size_t)slab * SLAB * 1024;
  const bf16_t* Bt = (const bf16_t*)(kws() + OFF_W + W_SG_IN);
  const float* bin = kin(6) + (size_t)j * 4096;
  bf16_t* Z = (bf16_t*)(kws() + OFF_U);
  float* SSQ = (float*)(kws() + OFF_SSQ);
  for (int tile = vblock(); tile < 64 * 16; tile += gridDim.x) {
    const int pm = tile >> 4, pn = tile & 15;
    f32x4 acc[2][2][4][2];
    gemm_big(A, 1024, Bt, 1024, 1024, (long)pm * 256, (long)pn * 256, acc);
    const int tid = opaque_tid(), wid = tid >> 6, lane = tid & 63;
    const float4 b4 = *(const float4*)(bin + pn * 256 + lane * 4);
#pragma unroll
    for (int ai = 0; ai < 2; ++ai) {
      __syncthreads();
      dump_half(acc, ai, tid);
      __syncthreads();
      for (int rr = 0; rr < 16; ++rr) {
        const int r = wid * 16 + rr;
        const float4 v = tile_ld4(r, lane * 4);
        const float z0 = gelu_exact(v.x + b4.x), z1 = gelu_exact(v.y + b4.y), z2 = gelu_exact(v.z + b4.z), z3 = gelu_exact(v.w + b4.w);
        const int row = pm * 256 + ai * 128 + r;
        uint2 o; o.x = pack2(z0, z1); o.y = pack2(z2, z3);
        *(uint2*)(Z + (size_t)row * 4096 + pn * 256 + lane * 4) = o;
        if (pn >= 8) {
          const float ss = wave_sum(z0 * z0 + z1 * z1 + z2 * z2 + z3 * z3);
          if (lane == 0) SSQ[(size_t)row * 8 + (pn - 8)] = ss;
        }
      }
    }
    __syncthreads();
  }
}

DEV void phase_tm_proj(const Params& p) {
  const bf16_t* A = (const bf16_t*)(kws() + OFF_HX);
  const bf16_t* Bt = (const bf16_t*)(kws() + OFF_W + W_TM_P);
  for (int tile = vblock(); tile < 64 * 14; tile += gridDim.x) {
    const int pm = tile / 14, pn = tile % 14;
    f32x4 acc[2][2][4][2];
    gemm_big(A, 2048, Bt, 2048, 2048, (long)pm * 256, (long)pn * 256, acc);
    const int tid = opaque_tid(), wid = tid >> 6, lane = tid & 63;
    bf16_t* O; int ld, cb;
    if (pn < 12) { O = (bf16_t*)(kws() + (pn < 4 ? OFF_R : (pn < 8 ? OFF_K : OFF_V))); ld = 1024; cb = (pn & 3) * 256; }
    else { O = (bf16_t*)(kws() + OFF_HL); ld = 512; cb = (pn - 12) * 256; }
    const int act = pn < 12 ? 0 : (pn == 12 ? (lane < 32 ? 1 : 0) : 2);
#pragma unroll
    for (int ai = 0; ai < 2; ++ai) {
      __syncthreads();
      dump_half(acc, ai, tid);
      __syncthreads();
      for (int rr = 0; rr < 16; ++rr) {
        const int r = wid * 16 + rr;
        float4 v = tile_ld4(r, lane * 4);
        if (act == 1) { v.x = tanhf(v.x); v.y = tanhf(v.y); v.z = tanhf(v.z); v.w = tanhf(v.w); }
        else if (act == 2) { v.x = sigmoidf_(v.x); v.y = sigmoidf_(v.y); v.z = sigmoidf_(v.z); v.w = sigmoidf_(v.w); }
        uint2 o; o.x = pack2(v.x, v.y); o.y = pack2(v.z, v.w);
        *(uint2*)(O + (size_t)(pm * 256 + ai * 128 + r) * ld + cb + lane * 4) = o;
      }
    }
    __syncthreads();
  }
}

DEV void phase_ffn_a(const Params& p, int layer) {
  const bf16_t* A = (const bf16_t*)(kws() + OFF_H0);
  const bf16_t* Bt = (const bf16_t*)(kws() + OFF_W + W_FF_A);
  bf16_t* HM = (bf16_t*)(kws() + OFF_HMID);
  const float* cw = kin(31) + (size_t)layer * 3 * 2816;
  const float* cb = kin(32) + (size_t)layer * 2816;
  float* UP = (float*)g_shm;
  bf16_t* gl = (bf16_t*)(g_shm + 65536);
  for (int tile = vblock(); tile < 202 * 22; tile += gridDim.x) {
    const int mi = tile / 22, pn = tile % 22;
    int base, L, i;
    if (mi < 130) { base = (mi / 65) * 16384; L = 16384; i = mi % 65; }
    else { const int m2 = mi - 130; base = 32768 + (m2 / 9) * 2048; L = 2048; i = m2 % 9; }
    const int s0 = 254 * i - 1;
    f32x4 acc[2][2][4][2];
    gemm_big(A, 1024, Bt, 1024, 1024, (long)base + s0, (long)pn * 256, acc);
    const int tid = opaque_tid(), wid = tid >> 6, lane = tid & 63, wr = wid >> 2, wc = wid & 3, fr = lane & 15, fq = lane >> 4;
    __syncthreads();
#pragma unroll
    for (int ai = 0; ai < 2; ++ai)
#pragma unroll
      for (int m = 0; m < 4; ++m)
#pragma unroll
        for (int n = 0; n < 2; ++n)
#pragma unroll
          for (int jj = 0; jj < 4; ++jj) {
            const int r = ai * 128 + wr * 64 + m * 16 + fq * 4 + jj, c = wc * 32 + n * 16 + fr;
            const int s = s0 + r;
            gl[r * 128 + c] = (s >= 0 && s < L) ? f2bf(acc[ai][0][m][n][jj]) : (bf16_t)0;
          }
    const int c4 = (lane & 31) * 4, f = pn * 128 + c4;
    const float4 w0 = *(const float4*)(cw + f), w1 = *(const float4*)(cw + 2816 + f), w2 = *(const float4*)(cw + 2 * 2816 + f), bb = *(const float4*)(cb + f);
#pragma unroll
    for (int ai = 0; ai < 2; ++ai) {
      __syncthreads();
#pragma unroll
      for (int m = 0; m < 4; ++m)
#pragma unroll
        for (int n = 0; n < 2; ++n)
#pragma unroll
          for (int jj = 0; jj < 4; ++jj) {
            const int r = wr * 64 + m * 16 + fq * 4 + jj, c = wc * 32 + n * 16 + fr;
            UP[r * 128 + (c ^ (fq << 4))] = (ai == 0) ? acc[0][1][m][n][jj] : acc[1][1][m][n][jj];
          }
      __syncthreads();
      for (int e = tid; e < 128 * 32; e += 512) {
        const int rl = e >> 5, r = ai * 128 + rl, s = s0 + r;
        if (r >= 1 && r <= 254 && s < L) {
          const float4 u = *(const float4*)(UP + rl * 128 + (c4 ^ (((rl >> 2) & 3) << 4)));
          const uint2 g0 = *(const uint2*)(gl + (r - 1) * 128 + c4), g1 = *(const uint2*)(gl + r * 128 + c4), g2 = *(const uint2*)(gl + (r + 1) * 128 + c4);
          const float c0 = w0.x * __uint_as_float(g0.x << 16) + w1.x * __uint_as_float(g1.x << 16) + w2.x * __uint_as_float(g2.x << 16) + bb.x;
          const float c1 = w0.y * __uint_as_float(g0.x & 0xffff0000u) + w1.y * __uint_as_float(g1.x & 0xffff0000u) + w2.y * __uint_as_float(g2.x & 0xffff0000u) + bb.y;
          const float c2 = w0.z * __uint_as_float(g0.y << 16) + w1.z * __uint_as_float(g1.y << 16) + w2.z * __uint_as_float(g2.y << 16) + bb.z;
          const float c3 = w0.w * __uint_as_float(g0.y & 0xffff0000u) + w1.w * __uint_as_float(g1.y & 0xffff0000u) + w2.w * __uint_as_float(g2.y & 0xffff0000u) + bb.w;
          uint2 o; o.x = pack2(gelu_exact(c0) * u.x, gelu_exact(c1) * u.y); o.y = pack2(gelu_exact(c2) * u.z, gelu_exact(c3) * u.w);
          *(uint2*)(HM + (size_t)(base + s) * 2816 + f) = o;
        }
      }
    }
    __syncthreads();
  }
}

template <int KP>
DEV void small_mma(f32x4 (&acc)[4][4]) {
  const int TIDX = opaque_tid();
  constexpr int LD = KP + 8;
  const bf16_t* sA = (const bf16_t*)g_shm;
  const bf16_t* sB = sA + 128 * LD;
  const int wid = TIDX >> 6, lane = TIDX & 63, wr = wid >> 2, wc = wid & 3, fr = lane & 15, fq = lane >> 4;
#pragma unroll
  for (int m = 0; m < 4; ++m)
#pragma unroll
    for (int n = 0; n < 4; ++n) acc[m][n] = (f32x4){0.f, 0.f, 0.f, 0.f};
#pragma unroll
  for (int kk = 0; kk < KP / 32; ++kk) {
    bf16x8 a[4], b[4];
#pragma unroll
    for (int m = 0; m < 4; ++m) a[m] = *(const bf16x8*)(sA + (wr * 64 + m * 16 + fr) * LD + kk * 32 + fq * 8);
#pragma unroll
    for (int n = 0; n < 4; ++n) b[n] = *(const bf16x8*)(sB + (wc * 64 + n * 16 + fr) * LD + kk * 32 + fq * 8);
#pragma unroll
    for (int m = 0; m < 4; ++m)
#pragma unroll
      for (int n = 0; n < 4; ++n) acc[m][n] = __builtin_amdgcn_mfma_f32_16x16x32_bf16(a[m], b[n], acc[m][n], 0, 0, 0);
  }
}
template <int KP>
DEV void small_load(bf16_t* s, const bf16_t* g, long ld, int rows) {
  const int TIDX = opaque_tid();
  constexpr int LD = KP + 8, CPR = KP / 8;
  for (int c = TIDX; c < rows * CPR; c += 512) {
    const int r = c / CPR, k8 = (c % CPR) * 8;
    *(uint4*)(s + r * LD + k8) = *(const uint4*)(g + (long)r * ld + k8);
  }
}

DEV void phase_sgu_mix(const Params& p, int j) {
  const int TIDX = opaque_tid();
  constexpr int KP = 128, LD = KP + 8;
  const int wid = TIDX >> 6, lane = TIDX & 63, wr = wid >> 2, wc = wid & 3, fr = lane & 15, fq = lane >> 4;
  bf16_t* sA = (bf16_t*)g_shm;
  bf16_t* sB = sA + 128 * LD;
  float* rsv = (float*)(g_shm + (128 + 256) * LD * 2);
  bf16_t* Z = (bf16_t*)(kws() + OFF_U);
  const float* SSQ = (const float*)(kws() + OFF_SSQ);
  const float* ws_ = kin(8) + (size_t)j * 8 * 128 * 128;
  const float* bs = kin(9) + (size_t)j * 8 * 128;
  const float* ng = kin(7) + (size_t)j * 2048;
  for (int unit = blockIdx.x; unit < 128 * 8; unit += gridDim.x) {
    const int chunk = unit >> 3, g = unit & 7;
    __syncthreads();
    if (TIDX < 128) {
      const float* sp = SSQ + (size_t)(chunk * 128 + TIDX) * 8;
      float s = 0.f;
      for (int i = 0; i < 8; ++i) s += sp[i];
      rsv[TIDX] = rsqrtf(s * (1.0f / 2048.f) + 1e-6f);
    }
    for (int e = TIDX; e < 128 * 32; e += 512) {
      const int pp = e >> 5, c8 = (e & 31) * 8;
      const uint4 v = *(const uint4*)(Z + (size_t)(chunk * 128 + pp) * 4096 + 2048 + g * 256 + c8);
      sB[(c8 + 0) * LD + pp] = (bf16_t)(v.x & 0xffff); sB[(c8 + 1) * LD + pp] = (bf16_t)(v.x >> 16);
      sB[(c8 + 2) * LD + pp] = (bf16_t)(v.y & 0xffff); sB[(c8 + 3) * LD + pp] = (bf16_t)(v.y >> 16);
      sB[(c8 + 4) * LD + pp] = (bf16_t)(v.z & 0xffff); sB[(c8 + 5) * LD + pp] = (bf16_t)(v.z >> 16);
      sB[(c8 + 6) * LD + pp] = (bf16_t)(v.w & 0xffff); sB[(c8 + 7) * LD + pp] = (bf16_t)(v.w >> 16);
    }
    __syncthreads();
    for (int c = TIDX; c < 128 * 16; c += 512) {
      const int q = c >> 4, p8 = (c & 15) * 8;
      const float4* wp = (const float4*)(ws_ + ((size_t)g * 128 + q) * 128 + p8);
      const float4 w0 = wp[0], w1 = wp[1];
      uint4 o;
      o.x = pack2(w0.x * rsv[p8 + 0], w0.y * rsv[p8 + 1]); o.y = pack2(w0.z * rsv[p8 + 2], w0.w * rsv[p8 + 3]);
      o.z = pack2(w1.x * rsv[p8 + 4], w1.y * rsv[p8 + 5]); o.w = pack2(w1.z * rsv[p8 + 6], w1.w * rsv[p8 + 7]);
      *(uint4*)(sA + q * LD + p8) = o;
    }
    __syncthreads();
    f32x4 acc[4][4];
    small_mma<KP>(acc);
#pragma unroll
    for (int m = 0; m < 4; ++m)
#pragma unroll
      for (int n = 0; n < 4; ++n) {
        const int c = g * 256 + wc * 64 + n * 16 + fr;
        const float gg = ng[c];
#pragma unroll
        for (int jj = 0; jj < 4; ++jj) {
          const int q = wr * 64 + m * 16 + fq * 4 + jj;
          const float mix = acc[m][n][jj] * gg + bs[g * 128 + q];
          bf16_t* up = Z + (size_t)(chunk * 128 + q) * 4096 + c;
          *up = f2bf(bf2f(*up) * mix);
        }
      }
  }
  __syncthreads();
}

template <int KP>
DEV void lora_out_unit(const Params& p, int j, int kind, int mt, int ntile) {
  const int TIDX = opaque_tid();
  constexpr int LD = KP + 8;
  const int wid = TIDX >> 6, lane = TIDX & 63, wr = wid >> 2, wc = wid & 3, fr = lane & 15, fq = lane >> 4;
  bf16_t* sA = (bf16_t*)g_shm;
  bf16_t* sB = sA + 128 * LD;
  const bf16_t* HL = (const bf16_t*)(kws() + OFF_HL);
  const int koff = kind < 4 ? kind * 64 : 256;
  const bf16_t* Bt = (const bf16_t*)(kws() + OFF_W + (kind < 2 ? W_TM_W2 + (size_t)kind * 1024 * 64 * 2 : (kind < 4 ? W_TM_A2 + (size_t)(kind - 2) * 1024 * 64 * 2 : W_TM_G2)));
  bf16_t* O = (bf16_t*)(kws() + (kind == 0 ? OFF_E0 : kind == 1 ? OFF_E1 : kind == 2 ? OFF_A0 : kind == 3 ? OFF_A1 : OFF_G));
  const float* bias = kind < 2 ? kin(15) + ((size_t)j * 2 + kind) * 1024 : (kind < 4 ? kin(18) + ((size_t)j * 2 + kind - 2) * 1024 : nullptr);
  __syncthreads();
  small_load<KP>(sA, HL + (size_t)mt * 128 * 512 + koff, 512, 128);
  small_load<KP>(sB, Bt + (size_t)ntile * 256 * KP, KP, 256);
  __syncthreads();
  f32x4 acc[4][4];
  small_mma<KP>(acc);
#pragma unroll
  for (int m = 0; m < 4; ++m)
#pragma unroll
    for (int n = 0; n < 4; ++n) {
      const int col = ntile * 256 + wc * 64 + n * 16 + fr;
      const float b = bias ? bias[col] : 0.f;
#pragma unroll
      for (int jj = 0; jj < 4; ++jj) {
        const int row = mt * 128 + wr * 64 + m * 16 + fq * 4 + jj;
        float v = acc[m][n][jj] + b;
        if (kind < 2) v = 0.6065306597126334f * sigmoidf_(v); else if (kind < 4) v = sigmoidf_(v);
        O[(size_t)row * 1024 + col] = f2bf(v);
      }
    }
}
DEV void phase_tm_lora_out(const Params& p, int j) {
  for (int unit = blockIdx.x; unit < 5 * 512; unit += gridDim.x) {
    const int kind = unit / 512, r = unit % 512, mt = r >> 2, ntile = r & 3;
    if (kind < 4) lora_out_unit<64>(p, j, kind, mt, ntile); else lora_out_unit<160>(p, j, kind, mt, ntile);
  }
  __syncthreads();
}

constexpr int LDP = 72;
constexpr int MATE = 64 * LDP;
DEV bf16_t* lbuf(int i) { return (bf16_t*)g_shm + i * MATE; }
DEV void bmm(const bf16_t* A, const bf16_t* Bt, int mb, int nh, int fr, int fq, f32x4 (&acc)[2]) {
  acc[0] = (f32x4){0.f, 0.f, 0.f, 0.f}; acc[1] = (f32x4){0.f, 0.f, 0.f, 0.f};
#pragma unroll
  for (int kk = 0; kk < 2; ++kk) {
    const bf16x8 a = *(const bf16x8*)(A + (mb * 16 + fr) * LDP + kk * 32 + fq * 8);
#pragma unroll
    for (int n = 0; n < 2; ++n) {
      const bf16x8 b = *(const bf16x8*)(Bt + (nh * 32 + n * 16 + fr) * LDP + kk * 32 + fq * 8);
      acc[n] = __builtin_amdgcn_mfma_f32_16x16x32_bf16(a, b, acc[n], 0, 0, 0);
    }
  }
}
#define LBAR2() do { asm volatile("s_waitcnt lgkmcnt(0)" ::: "memory"); __builtin_amdgcn_s_barrier(); asm volatile("" ::: "memory"); } while (0)
DEV void st_rm(bf16_t* C, const f32x4 (&v)[2], int mb, int nh, int fr, int fq) {
#pragma unroll
  for (int n = 0; n < 2; ++n)
#pragma unroll
    for (int j = 0; j < 4; ++j) C[(mb * 16 + fq * 4 + j) * LDP + nh * 32 + n * 16 + fr] = f2bf(v[n][j]);
}
DEV void st_tr(bf16_t* CT, const f32x4 (&v)[2], int mb, int nh, int fr, int fq) {
#pragma unroll
  for (int n = 0; n < 2; ++n) {
    uint2 o; o.x = pack2(v[n][0], v[n][1]); o.y = pack2(v[n][2], v[n][3]);
    *(uint2*)(CT + (nh * 32 + n * 16 + fr) * LDP + mb * 16 + fq * 4) = o;
  }
}

DEV void phase_wkv_a(const Params& p, int jl, int slab) {
  const int TIDX = opaque_tid();
  const int wid = __builtin_amdgcn_readfirstlane(TIDX >> 6), lane = TIDX & 63, fr = lane & 15, fq = lane >> 4, mb = wid >> 1, nh = wid & 1;
  const bf16_t* Rb = (const bf16_t*)(kws() + OFF_R);
  const bf16_t* Kb = (const bf16_t*)(kws() + OFF_K);
  const bf16_t* Vb = (const bf16_t*)(kws() + OFF_V);
  float* PSI = (float*)(kws() + OFF_PSI);
  float* BON = (float*)(kws() + OFF_BON);
  float* segsum = (float*)(g_shm + 15 * MATE * 2);
  float* gTs = segsum + 512;
  bf16_t *mAtil = lbuf(0), *mBtil = lbuf(1), *mKtil = lbuf(2), *mRtil = lbuf(3), *mBgamT = lbuf(4), *mKgam = lbuf(5), *mAtilT = lbuf(6), *mVT = lbuf(7),
         *mMak = lbuf(10), *mMrk = lbuf(11), *mMrbT = lbuf(12);
  uint4 nr, nk, nv, na, ne;
  const int lr = TIDX >> 3, lc8 = (TIDX & 7) * 8;
  auto load_raw = [&](int u) {
    const int e2 = u & 1, h2 = (u >> 1) & 15, c2 = u >> 5;
    const bf16_t* A2 = (const bf16_t*)(kws() + (e2 ? OFF_A1 : OFF_A0));
    const bf16_t* E2 = (const bf16_t*)(kws() + (e2 ? OFF_E1 : OFF_E0));
    const size_t o = (size_t)c2 * 64 * 1024 + h2 * 64 + (size_t)lr * 1024 + lc8;
    nr = *(const uint4*)(Rb + o); nk = *(const uint4*)(Kb + o); nv = *(const uint4*)(Vb + o); na = *(const uint4*)(A2 + o); ne = *(const uint4*)(E2 + o);
  };
  if ((int)blockIdx.x < 256 * 32) load_raw(blockIdx.x);
  for (int unit = blockIdx.x; unit < 256 * 32; unit += gridDim.x) {
    const int e = unit & 1, h = (unit >> 1) & 15, c = unit >> 5;
    bf16_t* Ab = (bf16_t*)(kws() + (e ? OFF_A1 : OFF_A0));
    bf16_t* Eb = (bf16_t*)(kws() + (e ? OFF_E1 : OFF_E0));
    bf16_t* YL = (bf16_t*)(kws() + (e ? OFF_YLB : OFF_YLF));
    const size_t tile0 = (size_t)c * 64 * 1024 + h * 64;
    {
      const int jcol = lane, sg = wid;
      const float kkw = kin(23)[(size_t)jl * 1024 + h * 64 + jcol], kaw = kin(24)[(size_t)jl * 1024 + h * 64 + jcol], rkw = kin(25)[(size_t)jl * 1024 + h * 64 + jcol];
      *(uint4*)(lbuf(8) + lr * LDP + lc8) = nr; *(uint4*)(lbuf(9) + lr * LDP + lc8) = nk; *(uint4*)(lbuf(10) + lr * LDP + lc8) = nv;
      *(uint4*)(lbuf(11) + lr * LDP + lc8) = na; *(uint4*)(lbuf(12) + lr * LDP + lc8) = ne;
      LBAR2();
      if (unit + (int)gridDim.x < 256 * 32) load_raw(unit + gridDim.x);
      float rv[8], kv[8], vv[8], av[8], lw[8];
#pragma unroll
      for (int q = 0; q < 8; ++q) {
        const int tau = sg * 8 + q, tok = e ? 63 - tau : tau;
        rv[q] = bf2f(lbuf(8)[tok * LDP + jcol]); kv[q] = bf2f(lbuf(9)[tok * LDP + jcol]); vv[q] = bf2f(lbuf(10)[tok * LDP + jcol]);
        av[q] = bf2f(lbuf(11)[tok * LDP + jcol]); lw[q] = -bf2f(lbuf(12)[tok * LDP + jcol]);
      }
      float pre[8]; float run = 0.f;
#pragma unroll
      for (int q = 0; q < 8; ++q) { run += lw[q]; pre[q] = run; }
      segsum[sg * 64 + jcol] = run;
      LBAR2();
      float off = 0.f, tot = 0.f;
#pragma unroll
      for (int s2 = 0; s2 < 8; ++s2) { const float sv = segsum[s2 * 64 + jcol]; tot += sv; if (s2 < sg) off += sv; }
      if (sg == 0) gTs[jcol] = __expf(tot);
      float at[8], bg[8], vt[8];
#pragma unroll
      for (int q = 0; q < 8; ++q) {
        const int tau = sg * 8 + q, tok = e ? 63 - tau : tau;
        const float g = off + pre[q], gp = g - lw[q];
        const float kr = kv[q] * kkw;
        const float ss = wave_sum(kr * kr);
        const float kk = kr * __builtin_amdgcn_rsqf(fmaxf(ss, 1e-24f));
        const float b = kk * av[q], kd = kv[q] * (1.0f + (av[q] - 1.0f) * kaw);
        const float eg = __expf(g), eng = __expf(-g), egp = __expf(gp), egt = __expf(tot - g);
        const float atil = -kk * egp;
        mAtil[tau * LDP + jcol] = f2bf(atil);
        mBtil[tau * LDP + jcol] = f2bf(b * eng);
        mKtil[tau * LDP + jcol] = f2bf(kd * eng);
        mRtil[tau * LDP + jcol] = f2bf(rv[q] * eg);
        mKgam[tau * LDP + jcol] = f2bf(kd * egt);
        at[q] = atil; bg[q] = b * egt; vt[q] = vv[q];
        const float bon = wave_sum(rv[q] * kd * rkw);
        if (lane == 0) BON[((size_t)e * SLAB + c * 64 + tok) * 16 + h] = bon;
      }
      uint4 o;
      o.x = pack2(at[0], at[1]); o.y = pack2(at[2], at[3]); o.z = pack2(at[4], at[5]); o.w = pack2(at[6], at[7]);
      *(uint4*)(mAtilT + jcol * LDP + sg * 8) = o;
      o.x = pack2(bg[0], bg[1]); o.y = pack2(bg[2], bg[3]); o.z = pack2(bg[4], bg[5]); o.w = pack2(bg[6], bg[7]);
      *(uint4*)(mBgamT + jcol * LDP + sg * 8) = o;
      o.x = pack2(vt[0], vt[1]); o.y = pack2(vt[2], vt[3]); o.z = pack2(vt[4], vt[5]); o.w = pack2(vt[6], vt[7]);
      *(uint4*)(mVT + jcol * LDP + sg * 8) = o;
    }
    LBAR2();
    f32x4 acc[2], acc2[2];
    bmm(mBtil, mAtil, mb, nh, fr, fq, acc);
#pragma unroll
    for (int n = 0; n < 2; ++n)
#pragma unroll
      for (int j = 0; j < 4; ++j) { const int s = mb * 16 + fq * 4 + j, t = nh * 32 + n * 16 + fr; acc[n][j] = s < t ? acc[n][j] : 0.f; }
    st_rm(lbuf(8), acc, mb, nh, fr, fq); st_tr(lbuf(9), acc, mb, nh, fr, fq);
#pragma unroll
    for (int n = 0; n < 2; ++n)
#pragma unroll
      for (int j = 0; j < 4; ++j) { const int s = mb * 16 + fq * 4 + j, t = nh * 32 + n * 16 + fr; acc[n][j] += (s == t) ? 1.f : 0.f; }
    st_rm(lbuf(13), acc, mb, nh, fr, fq);
    bmm(mKtil, mAtil, mb, nh, fr, fq, acc);
#pragma unroll
    for (int n = 0; n < 2; ++n)
#pragma unroll
      for (int j = 0; j < 4; ++j) { const int s = mb * 16 + fq * 4 + j, t = nh * 32 + n * 16 + fr; acc[n][j] = s < t ? acc[n][j] : 0.f; }
    st_rm(mMak, acc, mb, nh, fr, fq);
    bmm(mKtil, mRtil, mb, nh, fr, fq, acc);
#pragma unroll
    for (int n = 0; n < 2; ++n)
#pragma unroll
      for (int j = 0; j < 4; ++j) { const int s = mb * 16 + fq * 4 + j, t = nh * 32 + n * 16 + fr; acc[n][j] = s <= t ? acc[n][j] : 0.f; }
    st_rm(mMrk, acc, mb, nh, fr, fq);
    bmm(mBtil, mRtil, mb, nh, fr, fq, acc);
#pragma unroll
    for (int n = 0; n < 2; ++n)
#pragma unroll
      for (int j = 0; j < 4; ++j) { const int s = mb * 16 + fq * 4 + j, t = nh * 32 + n * 16 + fr; acc[n][j] = s <= t ? acc[n][j] : 0.f; }
    st_tr(mMrbT, acc, mb, nh, fr, fq);
    LBAR2();
    bmm(lbuf(8), lbuf(9), mb, nh, fr, fq, acc);
    st_rm(lbuf(1), acc, mb, nh, fr, fq); st_tr(lbuf(2), acc, mb, nh, fr, fq);
    LBAR2();
#pragma unroll
    for (int k = 0; k < 4; ++k) {
      const int pc = (k & 1) ? 8 : 1, pn = (k & 1) ? 1 : 8, wc_ = (k & 1) ? 14 : 13, wn = (k & 1) ? 13 : 14;
      bmm(lbuf(wc_), lbuf(pc + 1), mb, nh, fr, fq, acc);
      bmm(lbuf(pc), lbuf(pc + 1), mb, nh, fr, fq, acc2);
#pragma unroll
      for (int n = 0; n < 2; ++n)
#pragma unroll
        for (int j = 0; j < 4; ++j) acc[n][j] += bf2f(lbuf(wc_)[(mb * 16 + fq * 4 + j) * LDP + nh * 32 + n * 16 + fr]);
      st_rm(lbuf(wn), acc, mb, nh, fr, fq);
      st_rm(lbuf(pn), acc2, mb, nh, fr, fq); st_tr(lbuf(pn + 1), acc2, mb, nh, fr, fq);
      LBAR2();
    }
    bmm(lbuf(13), lbuf(2), mb, nh, fr, fq, acc);
#pragma unroll
    for (int n = 0; n < 2; ++n)
#pragma unroll
      for (int j = 0; j < 4; ++j) acc[n][j] += bf2f(lbuf(13)[(mb * 16 + fq * 4 + j) * LDP + nh * 32 + n * 16 + fr]);
    st_rm(lbuf(14), acc, mb, nh, fr, fq);
    LBAR2();
    bmm(mMrbT, lbuf(14), mb, nh, fr, fq, acc);  st_rm(lbuf(8), acc, mb, nh, fr, fq);
    bmm(mBgamT, lbuf(14), mb, nh, fr, fq, acc); st_rm(lbuf(9), acc, mb, nh, fr, fq);
    LBAR2();
    bmm(lbuf(8), mMak, mb, nh, fr, fq, acc);
#pragma unroll
    for (int n = 0; n < 2; ++n)
#pragma unroll
      for (int j = 0; j < 4; ++j) { const int t = mb * 16 + fq * 4 + j, s = nh * 32 + n * 16 + fr; acc[n][j] += bf2f(mMrk[s * LDP + t]); }
    st_rm(lbuf(1), acc, mb, nh, fr, fq);
    bmm(lbuf(9), mMak, mb, nh, fr, fq, acc);
#pragma unroll
    for (int n = 0; n < 2; ++n)
#pragma unroll
      for (int j = 0; j < 4; ++j) { const int jj = mb * 16 + fq * 4 + j, s = nh * 32 + n * 16 + fr; acc[n][j] += bf2f(mKgam[s * LDP + jj]); }
    st_rm(lbuf(2), acc, mb, nh, fr, fq);
    bmm(mAtilT, lbuf(8), mb, nh, fr, fq, acc);
#pragma unroll
    for (int n = 0; n < 2; ++n) {
      const int j0 = mb * 16 + fq * 4, t = nh * 32 + n * 16 + fr;
      const uint2 rt = *(const uint2*)(mRtil + t * LDP + j0);
      uint2 o;
      o.x = pack2(acc[n][0] + __uint_as_float(rt.x << 16), acc[n][1] + __uint_as_float(rt.x & 0xffff0000u));
      o.y = pack2(acc[n][2] + __uint_as_float(rt.y << 16), acc[n][3] + __uint_as_float(rt.y & 0xffff0000u));
      *(uint2*)(Eb + tile0 + (size_t)t * 1024 + j0) = o;
    }
    bmm(mAtilT, lbuf(9), mb, nh, fr, fq, acc);
#pragma unroll
    for (int n = 0; n < 2; ++n) {
      const int j0 = mb * 16 + fq * 4, jp = nh * 32 + n * 16 + fr;
      uint2 o;
      o.x = pack2(acc[n][0] + (jp == j0 ? gTs[j0] : 0.f), acc[n][1] + (jp == j0 + 1 ? gTs[j0 + 1] : 0.f));
      o.y = pack2(acc[n][2] + (jp == j0 + 2 ? gTs[j0 + 2] : 0.f), acc[n][3] + (jp == j0 + 3 ? gTs[j0 + 3] : 0.f));
      *(uint2*)(Ab + tile0 + (size_t)jp * 1024 + j0) = o;
    }
    LBAR2();
    bmm(mVT, lbuf(1), mb, nh, fr, fq, acc);
#pragma unroll
    for (int n = 0; n < 2; ++n) {
      const int i0 = mb * 16 + fq * 4, t = nh * 32 + n * 16 + fr;
      uint2 o; o.x = pack2(acc[n][0], acc[n][1]); o.y = pack2(acc[n][2], acc[n][3]);
      *(uint2*)(YL + tile0 + (size_t)t * 1024 + i0) = o;
    }
    bmm(mVT, lbuf(2), mb, nh, fr, fq, acc);
    *(f32x4*)(PSI + (size_t)unit * 4096 + (size_t)(wid * 64 + lane) * 8) = acc[0];
    *(f32x4*)(PSI + (size_t)unit * 4096 + (size_t)(wid * 64 + lane) * 8 + 4) = acc[1];
    LBAR2();
  }
}

DEV void phase_wkv_b(const Params& p, int slab, int mode) {
  const int TIDX = opaque_tid();
  const int wid = __builtin_amdgcn_readfirstlane(TIDX >> 6), lane = TIDX & 63, fr = lane & 15, fq = lane >> 4, mb = wid >> 1, nh = wid & 1;
  const float* PSI = (const float*)(kws() + OFF_PSI);
  bf16_t* PHG = (bf16_t*)(kws() + OFF_PHG);
  float* PSG = (float*)(kws() + OFF_PSG);
  float* SST = (float*)(kws() + OFF_SST);
  const bool two_level = slab < 2;
  if (!two_level && mode != 3) return;
  const int nseq = two_level ? 1 : 8, cps = 256 / nseq;
  const int ngrp = two_level ? 8 : 1;
  bf16_t *Sb = lbuf(0), *PhT = lbuf(1), *OmT = lbuf(2), *Sa = lbuf(3);
  const int lr = TIDX >> 3, lc8 = (TIDX & 7) * 8;
  const size_t nat = (size_t)(wid * 64 + lane) * 8;
  if (mode == 2) {
    for (int chain = blockIdx.x; chain < 32; chain += gridDim.x) {
      f32x4 S[2];
      S[0] = (f32x4){0.f, 0.f, 0.f, 0.f}; S[1] = (f32x4){0.f, 0.f, 0.f, 0.f};
      for (int g = 0; g < 8; ++g) {
        const size_t item = (size_t)chain * 8 + g;
        *(f32x4*)(SST + item * 4096 + nat) = S[0]; *(f32x4*)(SST + item * 4096 + nat + 4) = S[1];
        const uint4 ph = *(const uint4*)(PHG + item * 4096 + lr * 64 + lc8);
        const f32x4 q0 = *(const f32x4*)(PSG + item * 4096 + nat), q1 = *(const f32x4*)(PSG + item * 4096 + nat + 4);
        st_rm(Sb, S, mb, nh, fr, fq);
        *(uint4*)(PhT + lr * LDP + lc8) = ph;
        LBAR2();
        f32x4 acc[2];
        bmm(Sb, PhT, mb, nh, fr, fq, acc);
        S[0] = acc[0] + q0; S[1] = acc[1] + q1;
        LBAR2();
      }
    }
    return;
  }
  for (int item = blockIdx.x; item < nseq * 32 * ngrp; item += gridDim.x) {
    const int chain = item / ngrp, grp = item % ngrp;
    const int e = chain & 1, h = (chain >> 1) & 15, sq = chain >> 5;
    const bf16_t* Ab = (const bf16_t*)(kws() + (e ? OFF_A1 : OFF_A0));
    const bf16_t* Eb = (const bf16_t*)(kws() + (e ? OFF_E1 : OFF_E0));
    bf16_t* YL = (bf16_t*)(kws() + (e ? OFF_YLB : OFF_YLF));
    const int sbase = grp * 32;
    f32x4 S[2], SA[2];
    if (mode == 3 && two_level) { S[0] = *(const f32x4*)(SST + (size_t)item * 4096 + nat); S[1] = *(const f32x4*)(SST + (size_t)item * 4096 + nat + 4); }
    else { S[0] = (f32x4){0.f, 0.f, 0.f, 0.f}; S[1] = (f32x4){0.f, 0.f, 0.f, 0.f}; }
#pragma unroll
    for (int n = 0; n < 2; ++n)
#pragma unroll
      for (int j = 0; j < 4; ++j) SA[n][j] = (mb * 16 + fq * 4 + j == nh * 32 + n * 16 + fr) ? 1.f : 0.f;
    uint4 ph0, ph1, ph2, ph3, om0, om1, om2, om3;
    f32x4 ps0[2], ps1[2], ps2[2], ps3[2];
    uint2 yl0[2], yl1[2], yl2[2], yl3[2];
#define WB_PREFETCH(step_, ph, om, ps, y8) do { \
      const int st_ = sbase + ((step_) < 32 ? (step_) : 31); \
      const int c_ = sq * cps + (e ? cps - 1 - st_ : st_); \
      const size_t t0_ = (size_t)c_ * 64 * 1024 + h * 64; \
      ph = *(const uint4*)(Ab + t0_ + (size_t)lr * 1024 + lc8); \
      const size_t u_ = ((size_t)c_ * 16 + h) * 2 + e; \
      ps[0] = *(const f32x4*)(PSI + u_ * 4096 + nat); ps[1] = *(const f32x4*)(PSI + u_ * 4096 + nat + 4); \
      if (mode == 3) { \
        om = *(const uint4*)(Eb + t0_ + (size_t)lr * 1024 + lc8); \
        y8[0] = *(const uint2*)(YL + t0_ + (size_t)(nh * 32 + fr) * 1024 + mb * 16 + fq * 4); \
        y8[1] = *(const uint2*)(YL + t0_ + (size_t)(nh * 32 + 16 + fr) * 1024 + mb * 16 + fq * 4); } } while (0)
#define WB_STEP(step_, ph, om, ps, y8) do { \
      const int c = sq * cps + (e ? cps - 1 - (sbase + (step_)) : (sbase + (step_))); \
      const size_t tile0 = (size_t)c * 64 * 1024 + h * 64; \
      st_rm(Sb, S, mb, nh, fr, fq); \
      *(uint4*)(PhT + lr * LDP + lc8) = ph; \
      if (mode == 3) *(uint4*)(OmT + lr * LDP + lc8) = om; else st_rm(Sa, SA, mb, nh, fr, fq); \
      const f32x4 psc0 = ps[0], psc1 = ps[1]; const uint2 ylc0 = y8[0], ylc1 = y8[1]; \
      LBAR2(); \
      WB_PREFETCH((step_) + 4, ph, om, ps, y8); \
      f32x4 acc[2]; \
      if (mode == 3) { \
        bmm(Sb, OmT, mb, nh, fr, fq, acc); \
        uint2 o; \
        o.x = pack2(acc[0][0] + __uint_as_float(ylc0.x << 16), acc[0][1] + __uint_as_float(ylc0.x & 0xffff0000u)); \
        o.y = pack2(acc[0][2] + __uint_as_float(ylc0.y << 16), acc[0][3] + __uint_as_float(ylc0.y & 0xffff0000u)); \
        *(uint2*)(YL + tile0 + (size_t)(nh * 32 + fr) * 1024 + mb * 16 + fq * 4) = o; \
        o.x = pack2(acc[1][0] + __uint_as_float(ylc1.x << 16), acc[1][1] + __uint_as_float(ylc1.x & 0xffff0000u)); \
        o.y = pack2(acc[1][2] + __uint_as_float(ylc1.y << 16), acc[1][3] + __uint_as_float(ylc1.y & 0xffff0000u)); \
        *(uint2*)(YL + tile0 + (size_t)(nh * 32 + 16 + fr) * 1024 + mb * 16 + fq * 4) = o; \
      } else { \
        bmm(Sa, PhT, mb, nh, fr, fq, acc); SA[0] = acc[0]; SA[1] = acc[1]; \
      } \
      bmm(Sb, PhT, mb, nh, fr, fq, acc); \
      S[0] = acc[0] + psc0; S[1] = acc[1] + psc1; \
      LBAR2(); } while (0)
    yl0[0] = yl0[1] = yl1[0] = yl1[1] = yl2[0] = yl2[1] = yl3[0] = yl3[1] = make_uint2(0u, 0u);
    om0 = om1 = om2 = om3 = make_uint4(0u, 0u, 0u, 0u);
    WB_PREFETCH(0, ph0, om0, ps0, yl0); WB_PREFETCH(1, ph1, om1, ps1, yl1); WB_PREFETCH(2, ph2, om2, ps2, yl2); WB_PREFETCH(3, ph3, om3, ps3, yl3);
    for (int step0 = 0; step0 < 32; step0 += 4) {
      WB_STEP(step0 + 0, ph0, om0, ps0, yl0);
      WB_STEP(step0 + 1, ph1, om1, ps1, yl1);
      WB_STEP(step0 + 2, ph2, om2, ps2, yl2);
      WB_STEP(step0 + 3, ph3, om3, ps3, yl3);
    }
    if (mode == 1) {
#pragma unroll
      for (int n = 0; n < 2; ++n) {
        uint2 o; o.x = pack2(SA[n][0], SA[n][1]); o.y = pack2(SA[n][2], SA[n][3]);
        *(uint2*)(PHG + (size_t)item * 4096 + (nh * 32 + n * 16 + fr) * 64 + mb * 16 + fq * 4) = o;
      }
      *(f32x4*)(PSG + (size_t)item * 4096 + nat) = S[0]; *(f32x4*)(PSG + (size_t)item * 4096 + nat + 4) = S[1];
    }
  }
}

DEV void phase_tm_post(const Params& p, int jl) {
  const int TIDX = opaque_tid();
  const int wid = TIDX >> 6, lane = TIDX & 63;
  bf16_t* Rb = (bf16_t*)(kws() + OFF_R);
  const bf16_t* Vb = (const bf16_t*)(kws() + OFF_V);
  const bf16_t* Gb = (const bf16_t*)(kws() + OFF_G);
  const bf16_t* YF = (const bf16_t*)(kws() + OFF_YLF);
  const bf16_t* YB = (const bf16_t*)(kws() + OFF_YLB);
  const float* BON = (const float*)(kws() + OFF_BON);
  for (int item = blockIdx.x * 8 + wid; item < 2048; item += gridDim.x * 8) {
    const int hd = item & 15, tb = (item >> 4) * 128;
    const int cch = hd * 64 + lane;
    const float lg = kin(26)[(size_t)jl * 1024 + cch], lb = kin(27)[(size_t)jl * 1024 + cch];
    struct PostRaw { bf16_t yf, yb, v, g; float b0, b1; };
    auto load_raw = [&](int tt, PostRaw& w) {
      const int t = tb + (tt < 128 ? tt : 127);
      const size_t o = (size_t)t * 1024 + cch;
      const size_t ob = (size_t)((t & ~63) + 63 - (t & 63)) * 1024 + cch;
      w.yf = YF[o]; w.yb = YB[ob]; w.v = Vb[o]; w.g = Gb[o];
      w.b0 = BON[(size_t)t * 16 + hd]; w.b1 = BON[((size_t)SLAB + t) * 16 + hd];
    };
    PostRaw w0, w1;
    load_raw(0, w0); load_raw(1, w1);
    for (int tt = 0; tt < 128; ++tt) {
      PostRaw w2; load_raw(tt + 2, w2);
      const float y = bf2f(w0.yf) + bf2f(w0.yb);
      const float mean = wave_sum(y) * (1.0f / 64.f);
      const float dy = y - mean;
      const float var = wave_sum(dy * dy) * (1.0f / 64.f);
      const float yn = dy * rsqrtf(var + 64e-5f) * lg + lb;
      Rb[(size_t)(tb + tt) * 1024 + cch] = f2bf((yn + (w0.b0 + w0.b1) * bf2f(w0.v)) * bf2f(w0.g));
      w0 = w1; w1 = w2;
    }
  }
}

DEV void wprep_sgu(const Params& p, int j) {
  wprep_T2((bf16_t*)(kws() + OFF_W + W_SG_IN), 1024, 0, kin(5) + (size_t)j * 1024 * 4096, 1024, 4096, nullptr, 128, 0);
  wprep_T2((bf16_t*)(kws() + OFF_W + W_SG_OUT), 2048, 0, kin(10) + (size_t)j * 2048 * 1024, 2048, 1024, nullptr, 128, 0);
}
DEV void wprep_ffn(const Params& p, int layer) {
  wprep_T2((bf16_t*)(kws() + OFF_W + W_FF_A), 1024, 0, kin(29) + (size_t)layer * 1024 * 2816, 1024, 2816, nullptr, 256, 0);
  wprep_T2((bf16_t*)(kws() + OFF_W + W_FF_A), 1024, 0, kin(30) + (size_t)layer * 1024 * 2816, 1024, 2816, nullptr, 256, 128);
  wprep_T2((bf16_t*)(kws() + OFF_W + W_FF_D), 2816, 0, kin(33) + (size_t)layer * 2816 * 1024, 2816, 1024, nullptr, 128, 0);
}
DEV void wprep_tm(const Params& p, int j) {
  const int TIDX = opaque_tid();
  bf16_t* WP = (bf16_t*)(kws() + OFF_W + W_TM_P);
  const float* mu = kin(11) + (size_t)j * 6 * 1024;
  const float* srcs[3] = {kin(12) + (size_t)j * 1048576, kin(13) + (size_t)j * 1048576, kin(14) + (size_t)j * 1048576};
  const int mus[3] = {0, 2, 3};
#pragma unroll
  for (int i = 0; i < 3; ++i) {
    wprep_T2(WP, 2048, 0, srcs[i], 1024, 1024, nullptr, 128, i * 1024);
    wprep_T2(WP, 2048, 1024, srcs[i], 1024, 1024, mu + mus[i] * 1024, 128, i * 1024);
  }
#pragma unroll
  for (int e = 0; e < 2; ++e) {
    const float* w1 = kin(16) + ((size_t)j * 2 + e) * 1024 * 64;
    wprep_T(WP, 2048, 0, w1, 1024, 64, nullptr, 128, 3072 + 64 * e);
    wprep_T(WP, 2048, 1024, w1, 1024, 64, mu + 1 * 1024, 128, 3072 + 64 * e);
    const float* a1 = kin(19) + ((size_t)j * 2 + e) * 1024 * 64;
    wprep_T(WP, 2048, 0, a1, 1024, 64, nullptr, 128, 3200 + 64 * e);
    wprep_T(WP, 2048, 1024, a1, 1024, 64, mu + 4 * 1024, 128, 3200 + 64 * e);
    wprep_T2((bf16_t*)(kws() + OFF_W + W_TM_W2) + (size_t)e * 1024 * 64, 64, 0, kin(17) + ((size_t)j * 2 + e) * 64 * 1024, 64, 1024, nullptr, 128, 0);
    wprep_T2((bf16_t*)(kws() + OFF_W + W_TM_A2) + (size_t)e * 1024 * 64, 64, 0, kin(20) + ((size_t)j * 2 + e) * 64 * 1024, 64, 1024, nullptr, 128, 0);
  }
  const float* g1 = kin(21) + (size_t)j * 1024 * 160;
  wprep_T(WP, 2048, 0, g1, 1024, 160, nullptr, 128, 3328);
  wprep_T(WP, 2048, 1024, g1, 1024, 160, mu + 5 * 1024, 128, 3328);
  for (size_t i = (size_t)blockIdx.x * 512 + TIDX; i < (size_t)96 * 2048 / 2; i += (size_t)gridDim.x * 512) ((unsigned*)(WP + (size_t)3488 * 2048))[i] = 0u;
  wprep_T((bf16_t*)(kws() + OFF_W + W_TM_G2), 160, 0, kin(22) + (size_t)j * 160 * 1024, 160, 1024, nullptr, 128, 0);
  wprep_T2((bf16_t*)(kws() + OFF_W + W_TM_O), 1024, 0, kin(28) + (size_t)j * 1048576, 1024, 1024, nullptr, 128, 0);
}

constexpr int PH_SGU = 10, PH_FFN = 3, PH_TM = 27;
constexpr int N_PHASES = 1 + 2 * (PH_SGU + PH_FFN) + 2 * (PH_TM + PH_FFN) + 1;

DEV void run_phase(const Params& p, int ph) {
  if (ph == 0) { phase_init(p); return; }
  if (ph == N_PHASES - 1) { phase_final(p); return; }
  int q = ph - 1, layer = 0;
  for (;;) {
    const int len = (layer & 1) ? PH_TM + PH_FFN : PH_SGU + PH_FFN;
    if (q < len) break;
    q -= len; ++layer;
  }
  const int j = layer >> 1;
  bf16_t* H0 = (bf16_t*)(kws() + OFF_H0);
  const int nmix = (layer & 1) ? PH_TM : PH_SGU;
  if (q >= nmix) {
    const int f = q - nmix;
    if (f == 0) { phase_norm(p, kin(3) + (size_t)layer * 1024, H0); wprep_ffn(p, layer); }
    else if (f == 1) phase_ffn_a(p, layer);
    else phase_gemm_res(p, (const bf16_t*)(kws() + OFF_HMID), 2816, (const bf16_t*)(kws() + OFF_W + W_FF_D), 2816, 192, 0);
    return;
  }
  if (!(layer & 1)) {
    if (q == 0) { phase_norm(p, kin(2) + (size_t)layer * 1024, H0); wprep_sgu(p, j); return; }
    const int slab = (q - 1) / 3, s = (q - 1) % 3;
    if (s == 0) phase_sgu_in(p, j, slab);
    else if (s == 1) phase_sgu_mix(p, j);
    else phase_gemm_res(p, (const bf16_t*)(kws() + OFF_U), 4096, (const bf16_t*)(kws() + OFF_W + W_SG_OUT), 2048, 64, (long)slab * SLAB);
    return;
  }
  {
    const int slab = q / 9, s = q % 9;
    switch (s) {
      case 0: phase_norm_tm(p, kin(2) + (size_t)layer * 1024, (bf16_t*)(kws() + OFF_HX), slab); if (slab == 0) wprep_tm(p, j); break;
      case 1: phase_tm_proj(p); break;
      case 2: phase_tm_lora_out(p, j); break;
      case 3: phase_wkv_a(p, j, slab); break;
      case 4: phase_wkv_b(p, slab, 1); break;
      case 5: phase_wkv_b(p, slab, 2); break;
      case 6: phase_wkv_b(p, slab, 3); break;
      case 7: phase_tm_post(p, j); break;
      default: phase_gemm_res(p, (const bf16_t*)(kws() + OFF_R), 1024, (const bf16_t*)(kws() + OFF_W + W_TM_O), 1024, 64, (long)slab * SLAB); break;
    }
  }
}

__global__ void __launch_bounds__(512, 2) mega(Params p, int ph_lo, int ph_hi, int coop) {
#if PROBE_CAT >= 0
  if (blockIdx.x == 0 && threadIdx.x == 0) ((unsigned long long*)(kws() + 500 * MiB))[0] = wall_clock64();
#endif
  for (int ph = ph_lo; ph < ph_hi; ++ph) {
    run_phase(p, ph);
    if (coop && ph + 1 < ph_hi) cg::this_grid().sync();
#if PROBE_CAT >= 0
    if (blockIdx.x == 0 && threadIdx.x == 0) ((unsigned long long*)(kws() + 500 * MiB))[ph + 1] = wall_clock64();
#endif
  }
#if PROBE_CAT >= 0
  cg::this_grid().sync();
  if (blockIdx.x == 0 && threadIdx.x == 0) {
    const unsigned long long* ts = (const unsigned long long*)(kws() + 500 * MiB);
    unsigned long long acc = 0;
    for (int ph = 0; ph < N_PHASES; ++ph) if (PROBE_CAT == 9 || phase_cat(ph) == PROBE_CAT) acc += ts[ph + 1] - ts[ph];
    ((float*)(kws() + 500 * MiB))[1024] = (float)acc * (0.01f * 2e-5f);
  }
  __syncthreads();
  if (blockIdx.x == 0) {
    __threadfence();
    const float ev = ((volatile float*)(kws() + 500 * MiB))[1024];
    for (int i = threadIdx.x; i < 4096; i += 512) kx()[i] += ev;
    for (int i = threadIdx.x; i < 2048; i += 512) kx()[(size_t)32768 * 1024 + i] += ev;
  }
#endif
}

extern "C" void kernel_launch(void* const* d_in, const int* in_sizes, int n_in, void* d_out, int out_size, void* d_ws, size_t ws_size, hipStream_t stream) {
  static int grid = 0;
  if (!grid) {
    int dev = 0, cus = 0, per_cu = 0;
    (void)hipFuncSetAttribute((const void*)mega, hipFuncAttributeMaxDynamicSharedMemorySize, SHM_BYTES);
    (void)hipGetDevice(&dev);
    (void)hipDeviceGetAttribute(&cus, hipDeviceAttributeMultiprocessorCount, dev);
    (void)hipOccupancyMaxActiveBlocksPerMultiprocessor(&per_cu, (const void*)mega, 512, SHM_BYTES);
    if (per_cu < 1) per_cu = 1;
    grid = cus * per_cu;
    if (grid > 256) grid = 256;
    if (grid & 7) grid &= ~7;
  }
  Params p{};
  for (int i = 0; i < 34; ++i) p.in[i] = (const float*)d_in[i];
  p.x = (float*)d_out;
  p.ws = (char*)d_ws;
  int ph_lo = 0, ph_hi = N_PHASES, coop = 1;
  void* args[] = {&p, &ph_lo, &ph_hi, &coop};
  hipError_t e = hipLaunchCooperativeKernel((const void*)mega, dim3(grid), dim3(512), args, SHM_BYTES, stream);
  if (e != hipSuccess) fprintf(stderr, "cooperative launch failed: %s (grid %d)\n", hipGetErrorString(e), grid);
}
```

```cpp
#define PROBE_CAT -1
#include <hip/hip_runtime.h>
#include <hip/hip_cooperative_groups.h>
#include <cstdio>
namespace cg = cooperative_groups;

#define DEV __device__ __forceinline__
typedef unsigned short bf16_t;
typedef short bf16x8 __attribute__((ext_vector_type(8)));
typedef float f32x4 __attribute__((ext_vector_type(4)));

extern __shared__ __attribute__((aligned(16))) char g_shm[];

constexpr int NT = 49152, SLAB = 16384;
constexpr int SHM_BYTES = 147456;
constexpr size_t MiB = 1u << 20;
constexpr size_t OFF_W = 0;
constexpr size_t OFF_H = 24 * MiB;
constexpr size_t OFF_H0 = OFF_H + 256 * 2048;
constexpr size_t OFF_U = 122 * MiB, OFF_SSQ = 250 * MiB;
constexpr size_t OFF_HMID = 122 * MiB;
constexpr size_t OFF_HX = 24 * MiB, OFF_YLF = 24 * MiB, OFF_YLB = 56 * MiB, OFF_R = 88 * MiB, OFF_K = 120 * MiB, OFF_V = 152 * MiB,
                 OFF_HL = 184 * MiB, OFF_E0 = 200 * MiB, OFF_E1 = 232 * MiB, OFF_A0 = 264 * MiB, OFF_A1 = 296 * MiB, OFF_G = 328 * MiB,
                 OFF_PSI = 360 * MiB, OFF_BON = 488 * MiB, OFF_PHG = 490 * MiB, OFF_PSG = 492 * MiB, OFF_SST = 496 * MiB;
constexpr size_t W_SG_IN = 0, W_SG_OUT = 8 * MiB;
constexpr size_t W_FF_A = 0, W_FF_D = 12 * MiB;
constexpr size_t W_TM_P = 0, W_TM_O = 14 * MiB, W_TM_W2 = 16 * MiB, W_TM_A2 = 16 * MiB + 512 * 1024, W_TM_G2 = 17 * MiB;

struct Params {
  const float* in[34];
  float* x;
  char* ws;
};


typedef const __attribute__((address_space(4))) char* karg_t;
DEV int opaque0() { int z = 0; asm volatile("" : "+s"(z)); return z; }
DEV const float* kin(int i) { karg_t kp = (karg_t)__builtin_amdgcn_kernarg_segment_ptr(); return *(const float* const __attribute__((address_space(4)))*)(kp + (i + opaque0()) * 8); }
DEV float* kx() { karg_t kp = (karg_t)__builtin_amdgcn_kernarg_segment_ptr(); return *(float* const __attribute__((address_space(4)))*)(kp + (34 + opaque0()) * 8); }
DEV char* kws() { karg_t kp = (karg_t)__builtin_amdgcn_kernarg_segment_ptr(); return *(char* const __attribute__((address_space(4)))*)(kp + (35 + opaque0()) * 8); }

DEV int opaque_tid() { int z = 0; asm volatile("" : "+v"(z)); return (int)threadIdx.x + z; }
DEV float bf2f(bf16_t u) { return __uint_as_float(((unsigned)u) << 16); }
typedef float f32x2 __attribute__((ext_vector_type(2)));
typedef __bf16 bf16x2_t __attribute__((ext_vector_type(2)));
DEV unsigned pack2(float a, float b) { f32x2 v = {a, b}; bf16x2_t h = __builtin_convertvector(v, bf16x2_t); return __builtin_bit_cast(unsigned, h); }
DEV bf16_t f2bf(float f) { return (bf16_t)(pack2(f, f) & 0xffffu); }
template <int CTRL> DEV float dppmov(float v) { return __int_as_float(__builtin_amdgcn_update_dpp(0, __float_as_int(v), CTRL, 0xf, 0xf, true)); }
DEV float row_sum16(float v) {
  v += dppmov<0xB1>(v); v += dppmov<0x4E>(v); v += dppmov<0x141>(v); v += dppmov<0x140>(v);
  return v;
}
DEV float wave_sum(float v) {
  const int r = __float_as_int(row_sum16(v));
  return (__int_as_float(__builtin_amdgcn_readlane(r, 0)) + __int_as_float(__builtin_amdgcn_readlane(r, 16))) +
         (__int_as_float(__builtin_amdgcn_readlane(r, 32)) + __int_as_float(__builtin_amdgcn_readlane(r, 48)));
}
DEV float sigmoidf_(float x) { return 1.0f / (1.0f + __expf(-x)); }
DEV f32x2 gelu_pk(f32x2 v) {
  const f32x2 av = __builtin_elementwise_abs(v), d = av * 0.2316418882f + 1.0f;
  f32x2 t; t.x = __builtin_amdgcn_rcpf(d.x); t.y = __builtin_amdgcn_rcpf(d.y);
  f32x2 q = t * 0.5307027145f + (-0.7265760135f); q = q * t + 0.7107068705f; q = q * t + (-0.142248368f); q = q * t + 0.127414796f; q = q * t;
  const f32x2 s = (v * v) * (-0.72134752044f);
  f32x2 e; e.x = __builtin_amdgcn_exp2f(s.x); e.y = __builtin_amdgcn_exp2f(s.y);
  const f32x2 m = v * (q * e), r = v - m;
  f32x2 o; o.x = v.x < 0.f ? m.x : r.x; o.y = v.y < 0.f ? m.y : r.y; return o;
}
DEV float gelu_exact(float v) {
  const float av = fabsf(v), d = av * 0.2316418882f + 1.0f;
  const float t = __builtin_amdgcn_rcpf(d);
  float q = t * 0.5307027145f + (-0.7265760135f); q = q * t + 0.7107068705f; q = q * t + (-0.142248368f); q = q * t + 0.127414796f; q = q * t;
  const float e = __builtin_amdgcn_exp2f((v * v) * (-0.72134752044f));
  const float m = v * (q * e), r = v - m;
  return v < 0.f ? m : r;
}

DEV void phase_init(const Params& p) {
  const int TIDX = opaque_tid();
  const float4* xp = (const float4*)kin(0);
  const float4* xs = (const float4*)kin(1);
  float4* x = (float4*)kx();
  const size_t n0 = (size_t)32768 * 256, n1 = (size_t)16384 * 256;
  for (size_t i = (size_t)blockIdx.x * 512 + TIDX; i < n0 + n1; i += (size_t)gridDim.x * 512) x[i] = i < n0 ? xp[i] : xs[i - n0];
}

DEV void phase_norm(const Params& p, const float* g, bf16_t* h0) {
  const int TIDX = opaque_tid();
  const int wid = TIDX >> 6, lane = TIDX & 63;
  float4 gv[4];
#pragma unroll
  for (int i = 0; i < 4; ++i) gv[i] = ((const float4*)g)[lane + 64 * i];
  for (int t = blockIdx.x * 8 + wid; t < NT; t += gridDim.x * 8) {
    const float4* xr = (const float4*)(kx() + (size_t)t * 1024);
    float4 v[4]; float ss = 0.f;
#pragma unroll
    for (int i = 0; i < 4; ++i) { v[i] = xr[lane + 64 * i]; ss += v[i].x * v[i].x + v[i].y * v[i].y + v[i].z * v[i].z + v[i].w * v[i].w; }
    ss = wave_sum(ss);
    const float rs = rsqrtf(ss * (1.0f / 1024.f) + 1e-6f);
    uint2* hr = (uint2*)(h0 + (size_t)t * 1024);
#pragma unroll
    for (int i = 0; i < 4; ++i) {
      uint2 o; o.x = pack2(v[i].x * rs * gv[i].x, v[i].y * rs * gv[i].y); o.y = pack2(v[i].z * rs * gv[i].z, v[i].w * rs * gv[i].w);
      hr[lane + 64 * i] = o;
    }
  }
}

DEV void phase_norm_tm(const Params& p, const float* g, bf16_t* hx, int slab) {
  const int TIDX = opaque_tid();
  const int wid = TIDX >> 6, lane = TIDX & 63;
  const int L = slab < 2 ? 16384 : 2048;
  float4 gv[4];
#pragma unroll
  for (int i = 0; i < 4; ++i) gv[i] = ((const float4*)g)[lane + 64 * i];
  for (int ts = blockIdx.x * 8 + wid; ts < SLAB; ts += gridDim.x * 8) {
    const int t = slab * SLAB + ts, pos = ts & (L - 1);
    float4 hv[3][4];
#pragma unroll
    for (int d = 0; d < 3; ++d) {
      const bool valid = !((d == 0 && pos == 0) || (d == 2 && pos == L - 1));
      const int tt = valid ? t + d - 1 : t;
      const float4* xr = (const float4*)(kx() + (size_t)tt * 1024);
      float ss = 0.f;
#pragma unroll
      for (int i = 0; i < 4; ++i) { float4 v = xr[lane + 64 * i]; hv[d][i] = v; ss += v.x * v.x + v.y * v.y + v.z * v.z + v.w * v.w; }
      ss = wave_sum(ss);
      const float rs = valid ? rsqrtf(ss * (1.0f / 1024.f) + 1e-6f) : 0.f;
#pragma unroll
      for (int i = 0; i < 4; ++i) { hv[d][i].x *= rs * gv[i].x; hv[d][i].y *= rs * gv[i].y; hv[d][i].z *= rs * gv[i].z; hv[d][i].w *= rs * gv[i].w; }
    }
    uint2* hr = (uint2*)(hx + (size_t)ts * 2048);
#pragma unroll
    for (int i = 0; i < 4; ++i) {
      uint2 o; o.x = pack2(hv[1][i].x, hv[1][i].y); o.y = pack2(hv[1][i].z, hv[1][i].w);
      hr[lane + 64 * i] = o;
      uint2 q;
      q.x = pack2(0.5f * (hv[0][i].x + hv[2][i].x) - hv[1][i].x, 0.5f * (hv[0][i].y + hv[2][i].y) - hv[1][i].y);
      q.y = pack2(0.5f * (hv[0][i].z + hv[2][i].z) - hv[1][i].z, 0.5f * (hv[0][i].w + hv[2][i].w) - hv[1][i].w);
      hr[256 + lane + 64 * i] = q;
    }
  }
}

DEV void phase_final(const Params& p) {
  const int TIDX = opaque_tid();
  const int wid = TIDX >> 6, lane = TIDX & 63;
  const float* g = kin(4);
  float4 gv[4];
#pragma unroll
  for (int i = 0; i < 4; ++i) gv[i] = ((const float4*)g)[lane + 64 * i];
  for (int t = blockIdx.x * 8 + wid; t < NT; t += gridDim.x * 8) {
    float4* xr = (float4*)(kx() + (size_t)t * 1024);
    float4 v[4]; float ss = 0.f;
#pragma unroll
    for (int i = 0; i < 4; ++i) { v[i] = xr[lane + 64 * i]; ss += v[i].x * v[i].x + v[i].y * v[i].y + v[i].z * v[i].z + v[i].w * v[i].w; }
    ss = wave_sum(ss);
    const float rs = rsqrtf(ss * (1.0f / 1024.f) + 1e-6f);
#pragma unroll
    for (int i = 0; i < 4; ++i) {
      float4 o; o.x = v[i].x * rs * gv[i].x; o.y = v[i].y * rs * gv[i].y; o.z = v[i].z * rs * gv[i].z; o.w = v[i].w * rs * gv[i].w;
      xr[lane + 64 * i] = o;
    }
  }
}

DEV void wprep_T(bf16_t* dst, int ldd, int koff, const float* src, int Ks, int Ns, const float* scale, int rs, int roff) {
  const int TIDX = opaque_tid();
  float (*tile)[33] = (float (*)[33])g_shm;
  const int tx = TIDX & 31, ty = TIDX >> 5;
  const int nkt = Ks / 32, nnt = Ns / 32;
  for (int tIdx = blockIdx.x; tIdx < nkt * nnt; tIdx += gridDim.x) {
    const int k0 = (tIdx / nnt) * 32, n0 = (tIdx % nnt) * 32;
    __syncthreads();
#pragma unroll
    for (int i = 0; i < 2; ++i) tile[ty + 16 * i][tx] = src[(size_t)(k0 + ty + 16 * i) * Ns + n0 + tx];
    __syncthreads();
    const float sc = scale ? scale[k0 + tx] : 1.0f;
#pragma unroll
    for (int i = 0; i < 2; ++i) {
      const int n = n0 + ty + 16 * i;
      const int drow = (n >> 7) * rs + (n & 127) + roff;
      dst[(size_t)drow * ldd + koff + k0 + tx] = f2bf(tile[tx][ty + 16 * i] * sc);
    }
  }
  __syncthreads();
}


DEV void wprep_T2(bf16_t* dst, int ldd, int koff, const float* src, int Ks, int Ns, const float* scale, int rs, int roff) {
  const int TIDX = opaque_tid();
  float* tile = (float*)g_shm;
  const int nkt = Ks / 64, nnt = Ns / 128;
  const int lc = TIDX & 127, lr = TIDX >> 7;
  const int wk = TIDX & 63, wn = TIDX >> 6;
  for (int tIdx = blockIdx.x; tIdx < nkt * nnt; tIdx += gridDim.x) {
    const int k0 = (tIdx / nnt) * 64, n0 = (tIdx % nnt) * 128;
    float v[16];
#pragma unroll
    for (int i = 0; i < 16; ++i) v[i] = src[(size_t)(k0 + i * 4 + lr) * Ns + n0 + lc];
    __syncthreads();
#pragma unroll
    for (int i = 0; i < 16; ++i) tile[(i * 4 + lr) * 129 + lc] = v[i];
    __syncthreads();
    const float sc = scale ? scale[k0 + wk] : 1.0f;
#pragma unroll
    for (int i = 0; i < 16; ++i) {
      const int n = n0 + i * 8 + wn;
      const int drow = (n >> 7) * rs + (n & 127) + roff;
      dst[(size_t)drow * ldd + koff + k0 + wk] = f2bf(tile[wk * 129 + i * 8 + wn] * sc);
    }
  }
  __syncthreads();
}

constexpr int BM = 256, BK = 64, HALF = 128, HT = HALF * BK;
DEV int lds_byte(int r, int c) {
  int st = (r >> 4) * 2 + (c >> 5), rr = r & 15, cc = c & 31, ob = rr * 64 + cc * 2;
  return st * 1024 + (ob ^ (((ob >> 9) & 1) << 5));
}
DEV void stage_rc(int b, int& R, int& C) {
  int st = b / 1024, sb = b % 1024, swz = sb ^ (((sb >> 9) & 1) << 5);
  R = (st >> 1) * 16 + swz / 64; C = (st & 1) * 32 + (swz % 64) / 2;
}

typedef __attribute__((address_space(3))) unsigned char lds_u8;
DEV void gemm_big(const bf16_t* A, long lda, const bf16_t* Bt, long ldb, int K, long brow, long bcol, f32x4 (&acc)[2][2][4][2]) {
  const int TIDX = opaque_tid();
  lds_u8* lds = (lds_u8*)g_shm;
  constexpr int HTB = HT * 2;
#define SA(b, h) (((b) * 2 + (h)) * HTB)
#define SB(b, h) ((4 + (b) * 2 + (h)) * HTB)
#define STAGE(bufoff, gbase, VO, kt) do { const char* _gp = (gbase) + (size_t)(kt) * (BK * 2); \
    __builtin_amdgcn_global_load_lds((const unsigned*)(_gp + VO##0), (__attribute__((address_space(3))) unsigned*)(lds + (bufoff) + ldsw), 16, 0, 0); \
    __builtin_amdgcn_global_load_lds((const unsigned*)(_gp + VO##1), (__attribute__((address_space(3))) unsigned*)(lds + (bufoff) + ldsw + 8192), 16, 0, 0); } while (0)
#define LDA(dst, b, h) for (int m = 0; m < 4; ++m) for (int k = 0; k < 2; ++k) \
    dst[m][k] = *(const __attribute__((address_space(3))) bf16x8*)(lds + SA(b, h) + aoff + m * 2048 + k * 1024)
#define LDB(dst, b, h) for (int n = 0; n < 2; ++n) for (int k = 0; k < 2; ++k) \
    dst[n][k] = *(const __attribute__((address_space(3))) bf16x8*)(lds + SB(b, h) + boff + n * 2048 + k * 1024)
#define MMA(ai, bj, At, Bt_) do { __builtin_amdgcn_s_setprio(1); \
    for (int m = 0; m < 4; ++m) for (int n = 0; n < 2; ++n) for (int k = 0; k < 2; ++k) \
      acc[ai][bj][m][n] = __builtin_amdgcn_mfma_f32_16x16x32_bf16(At[m][k], Bt_[n][k], acc[ai][bj][m][n], 0, 0, 0); \
    __builtin_amdgcn_s_setprio(0); } while (0)
#define WAIT_V(n) asm volatile("s_waitcnt vmcnt(" #n ")" ::: "memory")
#define WAIT_L(n) asm volatile("s_waitcnt lgkmcnt(" #n ")" ::: "memory")
#define BAR __builtin_amdgcn_s_barrier()
#define SCHED __builtin_amdgcn_sched_barrier(0)
  const int tid = TIDX, wid = __builtin_amdgcn_readfirstlane(tid >> 6), lane = tid & 63, wr = wid >> 2, wc = wid & 3, fr = lane & 15, fq = lane >> 4;
  unsigned va0, va1, vb0, vb1;
  { int r_, c_; stage_rc(tid * 16, r_, c_); va0 = (unsigned)((r_ * lda + c_) * 2); vb0 = (unsigned)((r_ * ldb + c_) * 2);
    stage_rc(tid * 16 + 8192, r_, c_); va1 = (unsigned)((r_ * lda + c_) * 2); vb1 = (unsigned)((r_ * ldb + c_) * 2); }
  const unsigned ldsw = (unsigned)wid * 1024u;
  const int aoff = lds_byte(wr * 64 + fr, fq * 8), boff = lds_byte(wc * 32 + fr, fq * 8);
  const char* cA0 = (const char*)(A + brow * lda); const char* cA1 = cA0 + (size_t)HALF * lda * 2;
  const char* cB0 = (const char*)(Bt + bcol * ldb); const char* cB1 = cB0 + (size_t)HALF * ldb * 2;
#pragma unroll
  for (int a = 0; a < 2; ++a)
#pragma unroll
    for (int b = 0; b < 2; ++b)
#pragma unroll
      for (int m = 0; m < 4; ++m)
#pragma unroll
        for (int n = 0; n < 2; ++n) acc[a][b][m][n] = (f32x4){0.f, 0.f, 0.f, 0.f};
  bf16x8 At[4][2], B0[2][2], B1[2][2];
  const int nt = K / BK;
  STAGE(SB(0, 0), cB0, vb, 0); STAGE(SA(0, 0), cA0, va, 0);
  STAGE(SB(0, 1), cB1, vb, 0); STAGE(SA(0, 1), cA1, va, 0);
  if (wr == 1) BAR;
  WAIT_V(4); BAR;
  STAGE(SB(1, 0), cB0, vb, 1); STAGE(SA(1, 0), cA0, va, 1); STAGE(SB(1, 1), cB1, vb, 1);
  WAIT_V(6); BAR;
  for (int t = 0; t < nt - 2; t += 2) {
    LDB(B0, 0, 0); SCHED; LDA(At, 0, 0); STAGE(SA(1, 1), cA1, va, t + 1);
    WAIT_L(8); BAR; WAIT_L(0); MMA(0, 0, At, B0); BAR; SCHED;
    LDB(B1, 0, 1); STAGE(SB(0, 0), cB0, vb, t + 2);
    BAR; WAIT_L(0); MMA(0, 1, At, B1); BAR;
    LDA(At, 0, 1); STAGE(SA(0, 0), cA0, va, t + 2);
    BAR; WAIT_L(0); MMA(1, 0, At, B0); BAR; SCHED;
    STAGE(SB(0, 1), cB1, vb, t + 2);
    WAIT_V(6); BAR; MMA(1, 1, At, B1); BAR;
    LDB(B0, 1, 0); SCHED; LDA(At, 1, 0); STAGE(SA(0, 1), cA1, va, t + 2);
    WAIT_L(8); BAR; WAIT_L(0); MMA(0, 0, At, B0); BAR; SCHED;
    LDB(B1, 1, 1); STAGE(SB(1, 0), cB0, vb, t + 3);
    BAR; WAIT_L(0); MMA(0, 1, At, B1); BAR;
    LDA(At, 1, 1); STAGE(SA(1, 0), cA0, va, t + 3);
    BAR; WAIT_L(0); MMA(1, 0, At, B0); BAR; SCHED;
    STAGE(SB(1, 1), cB1, vb, t + 3);
    WAIT_V(6); BAR; MMA(1, 1, At, B1); BAR;
  }
  { LDB(B0, 0, 0); LDA(At, 0, 0); STAGE(SA(1, 1), cA1, va, nt - 1);
    BAR; WAIT_L(0); MMA(0, 0, At, B0); BAR;
    LDB(B1, 0, 1); BAR; WAIT_L(0); MMA(0, 1, At, B1); BAR;
    LDA(At, 0, 1); WAIT_V(4); BAR; WAIT_L(0); MMA(1, 0, At, B0); MMA(1, 1, At, B1); BAR; }
  { LDB(B0, 1, 0); LDA(At, 1, 0); WAIT_V(2); BAR; WAIT_L(0); MMA(0, 0, At, B0); BAR;
    LDB(B1, 1, 1); WAIT_V(0); BAR; WAIT_L(0); MMA(0, 1, At, B1); BAR;
    LDA(At, 1, 1); BAR; WAIT_L(0); MMA(1, 0, At, B0); MMA(1, 1, At, B1); BAR; }
  if (wr == 0) BAR;
}
DEV void dump_half(const f32x4 (&acc)[2][2][4][2], int ai, int tid) {
  float* T = (float*)g_shm;
  const int wid = tid >> 6, lane = tid & 63, wr = wid >> 2, wc = wid & 3, fr = lane & 15, fq = lane >> 4;
#pragma unroll
  for (int bj = 0; bj < 2; ++bj)
#pragma unroll
    for (int m = 0; m < 4; ++m)
#pragma unroll
      for (int n = 0; n < 2; ++n)
#pragma unroll
        for (int jj = 0; jj < 4; ++jj) {
          const int r = wr * 64 + m * 16 + fq * 4 + jj, c = bj * 128 + wc * 32 + n * 16 + fr;
          T[r * 256 + (c ^ (fq << 4))] = (ai == 0) ? acc[0][bj][m][n][jj] : acc[1][bj][m][n][jj];
        }
}
DEV float4 tile_ld4(int r, int c4) { return *(const float4*)((const float*)g_shm + r * 256 + (c4 ^ (((r >> 2) & 3) << 4))); }
DEV float tile_ld(int r, int c) { return ((const float*)g_shm)[r * 256 + (c ^ (((r >> 2) & 3) << 4))]; }

DEV int vblock() { return (blockIdx.x & 7) * (gridDim.x >> 3) + (blockIdx.x >> 3); }

DEV void phase_gemm_res(const Params& p, const bf16_t* A, long lda, const bf16_t* Bt, int K, int mtiles, long xrow0) {
  float* X = kx();
  for (int tile = vblock(); tile < mtiles * 4; tile += gridDim.x) {
    const int pm = tile >> 2, pn = tile & 3;
    f32x4 acc[2][2][4][2];
    gemm_big(A, lda, Bt, K, K, (long)pm * 256, (long)pn * 256, acc);
    const int tid = opaque_tid();
#pragma unroll
    for (int ai = 0; ai < 2; ++ai) {
      __syncthreads();
      dump_half(acc, ai, tid);
      __syncthreads();
      for (int e = tid; e < 128 * 64; e += 512) {
        const int r = e >> 6, c4 = (e & 63) * 4;
        const float4 v = tile_ld4(r, c4);
        float4* q = (float4*)(X + (xrow0 + pm * 256 + ai * 128 + r) * 1024 + pn * 256 + c4);
        float4 o = *q; o.x += v.x; o.y += v.y; o.z += v.z; o.w += v.w; *q = o;
      }
    }
    __syncthreads();
  }
}

DEV void phase_sgu_in(const Params& p, int j, int slab) {
  const bf16_t* A = (const bf16_t*)(kws() + OFF_H0) + (size_t)slab * SLAB * 1024;
  const bf16_t* Bt = (const bf16_t*)(kws() + OFF_W + W_SG_IN);
  const float* bin = kin(6) + (size_t)j * 4096;
  bf16_t* Z = (bf16_t*)(kws() + OFF_U);
  float* SSQ = (float*)(kws() + OFF_SSQ);
  for (int tile = vblock(); tile < 64 * 16; tile += gridDim.x) {
    const int pm = tile >> 4, pn = tile & 15;
    f32x4 acc[2][2][4][2];
    gemm_big(A, 1024, Bt, 1024, 1024, (long)pm * 256, (long)pn * 256, acc);
    const int tid = opaque_tid(), wid = tid >> 6, lane = tid & 63;
    const float4 b4 = *(const float4*)(bin + pn * 256 + lane * 4);
#pragma unroll
    for (int ai = 0; ai < 2; ++ai) {
      __syncthreads();
      dump_half(acc, ai, tid);
      __syncthreads();
      for (int rr = 0; rr < 16; ++rr) {
        const int r = wid * 16 + rr;
        const float4 v = tile_ld4(r, lane * 4);
        const f32x2 za = gelu_pk((f32x2){v.x + b4.x, v.y + b4.y}), zb = gelu_pk((f32x2){v.z + b4.z, v.w + b4.w});
        const float z0 = za.x, z1 = za.y, z2 = zb.x, z3 = zb.y;
        const int row = pm * 256 + ai * 128 + r;
        uint2 o; o.x = pack2(z0, z1); o.y = pack2(z2, z3);
        *(uint2*)(Z + (size_t)row * 4096 + pn * 256 + lane * 4) = o;
        if (pn >= 8) {
          const float ss = wave_sum(z0 * z0 + z1 * z1 + z2 * z2 + z3 * z3);
          if (lane == 0) SSQ[(size_t)row * 8 + (pn - 8)] = ss;
        }
      }
    }
    __syncthreads();
  }
}

DEV void phase_tm_proj(const Params& p) {
  const bf16_t* A = (const bf16_t*)(kws() + OFF_HX);
  const bf16_t* Bt = (const bf16_t*)(kws() + OFF_W + W_TM_P);
  for (int tile = vblock(); tile < 64 * 14; tile += gridDim.x) {
    const int pm = tile / 14, pn = tile % 14;
    f32x4 acc[2][2][4][2];
    gemm_big(A, 2048, Bt, 2048, 2048, (long)pm * 256, (long)pn * 256, acc);
    const int tid = opaque_tid(), wid = tid >> 6, lane = tid & 63;
    bf16_t* O; int ld, cb;
    if (pn < 12) { O = (bf16_t*)(kws() + (pn < 4 ? OFF_R : (pn < 8 ? OFF_K : OFF_V))); ld = 1024; cb = (pn & 3) * 256; }
    else { O = (bf16_t*)(kws() + OFF_HL); ld = 512; cb = (pn - 12) * 256; }
    const int act = pn < 12 ? 0 : (pn == 12 ? (lane < 32 ? 1 : 0) : 2);
#pragma unroll
    for (int ai = 0; ai < 2; ++ai) {
      __syncthreads();
      dump_half(acc, ai, tid);
      __syncthreads();
      for (int rr = 0; rr < 16; ++rr) {
        const int r = wid * 16 + rr;
        float4 v = tile_ld4(r, lane * 4);
        if (act == 1) { v.x = tanhf(v.x); v.y = tanhf(v.y); v.z = tanhf(v.z); v.w = tanhf(v.w); }
        else if (act == 2) { v.x = sigmoidf_(v.x); v.y = sigmoidf_(v.y); v.z = sigmoidf_(v.z); v.w = sigmoidf_(v.w); }
        uint2 o; o.x = pack2(v.x, v.y); o.y = pack2(v.z, v.w);
        *(uint2*)(O + (size_t)(pm * 256 + ai * 128 + r) * ld + cb + lane * 4) = o;
      }
    }
    __syncthreads();
  }
}

DEV void phase_ffn_a(const Params& p, int layer) {
  const bf16_t* A = (const bf16_t*)(kws() + OFF_H0);
  const bf16_t* Bt = (const bf16_t*)(kws() + OFF_W + W_FF_A);
  bf16_t* HM = (bf16_t*)(kws() + OFF_HMID);
  const float* cw = kin(31) + (size_t)layer * 3 * 2816;
  const float* cb = kin(32) + (size_t)layer * 2816;
  float* UP = (float*)g_shm;
  bf16_t* gl = (bf16_t*)(g_shm + 65536);
  for (int tile = vblock(); tile < 202 * 22; tile += gridDim.x) {
    const int mi = tile / 22, pn = tile % 22;
    int base, L, i;
    if (mi < 130) { base = (mi / 65) * 16384; L = 16384; i = mi % 65; }
    else { const int m2 = mi - 130; base = 32768 + (m2 / 9) * 2048; L = 2048; i = m2 % 9; }
    const int s0 = 254 * i - 1;
    f32x4 acc[2][2][4][2];
    gemm_big(A, 1024, Bt, 1024, 1024, (long)base + s0, (long)pn * 256, acc);
    const int tid = opaque_tid(), wid = tid >> 6, lane = tid & 63, wr = wid >> 2, wc = wid & 3, fr = lane & 15, fq = lane >> 4;
    __syncthreads();
#pragma unroll
    for (int ai = 0; ai < 2; ++ai)
#pragma unroll
      for (int m = 0; m < 4; ++m)
#pragma unroll
        for (int n = 0; n < 2; ++n)
#pragma unroll
          for (int jj = 0; jj < 4; ++jj) {
            const int r = ai * 128 + wr * 64 + m * 16 + fq * 4 + jj, c = wc * 32 + n * 16 + fr;
            const int s = s0 + r;
            gl[r * 136 + c] = (s >= 0 && s < L) ? f2bf(acc[ai][0][m][n][jj]) : (bf16_t)0;
          }
    const int c4 = (lane & 31) * 4, f = pn * 128 + c4;
    const float4 w0 = *(const float4*)(cw + f), w1 = *(const float4*)(cw + 2816 + f), w2 = *(const float4*)(cw + 2 * 2816 + f), bb = *(const float4*)(cb + f);
#pragma unroll
    for (int ai = 0; ai < 2; ++ai) {
      __syncthreads();
#pragma unroll
      for (int m = 0; m < 4; ++m)
#pragma unroll
        for (int n = 0; n < 2; ++n)
#pragma unroll
          for (int jj = 0; jj < 4; ++jj) {
            const int r = wr * 64 + m * 16 + fq * 4 + jj, c = wc * 32 + n * 16 + fr;
            UP[r * 128 + (c ^ (fq << 4))] = (ai == 0) ? acc[0][1][m][n][jj] : acc[1][1][m][n][jj];
          }
      __syncthreads();
      for (int e = tid; e < 128 * 32; e += 512) {
        const int rl = e >> 5, r = ai * 128 + rl, s = s0 + r;
        if (r >= 1 && r <= 254 && s < L) {
          const float4 u = *(const float4*)(UP + rl * 128 + (c4 ^ (((rl >> 2) & 3) << 4)));
          const uint2 g0 = *(const uint2*)(gl + (r - 1) * 136 + c4), g1 = *(const uint2*)(gl + r * 136 + c4), g2 = *(const uint2*)(gl + (r + 1) * 136 + c4);
          const float c0 = w0.x * __uint_as_float(g0.x << 16) + w1.x * __uint_as_float(g1.x << 16) + w2.x * __uint_as_float(g2.x << 16) + bb.x;
          const float c1 = w0.y * __uint_as_float(g0.x & 0xffff0000u) + w1.y * __uint_as_float(g1.x & 0xffff0000u) + w2.y * __uint_as_float(g2.x & 0xffff0000u) + bb.y;
          const float c2 = w0.z * __uint_as_float(g0.y << 16) + w1.z * __uint_as_float(g1.y << 16) + w2.z * __uint_as_float(g2.y << 16) + bb.z;
          const float c3 = w0.w * __uint_as_float(g0.y & 0xffff0000u) + w1.w * __uint_as_float(g1.y & 0xffff0000u) + w2.w * __uint_as_float(g2.y & 0xffff0000u) + bb.w;
          const f32x2 ga = gelu_pk((f32x2){c0, c1}), gb = gelu_pk((f32x2){c2, c3});
          uint2 o; o.x = pack2(ga.x * u.x, ga.y * u.y); o.y = pack2(gb.x * u.z, gb.y * u.w);
          *(uint2*)(HM + (size_t)(base + s) * 2816 + f) = o;
        }
      }
    }
    __syncthreads();
  }
}

template <int KP>
DEV void small_mma(f32x4 (&acc)[4][4]) {
  const int TIDX = opaque_tid();
  constexpr int LD = KP + 8;
  const bf16_t* sA = (const bf16_t*)g_shm;
  const bf16_t* sB = sA + 128 * LD;
  const int wid = TIDX >> 6, lane = TIDX & 63, wr = wid >> 2, wc = wid & 3, fr = lane & 15, fq = lane >> 4;
#pragma unroll
  for (int m = 0; m < 4; ++m)
#pragma unroll
    for (int n = 0; n < 4; ++n) acc[m][n] = (f32x4){0.f, 0.f, 0.f, 0.f};
#pragma unroll
  for (int kk = 0; kk < KP / 32; ++kk) {
    bf16x8 a[4], b[4];
#pragma unroll
    for (int m = 0; m < 4; ++m) a[m] = *(const bf16x8*)(sA + (wr * 64 + m * 16 + fr) * LD + kk * 32 + fq * 8);
#pragma unroll
    for (int n = 0; n < 4; ++n) b[n] = *(const bf16x8*)(sB + (wc * 64 + n * 16 + fr) * LD + kk * 32 + fq * 8);
#pragma unroll
    for (int m = 0; m < 4; ++m)
#pragma unroll
      for (int n = 0; n < 4; ++n) acc[m][n] = __builtin_amdgcn_mfma_f32_16x16x32_bf16(a[m], b[n], acc[m][n], 0, 0, 0);
  }
}
template <int KP>
DEV void small_load_ab(bf16_t* sA, const bf16_t* gA, long lda, bf16_t* sB, const bf16_t* gB, long ldb, int tid) {
  constexpr int LD = KP + 8, CPR = KP / 8, TA = 128 * CPR, TB = 256 * CPR, IA = TA / 512, IB = TB / 512;
  static_assert(TA % 512 == 0 && TB % 512 == 0, "panel sizes must be multiples of the block");
  uint4 va[IA], vb[IB];
#pragma unroll
  for (int it = 0; it < IA; ++it) { const int c = tid + it * 512; va[it] = *(const uint4*)(gA + (long)(c / CPR) * lda + (c % CPR) * 8); }
#pragma unroll
  for (int it = 0; it < IB; ++it) { const int c = tid + it * 512; vb[it] = *(const uint4*)(gB + (long)(c / CPR) * ldb + (c % CPR) * 8); }
#pragma unroll
  for (int it = 0; it < IA; ++it) { const int c = tid + it * 512; *(uint4*)(sA + (c / CPR) * LD + (c % CPR) * 8) = va[it]; }
#pragma unroll
  for (int it = 0; it < IB; ++it) { const int c = tid + it * 512; *(uint4*)(sB + (c / CPR) * LD + (c % CPR) * 8) = vb[it]; }
}

DEV void phase_sgu_mix(const Params& p, int j) {
  const int TIDX = opaque_tid();
  constexpr int KP = 128, LD = KP + 8;
  const int wid = TIDX >> 6, lane = TIDX & 63, wr = wid >> 2, wc = wid & 3, fr = lane & 15, fq = lane >> 4;
  bf16_t* sA = (bf16_t*)g_shm;
  bf16_t* sB = sA + 128 * LD;
  float* rsv = (float*)(g_shm + (128 + 256) * LD * 2);
  bf16_t* Z = (bf16_t*)(kws() + OFF_U);
  const float* SSQ = (const float*)(kws() + OFF_SSQ);
  const float* ws_ = kin(8) + (size_t)j * 8 * 128 * 128;
  const float* bs = kin(9) + (size_t)j * 8 * 128;
  const float* ng = kin(7) + (size_t)j * 2048;
  for (int unit = blockIdx.x; unit < 128 * 8; unit += gridDim.x) {
    const int chunk = unit >> 3, g = unit & 7;
    __syncthreads();
    uint4 vb[8]; float4 wa[4][2];
#pragma unroll
    for (int it = 0; it < 8; ++it) {
      const int e = TIDX + it * 512, pp = e & 127, c8 = (e >> 7) * 8;
      vb[it] = *(const uint4*)(Z + (size_t)(chunk * 128 + pp) * 4096 + 2048 + g * 256 + c8);
    }
#pragma unroll
    for (int it = 0; it < 4; ++it) {
      const int c = TIDX + it * 512, q = c >> 4, p8 = (c & 15) * 8;
      const float4* wp = (const float4*)(ws_ + ((size_t)g * 128 + q) * 128 + p8);
      wa[it][0] = wp[0]; wa[it][1] = wp[1];
    }
    if (TIDX < 128) {
      const float4* sp = (const float4*)(SSQ + (size_t)(chunk * 128 + TIDX) * 8);
      const float4 s0 = sp[0], s1 = sp[1];
      const float sm = ((s0.x + s0.y) + (s0.z + s0.w)) + ((s1.x + s1.y) + (s1.z + s1.w));
      rsv[TIDX] = rsqrtf(sm * (1.0f / 2048.f) + 1e-6f);
    }
#pragma unroll
    for (int it = 0; it < 8; ++it) {
      const int e = TIDX + it * 512, pp = e & 127, c8 = (e >> 7) * 8;
      const uint4 v = vb[it];
      sB[(c8 + 0) * LD + pp] = (bf16_t)(v.x & 0xffff); sB[(c8 + 1) * LD + pp] = (bf16_t)(v.x >> 16);
      sB[(c8 + 2) * LD + pp] = (bf16_t)(v.y & 0xffff); sB[(c8 + 3) * LD + pp] = (bf16_t)(v.y >> 16);
      sB[(c8 + 4) * LD + pp] = (bf16_t)(v.z & 0xffff); sB[(c8 + 5) * LD + pp] = (bf16_t)(v.z >> 16);
      sB[(c8 + 6) * LD + pp] = (bf16_t)(v.w & 0xffff); sB[(c8 + 7) * LD + pp] = (bf16_t)(v.w >> 16);
    }
    __syncthreads();
#pragma unroll
    for (int it = 0; it < 4; ++it) {
      const int c = TIDX + it * 512, q = c >> 4, p8 = (c & 15) * 8;
      const float4 w0 = wa[it][0], w1 = wa[it][1];
      uint4 o;
      o.x = pack2(w0.x * rsv[p8 + 0], w0.y * rsv[p8 + 1]); o.y = pack2(w0.z * rsv[p8 + 2], w0.w * rsv[p8 + 3]);
      o.z = pack2(w1.x * rsv[p8 + 4], w1.y * rsv[p8 + 5]); o.w = pack2(w1.z * rsv[p8 + 6], w1.w * rsv[p8 + 7]);
      *(uint4*)(sA + q * LD + p8) = o;
    }
    __syncthreads();
    f32x4 acc[4][4];
    small_mma<KP>(acc);
#pragma unroll
    for (int m = 0; m < 4; ++m)
#pragma unroll
      for (int n = 0; n < 4; ++n) {
        const int c = g * 256 + wc * 64 + n * 16 + fr;
        const float gg = ng[c];
#pragma unroll
        for (int jj = 0; jj < 4; ++jj) {
          const int q = wr * 64 + m * 16 + fq * 4 + jj;
          const float mix = acc[m][n][jj] * gg + bs[g * 128 + q];
          bf16_t* up = Z + (size_t)(chunk * 128 + q) * 4096 + c;
          *up = f2bf(bf2f(*up) * mix);
        }
      }
  }
  __syncthreads();
}

template <int KP>
DEV void lora_out_unit(const Params& p, int j, int kind, int mt, int ntile) {
  const int TIDX = opaque_tid();
  constexpr int LD = KP + 8;
  const int wid = TIDX >> 6, lane = TIDX & 63, wr = wid >> 2, wc = wid & 3, fr = lane & 15, fq = lane >> 4;
  bf16_t* sA = (bf16_t*)g_shm;
  bf16_t* sB = sA + 128 * LD;
  const bf16_t* HL = (const bf16_t*)(kws() + OFF_HL);
  const int koff = kind < 4 ? kind * 64 : 256;
  const bf16_t* Bt = (const bf16_t*)(kws() + OFF_W + (kind < 2 ? W_TM_W2 + (size_t)kind * 1024 * 64 * 2 : (kind < 4 ? W_TM_A2 + (size_t)(kind - 2) * 1024 * 64 * 2 : W_TM_G2)));
  bf16_t* O = (bf16_t*)(kws() + (kind == 0 ? OFF_E0 : kind == 1 ? OFF_E1 : kind == 2 ? OFF_A0 : kind == 3 ? OFF_A1 : OFF_G));
  const float* bias = kind < 2 ? kin(15) + ((size_t)j * 2 + kind) * 1024 : (kind < 4 ? kin(18) + ((size_t)j * 2 + kind - 2) * 1024 : nullptr);
  __syncthreads();
  small_load_ab<KP>(sA, HL + (size_t)mt * 128 * 512 + koff, 512, sB, Bt + (size_t)ntile * 256 * KP, KP, TIDX);
  __syncthreads();
  f32x4 acc[4][4];
  small_mma<KP>(acc);
#pragma unroll
  for (int m = 0; m < 4; ++m)
#pragma unroll
    for (int n = 0; n < 4; ++n) {
      const int col = ntile * 256 + wc * 64 + n * 16 + fr;
      const float b = bias ? bias[col] : 0.f;
#pragma unroll
      for (int jj = 0; jj < 4; ++jj) {
        const int row = mt * 128 + wr * 64 + m * 16 + fq * 4 + jj;
        float v = acc[m][n][jj] + b;
        if (kind < 2) v = 0.6065306597126334f * sigmoidf_(v); else if (kind < 4) v = sigmoidf_(v);
        O[(size_t)row * 1024 + col] = f2bf(v);
      }
    }
}
DEV void phase_tm_lora_out(const Params& p, int j) {
  for (int unit = blockIdx.x; unit < 5 * 512; unit += gridDim.x) {
    const int kind = unit / 512, r = unit % 512, mt = r >> 2, ntile = r & 3;
    if (kind < 4) lora_out_unit<64>(p, j, kind, mt, ntile); else lora_out_unit<160>(p, j, kind, mt, ntile);
  }
  __syncthreads();
}

constexpr int LDP = 72;
constexpr int MATE = 64 * LDP;
DEV bf16_t* lbuf(int i) { return (bf16_t*)g_shm + i * MATE; }
DEV void bmm(const bf16_t* A, const bf16_t* Bt, int mb, int nh, int fr, int fq, f32x4 (&acc)[2]) {
  acc[0] = (f32x4){0.f, 0.f, 0.f, 0.f}; acc[1] = (f32x4){0.f, 0.f, 0.f, 0.f};
#pragma unroll
  for (int kk = 0; kk < 2; ++kk) {
    const bf16x8 a = *(const bf16x8*)(A + (mb * 16 + fr) * LDP + kk * 32 + fq * 8);
#pragma unroll
    for (int n = 0; n < 2; ++n) {
      const bf16x8 b = *(const bf16x8*)(Bt + (nh * 32 + n * 16 + fr) * LDP + kk * 32 + fq * 8);
      acc[n] = __builtin_amdgcn_mfma_f32_16x16x32_bf16(a, b, acc[n], 0, 0, 0);
    }
  }
}
#define LBAR2() do { asm volatile("s_waitcnt lgkmcnt(0)" ::: "memory"); __builtin_amdgcn_s_barrier(); asm volatile("" ::: "memory"); } while (0)
DEV void st_rm(bf16_t* C, const f32x4 (&v)[2], int mb, int nh, int fr, int fq) {
#pragma unroll
  for (int n = 0; n < 2; ++n)
#pragma unroll
    for (int j = 0; j < 4; ++j) C[(mb * 16 + fq * 4 + j) * LDP + nh * 32 + n * 16 + fr] = f2bf(v[n][j]);
}
DEV void st_tr(bf16_t* CT, const f32x4 (&v)[2], int mb, int nh, int fr, int fq) {
#pragma unroll
  for (int n = 0; n < 2; ++n) {
    uint2 o; o.x = pack2(v[n][0], v[n][1]); o.y = pack2(v[n][2], v[n][3]);
    *(uint2*)(CT + (nh * 32 + n * 16 + fr) * LDP + mb * 16 + fq * 4) = o;
  }
}

DEV void phase_wkv_a(const Params& p, int jl, int slab) {
  const int TIDX = opaque_tid();
  const int wid = __builtin_amdgcn_readfirstlane(TIDX >> 6), lane = TIDX & 63, fr = lane & 15, fq = lane >> 4, mb = wid >> 1, nh = wid & 1;
  const bf16_t* Rb = (const bf16_t*)(kws() + OFF_R);
  const bf16_t* Kb = (const bf16_t*)(kws() + OFF_K);
  const bf16_t* Vb = (const bf16_t*)(kws() + OFF_V);
  float* PSI = (float*)(kws() + OFF_PSI);
  float* BON = (float*)(kws() + OFF_BON);
  float* segsum = (float*)(g_shm + 15 * MATE * 2);
  float* gTs = segsum + 512;
  bf16_t *mAtil = lbuf(0), *mBtil = lbuf(1), *mKtil = lbuf(2), *mRtil = lbuf(3), *mBgamT = lbuf(4), *mKgam = lbuf(5), *mAtilT = lbuf(6), *mVT = lbuf(7),
         *mMak = lbuf(10), *mMrk = lbuf(11), *mMrbT = lbuf(12);
  uint4 nr, nk, nv, na, ne;
  const int lr = TIDX >> 3, lc8 = (TIDX & 7) * 8;
  auto load_raw = [&](int u) {
    const int e2 = u & 1, h2 = (u >> 1) & 15, c2 = u >> 5;
    const bf16_t* A2 = (const bf16_t*)(kws() + (e2 ? OFF_A1 : OFF_A0));
    const bf16_t* E2 = (const bf16_t*)(kws() + (e2 ? OFF_E1 : OFF_E0));
    const size_t o = (size_t)c2 * 64 * 1024 + h2 * 64 + (size_t)lr * 1024 + lc8;
    nr = *(const uint4*)(Rb + o); nk = *(const uint4*)(Kb + o); nv = *(const uint4*)(Vb + o); na = *(const uint4*)(A2 + o); ne = *(const uint4*)(E2 + o);
  };
  if ((int)blockIdx.x < 256 * 32) load_raw(blockIdx.x);
  for (int unit = blockIdx.x; unit < 256 * 32; unit += gridDim.x) {
    const int e = unit & 1, h = (unit >> 1) & 15, c = unit >> 5;
    bf16_t* Ab = (bf16_t*)(kws() + (e ? OFF_A1 : OFF_A0));
    bf16_t* Eb = (bf16_t*)(kws() + (e ? OFF_E1 : OFF_E0));
    bf16_t* YL = (bf16_t*)(kws() + (e ? OFF_YLB : OFF_YLF));
    const size_t tile0 = (size_t)c * 64 * 1024 + h * 64;
    {
      const int jcol = lane, sg = wid;
      const float kkw = kin(23)[(size_t)jl * 1024 + h * 64 + jcol], kaw = kin(24)[(size_t)jl * 1024 + h * 64 + jcol], rkw = kin(25)[(size_t)jl * 1024 + h * 64 + jcol];
      *(uint4*)(lbuf(8) + lr * LDP + lc8) = nr; *(uint4*)(lbuf(9) + lr * LDP + lc8) = nk; *(uint4*)(lbuf(10) + lr * LDP + lc8) = nv;
      *(uint4*)(lbuf(11) + lr * LDP + lc8) = na; *(uint4*)(lbuf(12) + lr * LDP + lc8) = ne;
      LBAR2();
      if (unit + (int)gridDim.x < 256 * 32) load_raw(unit + gridDim.x);
      float rv[8], kv[8], vv[8], av[8], lw[8];
#pragma unroll
      for (int q = 0; q < 8; ++q) {
        const int tau = sg * 8 + q, tok = e ? 63 - tau : tau;
        rv[q] = bf2f(lbuf(8)[tok * LDP + jcol]); kv[q] = bf2f(lbuf(9)[tok * LDP + jcol]); vv[q] = bf2f(lbuf(10)[tok * LDP + jcol]);
        av[q] = bf2f(lbuf(11)[tok * LDP + jcol]); lw[q] = -bf2f(lbuf(12)[tok * LDP + jcol]);
      }
      float pre[8]; float run = 0.f;
#pragma unroll
      for (int q = 0; q < 8; ++q) { run += lw[q]; pre[q] = run; }
      segsum[sg * 64 + jcol] = run;
      LBAR2();
      float off = 0.f, tot = 0.f;
#pragma unroll
      for (int s2 = 0; s2 < 8; ++s2) { const float sv = segsum[s2 * 64 + jcol]; tot += sv; if (s2 < sg) off += sv; }
      if (sg == 0) gTs[jcol] = __expf(tot);
      float at[8], bg[8], vt[8];
#pragma unroll
      for (int q = 0; q < 8; ++q) {
        const int tau = sg * 8 + q, tok = e ? 63 - tau : tau;
        const float g = off + pre[q], gp = g - lw[q];
        const float kr = kv[q] * kkw;
        const float ss = wave_sum(kr * kr);
        const float kk = kr * __builtin_amdgcn_rsqf(fmaxf(ss, 1e-24f));
        const float b = kk * av[q], kd = kv[q] * (1.0f + (av[q] - 1.0f) * kaw);
        const float eg = __expf(g), eng = __expf(-g), egp = __expf(gp), egt = __expf(tot - g);
        const float atil = -kk * egp;
        mAtil[tau * LDP + jcol] = f2bf(atil);
        mBtil[tau * LDP + jcol] = f2bf(b * eng);
        mKtil[tau * LDP + jcol] = f2bf(kd * eng);
        mRtil[tau * LDP + jcol] = f2bf(rv[q] * eg);
        mKgam[tau * LDP + jcol] = f2bf(kd * egt);
        at[q] = atil; bg[q] = b * egt; vt[q] = vv[q];
        const float bon = wave_sum(rv[q] * kd * rkw);
        if (lane == 0) BON[((size_t)e * SLAB + c * 64 + tok) * 16 + h] = bon;
      }
      uint4 o;
      o.x = pack2(at[0], at[1]); o.y = pack2(at[2], at[3]); o.z = pack2(at[4], at[5]); o.w = pack2(at[6], at[7]);
      *(uint4*)(mAtilT + jcol * LDP + sg * 8) = o;
      o.x = pack2(bg[0], bg[1]); o.y = pack2(bg[2], bg[3]); o.z = pack2(bg[4], bg[5]); o.w = pack2(bg[6], bg[7]);
      *(uint4*)(mBgamT + jcol * LDP + sg * 8) = o;
      o.x = pack2(vt[0], vt[1]); o.y = pack2(vt[2], vt[3]); o.z = pack2(vt[4], vt[5]); o.w = pack2(vt[6], vt[7]);
      *(uint4*)(mVT + jcol * LDP + sg * 8) = o;
    }
    LBAR2();
    f32x4 acc[2], acc2[2];
    bmm(mBtil, mAtil, mb, nh, fr, fq, acc);
#pragma unroll
    for (int n = 0; n < 2; ++n)
#pragma unroll
      for (int j = 0; j < 4; ++j) { const int s = mb * 16 + fq * 4 + j, t = nh * 32 + n * 16 + fr; acc[n][j] = s < t ? acc[n][j] : 0.f; }
    st_rm(lbuf(8), acc, mb, nh, fr, fq); st_tr(lbuf(9), acc, mb, nh, fr, fq);
#pragma unroll
    for (int n = 0; n < 2; ++n)
#pragma unroll
      for (int j = 0; j < 4; ++j) { const int s = mb * 16 + fq * 4 + j, t = nh * 32 + n * 16 + fr; acc[n][j] += (s == t) ? 1.f : 0.f; }
    st_rm(lbuf(13), acc, mb, nh, fr, fq);
    bmm(mKtil, mAtil, mb, nh, fr, fq, acc);
#pragma unroll
    for (int n = 0; n < 2; ++n)
#pragma unroll
      for (int j = 0; j < 4; ++j) { const int s = mb * 16 + fq * 4 + j, t = nh * 32 + n * 16 + fr; acc[n][j] = s < t ? acc[n][j] : 0.f; }
    st_rm(mMak, acc, mb, nh, fr, fq);
    bmm(mKtil, mRtil, mb, nh, fr, fq, acc);
#pragma unroll
    for (int n = 0; n < 2; ++n)
#pragma unroll
      for (int j = 0; j < 4; ++j) { const int s = mb * 16 + fq * 4 + j, t = nh * 32 + n * 16 + fr; acc[n][j] = s <= t ? acc[n][j] : 0.f; }
    st_rm(mMrk, acc, mb, nh, fr, fq);
    bmm(mBtil, mRtil, mb, nh, fr, fq, acc);
#pragma unroll
    for (int n = 0; n < 2; ++n)
#pragma unroll
      for (int j = 0; j < 4; ++j) { const int s = mb * 16 + fq * 4 + j, t = nh * 32 + n * 16 + fr; acc[n][j] = s <= t ? acc[n][j] : 0.f; }
    st_tr(mMrbT, acc, mb, nh, fr, fq);
    LBAR2();
    bmm(lbuf(8), lbuf(9), mb, nh, fr, fq, acc);
    st_rm(lbuf(1), acc, mb, nh, fr, fq); st_tr(lbuf(2), acc, mb, nh, fr, fq);
    LBAR2();
#pragma unroll
    for (int k = 0; k < 4; ++k) {
      const int pc = (k & 1) ? 8 : 1, pn = (k & 1) ? 1 : 8, wc_ = (k & 1) ? 14 : 13, wn = (k & 1) ? 13 : 14;
      bmm(lbuf(wc_), lbuf(pc + 1), mb, nh, fr, fq, acc);
      bmm(lbuf(pc), lbuf(pc + 1), mb, nh, fr, fq, acc2);
#pragma unroll
      for (int n = 0; n < 2; ++n)
#pragma unroll
        for (int j = 0; j < 4; ++j) acc[n][j] += bf2f(lbuf(wc_)[(mb * 16 + fq * 4 + j) * LDP + nh * 32 + n * 16 + fr]);
      st_rm(lbuf(wn), acc, mb, nh, fr, fq);
      st_rm(lbuf(pn), acc2, mb, nh, fr, fq); st_tr(lbuf(pn + 1), acc2, mb, nh, fr, fq);
      LBAR2();
    }
    bmm(lbuf(13), lbuf(2), mb, nh, fr, fq, acc);
#pragma unroll
    for (int n = 0; n < 2; ++n)
#pragma unroll
      for (int j = 0; j < 4; ++j) acc[n][j] += bf2f(lbuf(13)[(mb * 16 + fq * 4 + j) * LDP + nh * 32 + n * 16 + fr]);
    st_rm(lbuf(14), acc, mb, nh, fr, fq);
    LBAR2();
    bmm(mMrbT, lbuf(14), mb, nh, fr, fq, acc);  st_rm(lbuf(8), acc, mb, nh, fr, fq);
    bmm(mBgamT, lbuf(14), mb, nh, fr, fq, acc); st_rm(lbuf(9), acc, mb, nh, fr, fq);
    LBAR2();
    bmm(lbuf(8), mMak, mb, nh, fr, fq, acc);
#pragma unroll
    for (int n = 0; n < 2; ++n)
#pragma unroll
      for (int j = 0; j < 4; ++j) { const int t = mb * 16 + fq * 4 + j, s = nh * 32 + n * 16 + fr; acc[n][j] += bf2f(mMrk[s * LDP + t]); }
    st_rm(lbuf(1), acc, mb, nh, fr, fq);
    bmm(lbuf(9), mMak, mb, nh, fr, fq, acc);
#pragma unroll
    for (int n = 0; n < 2; ++n)
#pragma unroll
      for (int j = 0; j < 4; ++j) { const int jj = mb * 16 + fq * 4 + j, s = nh * 32 + n * 16 + fr; acc[n][j] += bf2f(mKgam[s * LDP + jj]); }
    st_rm(lbuf(2), acc, mb, nh, fr, fq);
    bmm(mAtilT, lbuf(8), mb, nh, fr, fq, acc);
#pragma unroll
    for (int n = 0; n < 2; ++n) {
      const int j0 = mb * 16 + fq * 4, t = nh * 32 + n * 16 + fr;
      const uint2 rt = *(const uint2*)(mRtil + t * LDP + j0);
      uint2 o;
      o.x = pack2(acc[n][0] + __uint_as_float(rt.x << 16), acc[n][1] + __uint_as_float(rt.x & 0xffff0000u));
      o.y = pack2(acc[n][2] + __uint_as_float(rt.y << 16), acc[n][3] + __uint_as_float(rt.y & 0xffff0000u));
      *(uint2*)(Eb + tile0 + (size_t)t * 1024 + j0) = o;
    }
    bmm(mAtilT, lbuf(9), mb, nh, fr, fq, acc);
#pragma unroll
    for (int n = 0; n < 2; ++n) {
      const int j0 = mb * 16 + fq * 4, jp = nh * 32 + n * 16 + fr;
      uint2 o;
      o.x = pack2(acc[n][0] + (jp == j0 ? gTs[j0] : 0.f), acc[n][1] + (jp == j0 + 1 ? gTs[j0 + 1] : 0.f));
      o.y = pack2(acc[n][2] + (jp == j0 + 2 ? gTs[j0 + 2] : 0.f), acc[n][3] + (jp == j0 + 3 ? gTs[j0 + 3] : 0.f));
      *(uint2*)(Ab + tile0 + (size_t)jp * 1024 + j0) = o;
    }
    LBAR2();
    bmm(mVT, lbuf(1), mb, nh, fr, fq, acc);
#pragma unroll
    for (int n = 0; n < 2; ++n) {
      const int i0 = mb * 16 + fq * 4, t = nh * 32 + n * 16 + fr;
      uint2 o; o.x = pack2(acc[n][0], acc[n][1]); o.y = pack2(acc[n][2], acc[n][3]);
      *(uint2*)(YL + tile0 + (size_t)t * 1024 + i0) = o;
    }
    bmm(mVT, lbuf(2), mb, nh, fr, fq, acc);
    *(f32x4*)(PSI + (size_t)unit * 4096 + (size_t)(wid * 64 + lane) * 8) = acc[0];
    *(f32x4*)(PSI + (size_t)unit * 4096 + (size_t)(wid * 64 + lane) * 8 + 4) = acc[1];
    LBAR2();
  }
}

DEV void phase_wkv_b(const Params& p, int slab, int mode) {
  const int TIDX = opaque_tid();
  const int wid = __builtin_amdgcn_readfirstlane(TIDX >> 6), lane = TIDX & 63, fr = lane & 15, fq = lane >> 4, mb = wid >> 1, nh = wid & 1;
  const float* PSI = (const float*)(kws() + OFF_PSI);
  bf16_t* PHG = (bf16_t*)(kws() + OFF_PHG);
  float* PSG = (float*)(kws() + OFF_PSG);
  float* SST = (float*)(kws() + OFF_SST);
  const bool two_level = slab < 2;
  if (!two_level && mode != 3) return;
  const int nseq = two_level ? 1 : 8, cps = 256 / nseq;
  const int ngrp = two_level ? 8 : 1;
  bf16_t *Sb = lbuf(0), *PhT = lbuf(1), *OmT = lbuf(2), *Sa = lbuf(3);
  const int lr = TIDX >> 3, lc8 = (TIDX & 7) * 8;
  const size_t nat = (size_t)(wid * 64 + lane) * 8;
  if (mode == 2) {
    for (int chain = blockIdx.x; chain < 32; chain += gridDim.x) {
      f32x4 S[2];
      S[0] = (f32x4){0.f, 0.f, 0.f, 0.f}; S[1] = (f32x4){0.f, 0.f, 0.f, 0.f};
      for (int g = 0; g < 8; ++g) {
        const size_t item = (size_t)chain * 8 + g;
        *(f32x4*)(SST + item * 4096 + nat) = S[0]; *(f32x4*)(SST + item * 4096 + nat + 4) = S[1];
        const uint4 ph = *(const uint4*)(PHG + item * 4096 + lr * 64 + lc8);
        const f32x4 q0 = *(const f32x4*)(PSG + item * 4096 + nat), q1 = *(const f32x4*)(PSG + item * 4096 + nat + 4);
        st_rm(Sb, S, mb, nh, fr, fq);
        *(uint4*)(PhT + lr * LDP + lc8) = ph;
        LBAR2();
        f32x4 acc[2];
        bmm(Sb, PhT, mb, nh, fr, fq, acc);
        S[0] = acc[0] + q0; S[1] = acc[1] + q1;
        LBAR2();
      }
    }
    return;
  }
  for (int item = blockIdx.x; item < nseq * 32 * ngrp; item += gridDim.x) {
    const int chain = item / ngrp, grp = item % ngrp;
    const int e = chain & 1, h = (chain >> 1) & 15, sq = chain >> 5;
    const bf16_t* Ab = (const bf16_t*)(kws() + (e ? OFF_A1 : OFF_A0));
    const bf16_t* Eb = (const bf16_t*)(kws() + (e ? OFF_E1 : OFF_E0));
    bf16_t* YL = (bf16_t*)(kws() + (e ? OFF_YLB : OFF_YLF));
    const int sbase = grp * 32;
    f32x4 S[2], SA[2];
    if (mode == 3 && two_level) { S[0] = *(const f32x4*)(SST + (size_t)item * 4096 + nat); S[1] = *(const f32x4*)(SST + (size_t)item * 4096 + nat + 4); }
    else { S[0] = (f32x4){0.f, 0.f, 0.f, 0.f}; S[1] = (f32x4){0.f, 0.f, 0.f, 0.f}; }
#pragma unroll
    for (int n = 0; n < 2; ++n)
#pragma unroll
      for (int j = 0; j < 4; ++j) SA[n][j] = (mb * 16 + fq * 4 + j == nh * 32 + n * 16 + fr) ? 1.f : 0.f;
    uint4 ph0, ph1, ph2, ph3, om0, om1, om2, om3;
    f32x4 ps0[2], ps1[2], ps2[2], ps3[2];
    uint2 yl0[2], yl1[2], yl2[2], yl3[2];
#define WB_PREFETCH(step_, ph, om, ps, y8) do { \
      const int st_ = sbase + ((step_) < 32 ? (step_) : 31); \
      const int c_ = sq * cps + (e ? cps - 1 - st_ : st_); \
      const size_t t0_ = (size_t)c_ * 64 * 1024 + h * 64; \
      ph = *(const uint4*)(Ab + t0_ + (size_t)lr * 1024 + lc8); \
      const size_t u_ = ((size_t)c_ * 16 + h) * 2 + e; \
      ps[0] = *(const f32x4*)(PSI + u_ * 4096 + nat); ps[1] = *(const f32x4*)(PSI + u_ * 4096 + nat + 4); \
      if (mode == 3) { \
        om = *(const uint4*)(Eb + t0_ + (size_t)lr * 1024 + lc8); \
        y8[0] = *(const uint2*)(YL + t0_ + (size_t)(nh * 32 + fr) * 1024 + mb * 16 + fq * 4); \
        y8[1] = *(const uint2*)(YL + t0_ + (size_t)(nh * 32 + 16 + fr) * 1024 + mb * 16 + fq * 4); } } while (0)
#define WB_STEP(step_, ph, om, ps, y8) do { \
      const int c = sq * cps + (e ? cps - 1 - (sbase + (step_)) : (sbase + (step_))); \
      const size_t tile0 = (size_t)c * 64 * 1024 + h * 64; \
      st_rm(Sb, S, mb, nh, fr, fq); \
      *(uint4*)(PhT + lr * LDP + lc8) = ph; \
      if (mode == 3) *(uint4*)(OmT + lr * LDP + lc8) = om; else st_rm(Sa, SA, mb, nh, fr, fq); \
      const f32x4 psc0 = ps[0], psc1 = ps[1]; const uint2 ylc0 = y8[0], ylc1 = y8[1]; \
      LBAR2(); \
      WB_PREFETCH((step_) + 4, ph, om, ps, y8); \
      f32x4 acc[2]; \
      if (mode == 3) { \
        bmm(Sb, OmT, mb, nh, fr, fq, acc); \
        uint2 o; \
        o.x = pack2(acc[0][0] + __uint_as_float(ylc0.x << 16), acc[0][1] + __uint_as_float(ylc0.x & 0xffff0000u)); \
        o.y = pack2(acc[0][2] + __uint_as_float(ylc0.y << 16), acc[0][3] + __uint_as_float(ylc0.y & 0xffff0000u)); \
        *(uint2*)(YL + tile0 + (size_t)(nh * 32 + fr) * 1024 + mb * 16 + fq * 4) = o; \
        o.x = pack2(acc[1][0] + __uint_as_float(ylc1.x << 16), acc[1][1] + __uint_as_float(ylc1.x & 0xffff0000u)); \
        o.y = pack2(acc[1][2] + __uint_as_float(ylc1.y << 16), acc[1][3] + __uint_as_float(ylc1.y & 0xffff0000u)); \
        *(uint2*)(YL + tile0 + (size_t)(nh * 32 + 16 + fr) * 1024 + mb * 16 + fq * 4) = o; \
      } else { \
        bmm(Sa, PhT, mb, nh, fr, fq, acc); SA[0] = acc[0]; SA[1] = acc[1]; \
      } \
      bmm(Sb, PhT, mb, nh, fr, fq, acc); \
      S[0] = acc[0] + psc0; S[1] = acc[1] + psc1; \
      LBAR2(); } while (0)
    yl0[0] = yl0[1] = yl1[0] = yl1[1] = yl2[0] = yl2[1] = yl3[0] = yl3[1] = make_uint2(0u, 0u);
    om0 = om1 = om2 = om3 = make_uint4(0u, 0u, 0u, 0u);
    WB_PREFETCH(0, ph0, om0, ps0, yl0); WB_PREFETCH(1, ph1, om1, ps1, yl1); WB_PREFETCH(2, ph2, om2, ps2, yl2); WB_PREFETCH(3, ph3, om3, ps3, yl3);
    for (int step0 = 0; step0 < 32; step0 += 4) {
      WB_STEP(step0 + 0, ph0, om0, ps0, yl0);
      WB_STEP(step0 + 1, ph1, om1, ps1, yl1);
      WB_STEP(step0 + 2, ph2, om2, ps2, yl2);
      WB_STEP(step0 + 3, ph3, om3, ps3, yl3);
    }
    if (mode == 1) {
#pragma unroll
      for (int n = 0; n < 2; ++n) {
        uint2 o; o.x = pack2(SA[n][0], SA[n][1]); o.y = pack2(SA[n][2], SA[n][3]);
        *(uint2*)(PHG + (size_t)item * 4096 + (nh * 32 + n * 16 + fr) * 64 + mb * 16 + fq * 4) = o;
      }
      *(f32x4*)(PSG + (size_t)item * 4096 + nat) = S[0]; *(f32x4*)(PSG + (size_t)item * 4096 + nat + 4) = S[1];
    }
  }
}

DEV void phase_tm_post(const Params& p, int jl) {
  const int TIDX = opaque_tid();
  const int wid = TIDX >> 6, lane = TIDX & 63, hs = lane >> 4, c4 = (lane & 15) * 4;
  bf16_t* Rb = (bf16_t*)(kws() + OFF_R);
  const bf16_t* Vb = (const bf16_t*)(kws() + OFF_V);
  const bf16_t* Gb = (const bf16_t*)(kws() + OFF_G);
  const bf16_t* YF = (const bf16_t*)(kws() + OFF_YLF);
  const bf16_t* YB = (const bf16_t*)(kws() + OFF_YLB);
  const float* BON = (const float*)(kws() + OFF_BON);
  for (int item = blockIdx.x * 8 + wid; item < 2048; item += gridDim.x * 8) {
    const int hd = (item & 3) * 4 + hs, tb = (item >> 2) * 32;
    const int cch = hd * 64 + c4;
    const float4 lg = *(const float4*)(kin(26) + (size_t)jl * 1024 + cch), lb = *(const float4*)(kin(27) + (size_t)jl * 1024 + cch);
    struct PostRaw { uint2 yf, yb, v, g; float b0, b1; };
    auto load_raw = [&](int tt, PostRaw& w) {
      const int t = tb + (tt < 32 ? tt : 31);
      const size_t o = (size_t)t * 1024 + cch;
      const size_t ob = (size_t)((t & ~63) + 63 - (t & 63)) * 1024 + cch;
      w.yf = *(const uint2*)(YF + o); w.yb = *(const uint2*)(YB + ob); w.v = *(const uint2*)(Vb + o); w.g = *(const uint2*)(Gb + o);
      w.b0 = BON[(size_t)t * 16 + hd]; w.b1 = BON[((size_t)SLAB + t) * 16 + hd];
    };
    PostRaw w0, w1;
    load_raw(0, w0); load_raw(1, w1);
    for (int tt = 0; tt < 32; ++tt) {
      PostRaw w2; load_raw(tt + 2, w2);
      float y[4];
      y[0] = __uint_as_float(w0.yf.x << 16) + __uint_as_float(w0.yb.x << 16); y[1] = __uint_as_float(w0.yf.x & 0xffff0000u) + __uint_as_float(w0.yb.x & 0xffff0000u);
      y[2] = __uint_as_float(w0.yf.y << 16) + __uint_as_float(w0.yb.y << 16); y[3] = __uint_as_float(w0.yf.y & 0xffff0000u) + __uint_as_float(w0.yb.y & 0xffff0000u);
      const float mean = row_sum16((y[0] + y[1]) + (y[2] + y[3])) * (1.0f / 64.f);
      const float d0 = y[0] - mean, d1 = y[1] - mean, d2 = y[2] - mean, d3 = y[3] - mean;
      const float var = row_sum16((d0 * d0 + d1 * d1) + (d2 * d2 + d3 * d3)) * (1.0f / 64.f);
      const float rs = rsqrtf(var + 64e-5f), bon = w0.b0 + w0.b1;
      const float o0 = (d0 * rs * lg.x + lb.x + bon * __uint_as_float(w0.v.x << 16)) * __uint_as_float(w0.g.x << 16);
      const float o1 = (d1 * rs * lg.y + lb.y + bon * __uint_as_float(w0.v.x & 0xffff0000u)) * __uint_as_float(w0.g.x & 0xffff0000u);
      const float o2 = (d2 * rs * lg.z + lb.z + bon * __uint_as_float(w0.v.y << 16)) * __uint_as_float(w0.g.y << 16);
      const float o3 = (d3 * rs * lg.w + lb.w + bon * __uint_as_float(w0.v.y & 0xffff0000u)) * __uint_as_float(w0.g.y & 0xffff0000u);
      uint2 o; o.x = pack2(o0, o1); o.y = pack2(o2, o3);
      *(uint2*)(Rb + (size_t)(tb + tt) * 1024 + cch) = o;
      w0 = w1; w1 = w2;
    }
  }
}

DEV void wprep_sgu(const Params& p, int j) {
  wprep_T2((bf16_t*)(kws() + OFF_W + W_SG_IN), 1024, 0, kin(5) + (size_t)j * 1024 * 4096, 1024, 4096, nullptr, 128, 0);
  wprep_T2((bf16_t*)(kws() + OFF_W + W_SG_OUT), 2048, 0, kin(10) + (size_t)j * 2048 * 1024, 2048, 1024, nullptr, 128, 0);
}
DEV void wprep_ffn(const Params& p, int layer) {
  wprep_T2((bf16_t*)(kws() + OFF_W + W_FF_A), 1024, 0, kin(29) + (size_t)layer * 1024 * 2816, 1024, 2816, nullptr, 256, 0);
  wprep_T2((bf16_t*)(kws() + OFF_W + W_FF_A), 1024, 0, kin(30) + (size_t)layer * 1024 * 2816, 1024, 2816, nullptr, 256, 128);
  wprep_T2((bf16_t*)(kws() + OFF_W + W_FF_D), 2816, 0, kin(33) + (size_t)layer * 2816 * 1024, 2816, 1024, nullptr, 128, 0);
}
DEV void wprep_tm(const Params& p, int j) {
  const int TIDX = opaque_tid();
  bf16_t* WP = (bf16_t*)(kws() + OFF_W + W_TM_P);
  const float* mu = kin(11) + (size_t)j * 6 * 1024;
  const float* srcs[3] = {kin(12) + (size_t)j * 1048576, kin(13) + (size_t)j * 1048576, kin(14) + (size_t)j * 1048576};
  const int mus[3] = {0, 2, 3};
#pragma unroll
  for (int i = 0; i < 3; ++i) {
    wprep_T2(WP, 2048, 0, srcs[i], 1024, 1024, nullptr, 128, i * 1024);
    wprep_T2(WP, 2048, 1024, srcs[i], 1024, 1024, mu + mus[i] * 1024, 128, i * 1024);
  }
#pragma unroll
  for (int e = 0; e < 2; ++e) {
    const float* w1 = kin(16) + ((size_t)j * 2 + e) * 1024 * 64;
    wprep_T(WP, 2048, 0, w1, 1024, 64, nullptr, 128, 3072 + 64 * e);
    wprep_T(WP, 2048, 1024, w1, 1024, 64, mu + 1 * 1024, 128, 3072 + 64 * e);
    const float* a1 = kin(19) + ((size_t)j * 2 + e) * 1024 * 64;
    wprep_T(WP, 2048, 0, a1, 1024, 64, nullptr, 128, 3200 + 64 * e);
    wprep_T(WP, 2048, 1024, a1, 1024, 64, mu + 4 * 1024, 128, 3200 + 64 * e);
    wprep_T2((bf16_t*)(kws() + OFF_W + W_TM_W2) + (size_t)e * 1024 * 64, 64, 0, kin(17) + ((size_t)j * 2 + e) * 64 * 1024, 64, 1024, nullptr, 128, 0);
    wprep_T2((bf16_t*)(kws() + OFF_W + W_TM_A2) + (size_t)e * 1024 * 64, 64, 0, kin(20) + ((size_t)j * 2 + e) * 64 * 1024, 64, 1024, nullptr, 128, 0);
  }
  const float* g1 = kin(21) + (size_t)j * 1024 * 160;
  wprep_T(WP, 2048, 0, g1, 1024, 160, nullptr, 128, 3328);
  wprep_T(WP, 2048, 1024, g1, 1024, 160, mu + 5 * 1024, 128, 3328);
  for (size_t i = (size_t)blockIdx.x * 512 + TIDX; i < (size_t)96 * 2048 / 2; i += (size_t)gridDim.x * 512) ((unsigned*)(WP + (size_t)3488 * 2048))[i] = 0u;
  wprep_T((bf16_t*)(kws() + OFF_W + W_TM_G2), 160, 0, kin(22) + (size_t)j * 160 * 1024, 160, 1024, nullptr, 128, 0);
  wprep_T2((bf16_t*)(kws() + OFF_W + W_TM_O), 1024, 0, kin(28) + (size_t)j * 1048576, 1024, 1024, nullptr, 128, 0);
}

constexpr int PH_SGU = 10, PH_FFN = 3, PH_TM = 27;
constexpr int N_PHASES = 1 + 2 * (PH_SGU + PH_FFN) + 2 * (PH_TM + PH_FFN) + 1;

DEV void run_phase(const Params& p, int ph) {
  if (ph == 0) { phase_init(p); return; }
  if (ph == N_PHASES - 1) { phase_final(p); return; }
  int q = ph - 1, layer = 0;
  for (;;) {
    const int len = (layer & 1) ? PH_TM + PH_FFN : PH_SGU + PH_FFN;
    if (q < len) break;
    q -= len; ++layer;
  }
  const int j = layer >> 1;
  bf16_t* H0 = (bf16_t*)(kws() + OFF_H0);
  const int nmix = (layer & 1) ? PH_TM : PH_SGU;
  if (q >= nmix) {
    const int f = q - nmix;
    if (f == 0) { phase_norm(p, kin(3) + (size_t)layer * 1024, H0); wprep_ffn(p, layer); }
    else if (f == 1) phase_ffn_a(p, layer);
    else phase_gemm_res(p, (const bf16_t*)(kws() + OFF_HMID), 2816, (const bf16_t*)(kws() + OFF_W + W_FF_D), 2816, 192, 0);
    return;
  }
  if (!(layer & 1)) {
    if (q == 0) { phase_norm(p, kin(2) + (size_t)layer * 1024, H0); wprep_sgu(p, j); return; }
    const int slab = (q - 1) / 3, s = (q - 1) % 3;
    if (s == 0) phase_sgu_in(p, j, slab);
    else if (s == 1) phase_sgu_mix(p, j);
    else phase_gemm_res(p, (const bf16_t*)(kws() + OFF_U), 4096, (const bf16_t*)(kws() + OFF_W + W_SG_OUT), 2048, 64, (long)slab * SLAB);
    return;
  }
  {
    const int slab = q / 9, s = q % 9;
    switch (s) {
      case 0: phase_norm_tm(p, kin(2) + (size_t)layer * 1024, (bf16_t*)(kws() + OFF_HX), slab); if (slab == 0) wprep_tm(p, j); break;
      case 1: phase_tm_proj(p); break;
      case 2: phase_tm_lora_out(p, j); break;
      case 3: phase_wkv_a(p, j, slab); break;
      case 4: phase_wkv_b(p, slab, 1); break;
      case 5: phase_wkv_b(p, slab, 2); break;
      case 6: phase_wkv_b(p, slab, 3); break;
      case 7: phase_tm_post(p, j); break;
      default: phase_gemm_res(p, (const bf16_t*)(kws() + OFF_R), 1024, (const bf16_t*)(kws() + OFF_W + W_TM_O), 1024, 64, (long)slab * SLAB); break;
    }
  }
}

#ifndef PROBE_CAT
#define PROBE_CAT -1
#endif
DEV int phase_cat(int ph) {
  if (ph == 0 || ph == N_PHASES - 1) return 2;
  int q = ph - 1, layer = 0;
  for (;;) { const int len = (layer & 1) ? PH_TM + PH_FFN : PH_SGU + PH_FFN; if (q < len) break; q -= len; ++layer; }
  const int nmix = (layer & 1) ? PH_TM : PH_SGU;
  if (q >= nmix) return (q - nmix) == 0 ? 2 : ((q - nmix) == 1 ? 7 : 8);
  if (!(layer & 1)) { if (q == 0) return 2; const int s = (q - 1) % 3; return s == 1 ? 3 : 0; }
  const int s = q % 9;
  return s == 0 ? 2 : (s == 1 || s == 8) ? 0 : (s == 2 ? 4 : (s == 3 ? 1 : (s == 7 ? 6 : 5)));
}
__global__ void __launch_bounds__(512, 2) mega(Params p, int ph_lo, int ph_hi, int coop) {
#if PROBE_CAT >= 0
  if (blockIdx.x == 0 && threadIdx.x == 0) ((unsigned long long*)(kws() + 500 * MiB))[0] = wall_clock64();
#endif
  for (int ph = ph_lo; ph < ph_hi; ++ph) {
    run_phase(p, ph);
    if (coop && ph + 1 < ph_hi) cg::this_grid().sync();
#if PROBE_CAT >= 0
    if (blockIdx.x == 0 && threadIdx.x == 0) ((unsigned long long*)(kws() + 500 * MiB))[ph + 1] = wall_clock64();
#endif
  }
#if PROBE_CAT >= 0
  cg::this_grid().sync();
  if (blockIdx.x == 0 && threadIdx.x == 0) {
    const unsigned long long* ts = (const unsigned long long*)(kws() + 500 * MiB);
    unsigned long long acc = 0;
    for (int ph = 0; ph < N_PHASES; ++ph) if (PROBE_CAT == 9 || phase_cat(ph) == PROBE_CAT) acc += ts[ph + 1] - ts[ph];
    ((float*)(kws() + 500 * MiB))[1024] = (float)acc * (0.01f * 2e-5f);
  }
  __syncthreads();
  if (blockIdx.x == 0) {
    __threadfence();
    const float ev = ((volatile float*)(kws() + 500 * MiB))[1024];
    for (int i = threadIdx.x; i < 4096; i += 512) kx()[i] += ev;
    for (int i = threadIdx.x; i < 2048; i += 512) kx()[(size_t)32768 * 1024 + i] += ev;
  }
#endif
}

extern "C" void kernel_launch(void* const* d_in, const int* in_sizes, int n_in, void* d_out, int out_size, void* d_ws, size_t ws_size, hipStream_t stream) {
  static int grid = 0;
  if (!grid) {
    int dev = 0, cus = 0, per_cu = 0;
    (void)hipFuncSetAttribute((const void*)mega, hipFuncAttributeMaxDynamicSharedMemorySize, SHM_BYTES);
    (void)hipGetDevice(&dev);
    (void)hipDeviceGetAttribute(&cus, hipDeviceAttributeMultiprocessorCount, dev);
    (void)hipOccupancyMaxActiveBlocksPerMultiprocessor(&per_cu, (const void*)mega, 512, SHM_BYTES);
    if (per_cu < 1) per_cu = 1;
    grid = cus * per_cu;
    if (grid > 256) grid = 256;
    if (grid & 7) grid &= ~7;
  }
  Params p{};
  for (int i = 0; i < 34; ++i) p.in[i] = (const float*)d_in[i];
  p.x = (float*)d_out;
  p.ws = (char*)d_ws;
  int ph_lo = 0, ph_hi = N_PHASES, coop = 1;
  void* args[] = {&p, &ph_lo, &ph_hi, &coop};
  hipError_t e = hipLaunchCooperativeKernel((const void*)mega, dim3(grid), dim3(512), args, SHM_BYTES, stream);
  if (e != hipSuccess) fprintf(stderr, "cooperative launch failed: %s (grid %d)\n", hipGetErrorString(e), grid);
}
```

```cpp
#define PROBE_CAT -1
#include <hip/hip_runtime.h>
#include <hip/hip_cooperative_groups.h>
#include <cstdio>
namespace cg = cooperative_groups;

#define DEV __device__ __forceinline__
typedef unsigned short bf16_t;
typedef short bf16x8 __attribute__((ext_vector_type(8)));
typedef float f32x4 __attribute__((ext_vector_type(4)));

extern __shared__ __attribute__((aligned(16))) char g_shm[];

constexpr int NT = 49152, SLAB = 16384;
constexpr int SHM_BYTES = 147456;
constexpr size_t MiB = 1u << 20;
constexpr size_t OFF_W = 0;
constexpr size_t OFF_H = 24 * MiB;
constexpr size_t OFF_H0 = OFF_H + 256 * 2048;
constexpr size_t OFF_U = 122 * MiB, OFF_SSQ = 250 * MiB;
constexpr size_t OFF_HMID = 122 * MiB;
constexpr size_t OFF_MIX = 200 * MiB;
constexpr size_t OFF_HX = 24 * MiB, OFF_YLF = 24 * MiB, OFF_YLB = 56 * MiB, OFF_R = 88 * MiB, OFF_K = 120 * MiB, OFF_V = 152 * MiB,
                 OFF_HL = 184 * MiB, OFF_E0 = 200 * MiB, OFF_E1 = 232 * MiB, OFF_A0 = 264 * MiB, OFF_A1 = 296 * MiB, OFF_G = 328 * MiB,
                 OFF_PSI = 360 * MiB, OFF_BON = 488 * MiB, OFF_PHG = 490 * MiB, OFF_PSG = 492 * MiB, OFF_SST = 496 * MiB;
constexpr size_t W_SG_IN = 0, W_SG_OUT = 8 * MiB;
constexpr size_t W_FF_A = 0, W_FF_D = 12 * MiB;
constexpr size_t W_TM_P = 0, W_TM_O = 14 * MiB, W_TM_W2 = 16 * MiB, W_TM_A2 = 16 * MiB + 512 * 1024, W_TM_G2 = 17 * MiB;

struct Params {
  const float* in[34];
  float* x;
  char* ws;
};


typedef const __attribute__((address_space(4))) char* karg_t;
DEV int opaque0() { int z = 0; asm volatile("" : "+s"(z)); return z; }
DEV const float* kin(int i) { karg_t kp = (karg_t)__builtin_amdgcn_kernarg_segment_ptr(); return *(const float* const __attribute__((address_space(4)))*)(kp + (i + opaque0()) * 8); }
DEV float* kx() { karg_t kp = (karg_t)__builtin_amdgcn_kernarg_segment_ptr(); return *(float* const __attribute__((address_space(4)))*)(kp + (34 + opaque0()) * 8); }
DEV char* kws() { karg_t kp = (karg_t)__builtin_amdgcn_kernarg_segment_ptr(); return *(char* const __attribute__((address_space(4)))*)(kp + (35 + opaque0()) * 8); }

DEV int opaque_tid() { int z = 0; asm volatile("" : "+v"(z)); return (int)threadIdx.x + z; }
#define LBAR2() do { asm volatile("s_waitcnt lgkmcnt(0)" ::: "memory"); __builtin_amdgcn_s_barrier(); asm volatile("" ::: "memory"); } while (0)
DEV float bf2f(bf16_t u) { return __uint_as_float(((unsigned)u) << 16); }
typedef float f32x2 __attribute__((ext_vector_type(2)));
typedef __bf16 bf16x2_t __attribute__((ext_vector_type(2)));
DEV unsigned pack2(float a, float b) { f32x2 v = {a, b}; bf16x2_t h = __builtin_convertvector(v, bf16x2_t); return __builtin_bit_cast(unsigned, h); }
DEV bf16_t f2bf(float f) { return (bf16_t)(pack2(f, f) & 0xffffu); }
template <int CTRL> DEV float dppmov(float v) { return __int_as_float(__builtin_amdgcn_update_dpp(0, __float_as_int(v), CTRL, 0xf, 0xf, true)); }
DEV float row_sum16(float v) {
  v += dppmov<0xB1>(v); v += dppmov<0x4E>(v); v += dppmov<0x141>(v); v += dppmov<0x140>(v);
  return v;
}
DEV float wave_sum(float v) {
  const int r = __float_as_int(row_sum16(v));
  return (__int_as_float(__builtin_amdgcn_readlane(r, 0)) + __int_as_float(__builtin_amdgcn_readlane(r, 16))) +
         (__int_as_float(__builtin_amdgcn_readlane(r, 32)) + __int_as_float(__builtin_amdgcn_readlane(r, 48)));
}
DEV float sigmoidf_(float x) { return 1.0f / (1.0f + __expf(-x)); }
DEV f32x2 gelu_pk(f32x2 v) {
  const f32x2 av = __builtin_elementwise_abs(v), d = av * 0.2316418882f + 1.0f;
  f32x2 t; t.x = __builtin_amdgcn_rcpf(d.x); t.y = __builtin_amdgcn_rcpf(d.y);
  f32x2 q = t * 0.5307027145f + (-0.7265760135f); q = q * t + 0.7107068705f; q = q * t + (-0.142248368f); q = q * t + 0.127414796f; q = q * t;
  const f32x2 s = (v * v) * (-0.72134752044f);
  f32x2 e; e.x = __builtin_amdgcn_exp2f(s.x); e.y = __builtin_amdgcn_exp2f(s.y);
  const f32x2 m = v * (q * e), r = v - m;
  f32x2 o; o.x = v.x < 0.f ? m.x : r.x; o.y = v.y < 0.f ? m.y : r.y; return o;
}
DEV float gelu_exact(float v) {
  const float av = fabsf(v), d = av * 0.2316418882f + 1.0f;
  const float t = __builtin_amdgcn_rcpf(d);
  float q = t * 0.5307027145f + (-0.7265760135f); q = q * t + 0.7107068705f; q = q * t + (-0.142248368f); q = q * t + 0.127414796f; q = q * t;
  const float e = __builtin_amdgcn_exp2f((v * v) * (-0.72134752044f));
  const float m = v * (q * e), r = v - m;
  return v < 0.f ? m : r;
}

DEV void phase_init(const Params& p) {
  const int TIDX = opaque_tid();
  const float4* xp = (const float4*)kin(0);
  const float4* xs = (const float4*)kin(1);
  float4* x = (float4*)kx();
  const size_t n0 = (size_t)32768 * 256, n1 = (size_t)16384 * 256;
  for (size_t i = (size_t)blockIdx.x * 512 + TIDX; i < n0 + n1; i += (size_t)gridDim.x * 512) x[i] = i < n0 ? xp[i] : xs[i - n0];
}

DEV void phase_norm(const Params& p, const float* g, bf16_t* h0) {
  const int TIDX = opaque_tid();
  const int wid = TIDX >> 6, lane = TIDX & 63;
  float4 gv[4];
#pragma unroll
  for (int i = 0; i < 4; ++i) gv[i] = ((const float4*)g)[lane + 64 * i];
  for (int t = blockIdx.x * 8 + wid; t < NT; t += gridDim.x * 8) {
    const float4* xr = (const float4*)(kx() + (size_t)t * 1024);
    float4 v[4]; float ss = 0.f;
#pragma unroll
    for (int i = 0; i < 4; ++i) { v[i] = xr[lane + 64 * i]; ss += v[i].x * v[i].x + v[i].y * v[i].y + v[i].z * v[i].z + v[i].w * v[i].w; }
    ss = wave_sum(ss);
    const float rs = rsqrtf(ss * (1.0f / 1024.f) + 1e-6f);
    uint2* hr = (uint2*)(h0 + (size_t)t * 1024);
#pragma unroll
    for (int i = 0; i < 4; ++i) {
      uint2 o; o.x = pack2(v[i].x * rs * gv[i].x, v[i].y * rs * gv[i].y); o.y = pack2(v[i].z * rs * gv[i].z, v[i].w * rs * gv[i].w);
      hr[lane + 64 * i] = o;
    }
  }
}

DEV void phase_norm_tm(const Params& p, const float* g, const float* mu, bf16_t* mixb, int slab) {
  const int TIDX = opaque_tid();
  const int wid = TIDX >> 6, lane = TIDX & 63;
  const int L = slab < 2 ? 16384 : 2048;
  float4 gv[4], muv[6][4];
#pragma unroll
  for (int i = 0; i < 4; ++i) gv[i] = ((const float4*)g)[lane + 64 * i];
#pragma unroll
  for (int m = 0; m < 6; ++m)
#pragma unroll
    for (int i = 0; i < 4; ++i) muv[m][i] = ((const float4*)(mu + m * 1024))[lane + 64 * i];
  for (int ts = blockIdx.x * 8 + wid; ts < SLAB; ts += gridDim.x * 8) {
    const int t = slab * SLAB + ts, pos = ts & (L - 1);
    float4 hv[3][4];
#pragma unroll
    for (int d = 0; d < 3; ++d) {
      const bool valid = !((d == 0 && pos == 0) || (d == 2 && pos == L - 1));
      const int tt = valid ? t + d - 1 : t;
      const float4* xr = (const float4*)(kx() + (size_t)tt * 1024);
      float ss = 0.f;
#pragma unroll
      for (int i = 0; i < 4; ++i) { float4 v = xr[lane + 64 * i]; hv[d][i] = v; ss += v.x * v.x + v.y * v.y + v.z * v.z + v.w * v.w; }
      ss = wave_sum(ss);
      const float rs = valid ? rsqrtf(ss * (1.0f / 1024.f) + 1e-6f) : 0.f;
#pragma unroll
      for (int i = 0; i < 4; ++i) { hv[d][i].x *= rs * gv[i].x; hv[d][i].y *= rs * gv[i].y; hv[d][i].z *= rs * gv[i].z; hv[d][i].w *= rs * gv[i].w; }
    }
#pragma unroll
    for (int i = 0; i < 4; ++i) {
      hv[0][i].x = 0.5f * (hv[0][i].x + hv[2][i].x) - hv[1][i].x; hv[0][i].y = 0.5f * (hv[0][i].y + hv[2][i].y) - hv[1][i].y;
      hv[0][i].z = 0.5f * (hv[0][i].z + hv[2][i].z) - hv[1][i].z; hv[0][i].w = 0.5f * (hv[0][i].w + hv[2][i].w) - hv[1][i].w;
    }
#pragma unroll
    for (int m = 0; m < 6; ++m) {
      uint2* orow = (uint2*)(mixb + ((size_t)m * SLAB + ts) * 1024);
#pragma unroll
      for (int i = 0; i < 4; ++i) {
        const float4 mv = muv[m][i];
        uint2 o;
        o.x = pack2(hv[1][i].x + hv[0][i].x * mv.x, hv[1][i].y + hv[0][i].y * mv.y);
        o.y = pack2(hv[1][i].z + hv[0][i].z * mv.z, hv[1][i].w + hv[0][i].w * mv.w);
        orow[lane + 64 * i] = o;
      }
    }
  }
}

DEV void phase_final(const Params& p) {
  const int TIDX = opaque_tid();
  const int wid = TIDX >> 6, lane = TIDX & 63;
  const float* g = kin(4);
  float4 gv[4];
#pragma unroll
  for (int i = 0; i < 4; ++i) gv[i] = ((const float4*)g)[lane + 64 * i];
  for (int t = blockIdx.x * 8 + wid; t < NT; t += gridDim.x * 8) {
    float4* xr = (float4*)(kx() + (size_t)t * 1024);
    float4 v[4]; float ss = 0.f;
#pragma unroll
    for (int i = 0; i < 4; ++i) { v[i] = xr[lane + 64 * i]; ss += v[i].x * v[i].x + v[i].y * v[i].y + v[i].z * v[i].z + v[i].w * v[i].w; }
    ss = wave_sum(ss);
    const float rs = rsqrtf(ss * (1.0f / 1024.f) + 1e-6f);
#pragma unroll
    for (int i = 0; i < 4; ++i) {
      float4 o; o.x = v[i].x * rs * gv[i].x; o.y = v[i].y * rs * gv[i].y; o.z = v[i].z * rs * gv[i].z; o.w = v[i].w * rs * gv[i].w;
      xr[lane + 64 * i] = o;
    }
  }
}

DEV void wprep_T(bf16_t* dst, int ldd, int koff, const float* src, int Ks, int Ns, const float* scale, int rs, int roff) {
  const int TIDX = opaque_tid();
  float (*tile)[33] = (float (*)[33])g_shm;
  const int tx = TIDX & 31, ty = TIDX >> 5;
  const int nkt = Ks / 32, nnt = Ns / 32;
  for (int tIdx = blockIdx.x; tIdx < nkt * nnt; tIdx += gridDim.x) {
    const int k0 = (tIdx / nnt) * 32, n0 = (tIdx % nnt) * 32;
    __syncthreads();
#pragma unroll
    for (int i = 0; i < 2; ++i) tile[ty + 16 * i][tx] = src[(size_t)(k0 + ty + 16 * i) * Ns + n0 + tx];
    __syncthreads();
    const float sc = scale ? scale[k0 + tx] : 1.0f;
#pragma unroll
    for (int i = 0; i < 2; ++i) {
      const int n = n0 + ty + 16 * i;
      const int drow = (n >> 7) * rs + (n & 127) + roff;
      dst[(size_t)drow * ldd + koff + k0 + tx] = f2bf(tile[tx][ty + 16 * i] * sc);
    }
  }
  __syncthreads();
}


DEV void wprep_T2(bf16_t* dst, int ldd, int koff, const float* src, int Ks, int Ns, const float* scale, int rs, int roff) {
  const int TIDX = opaque_tid();
  float* tile = (float*)g_shm;
  const int nkt = Ks / 64, nnt = Ns / 128;
  const int lc = TIDX & 127, lr = TIDX >> 7;
  const int wk = TIDX & 63, wn = TIDX >> 6;
  for (int tIdx = blockIdx.x; tIdx < nkt * nnt; tIdx += gridDim.x) {
    const int k0 = (tIdx / nnt) * 64, n0 = (tIdx % nnt) * 128;
    float v[16];
#pragma unroll
    for (int i = 0; i < 16; ++i) v[i] = src[(size_t)(k0 + i * 4 + lr) * Ns + n0 + lc];
    __syncthreads();
#pragma unroll
    for (int i = 0; i < 16; ++i) tile[(i * 4 + lr) * 129 + lc] = v[i];
    __syncthreads();
    const float sc = scale ? scale[k0 + wk] : 1.0f;
#pragma unroll
    for (int i = 0; i < 16; ++i) {
      const int n = n0 + i * 8 + wn;
      const int drow = (n >> 7) * rs + (n & 127) + roff;
      dst[(size_t)drow * ldd + koff + k0 + wk] = f2bf(tile[wk * 129 + i * 8 + wn] * sc);
    }
  }
  __syncthreads();
}

constexpr int BM = 256, BK = 64, HALF = 128, HT = HALF * BK;
DEV int lds_byte(int r, int c) {
  int st = (r >> 4) * 2 + (c >> 5), rr = r & 15, cc = c & 31, ob = rr * 64 + cc * 2;
  return st * 1024 + (ob ^ (((ob >> 9) & 1) << 5));
}
DEV void stage_rc(int b, int& R, int& C) {
  int st = b / 1024, sb = b % 1024, swz = sb ^ (((sb >> 9) & 1) << 5);
  R = (st >> 1) * 16 + swz / 64; C = (st & 1) * 32 + (swz % 64) / 2;
}

typedef __attribute__((address_space(3))) unsigned char lds_u8;
DEV void gemm_big(const bf16_t* A, long lda, const bf16_t* Bt, long ldb, int K, long brow, long bcol, f32x4 (&acc)[2][2][4][2]) {
  const int TIDX = opaque_tid();
  lds_u8* lds = (lds_u8*)g_shm;
  constexpr int HTB = HT * 2;
#define SA(b, h) (((b) * 2 + (h)) * HTB)
#define SB(b, h) ((4 + (b) * 2 + (h)) * HTB)
#define STAGE(bufoff, gbase, VO, kt) do { const char* _gp = (gbase) + (size_t)(kt) * (BK * 2); \
    __builtin_amdgcn_global_load_lds((const unsigned*)(_gp + VO##0), (__attribute__((address_space(3))) unsigned*)(lds + (bufoff) + ldsw), 16, 0, 0); \
    __builtin_amdgcn_global_load_lds((const unsigned*)(_gp + VO##1), (__attribute__((address_space(3))) unsigned*)(lds + (bufoff) + ldsw + 8192), 16, 0, 0); } while (0)
#define LDA(dst, b, h) for (int m = 0; m < 4; ++m) for (int k = 0; k < 2; ++k) \
    dst[m][k] = *(const __attribute__((address_space(3))) bf16x8*)(lds + SA(b, h) + aoff + m * 2048 + k * 1024)
#define LDB(dst, b, h) for (int n = 0; n < 2; ++n) for (int k = 0; k < 2; ++k) \
    dst[n][k] = *(const __attribute__((address_space(3))) bf16x8*)(lds + SB(b, h) + boff + n * 2048 + k * 1024)
#define MMA(ai, bj, At, Bt_) do { __builtin_amdgcn_s_setprio(1); \
    for (int m = 0; m < 4; ++m) for (int n = 0; n < 2; ++n) for (int k = 0; k < 2; ++k) \
      acc[ai][bj][m][n] = __builtin_amdgcn_mfma_f32_16x16x32_bf16(At[m][k], Bt_[n][k], acc[ai][bj][m][n], 0, 0, 0); \
    __builtin_amdgcn_s_setprio(0); } while (0)
#define WAIT_V(n) asm volatile("s_waitcnt vmcnt(" #n ")" ::: "memory")
#define WAIT_L(n) asm volatile("s_waitcnt lgkmcnt(" #n ")" ::: "memory")
#define BAR __builtin_amdgcn_s_barrier()
#define SCHED __builtin_amdgcn_sched_barrier(0)
  const int tid = TIDX, wid = __builtin_amdgcn_readfirstlane(tid >> 6), lane = tid & 63, wr = wid >> 2, wc = wid & 3, fr = lane & 15, fq = lane >> 4;
  unsigned va0, va1, vb0, vb1;
  { int r_, c_; stage_rc(tid * 16, r_, c_); va0 = (unsigned)((r_ * lda + c_) * 2); vb0 = (unsigned)((r_ * ldb + c_) * 2);
    stage_rc(tid * 16 + 8192, r_, c_); va1 = (unsigned)((r_ * lda + c_) * 2); vb1 = (unsigned)((r_ * ldb + c_) * 2); }
  const unsigned ldsw = (unsigned)wid * 1024u;
  const int aoff = lds_byte(wr * 64 + fr, fq * 8), boff = lds_byte(wc * 32 + fr, fq * 8);
  const char* cA0 = (const char*)(A + brow * lda); const char* cA1 = cA0 + (size_t)HALF * lda * 2;
  const char* cB0 = (const char*)(Bt + bcol * ldb); const char* cB1 = cB0 + (size_t)HALF * ldb * 2;
#pragma unroll
  for (int a = 0; a < 2; ++a)
#pragma unroll
    for (int b = 0; b < 2; ++b)
#pragma unroll
      for (int m = 0; m < 4; ++m)
#pragma unroll
        for (int n = 0; n < 2; ++n) acc[a][b][m][n] = (f32x4){0.f, 0.f, 0.f, 0.f};
  bf16x8 At[4][2], B0[2][2], B1[2][2];
  const int nt = K / BK;
  STAGE(SB(0, 0), cB0, vb, 0); STAGE(SA(0, 0), cA0, va, 0);
  STAGE(SB(0, 1), cB1, vb, 0); STAGE(SA(0, 1), cA1, va, 0);
  if (wr == 1) BAR;
  WAIT_V(4); BAR;
  STAGE(SB(1, 0), cB0, vb, 1); STAGE(SA(1, 0), cA0, va, 1); STAGE(SB(1, 1), cB1, vb, 1);
  WAIT_V(6); BAR;
  for (int t = 0; t < nt - 2; t += 2) {
    LDB(B0, 0, 0); SCHED; LDA(At, 0, 0); STAGE(SA(1, 1), cA1, va, t + 1);
    WAIT_L(8); BAR; WAIT_L(0); MMA(0, 0, At, B0); BAR; SCHED;
    LDB(B1, 0, 1); STAGE(SB(0, 0), cB0, vb, t + 2);
    BAR; WAIT_L(0); MMA(0, 1, At, B1); BAR;
    LDA(At, 0, 1); STAGE(SA(0, 0), cA0, va, t + 2);
    BAR; WAIT_L(0); MMA(1, 0, At, B0); BAR; SCHED;
    STAGE(SB(0, 1), cB1, vb, t + 2);
    WAIT_V(6); BAR; MMA(1, 1, At, B1); BAR;
    LDB(B0, 1, 0); SCHED; LDA(At, 1, 0); STAGE(SA(0, 1), cA1, va, t + 2);
    WAIT_L(8); BAR; WAIT_L(0); MMA(0, 0, At, B0); BAR; SCHED;
    LDB(B1, 1, 1); STAGE(SB(1, 0), cB0, vb, t + 3);
    BAR; WAIT_L(0); MMA(0, 1, At, B1); BAR;
    LDA(At, 1, 1); STAGE(SA(1, 0), cA0, va, t + 3);
    BAR; WAIT_L(0); MMA(1, 0, At, B0); BAR; SCHED;
    STAGE(SB(1, 1), cB1, vb, t + 3);
    WAIT_V(6); BAR; MMA(1, 1, At, B1); BAR;
  }
  { LDB(B0, 0, 0); LDA(At, 0, 0); STAGE(SA(1, 1), cA1, va, nt - 1);
    BAR; WAIT_L(0); MMA(0, 0, At, B0); BAR;
    LDB(B1, 0, 1); BAR; WAIT_L(0); MMA(0, 1, At, B1); BAR;
    LDA(At, 0, 1); WAIT_V(4); BAR; WAIT_L(0); MMA(1, 0, At, B0); MMA(1, 1, At, B1); BAR; }
  { LDB(B0, 1, 0); LDA(At, 1, 0); WAIT_V(2); BAR; WAIT_L(0); MMA(0, 0, At, B0); BAR;
    LDB(B1, 1, 1); WAIT_V(0); BAR; WAIT_L(0); MMA(0, 1, At, B1); BAR;
    LDA(At, 1, 1); BAR; WAIT_L(0); MMA(1, 0, At, B0); MMA(1, 1, At, B1); BAR; }
  if (wr == 0) BAR;
}
DEV void dump_half(const f32x4 (&acc)[2][2][4][2], int ai, int tid) {
  float* T = (float*)g_shm;
  const int wid = tid >> 6, lane = tid & 63, wr = wid >> 2, wc = wid & 3, fr = lane & 15, fq = lane >> 4;
#pragma unroll
  for (int bj = 0; bj < 2; ++bj)
#pragma unroll
    for (int m = 0; m < 4; ++m)
#pragma unroll
      for (int n = 0; n < 2; ++n)
#pragma unroll
        for (int jj = 0; jj < 4; ++jj) {
          const int r = wr * 64 + m * 16 + fq * 4 + jj, c = bj * 128 + wc * 32 + n * 16 + fr;
          T[r * 256 + (c ^ (fq << 4))] = (ai == 0) ? acc[0][bj][m][n][jj] : acc[1][bj][m][n][jj];
        }
}
DEV float4 tile_ld4(int r, int c4) { return *(const float4*)((const float*)g_shm + r * 256 + (c4 ^ (((r >> 2) & 3) << 4))); }
DEV float tile_ld(int r, int c) { return ((const float*)g_shm)[r * 256 + (c ^ (((r >> 2) & 3) << 4))]; }

DEV int vblock() { return (blockIdx.x & 7) * (gridDim.x >> 3) + (blockIdx.x >> 3); }

DEV void tile_pmpn(int tile, int nM, int nN, int& pm, int& pn) {
  const int nig = 8 * nN, gid = tile / nig, fm = gid * 8, gsz = (nM - fm) < 8 ? (nM - fm) : 8;
  pm = fm + ((tile % nig) % gsz); pn = (tile % nig) / gsz;
}
DEV void phase_gemm_res(const Params& p, const bf16_t* A, long lda, const bf16_t* Bt, int K, int mtiles, long xrow0) {
  float* X = kx();
  for (int tile = vblock(); tile < mtiles * 4; tile += gridDim.x) {
    int pm, pn; tile_pmpn(tile, mtiles, 4, pm, pn);
    f32x4 acc[2][2][4][2];
    gemm_big(A, lda, Bt, K, K, (long)pm * 256, (long)pn * 256, acc);
    const int tid = opaque_tid();
#pragma unroll
    for (int ai = 0; ai < 2; ++ai) {
      LBAR2();
      dump_half(acc, ai, tid);
      LBAR2();
      for (int e = tid; e < 128 * 64; e += 512) {
        const int r = e >> 6, c4 = (e & 63) * 4;
        const float4 v = tile_ld4(r, c4);
        float4* q = (float4*)(X + (xrow0 + pm * 256 + ai * 128 + r) * 1024 + pn * 256 + c4);
        float4 o = *q; o.x += v.x; o.y += v.y; o.z += v.z; o.w += v.w; *q = o;
      }
    }
    LBAR2();
  }
}

DEV void phase_sgu_in(const Params& p, int j, int slab) {
  const bf16_t* A = (const bf16_t*)(kws() + OFF_H0) + (size_t)slab * SLAB * 1024;
  const bf16_t* Bt = (const bf16_t*)(kws() + OFF_W + W_SG_IN);
  const float* bin = kin(6) + (size_t)j * 4096;
  bf16_t* Z = (bf16_t*)(kws() + OFF_U);
  float* SSQ = (float*)(kws() + OFF_SSQ);
  for (int tile = vblock(); tile < 64 * 16; tile += gridDim.x) {
    int pm, pn; tile_pmpn(tile, 64, 16, pm, pn);
    f32x4 acc[2][2][4][2];
    gemm_big(A, 1024, Bt, 1024, 1024, (long)pm * 256, (long)pn * 256, acc);
    const int tid = opaque_tid(), wid = tid >> 6, lane = tid & 63;
    const float4 b4 = *(const float4*)(bin + pn * 256 + lane * 4);
#pragma unroll
    for (int ai = 0; ai < 2; ++ai) {
      LBAR2();
      dump_half(acc, ai, tid);
      LBAR2();
      for (int rr = 0; rr < 16; ++rr) {
        const int r = wid * 16 + rr;
        const float4 v = tile_ld4(r, lane * 4);
        const f32x2 za = gelu_pk((f32x2){v.x + b4.x, v.y + b4.y}), zb = gelu_pk((f32x2){v.z + b4.z, v.w + b4.w});
        const float z0 = za.x, z1 = za.y, z2 = zb.x, z3 = zb.y;
        const int row = pm * 256 + ai * 128 + r;
        uint2 o; o.x = pack2(z0, z1); o.y = pack2(z2, z3);
        *(uint2*)(Z + (size_t)row * 4096 + pn * 256 + lane * 4) = o;
        if (pn >= 8) {
          const float ss = wave_sum(z0 * z0 + z1 * z1 + z2 * z2 + z3 * z3);
          if (lane == 0) SSQ[(size_t)row * 8 + (pn - 8)] = ss;
        }
      }
    }
    LBAR2();
  }
}

DEV void phase_tm_proj(const Params& p) {
  const bf16_t* MIX = (const bf16_t*)(kws() + OFF_MIX);
  const bf16_t* Bt = (const bf16_t*)(kws() + OFF_W + W_TM_P);
  for (int tile = vblock(); tile < 64 * 15; tile += gridDim.x) {
    int pm, pn; tile_pmpn(tile, 64, 15, pm, pn);
    const int msel = pn < 4 ? 0 : (pn < 8 ? 2 : (pn < 12 ? 3 : (pn == 12 ? 1 : (pn == 13 ? 4 : 5))));
    f32x4 acc[2][2][4][2];
    gemm_big(MIX + (size_t)msel * SLAB * 1024, 1024, Bt, 1024, 1024, (long)pm * 256, (long)pn * 256, acc);
    const int tid = opaque_tid(), wid = tid >> 6, lane = tid & 63;
    bf16_t* O; int ld, cb;
    if (pn < 12) { O = (bf16_t*)(kws() + (pn < 4 ? OFF_R : (pn < 8 ? OFF_K : OFF_V))); ld = 1024; cb = (pn & 3) * 256; }
    else { O = (bf16_t*)(kws() + OFF_HL); ld = 512; cb = pn == 12 ? 0 : (pn == 13 ? 128 : 256); }
    const int act = pn == 12 ? 1 : (pn == 14 ? 2 : 0);
    const bool live = pn < 12 || pn == 14 || lane < 32;
#pragma unroll
    for (int ai = 0; ai < 2; ++ai) {
      LBAR2();
      dump_half(acc, ai, tid);
      LBAR2();
      for (int rr = 0; rr < 16; ++rr) {
        const int r = wid * 16 + rr;
        float4 v = tile_ld4(r, lane * 4);
        if (act == 1) { v.x = tanhf(v.x); v.y = tanhf(v.y); v.z = tanhf(v.z); v.w = tanhf(v.w); }
        else if (act == 2) { v.x = sigmoidf_(v.x); v.y = sigmoidf_(v.y); v.z = sigmoidf_(v.z); v.w = sigmoidf_(v.w); }
        uint2 o; o.x = pack2(v.x, v.y); o.y = pack2(v.z, v.w);
        if (live) *(uint2*)(O + (size_t)(pm * 256 + ai * 128 + r) * ld + cb + lane * 4) = o;
      }
    }
    LBAR2();
  }
}

DEV void phase_ffn_a(const Params& p, int layer) {
  const bf16_t* A = (const bf16_t*)(kws() + OFF_H0);
  const bf16_t* Bt = (const bf16_t*)(kws() + OFF_W + W_FF_A);
  bf16_t* HM = (bf16_t*)(kws() + OFF_HMID);
  const float* cw = kin(31) + (size_t)layer * 3 * 2816;
  const float* cb = kin(32) + (size_t)layer * 2816;
  float* UP = (float*)g_shm;
  bf16_t* gl = (bf16_t*)(g_shm + 65536);
  for (int tile = vblock(); tile < 202 * 22; tile += gridDim.x) {
    int mi, pn; tile_pmpn(tile, 202, 22, mi, pn);
    int base, L, i;
    if (mi < 130) { base = (mi / 65) * 16384; L = 16384; i = mi % 65; }
    else { const int m2 = mi - 130; base = 32768 + (m2 / 9) * 2048; L = 2048; i = m2 % 9; }
    const int s0 = 254 * i - 1;
    f32x4 acc[2][2][4][2];
    gemm_big(A, 1024, Bt, 1024, 1024, (long)base + s0, (long)pn * 256, acc);
    const int tid = opaque_tid(), wid = tid >> 6, lane = tid & 63, wr = wid >> 2, wc = wid & 3, fr = lane & 15, fq = lane >> 4;
    LBAR2();
#pragma unroll
    for (int ai = 0; ai < 2; ++ai)
#pragma unroll
      for (int m = 0; m < 4; ++m)
#pragma unroll
        for (int n = 0; n < 2; ++n)
#pragma unroll
          for (int jj = 0; jj < 4; ++jj) {
            const int r = ai * 128 + wr * 64 + m * 16 + fq * 4 + jj, c = wc * 32 + n * 16 + fr;
            const int s = s0 + r;
            gl[r * 136 + c] = (s >= 0 && s < L) ? f2bf(acc[ai][0][m][n][jj]) : (bf16_t)0;
          }
    const int c4 = (lane & 31) * 4, f = pn * 128 + c4;
    const float4 w0 = *(const float4*)(cw + f), w1 = *(const float4*)(cw + 2816 + f), w2 = *(const float4*)(cw + 2 * 2816 + f), bb = *(const float4*)(cb + f);
#pragma unroll
    for (int ai = 0; ai < 2; ++ai) {
      LBAR2();
#pragma unroll
      for (int m = 0; m < 4; ++m)
#pragma unroll
        for (int n = 0; n < 2; ++n)
#pragma unroll
          for (int jj = 0; jj < 4; ++jj) {
            const int r = wr * 64 + m * 16 + fq * 4 + jj, c = wc * 32 + n * 16 + fr;
            UP[r * 128 + (c ^ (fq << 4))] = (ai == 0) ? acc[0][1][m][n][jj] : acc[1][1][m][n][jj];
          }
      LBAR2();
      for (int e = tid; e < 128 * 32; e += 512) {
        const int rl = e >> 5, r = ai * 128 + rl, s = s0 + r;
        if (r >= 1 && r <= 254 && s < L) {
          const float4 u = *(const float4*)(UP + rl * 128 + (c4 ^ (((rl >> 2) & 3) << 4)));
          const uint2 g0 = *(const uint2*)(gl + (r - 1) * 136 + c4), g1 = *(const uint2*)(gl + r * 136 + c4), g2 = *(const uint2*)(gl + (r + 1) * 136 + c4);
          const float c0 = w0.x * __uint_as_float(g0.x << 16) + w1.x * __uint_as_float(g1.x << 16) + w2.x * __uint_as_float(g2.x << 16) + bb.x;
          const float c1 = w0.y * __uint_as_float(g0.x & 0xffff0000u) + w1.y * __uint_as_float(g1.x & 0xffff0000u) + w2.y * __uint_as_float(g2.x & 0xffff0000u) + bb.y;
          const float c2 = w0.z * __uint_as_float(g0.y << 16) + w1.z * __uint_as_float(g1.y << 16) + w2.z * __uint_as_float(g2.y << 16) + bb.z;
          const float c3 = w0.w * __uint_as_float(g0.y & 0xffff0000u) + w1.w * __uint_as_float(g1.y & 0xffff0000u) + w2.w * __uint_as_float(g2.y & 0xffff0000u) + bb.w;
          const f32x2 ga = gelu_pk((f32x2){c0, c1}), gb = gelu_pk((f32x2){c2, c3});
          uint2 o; o.x = pack2(ga.x * u.x, ga.y * u.y); o.y = pack2(gb.x * u.z, gb.y * u.w);
          *(uint2*)(HM + (size_t)(base + s) * 2816 + f) = o;
        }
      }
    }
    LBAR2();
  }
}

template <int KP>
DEV void small_mma(f32x4 (&acc)[4][4]) {
  const int TIDX = opaque_tid();
  constexpr int LD = KP + 8;
  const bf16_t* sA = (const bf16_t*)g_shm;
  const bf16_t* sB = sA + 128 * LD;
  const int wid = TIDX >> 6, lane = TIDX & 63, wr = wid >> 2, wc = wid & 3, fr = lane & 15, fq = lane >> 4;
#pragma unroll
  for (int m = 0; m < 4; ++m)
#pragma unroll
    for (int n = 0; n < 4; ++n) acc[m][n] = (f32x4){0.f, 0.f, 0.f, 0.f};
#pragma unroll
  for (int kk = 0; kk < KP / 32; ++kk) {
    bf16x8 a[4], b[4];
#pragma unroll
    for (int m = 0; m < 4; ++m) a[m] = *(const bf16x8*)(sA + (wr * 64 + m * 16 + fr) * LD + kk * 32 + fq * 8);
#pragma unroll
    for (int n = 0; n < 4; ++n) b[n] = *(const bf16x8*)(sB + (wc * 64 + n * 16 + fr) * LD + kk * 32 + fq * 8);
#pragma unroll
    for (int m = 0; m < 4; ++m)
#pragma unroll
      for (int n = 0; n < 4; ++n) acc[m][n] = __builtin_amdgcn_mfma_f32_16x16x32_bf16(a[m], b[n], acc[m][n], 0, 0, 0);
  }
}
template <int KP>
DEV void small_load_ab(bf16_t* sA, const bf16_t* gA, long lda, bf16_t* sB, const bf16_t* gB, long ldb, int tid) {
  constexpr int LD = KP + 8, CPR = KP / 8, TA = 128 * CPR, TB = 256 * CPR, IA = TA / 512, IB = TB / 512;
  static_assert(TA % 512 == 0 && TB % 512 == 0, "panel sizes must be multiples of the block");
  uint4 va[IA], vb[IB];
#pragma unroll
  for (int it = 0; it < IA; ++it) { const int c = tid + it * 512; va[it] = *(const uint4*)(gA + (long)(c / CPR) * lda + (c % CPR) * 8); }
#pragma unroll
  for (int it = 0; it < IB; ++it) { const int c = tid + it * 512; vb[it] = *(const uint4*)(gB + (long)(c / CPR) * ldb + (c % CPR) * 8); }
#pragma unroll
  for (int it = 0; it < IA; ++it) { const int c = tid + it * 512; *(uint4*)(sA + (c / CPR) * LD + (c % CPR) * 8) = va[it]; }
#pragma unroll
  for (int it = 0; it < IB; ++it) { const int c = tid + it * 512; *(uint4*)(sB + (c / CPR) * LD + (c % CPR) * 8) = vb[it]; }
}

DEV void phase_sgu_mix(const Params& p, int j) {
  const int TIDX = opaque_tid();
  constexpr int KP = 128, LD = KP + 8;
  const int wid = TIDX >> 6, lane = TIDX & 63, wr = wid >> 2, wc = wid & 3, fr = lane & 15, fq = lane >> 4;
  bf16_t* sA = (bf16_t*)g_shm;
  bf16_t* sB = sA + 128 * LD;
  float* rsv = (float*)(g_shm + (128 + 256) * LD * 2);
  bf16_t* Z = (bf16_t*)(kws() + OFF_U);
  const float* SSQ = (const float*)(kws() + OFF_SSQ);
  const float* ws_ = kin(8) + (size_t)j * 8 * 128 * 128;
  const float* bs = kin(9) + (size_t)j * 8 * 128;
  const float* ng = kin(7) + (size_t)j * 2048;
  for (int unit = blockIdx.x; unit < 128 * 8; unit += gridDim.x) {
    const int chunk = unit >> 3, g = unit & 7;
    __syncthreads();
    uint4 vb[8]; float4 wa[4][2];
#pragma unroll
    for (int it = 0; it < 8; ++it) {
      const int e = TIDX + it * 512, pp = e & 127, c8 = (e >> 7) * 8;
      vb[it] = *(const uint4*)(Z + (size_t)(chunk * 128 + pp) * 4096 + 2048 + g * 256 + c8);
    }
#pragma unroll
    for (int it = 0; it < 4; ++it) {
      const int c = TIDX + it * 512, q = c >> 4, p8 = (c & 15) * 8;
      const float4* wp = (const float4*)(ws_ + ((size_t)g * 128 + q) * 128 + p8);
      wa[it][0] = wp[0]; wa[it][1] = wp[1];
    }
    if (TIDX < 128) {
      const float4* sp = (const float4*)(SSQ + (size_t)(chunk * 128 + TIDX) * 8);
      const float4 s0 = sp[0], s1 = sp[1];
      const float sm = ((s0.x + s0.y) + (s0.z + s0.w)) + ((s1.x + s1.y) + (s1.z + s1.w));
      rsv[TIDX] = rsqrtf(sm * (1.0f / 2048.f) + 1e-6f);
    }
#pragma unroll
    for (int it = 0; it < 8; ++it) {
      const int e = TIDX + it * 512, pp = e & 127, c8 = (e >> 7) * 8;
      const uint4 v = vb[it];
      sB[(c8 + 0) * LD + pp] = (bf16_t)(v.x & 0xffff); sB[(c8 + 1) * LD + pp] = (bf16_t)(v.x >> 16);
      sB[(c8 + 2) * LD + pp] = (bf16_t)(v.y & 0xffff); sB[(c8 + 3) * LD + pp] = (bf16_t)(v.y >> 16);
      sB[(c8 + 4) * LD + pp] = (bf16_t)(v.z & 0xffff); sB[(c8 + 5) * LD + pp] = (bf16_t)(v.z >> 16);
      sB[(c8 + 6) * LD + pp] = (bf16_t)(v.w & 0xffff); sB[(c8 + 7) * LD + pp] = (bf16_t)(v.w >> 16);
    }
    __syncthreads();
#pragma unroll
    for (int it = 0; it < 4; ++it) {
      const int c = TIDX + it * 512, q = c >> 4, p8 = (c & 15) * 8;
      const float4 w0 = wa[it][0], w1 = wa[it][1];
      uint4 o;
      o.x = pack2(w0.x * rsv[p8 + 0], w0.y * rsv[p8 + 1]); o.y = pack2(w0.z * rsv[p8 + 2], w0.w * rsv[p8 + 3]);
      o.z = pack2(w1.x * rsv[p8 + 4], w1.y * rsv[p8 + 5]); o.w = pack2(w1.z * rsv[p8 + 6], w1.w * rsv[p8 + 7]);
      *(uint4*)(sA + q * LD + p8) = o;
    }
    __syncthreads();
    f32x4 acc[4][4];
    small_mma<KP>(acc);
#pragma unroll
    for (int m = 0; m < 4; ++m)
#pragma unroll
      for (int n = 0; n < 4; ++n) {
        const int c = g * 256 + wc * 64 + n * 16 + fr;
        const float gg = ng[c];
#pragma unroll
        for (int jj = 0; jj < 4; ++jj) {
          const int q = wr * 64 + m * 16 + fq * 4 + jj;
          const float mix = acc[m][n][jj] * gg + bs[g * 128 + q];
          bf16_t* up = Z + (size_t)(chunk * 128 + q) * 4096 + c;
          *up = f2bf(bf2f(*up) * mix);
        }
      }
  }
  __syncthreads();
}

template <int KP>
DEV void lora_out_unit(const Params& p, int j, int kind, int mt, int ntile) {
  const int TIDX = opaque_tid();
  constexpr int LD = KP + 8;
  const int wid = TIDX >> 6, lane = TIDX & 63, wr = wid >> 2, wc = wid & 3, fr = lane & 15, fq = lane >> 4;
  bf16_t* sA = (bf16_t*)g_shm;
  bf16_t* sB = sA + 128 * LD;
  const bf16_t* HL = (const bf16_t*)(kws() + OFF_HL);
  const int koff = kind < 4 ? kind * 64 : 256;
  const bf16_t* Bt = (const bf16_t*)(kws() + OFF_W + (kind < 2 ? W_TM_W2 + (size_t)kind * 1024 * 64 * 2 : (kind < 4 ? W_TM_A2 + (size_t)(kind - 2) * 1024 * 64 * 2 : W_TM_G2)));
  bf16_t* O = (bf16_t*)(kws() + (kind == 0 ? OFF_E0 : kind == 1 ? OFF_E1 : kind == 2 ? OFF_A0 : kind == 3 ? OFF_A1 : OFF_G));
  const float* bias = kind < 2 ? kin(15) + ((size_t)j * 2 + kind) * 1024 : (kind < 4 ? kin(18) + ((size_t)j * 2 + kind - 2) * 1024 : nullptr);
  __syncthreads();
  small_load_ab<KP>(sA, HL + (size_t)mt * 128 * 512 + koff, 512, sB, Bt + (size_t)ntile * 256 * KP, KP, TIDX);
  __syncthreads();
  f32x4 acc[4][4];
  small_mma<KP>(acc);
#pragma unroll
  for (int m = 0; m < 4; ++m)
#pragma unroll
    for (int n = 0; n < 4; ++n) {
      const int col = ntile * 256 + wc * 64 + n * 16 + fr;
      const float b = bias ? bias[col] : 0.f;
#pragma unroll
      for (int jj = 0; jj < 4; ++jj) {
        const int row = mt * 128 + wr * 64 + m * 16 + fq * 4 + jj;
        float v = acc[m][n][jj] + b;
        if (kind < 2) v = 0.6065306597126334f * sigmoidf_(v); else if (kind < 4) v = sigmoidf_(v);
        O[(size_t)row * 1024 + col] = f2bf(v);
      }
    }
}
DEV void phase_tm_lora_out(const Params& p, int j) {
  for (int unit = blockIdx.x; unit < 5 * 512; unit += gridDim.x) {
    const int kind = unit / 512, r = unit % 512, mt = r >> 2, ntile = r & 3;
    if (kind < 4) lora_out_unit<64>(p, j, kind, mt, ntile); else lora_out_unit<160>(p, j, kind, mt, ntile);
  }
  __syncthreads();
}

constexpr int LDP = 72;
constexpr int MATE = 64 * LDP;
DEV bf16_t* lbuf(int i) { return (bf16_t*)g_shm + i * MATE; }
DEV void bmm(const bf16_t* A, const bf16_t* Bt, int mb, int nh, int fr, int fq, f32x4 (&acc)[2]) {
  acc[0] = (f32x4){0.f, 0.f, 0.f, 0.f}; acc[1] = (f32x4){0.f, 0.f, 0.f, 0.f};
#pragma unroll
  for (int kk = 0; kk < 2; ++kk) {
    const bf16x8 a = *(const bf16x8*)(A + (mb * 16 + fr) * LDP + kk * 32 + fq * 8);
#pragma unroll
    for (int n = 0; n < 2; ++n) {
      const bf16x8 b = *(const bf16x8*)(Bt + (nh * 32 + n * 16 + fr) * LDP + kk * 32 + fq * 8);
      acc[n] = __builtin_amdgcn_mfma_f32_16x16x32_bf16(a, b, acc[n], 0, 0, 0);
    }
  }
}
DEV void st_rm(bf16_t* C, const f32x4 (&v)[2], int mb, int nh, int fr, int fq) {
#pragma unroll
  for (int n = 0; n < 2; ++n)
#pragma unroll
    for (int j = 0; j < 4; ++j) C[(mb * 16 + fq * 4 + j) * LDP + nh * 32 + n * 16 + fr] = f2bf(v[n][j]);
}
DEV void st_tr(bf16_t* CT, const f32x4 (&v)[2], int mb, int nh, int fr, int fq) {
#pragma unroll
  for (int n = 0; n < 2; ++n) {
    uint2 o; o.x = pack2(v[n][0], v[n][1]); o.y = pack2(v[n][2], v[n][3]);
    *(uint2*)(CT + (nh * 32 + n * 16 + fr) * LDP + mb * 16 + fq * 4) = o;
  }
}

DEV void phase_wkv_a(const Params& p, int jl, int slab) {
  const int TIDX = opaque_tid();
  const int wid = __builtin_amdgcn_readfirstlane(TIDX >> 6), lane = TIDX & 63, fr = lane & 15, fq = lane >> 4, mb = wid >> 1, nh = wid & 1;
  const bf16_t* Rb = (const bf16_t*)(kws() + OFF_R);
  const bf16_t* Kb = (const bf16_t*)(kws() + OFF_K);
  const bf16_t* Vb = (const bf16_t*)(kws() + OFF_V);
  float* PSI = (float*)(kws() + OFF_PSI);
  float* BON = (float*)(kws() + OFF_BON);
  float* segsum = (float*)(g_shm + 15 * MATE * 2);
  float* gTs = segsum + 512;
  bf16_t *mAtil = lbuf(0), *mBtil = lbuf(1), *mKtil = lbuf(2), *mRtil = lbuf(3), *mBgamT = lbuf(4), *mKgam = lbuf(5), *mAtilT = lbuf(6), *mVT = lbuf(7),
         *mMak = lbuf(10), *mMrk = lbuf(11), *mMrbT = lbuf(12);
  uint4 nr, nk, nv, na, ne;
  const int lr = TIDX >> 3, lc8 = (TIDX & 7) * 8;
  auto load_raw = [&](int u) {
    const int e2 = u & 1, h2 = (u >> 1) & 15, c2 = u >> 5;
    const bf16_t* A2 = (const bf16_t*)(kws() + (e2 ? OFF_A1 : OFF_A0));
    const bf16_t* E2 = (const bf16_t*)(kws() + (e2 ? OFF_E1 : OFF_E0));
    const size_t o = (size_t)c2 * 64 * 1024 + h2 * 64 + (size_t)lr * 1024 + lc8;
    nr = *(const uint4*)(Rb + o); nk = *(const uint4*)(Kb + o); nv = *(const uint4*)(Vb + o); na = *(const uint4*)(A2 + o); ne = *(const uint4*)(E2 + o);
  };
  if ((int)blockIdx.x < 256 * 32) load_raw(blockIdx.x);
  for (int unit = blockIdx.x; unit < 256 * 32; unit += gridDim.x) {
    const int e = unit & 1, h = (unit >> 1) & 15, c = unit >> 5;
    bf16_t* Ab = (bf16_t*)(kws() + (e ? OFF_A1 : OFF_A0));
    bf16_t* Eb = (bf16_t*)(kws() + (e ? OFF_E1 : OFF_E0));
    bf16_t* YL = (bf16_t*)(kws() + (e ? OFF_YLB : OFF_YLF));
    const size_t tile0 = (size_t)c * 64 * 1024 + h * 64;
    {
      const int jcol = lane, sg = wid;
      const float kkw = kin(23)[(size_t)jl * 1024 + h * 64 + jcol], kaw = kin(24)[(size_t)jl * 1024 + h * 64 + jcol], rkw = kin(25)[(size_t)jl * 1024 + h * 64 + jcol];
      *(uint4*)(lbuf(8) + lr * LDP + lc8) = nr; *(uint4*)(lbuf(9) + lr * LDP + lc8) = nk; *(uint4*)(lbuf(10) + lr * LDP + lc8) = nv;
      *(uint4*)(lbuf(11) + lr * LDP + lc8) = na; *(uint4*)(lbuf(12) + lr * LDP + lc8) = ne;
      LBAR2();
      if (unit + (int)gridDim.x < 256 * 32) load_raw(unit + gridDim.x);
      float rv[8], kv[8], vv[8], av[8], lw[8];
#pragma unroll
      for (int q = 0; q < 8; ++q) {
        const int tau = sg * 8 + q, tok = e ? 63 - tau : tau;
        rv[q] = bf2f(lbuf(8)[tok * LDP + jcol]); kv[q] = bf2f(lbuf(9)[tok * LDP + jcol]); vv[q] = bf2f(lbuf(10)[tok * LDP + jcol]);
        av[q] = bf2f(lbuf(11)[tok * LDP + jcol]); lw[q] = -bf2f(lbuf(12)[tok * LDP + jcol]);
      }
      float pre[8]; float run = 0.f;
#pragma unroll
      for (int q = 0; q < 8; ++q) { run += lw[q]; pre[q] = run; }
      segsum[sg * 64 + jcol] = run;
      LBAR2();
      float off = 0.f, tot = 0.f;
#pragma unroll
      for (int s2 = 0; s2 < 8; ++s2) { const float sv = segsum[s2 * 64 + jcol]; tot += sv; if (s2 < sg) off += sv; }
      if (sg == 0) gTs[jcol] = __expf(tot);
      float at[8], bg[8], vt[8];
#pragma unroll
      for (int q = 0; q < 8; ++q) {
        const int tau = sg * 8 + q, tok = e ? 63 - tau : tau;
        const float g = off + pre[q], gp = g - lw[q];
        const float kr = kv[q] * kkw;
        const float ss = wave_sum(kr * kr);
        const float kk = kr * __builtin_amdgcn_rsqf(fmaxf(ss, 1e-24f));
        const float b = kk * av[q], kd = kv[q] * (1.0f + (av[q] - 1.0f) * kaw);
        const float eg = __expf(g), eng = __expf(-g), egp = __expf(gp), egt = __expf(tot - g);
        const float atil = -kk * egp;
        mAtil[tau * LDP + jcol] = f2bf(atil);
        mBtil[tau * LDP + jcol] = f2bf(b * eng);
        mKtil[tau * LDP + jcol] = f2bf(kd * eng);
        mRtil[tau * LDP + jcol] = f2bf(rv[q] * eg);
        mKgam[tau * LDP + jcol] = f2bf(kd * egt);
        at[q] = atil; bg[q] = b * egt; vt[q] = vv[q];
        const float bon = wave_sum(rv[q] * kd * rkw);
        if (lane == 0) BON[((size_t)e * SLAB + c * 64 + tok) * 16 + h] = bon;
      }
      uint4 o;
      o.x = pack2(at[0], at[1]); o.y = pack2(at[2], at[3]); o.z = pack2(at[4], at[5]); o.w = pack2(at[6], at[7]);
      *(uint4*)(mAtilT + jcol * LDP + sg * 8) = o;
      o.x = pack2(bg[0], bg[1]); o.y = pack2(bg[2], bg[3]); o.z = pack2(bg[4], bg[5]); o.w = pack2(bg[6], bg[7]);
      *(uint4*)(mBgamT + jcol * LDP + sg * 8) = o;
      o.x = pack2(vt[0], vt[1]); o.y = pack2(vt[2], vt[3]); o.z = pack2(vt[4], vt[5]); o.w = pack2(vt[6], vt[7]);
      *(uint4*)(mVT + jcol * LDP + sg * 8) = o;
    }
    LBAR2();
    f32x4 acc[2], acc2[2];
    bmm(mBtil, mAtil, mb, nh, fr, fq, acc);
#pragma unroll
    for (int n = 0; n < 2; ++n)
#pragma unroll
      for (int j = 0; j < 4; ++j) { const int s = mb * 16 + fq * 4 + j, t = nh * 32 + n * 16 + fr; acc[n][j] = s < t ? acc[n][j] : 0.f; }
    st_rm(lbuf(8), acc, mb, nh, fr, fq); st_tr(lbuf(9), acc, mb, nh, fr, fq);
#pragma unroll
    for (int n = 0; n < 2; ++n)
#pragma unroll
      for (int j = 0; j < 4; ++j) { const int s = mb * 16 + fq * 4 + j, t = nh * 32 + n * 16 + fr; acc[n][j] += (s == t) ? 1.f : 0.f; }
    st_rm(lbuf(13), acc, mb, nh, fr, fq);
    bmm(mKtil, mAtil, mb, nh, fr, fq, acc);
#pragma unroll
    for (int n = 0; n < 2; ++n)
#pragma unroll
      for (int j = 0; j < 4; ++j) { const int s = mb * 16 + fq * 4 + j, t = nh * 32 + n * 16 + fr; acc[n][j] = s < t ? acc[n][j] : 0.f; }
    st_rm(mMak, acc, mb, nh, fr, fq);
    bmm(mKtil, mRtil, mb, nh, fr, fq, acc);
#pragma unroll
    for (int n = 0; n < 2; ++n)
#pragma unroll
      for (int j = 0; j < 4; ++j) { const int s = mb * 16 + fq * 4 + j, t = nh * 32 + n * 16 + fr; acc[n][j] = s <= t ? acc[n][j] : 0.f; }
    st_rm(mMrk, acc, mb, nh, fr, fq);
    bmm(mBtil, mRtil, mb, nh, fr, fq, acc);
#pragma unroll
    for (int n = 0; n < 2; ++n)
#pragma unroll
      for (int j = 0; j < 4; ++j) { const int s = mb * 16 + fq * 4 + j, t = nh * 32 + n * 16 + fr; acc[n][j] = s <= t ? acc[n][j] : 0.f; }
    st_tr(mMrbT, acc, mb, nh, fr, fq);
    LBAR2();
    bmm(lbuf(8), lbuf(9), mb, nh, fr, fq, acc);
    st_rm(lbuf(1), acc, mb, nh, fr, fq); st_tr(lbuf(2), acc, mb, nh, fr, fq);
    LBAR2();
#pragma unroll
    for (int k = 0; k < 4; ++k) {
      const int pc = (k & 1) ? 8 : 1, pn = (k & 1) ? 1 : 8, wc_ = (k & 1) ? 14 : 13, wn = (k & 1) ? 13 : 14;
      bmm(lbuf(wc_), lbuf(pc + 1), mb, nh, fr, fq, acc);
      bmm(lbuf(pc), lbuf(pc + 1), mb, nh, fr, fq, acc2);
#pragma unroll
      for (int n = 0; n < 2; ++n)
#pragma unroll
        for (int j = 0; j < 4; ++j) acc[n][j] += bf2f(lbuf(wc_)[(mb * 16 + fq * 4 + j) * LDP + nh * 32 + n * 16 + fr]);
      st_rm(lbuf(wn), acc, mb, nh, fr, fq);
      st_rm(lbuf(pn), acc2, mb, nh, fr, fq); st_tr(lbuf(pn + 1), acc2, mb, nh, fr, fq);
      LBAR2();
    }
    bmm(lbuf(13), lbuf(2), mb, nh, fr, fq, acc);
#pragma unroll
    for (int n = 0; n < 2; ++n)
#pragma unroll
      for (int j = 0; j < 4; ++j) acc[n][j] += bf2f(lbuf(13)[(mb * 16 + fq * 4 + j) * LDP + nh * 32 + n * 16 + fr]);
    st_rm(lbuf(14), acc, mb, nh, fr, fq);
    LBAR2();
    bmm(mMrbT, lbuf(14), mb, nh, fr, fq, acc);  st_rm(lbuf(8), acc, mb, nh, fr, fq);
    bmm(mBgamT, lbuf(14), mb, nh, fr, fq, acc); st_rm(lbuf(9), acc, mb, nh, fr, fq);
    LBAR2();
    bmm(lbuf(8), mMak, mb, nh, fr, fq, acc);
#pragma unroll
    for (int n = 0; n < 2; ++n)
#pragma unroll
      for (int j = 0; j < 4; ++j) { const int t = mb * 16 + fq * 4 + j, s = nh * 32 + n * 16 + fr; acc[n][j] += bf2f(mMrk[s * LDP + t]); }
    st_rm(lbuf(1), acc, mb, nh, fr, fq);
    bmm(lbuf(9), mMak, mb, nh, fr, fq, acc);
#pragma unroll
    for (int n = 0; n < 2; ++n)
#pragma unroll
      for (int j = 0; j < 4; ++j) { const int jj = mb * 16 + fq * 4 + j, s = nh * 32 + n * 16 + fr; acc[n][j] += bf2f(mKgam[s * LDP + jj]); }
    st_rm(lbuf(2), acc, mb, nh, fr, fq);
    bmm(mAtilT, lbuf(8), mb, nh, fr, fq, acc);
#pragma unroll
    for (int n = 0; n < 2; ++n) {
      const int j0 = mb * 16 + fq * 4, t = nh * 32 + n * 16 + fr;
      const uint2 rt = *(const uint2*)(mRtil + t * LDP + j0);
      uint2 o;
      o.x = pack2(acc[n][0] + __uint_as_float(rt.x << 16), acc[n][1] + __uint_as_float(rt.x & 0xffff0000u));
      o.y = pack2(acc[n][2] + __uint_as_float(rt.y << 16), acc[n][3] + __uint_as_float(rt.y & 0xffff0000u));
      *(uint2*)(Eb + tile0 + (size_t)t * 1024 + j0) = o;
    }
    bmm(mAtilT, lbuf(9), mb, nh, fr, fq, acc);
#pragma unroll
    for (int n = 0; n < 2; ++n) {
      const int j0 = mb * 16 + fq * 4, jp = nh * 32 + n * 16 + fr;
      uint2 o;
      o.x = pack2(acc[n][0] + (jp == j0 ? gTs[j0] : 0.f), acc[n][1] + (jp == j0 + 1 ? gTs[j0 + 1] : 0.f));
      o.y = pack2(acc[n][2] + (jp == j0 + 2 ? gTs[j0 + 2] : 0.f), acc[n][3] + (jp == j0 + 3 ? gTs[j0 + 3] : 0.f));
      *(uint2*)(Ab + tile0 + (size_t)jp * 1024 + j0) = o;
    }
    LBAR2();
    bmm(mVT, lbuf(1), mb, nh, fr, fq, acc);
#pragma unroll
    for (int n = 0; n < 2; ++n) {
      const int i0 = mb * 16 + fq * 4, t = nh * 32 + n * 16 + fr;
      uint2 o; o.x = pack2(acc[n][0], acc[n][1]); o.y = pack2(acc[n][2], acc[n][3]);
      *(uint2*)(YL + tile0 + (size_t)t * 1024 + i0) = o;
    }
    bmm(mVT, lbuf(2), mb, nh, fr, fq, acc);
    *(f32x4*)(PSI + (size_t)unit * 4096 + (size_t)(wid * 64 + lane) * 8) = acc[0];
    *(f32x4*)(PSI + (size_t)unit * 4096 + (size_t)(wid * 64 + lane) * 8 + 4) = acc[1];
    LBAR2();
  }
}

DEV void phase_wkv_b(const Params& p, int slab, int mode) {
  const int TIDX = opaque_tid();
  const int wid = __builtin_amdgcn_readfirstlane(TIDX >> 6), lane = TIDX & 63, fr = lane & 15, fq = lane >> 4, mb = wid >> 1, nh = wid & 1;
  const float* PSI = (const float*)(kws() + OFF_PSI);
  bf16_t* PHG = (bf16_t*)(kws() + OFF_PHG);
  float* PSG = (float*)(kws() + OFF_PSG);
  float* SST = (float*)(kws() + OFF_SST);
  const bool two_level = slab < 2;
  if (!two_level && mode != 3) return;
  const int nseq = two_level ? 1 : 8, cps = 256 / nseq;
  const int ngrp = two_level ? 8 : 1;
  bf16_t *Sb = lbuf(0), *PhT = lbuf(1), *OmT = lbuf(2), *Sa = lbuf(3);
  const int lr = TIDX >> 3, lc8 = (TIDX & 7) * 8;
  const size_t nat = (size_t)(wid * 64 + lane) * 8;
  if (mode == 2) {
    for (int chain = blockIdx.x; chain < 32; chain += gridDim.x) {
      f32x4 S[2];
      S[0] = (f32x4){0.f, 0.f, 0.f, 0.f}; S[1] = (f32x4){0.f, 0.f, 0.f, 0.f};
      for (int g = 0; g < 8; ++g) {
        const size_t item = (size_t)chain * 8 + g;
        *(f32x4*)(SST + item * 4096 + nat) = S[0]; *(f32x4*)(SST + item * 4096 + nat + 4) = S[1];
        const uint4 ph = *(const uint4*)(PHG + item * 4096 + lr * 64 + lc8);
        const f32x4 q0 = *(const f32x4*)(PSG + item * 4096 + nat), q1 = *(const f32x4*)(PSG + item * 4096 + nat + 4);
        st_rm(Sb, S, mb, nh, fr, fq);
        *(uint4*)(PhT + lr * LDP + lc8) = ph;
        LBAR2();
        f32x4 acc[2];
        bmm(Sb, PhT, mb, nh, fr, fq, acc);
        S[0] = acc[0] + q0; S[1] = acc[1] + q1;
        LBAR2();
      }
    }
    return;
  }
  for (int item = blockIdx.x; item < nseq * 32 * ngrp; item += gridDim.x) {
    const int chain = item / ngrp, grp = item % ngrp;
    const int e = chain & 1, h = (chain >> 1) & 15, sq = chain >> 5;
    const bf16_t* Ab = (const bf16_t*)(kws() + (e ? OFF_A1 : OFF_A0));
    const bf16_t* Eb = (const bf16_t*)(kws() + (e ? OFF_E1 : OFF_E0));
    bf16_t* YL = (bf16_t*)(kws() + (e ? OFF_YLB : OFF_YLF));
    const int sbase = grp * 32;
    f32x4 S[2], SA[2];
    if (mode == 3 && two_level) { S[0] = *(const f32x4*)(SST + (size_t)item * 4096 + nat); S[1] = *(const f32x4*)(SST + (size_t)item * 4096 + nat + 4); }
    else { S[0] = (f32x4){0.f, 0.f, 0.f, 0.f}; S[1] = (f32x4){0.f, 0.f, 0.f, 0.f}; }
#pragma unroll
    for (int n = 0; n < 2; ++n)
#pragma unroll
      for (int j = 0; j < 4; ++j) SA[n][j] = (mb * 16 + fq * 4 + j == nh * 32 + n * 16 + fr) ? 1.f : 0.f;
    uint4 ph0, ph1, ph2, ph3, om0, om1, om2, om3;
    f32x4 ps0[2], ps1[2], ps2[2], ps3[2];
    uint2 yl0[2], yl1[2], yl2[2], yl3[2];
#define WB_PREFETCH(step_, ph, om, ps, y8) do { \
      const int st_ = sbase + ((step_) < 32 ? (step_) : 31); \
      const int c_ = sq * cps + (e ? cps - 1 - st_ : st_); \
      const size_t t0_ = (size_t)c_ * 64 * 1024 + h * 64; \
      ph = *(const uint4*)(Ab + t0_ + (size_t)lr * 1024 + lc8); \
      const size_t u_ = ((size_t)c_ * 16 + h) * 2 + e; \
      ps[0] = *(const f32x4*)(PSI + u_ * 4096 + nat); ps[1] = *(const f32x4*)(PSI + u_ * 4096 + nat + 4); \
      if (mode == 3) { \
        om = *(const uint4*)(Eb + t0_ + (size_t)lr * 1024 + lc8); \
        y8[0] = *(const uint2*)(YL + t0_ + (size_t)(nh * 32 + fr) * 1024 + mb * 16 + fq * 4); \
        y8[1] = *(const uint2*)(YL + t0_ + (size_t)(nh * 32 + 16 + fr) * 1024 + mb * 16 + fq * 4); } } while (0)
#define WB_STEP(step_, ph, om, ps, y8) do { \
      const int c = sq * cps + (e ? cps - 1 - (sbase + (step_)) : (sbase + (step_))); \
      const size_t tile0 = (size_t)c * 64 * 1024 + h * 64; \
      bf16_t *Sb_ = lbuf(((step_) & 1) * 4), *PhT_ = lbuf(((step_) & 1) * 4 + 1), *OmT_ = lbuf(((step_) & 1) * 4 + 2), *Sa_ = lbuf(((step_) & 1) * 4 + 3); \
      st_rm(Sb_, S, mb, nh, fr, fq); \
      *(uint4*)(PhT_ + lr * LDP + lc8) = ph; \
      if (mode == 3) *(uint4*)(OmT_ + lr * LDP + lc8) = om; else st_rm(Sa_, SA, mb, nh, fr, fq); \
      const f32x4 psc0 = ps[0], psc1 = ps[1]; const uint2 ylc0 = y8[0], ylc1 = y8[1]; \
      LBAR2(); \
      WB_PREFETCH((step_) + 4, ph, om, ps, y8); \
      f32x4 acc[2]; \
      if (mode == 3) { \
        bmm(Sb_, OmT_, mb, nh, fr, fq, acc); \
        uint2 o; \
        o.x = pack2(acc[0][0] + __uint_as_float(ylc0.x << 16), acc[0][1] + __uint_as_float(ylc0.x & 0xffff0000u)); \
        o.y = pack2(acc[0][2] + __uint_as_float(ylc0.y << 16), acc[0][3] + __uint_as_float(ylc0.y & 0xffff0000u)); \
        *(uint2*)(YL + tile0 + (size_t)(nh * 32 + fr) * 1024 + mb * 16 + fq * 4) = o; \
        o.x = pack2(acc[1][0] + __uint_as_float(ylc1.x << 16), acc[1][1] + __uint_as_float(ylc1.x & 0xffff0000u)); \
        o.y = pack2(acc[1][2] + __uint_as_float(ylc1.y << 16), acc[1][3] + __uint_as_float(ylc1.y & 0xffff0000u)); \
        *(uint2*)(YL + tile0 + (size_t)(nh * 32 + 16 + fr) * 1024 + mb * 16 + fq * 4) = o; \
      } else { \
        bmm(Sa_, PhT_, mb, nh, fr, fq, acc); SA[0] = acc[0]; SA[1] = acc[1]; \
      } \
      bmm(Sb_, PhT_, mb, nh, fr, fq, acc); \
      S[0] = acc[0] + psc0; S[1] = acc[1] + psc1; } while (0)
    yl0[0] = yl0[1] = yl1[0] = yl1[1] = yl2[0] = yl2[1] = yl3[0] = yl3[1] = make_uint2(0u, 0u);
    om0 = om1 = om2 = om3 = make_uint4(0u, 0u, 0u, 0u);
    WB_PREFETCH(0, ph0, om0, ps0, yl0); WB_PREFETCH(1, ph1, om1, ps1, yl1); WB_PREFETCH(2, ph2, om2, ps2, yl2); WB_PREFETCH(3, ph3, om3, ps3, yl3);
    for (int step0 = 0; step0 < 32; step0 += 4) {
      WB_STEP(step0 + 0, ph0, om0, ps0, yl0);
      WB_STEP(step0 + 1, ph1, om1, ps1, yl1);
      WB_STEP(step0 + 2, ph2, om2, ps2, yl2);
      WB_STEP(step0 + 3, ph3, om3, ps3, yl3);
    }
    LBAR2();
    if (mode == 1) {
#pragma unroll
      for (int n = 0; n < 2; ++n) {
        uint2 o; o.x = pack2(SA[n][0], SA[n][1]); o.y = pack2(SA[n][2], SA[n][3]);
        *(uint2*)(PHG + (size_t)item * 4096 + (nh * 32 + n * 16 + fr) * 64 + mb * 16 + fq * 4) = o;
      }
      *(f32x4*)(PSG + (size_t)item * 4096 + nat) = S[0]; *(f32x4*)(PSG + (size_t)item * 4096 + nat + 4) = S[1];
    }
  }
}

DEV void phase_tm_post(const Params& p, int jl) {
  const int TIDX = opaque_tid();
  const int wid = TIDX >> 6, lane = TIDX & 63, hs = lane >> 4, c4 = (lane & 15) * 4;
  bf16_t* Rb = (bf16_t*)(kws() + OFF_R);
  const bf16_t* Vb = (const bf16_t*)(kws() + OFF_V);
  const bf16_t* Gb = (const bf16_t*)(kws() + OFF_G);
  const bf16_t* YF = (const bf16_t*)(kws() + OFF_YLF);
  const bf16_t* YB = (const bf16_t*)(kws() + OFF_YLB);
  const float* BON = (const float*)(kws() + OFF_BON);
  for (int item = blockIdx.x * 8 + wid; item < 2048; item += gridDim.x * 8) {
    const int hd = (item & 3) * 4 + hs, tb = (item >> 2) * 32;
    const int cch = hd * 64 + c4;
    const float4 lg = *(const float4*)(kin(26) + (size_t)jl * 1024 + cch), lb = *(const float4*)(kin(27) + (size_t)jl * 1024 + cch);
    struct PostRaw { uint2 yf, yb, v, g; float b0, b1; };
    auto load_raw = [&](int tt, PostRaw& w) {
      const int t = tb + (tt < 32 ? tt : 31);
      const size_t o = (size_t)t * 1024 + cch;
      const size_t ob = (size_t)((t & ~63) + 63 - (t & 63)) * 1024 + cch;
      w.yf = *(const uint2*)(YF + o); w.yb = *(const uint2*)(YB + ob); w.v = *(const uint2*)(Vb + o); w.g = *(const uint2*)(Gb + o);
      w.b0 = BON[(size_t)t * 16 + hd]; w.b1 = BON[((size_t)SLAB + t) * 16 + hd];
    };
    PostRaw w0, w1;
    load_raw(0, w0); load_raw(1, w1);
    for (int tt = 0; tt < 32; ++tt) {
      PostRaw w2; load_raw(tt + 2, w2);
      float y[4];
      y[0] = __uint_as_float(w0.yf.x << 16) + __uint_as_float(w0.yb.x << 16); y[1] = __uint_as_float(w0.yf.x & 0xffff0000u) + __uint_as_float(w0.yb.x & 0xffff0000u);
      y[2] = __uint_as_float(w0.yf.y << 16) + __uint_as_float(w0.yb.y << 16); y[3] = __uint_as_float(w0.yf.y & 0xffff0000u) + __uint_as_float(w0.yb.y & 0xffff0000u);
      const float mean = row_sum16((y[0] + y[1]) + (y[2] + y[3])) * (1.0f / 64.f);
      const float d0 = y[0] - mean, d1 = y[1] - mean, d2 = y[2] - mean, d3 = y[3] - mean;
      const float var = row_sum16((d0 * d0 + d1 * d1) + (d2 * d2 + d3 * d3)) * (1.0f / 64.f);
      const float rs = rsqrtf(var + 64e-5f), bon = w0.b0 + w0.b1;
      const float o0 = (d0 * rs * lg.x + lb.x + bon * __uint_as_float(w0.v.x << 16)) * __uint_as_float(w0.g.x << 16);
      const float o1 = (d1 * rs * lg.y + lb.y + bon * __uint_as_float(w0.v.x & 0xffff0000u)) * __uint_as_float(w0.g.x & 0xffff0000u);
      const float o2 = (d2 * rs * lg.z + lb.z + bon * __uint_as_float(w0.v.y << 16)) * __uint_as_float(w0.g.y << 16);
      const float o3 = (d3 * rs * lg.w + lb.w + bon * __uint_as_float(w0.v.y & 0xffff0000u)) * __uint_as_float(w0.g.y & 0xffff0000u);
      uint2 o; o.x = pack2(o0, o1); o.y = pack2(o2, o3);
      *(uint2*)(Rb + (size_t)(tb + tt) * 1024 + cch) = o;
      w0 = w1; w1 = w2;
    }
  }
}

DEV void wprep_sgu(const Params& p, int j) {
  wprep_T2((bf16_t*)(kws() + OFF_W + W_SG_IN), 1024, 0, kin(5) + (size_t)j * 1024 * 4096, 1024, 4096, nullptr, 128, 0);
  wprep_T2((bf16_t*)(kws() + OFF_W + W_SG_OUT), 2048, 0, kin(10) + (size_t)j * 2048 * 1024, 2048, 1024, nullptr, 128, 0);
}
DEV void wprep_ffn(const Params& p, int layer) {
  wprep_T2((bf16_t*)(kws() + OFF_W + W_FF_A), 1024, 0, kin(29) + (size_t)layer * 1024 * 2816, 1024, 2816, nullptr, 256, 0);
  wprep_T2((bf16_t*)(kws() + OFF_W + W_FF_A), 1024, 0, kin(30) + (size_t)layer * 1024 * 2816, 1024, 2816, nullptr, 256, 128);
  wprep_T2((bf16_t*)(kws() + OFF_W + W_FF_D), 2816, 0, kin(33) + (size_t)layer * 2816 * 1024, 2816, 1024, nullptr, 128, 0);
}
DEV void wprep_tm(const Params& p, int j) {
  const int TIDX = opaque_tid();
  bf16_t* WP = (bf16_t*)(kws() + OFF_W + W_TM_P);
  const float* srcs[3] = {kin(12) + (size_t)j * 1048576, kin(13) + (size_t)j * 1048576, kin(14) + (size_t)j * 1048576};
#pragma unroll
  for (int i = 0; i < 3; ++i) wprep_T2(WP, 1024, 0, srcs[i], 1024, 1024, nullptr, 128, i * 1024);
#pragma unroll
  for (int e = 0; e < 2; ++e) {
    wprep_T(WP, 1024, 0, kin(16) + ((size_t)j * 2 + e) * 1024 * 64, 1024, 64, nullptr, 128, 3072 + 64 * e);
    wprep_T(WP, 1024, 0, kin(19) + ((size_t)j * 2 + e) * 1024 * 64, 1024, 64, nullptr, 128, 3328 + 64 * e);
    wprep_T2((bf16_t*)(kws() + OFF_W + W_TM_W2) + (size_t)e * 1024 * 64, 64, 0, kin(17) + ((size_t)j * 2 + e) * 64 * 1024, 64, 1024, nullptr, 128, 0);
    wprep_T2((bf16_t*)(kws() + OFF_W + W_TM_A2) + (size_t)e * 1024 * 64, 64, 0, kin(20) + ((size_t)j * 2 + e) * 64 * 1024, 64, 1024, nullptr, 128, 0);
  }
  wprep_T(WP, 1024, 0, kin(21) + (size_t)j * 1024 * 160, 1024, 160, nullptr, 128, 3584);
  for (size_t i = (size_t)blockIdx.x * 512 + TIDX; i < (size_t)(128 + 128 + 96) * 512; i += (size_t)gridDim.x * 512) {
    const size_t row = i / 512, w = i % 512;
    const size_t drow = row < 128 ? 3200 + row : (row < 256 ? 3456 + (row - 128) : 3744 + (row - 256));
    ((unsigned*)(WP + drow * 1024))[w] = 0u;
  }
  wprep_T((bf16_t*)(kws() + OFF_W + W_TM_G2), 160, 0, kin(22) + (size_t)j * 160 * 1024, 160, 1024, nullptr, 128, 0);
  wprep_T2((bf16_t*)(kws() + OFF_W + W_TM_O), 1024, 0, kin(28) + (size_t)j * 1048576, 1024, 1024, nullptr, 128, 0);
}

constexpr int PH_SGU = 10, PH_FFN = 3, PH_TM = 25;
constexpr int N_PHASES = 1 + 2 * (PH_SGU + PH_FFN) + 2 * (PH_TM + PH_FFN) + 1;

DEV void run_phase(const Params& p, int ph) {
  if (ph == 0) { phase_init(p); return; }
  if (ph == N_PHASES - 1) { phase_final(p); return; }
  int q = ph - 1, layer = 0;
  for (;;) {
    const int len = (layer & 1) ? PH_TM + PH_FFN : PH_SGU + PH_FFN;
    if (q < len) break;
    q -= len; ++layer;
  }
  const int j = layer >> 1;
  bf16_t* H0 = (bf16_t*)(kws() + OFF_H0);
  const int nmix = (layer & 1) ? PH_TM : PH_SGU;
  if (q >= nmix) {
    const int f = q - nmix;
    if (f == 0) { phase_norm(p, kin(3) + (size_t)layer * 1024, H0); wprep_ffn(p, layer); }
    else if (f == 1) phase_ffn_a(p, layer);
    else phase_gemm_res(p, (const bf16_t*)(kws() + OFF_HMID), 2816, (const bf16_t*)(kws() + OFF_W + W_FF_D), 2816, 192, 0);
    return;
  }
  if (!(layer & 1)) {
    if (q == 0) { phase_norm(p, kin(2) + (size_t)layer * 1024, H0); wprep_sgu(p, j); return; }
    const int slab = (q - 1) / 3, s = (q - 1) % 3;
    if (s == 0) phase_sgu_in(p, j, slab);
    else if (s == 1) phase_sgu_mix(p, j);
    else phase_gemm_res(p, (const bf16_t*)(kws() + OFF_U), 4096, (const bf16_t*)(kws() + OFF_W + W_SG_OUT), 2048, 64, (long)slab * SLAB);
    return;
  }
  {
    const int slab = q < 18 ? q / 9 : 2;
    int s = q < 18 ? q % 9 : q - 18;
    if (slab == 2 && s >= 4) s += 2;
    switch (s) {
      case 0: phase_norm_tm(p, kin(2) + (size_t)layer * 1024, kin(11) + (size_t)j * 6 * 1024, (bf16_t*)(kws() + OFF_MIX), slab); if (slab == 0) wprep_tm(p, j); break;
      case 1: phase_tm_proj(p); break;
      case 2: phase_tm_lora_out(p, j); break;
      case 3: phase_wkv_a(p, j, slab); break;
      case 4: phase_wkv_b(p, slab, 1); break;
      case 5: phase_wkv_b(p, slab, 2); break;
      case 6: phase_wkv_b(p, slab, 3); break;
      case 7: phase_tm_post(p, j); break;
      default: phase_gemm_res(p, (const bf16_t*)(kws() + OFF_R), 1024, (const bf16_t*)(kws() + OFF_W + W_TM_O), 1024, 64, (long)slab * SLAB); break;
    }
  }
}

#ifndef PROBE_CAT
#define PROBE_CAT -1
#endif
DEV int phase_cat(int ph) {
  if (ph == 0 || ph == N_PHASES - 1) return 2;
  int q = ph - 1, layer = 0;
  for (;;) { const int len = (layer & 1) ? PH_TM + PH_FFN : PH_SGU + PH_FFN; if (q < len) break; q -= len; ++layer; }
  const int nmix = (layer & 1) ? PH_TM : PH_SGU;
  if (q >= nmix) return (q - nmix) == 0 ? 2 : ((q - nmix) == 1 ? 7 : 8);
  if (!(layer & 1)) { if (q == 0) return 2; const int s = (q - 1) % 3; return s == 1 ? 3 : 0; }
  int s = q < 18 ? q % 9 : q - 18; if (q >= 18 && s >= 4) s += 2;
  return s == 0 ? 2 : (s == 1 || s == 8) ? 0 : (s == 2 ? 4 : (s == 3 ? 1 : (s == 7 ? 6 : 5)));
}
__global__ void __launch_bounds__(512, 2) mega(Params p, int ph_lo, int ph_hi, int coop) {
#if PROBE_CAT >= 0
  if (blockIdx.x == 0 && threadIdx.x == 0) ((unsigned long long*)(kws() + 500 * MiB))[0] = wall_clock64();
#endif
  for (int ph = ph_lo; ph < ph_hi; ++ph) {
    run_phase(p, ph);
    if (coop && ph + 1 < ph_hi) cg::this_grid().sync();
#if PROBE_CAT >= 0
    if (blockIdx.x == 0 && threadIdx.x == 0) ((unsigned long long*)(kws() + 500 * MiB))[ph + 1] = wall_clock64();
#endif
  }
#if PROBE_CAT >= 0
  cg::this_grid().sync();
  if (blockIdx.x == 0 && threadIdx.x == 0) {
    const unsigned long long* ts = (const unsigned long long*)(kws() + 500 * MiB);
    unsigned long long acc = 0;
    for (int ph = 0; ph < N_PHASES; ++ph) if (PROBE_CAT == 9 || phase_cat(ph) == PROBE_CAT) acc += ts[ph + 1] - ts[ph];
    ((float*)(kws() + 500 * MiB))[1024] = (float)acc * (0.01f * 2e-5f);
  }
  __syncthreads();
  if (blockIdx.x == 0) {
    __threadfence();
    const float ev = ((volatile float*)(kws() + 500 * MiB))[1024];
    for (int i = threadIdx.x; i < 4096; i += 512) kx()[i] += ev;
    for (int i = threadIdx.x; i < 2048; i += 512) kx()[(size_t)32768 * 1024 + i] += ev;
  }
#endif
}

extern "C" void kernel_launch(void* const* d_in, const int* in_sizes, int n_in, void* d_out, int out_size, void* d_ws, size_t ws_size, hipStream_t stream) {
  static int grid = 0;
  if (!grid) {
    int dev = 0, cus = 0, per_cu = 0;
    (void)hipFuncSetAttribute((const void*)mega, hipFuncAttributeMaxDynamicSharedMemorySize, SHM_BYTES);
    (void)hipGetDevice(&dev);
    (void)hipDeviceGetAttribute(&cus, hipDeviceAttributeMultiprocessorCount, dev);
    (void)hipOccupancyMaxActiveBlocksPerMultiprocessor(&per_cu, (const void*)mega, 512, SHM_BYTES);
    if (per_cu < 1) per_cu = 1;
    grid = cus * per_cu;
    if (grid > 256) grid = 256;
    if (grid & 7) grid &= ~7;
  }
  Params p{};
  for (int i = 0; i < 34; ++i) p.in[i] = (const float*)d_in[i];
  p.x = (float*)d_out;
  p.ws = (char*)d_ws;
  int ph_lo = 0, ph_hi = N_PHASES, coop = 1;
  void* args[] = {&p, &ph_lo, &ph_hi, &coop};
  hipError_t e = hipLaunchCooperativeKernel((const void*)mega, dim3(grid), dim3(512), args, SHM_BYTES, stream);
  if (e != hipSuccess) fprintf(stderr, "cooperative launch failed: %s (grid %d)\n", hipGetErrorString(e), grid);
}
```

```cpp
#define PROBE_CAT -1
#include <hip/hip_runtime.h>
#include <hip/hip_cooperative_groups.h>
#include <cstdio>
namespace cg = cooperative_groups;

#define DEV __device__ __forceinline__
typedef unsigned short bf16_t;
typedef short bf16x8 __attribute__((ext_vector_type(8)));
typedef float f32x4 __attribute__((ext_vector_type(4)));

extern __shared__ __attribute__((aligned(16))) char g_shm[];

constexpr int NT = 49152, SLAB = 16384;
constexpr int SHM_BYTES = 147456;
constexpr size_t MiB = 1u << 20;
constexpr size_t OFF_W = 0;
constexpr size_t OFF_H = 24 * MiB;
constexpr size_t OFF_H0 = OFF_H + 256 * 2048;
constexpr size_t OFF_U = 122 * MiB, OFF_SSQ = 250 * MiB;
constexpr size_t OFF_HMID = 122 * MiB;
constexpr size_t OFF_MIX = 200 * MiB;
constexpr size_t OFF_HX = 24 * MiB, OFF_YLF = 24 * MiB, OFF_YLB = 56 * MiB, OFF_R = 88 * MiB, OFF_K = 120 * MiB, OFF_V = 152 * MiB,
                 OFF_HL = 184 * MiB, OFF_E0 = 200 * MiB, OFF_E1 = 232 * MiB, OFF_A0 = 264 * MiB, OFF_A1 = 296 * MiB, OFF_G = 328 * MiB,
                 OFF_PSI = 360 * MiB, OFF_BON = 488 * MiB, OFF_PHG = 490 * MiB, OFF_PSG = 492 * MiB, OFF_SST = 496 * MiB;
constexpr size_t W_SG_IN = 0, W_SG_OUT = 8 * MiB;
constexpr size_t W_FF_A = 0, W_FF_D = 12 * MiB;
constexpr size_t W_TM_P = 0, W_TM_O = 14 * MiB, W_TM_W2 = 16 * MiB, W_TM_A2 = 16 * MiB + 512 * 1024, W_TM_G2 = 17 * MiB;

struct Params {
  const float* in[34];
  float* x;
  char* ws;
};


typedef const __attribute__((address_space(4))) char* karg_t;
DEV int opaque0() { int z = 0; asm volatile("" : "+s"(z)); return z; }
DEV const float* kin(int i) { karg_t kp = (karg_t)__builtin_amdgcn_kernarg_segment_ptr(); return *(const float* const __attribute__((address_space(4)))*)(kp + (i + opaque0()) * 8); }
DEV float* kx() { karg_t kp = (karg_t)__builtin_amdgcn_kernarg_segment_ptr(); return *(float* const __attribute__((address_space(4)))*)(kp + (34 + opaque0()) * 8); }
DEV char* kws() { karg_t kp = (karg_t)__builtin_amdgcn_kernarg_segment_ptr(); return *(char* const __attribute__((address_space(4)))*)(kp + (35 + opaque0()) * 8); }

DEV int opaque_tid() { int z = 0; asm volatile("" : "+v"(z)); return (int)threadIdx.x + z; }
#define LBAR2() do { asm volatile("s_waitcnt lgkmcnt(0)" ::: "memory"); __builtin_amdgcn_s_barrier(); asm volatile("" ::: "memory"); } while (0)
DEV float bf2f(bf16_t u) { return __uint_as_float(((unsigned)u) << 16); }
typedef float f32x2 __attribute__((ext_vector_type(2)));
typedef __bf16 bf16x2_t __attribute__((ext_vector_type(2)));
DEV unsigned pack2(float a, float b) { f32x2 v = {a, b}; bf16x2_t h = __builtin_convertvector(v, bf16x2_t); return __builtin_bit_cast(unsigned, h); }
DEV bf16_t f2bf(float f) { return (bf16_t)(pack2(f, f) & 0xffffu); }
template <int CTRL> DEV float dppmov(float v) { return __int_as_float(__builtin_amdgcn_update_dpp(0, __float_as_int(v), CTRL, 0xf, 0xf, true)); }
DEV float row_sum16(float v) {
  v += dppmov<0xB1>(v); v += dppmov<0x4E>(v); v += dppmov<0x141>(v); v += dppmov<0x140>(v);
  return v;
}
DEV float wave_sum(float v) {
  const int r = __float_as_int(row_sum16(v));
  return (__int_as_float(__builtin_amdgcn_readlane(r, 0)) + __int_as_float(__builtin_amdgcn_readlane(r, 16))) +
         (__int_as_float(__builtin_amdgcn_readlane(r, 32)) + __int_as_float(__builtin_amdgcn_readlane(r, 48)));
}
DEV float sigmoidf_(float x) { return 1.0f / (1.0f + __expf(-x)); }
DEV f32x2 gelu_pk(f32x2 v) {
  const f32x2 av = __builtin_elementwise_abs(v), d = av * 0.2316418882f + 1.0f;
  f32x2 t; t.x = __builtin_amdgcn_rcpf(d.x); t.y = __builtin_amdgcn_rcpf(d.y);
  f32x2 q = t * 0.5307027145f + (-0.7265760135f); q = q * t + 0.7107068705f; q = q * t + (-0.142248368f); q = q * t + 0.127414796f; q = q * t;
  const f32x2 s = (v * v) * (-0.72134752044f);
  f32x2 e; e.x = __builtin_amdgcn_exp2f(s.x); e.y = __builtin_amdgcn_exp2f(s.y);
  const f32x2 m = v * (q * e), r = v - m;
  f32x2 o; o.x = v.x < 0.f ? m.x : r.x; o.y = v.y < 0.f ? m.y : r.y; return o;
}
DEV float gelu_exact(float v) {
  const float av = fabsf(v), d = av * 0.2316418882f + 1.0f;
  const float t = __builtin_amdgcn_rcpf(d);
  float q = t * 0.5307027145f + (-0.7265760135f); q = q * t + 0.7107068705f; q = q * t + (-0.142248368f); q = q * t + 0.127414796f; q = q * t;
  const float e = __builtin_amdgcn_exp2f((v * v) * (-0.72134752044f));
  const float m = v * (q * e), r = v - m;
  return v < 0.f ? m : r;
}

DEV void phase_init(const Params& p) {
  const int TIDX = opaque_tid();
  const float4* xp = (const float4*)kin(0);
  const float4* xs = (const float4*)kin(1);
  float4* x = (float4*)kx();
  const size_t n0 = (size_t)32768 * 256, n1 = (size_t)16384 * 256;
  for (size_t i = (size_t)blockIdx.x * 512 + TIDX; i < n0 + n1; i += (size_t)gridDim.x * 512) x[i] = i < n0 ? xp[i] : xs[i - n0];
}

template <bool FROM_INPUT>
DEV void phase_norm(const Params& p, const float* g, bf16_t* h0) {
  const int TIDX = opaque_tid();
  const int wid = TIDX >> 6, lane = TIDX & 63;
  float4 gv[4];
#pragma unroll
  for (int i = 0; i < 4; ++i) gv[i] = ((const float4*)g)[lane + 64 * i];
  const int tstep = gridDim.x * 8;
  auto row_ptr = [&](int t) -> const float4* {
    const int tc = t < NT ? t : NT - 1;
    return FROM_INPUT ? (const float4*)(tc < 32768 ? kin(0) + (size_t)tc * 1024 : kin(1) + (size_t)(tc - 32768) * 1024)
                      : (const float4*)(kx() + (size_t)tc * 1024);
  };
  float4 nx[4];
  { const float4* xr = row_ptr(blockIdx.x * 8 + wid);
#pragma unroll
    for (int i = 0; i < 4; ++i) nx[i] = xr[lane + 64 * i]; }
  for (int t = blockIdx.x * 8 + wid; t < NT; t += tstep) {
    float4 v[4]; float ss = 0.f;
#pragma unroll
    for (int i = 0; i < 4; ++i) { v[i] = nx[i]; ss += v[i].x * v[i].x + v[i].y * v[i].y + v[i].z * v[i].z + v[i].w * v[i].w; }
    { const float4* xr = row_ptr(t + tstep);
#pragma unroll
      for (int i = 0; i < 4; ++i) nx[i] = xr[lane + 64 * i]; }
    if (FROM_INPUT) {
      float4* xw = (float4*)(kx() + (size_t)t * 1024);
#pragma unroll
      for (int i = 0; i < 4; ++i) xw[lane + 64 * i] = v[i];
    }
    ss = wave_sum(ss);
    const float rs = rsqrtf(ss * (1.0f / 1024.f) + 1e-6f);
    uint2* hr = (uint2*)(h0 + (size_t)t * 1024);
#pragma unroll
    for (int i = 0; i < 4; ++i) {
      uint2 o; o.x = pack2(v[i].x * rs * gv[i].x, v[i].y * rs * gv[i].y); o.y = pack2(v[i].z * rs * gv[i].z, v[i].w * rs * gv[i].w);
      hr[lane + 64 * i] = o;
    }
  }
}

DEV void phase_norm_tm(const Params& p, const float* g, const float* mu, bf16_t* mixb, int slab) {
  const int TIDX = opaque_tid();
  const int wid = TIDX >> 6, lane = TIDX & 63;
  const int L = slab < 2 ? 16384 : 2048;
  float4 gv[4], muv[6][4];
#pragma unroll
  for (int i = 0; i < 4; ++i) gv[i] = ((const float4*)g)[lane + 64 * i];
#pragma unroll
  for (int m = 0; m < 6; ++m)
#pragma unroll
    for (int i = 0; i < 4; ++i) muv[m][i] = ((const float4*)(mu + m * 1024))[lane + 64 * i];
  for (int ts = blockIdx.x * 8 + wid; ts < SLAB; ts += gridDim.x * 8) {
    const int t = slab * SLAB + ts, pos = ts & (L - 1);
    float4 hv[3][4];
#pragma unroll
    for (int d = 0; d < 3; ++d) {
      const bool valid = !((d == 0 && pos == 0) || (d == 2 && pos == L - 1));
      const int tt = valid ? t + d - 1 : t;
      const float4* xr = (const float4*)(kx() + (size_t)tt * 1024);
      float ss = 0.f;
#pragma unroll
      for (int i = 0; i < 4; ++i) { float4 v = xr[lane + 64 * i]; hv[d][i] = v; ss += v.x * v.x + v.y * v.y + v.z * v.z + v.w * v.w; }
      ss = wave_sum(ss);
      const float rs = valid ? rsqrtf(ss * (1.0f / 1024.f) + 1e-6f) : 0.f;
#pragma unroll
      for (int i = 0; i < 4; ++i) { hv[d][i].x *= rs * gv[i].x; hv[d][i].y *= rs * gv[i].y; hv[d][i].z *= rs * gv[i].z; hv[d][i].w *= rs * gv[i].w; }
    }
#pragma unroll
    for (int i = 0; i < 4; ++i) {
      hv[0][i].x = 0.5f * (hv[0][i].x + hv[2][i].x) - hv[1][i].x; hv[0][i].y = 0.5f * (hv[0][i].y + hv[2][i].y) - hv[1][i].y;
      hv[0][i].z = 0.5f * (hv[0][i].z + hv[2][i].z) - hv[1][i].z; hv[0][i].w = 0.5f * (hv[0][i].w + hv[2][i].w) - hv[1][i].w;
    }
#pragma unroll
    for (int m = 0; m < 6; ++m) {
      uint2* orow = (uint2*)(mixb + ((size_t)m * SLAB + ts) * 1024);
#pragma unroll
      for (int i = 0; i < 4; ++i) {
        const float4 mv = muv[m][i];
        uint2 o;
        o.x = pack2(hv[1][i].x + hv[0][i].x * mv.x, hv[1][i].y + hv[0][i].y * mv.y);
        o.y = pack2(hv[1][i].z + hv[0][i].z * mv.z, hv[1][i].w + hv[0][i].w * mv.w);
        orow[lane + 64 * i] = o;
      }
    }
  }
}

DEV void phase_final(const Params& p) {
  const int TIDX = opaque_tid();
  const int wid = TIDX >> 6, lane = TIDX & 63;
  const float* g = kin(4);
  float4 gv[4];
#pragma unroll
  for (int i = 0; i < 4; ++i) gv[i] = ((const float4*)g)[lane + 64 * i];
  for (int t = blockIdx.x * 8 + wid; t < NT; t += gridDim.x * 8) {
    float4* xr = (float4*)(kx() + (size_t)t * 1024);
    float4 v[4]; float ss = 0.f;
#pragma unroll
    for (int i = 0; i < 4; ++i) { v[i] = xr[lane + 64 * i]; ss += v[i].x * v[i].x + v[i].y * v[i].y + v[i].z * v[i].z + v[i].w * v[i].w; }
    ss = wave_sum(ss);
    const float rs = rsqrtf(ss * (1.0f / 1024.f) + 1e-6f);
#pragma unroll
    for (int i = 0; i < 4; ++i) {
      float4 o; o.x = v[i].x * rs * gv[i].x; o.y = v[i].y * rs * gv[i].y; o.z = v[i].z * rs * gv[i].z; o.w = v[i].w * rs * gv[i].w;
      xr[lane + 64 * i] = o;
    }
  }
}

DEV void wprep_T(bf16_t* dst, int ldd, int koff, const float* src, int Ks, int Ns, const float* scale, int rs, int roff) {
  const int TIDX = opaque_tid();
  float (*tile)[33] = (float (*)[33])g_shm;
  const int tx = TIDX & 31, ty = TIDX >> 5;
  const int nkt = Ks / 32, nnt = Ns / 32;
  for (int tIdx = blockIdx.x; tIdx < nkt * nnt; tIdx += gridDim.x) {
    const int k0 = (tIdx / nnt) * 32, n0 = (tIdx % nnt) * 32;
    __syncthreads();
#pragma unroll
    for (int i = 0; i < 2; ++i) tile[ty + 16 * i][tx] = src[(size_t)(k0 + ty + 16 * i) * Ns + n0 + tx];
    __syncthreads();
    const float sc = scale ? scale[k0 + tx] : 1.0f;
#pragma unroll
    for (int i = 0; i < 2; ++i) {
      const int n = n0 + ty + 16 * i;
      const int drow = (n >> 7) * rs + (n & 127) + roff;
      dst[(size_t)drow * ldd + koff + k0 + tx] = f2bf(tile[tx][ty + 16 * i] * sc);
    }
  }
  __syncthreads();
}


DEV void wprep_T2(bf16_t* dst, int ldd, int koff, const float* src, int Ks, int Ns, const float* scale, int rs, int roff) {
  const int TIDX = opaque_tid();
  float* tile = (float*)g_shm;
  const int nkt = Ks / 64, nnt = Ns / 128;
  const int lc = TIDX & 127, lr = TIDX >> 7;
  const int wk = TIDX & 63, wn = TIDX >> 6;
  for (int tIdx = blockIdx.x; tIdx < nkt * nnt; tIdx += gridDim.x) {
    const int k0 = (tIdx / nnt) * 64, n0 = (tIdx % nnt) * 128;
    float v[16];
#pragma unroll
    for (int i = 0; i < 16; ++i) v[i] = src[(size_t)(k0 + i * 4 + lr) * Ns + n0 + lc];
    __syncthreads();
#pragma unroll
    for (int i = 0; i < 16; ++i) tile[(i * 4 + lr) * 129 + lc] = v[i];
    __syncthreads();
    const float sc = scale ? scale[k0 + wk] : 1.0f;
#pragma unroll
    for (int i = 0; i < 16; ++i) {
      const int n = n0 + i * 8 + wn;
      const int drow = (n >> 7) * rs + (n & 127) + roff;
      dst[(size_t)drow * ldd + koff + k0 + wk] = f2bf(tile[wk * 129 + i * 8 + wn] * sc);
    }
  }
  __syncthreads();
}

constexpr int BM = 256, BK = 64, HALF = 128, HT = HALF * BK;
DEV int lds_byte(int r, int c) {
  int st = (r >> 4) * 2 + (c >> 5), rr = r & 15, cc = c & 31, ob = rr * 64 + cc * 2;
  return st * 1024 + (ob ^ (((ob >> 9) & 1) << 5));
}
DEV void stage_rc(int b, int& R, int& C) {
  int st = b / 1024, sb = b % 1024, swz = sb ^ (((sb >> 9) & 1) << 5);
  R = (st >> 1) * 16 + swz / 64; C = (st & 1) * 32 + (swz % 64) / 2;
}

typedef __attribute__((address_space(3))) unsigned char lds_u8;
DEV void gemm_big(const bf16_t* A, long lda, const bf16_t* Bt, long ldb, int K, long brow, long bcol, f32x4 (&acc)[2][2][4][2]) {
  const int TIDX = opaque_tid();
  lds_u8* lds = (lds_u8*)g_shm;
  constexpr int HTB = HT * 2;
#define SA(b, h) (((b) * 2 + (h)) * HTB)
#define SB(b, h) ((4 + (b) * 2 + (h)) * HTB)
#define STAGE(bufoff, gbase, VO, kt) do { const char* _gp = (gbase) + (size_t)(kt) * (BK * 2); \
    __builtin_amdgcn_global_load_lds((const unsigned*)(_gp + VO##0), (__attribute__((address_space(3))) unsigned*)(lds + (bufoff) + ldsw), 16, 0, 0); \
    __builtin_amdgcn_global_load_lds((const unsigned*)(_gp + VO##1), (__attribute__((address_space(3))) unsigned*)(lds + (bufoff) + ldsw + 8192), 16, 0, 0); } while (0)
#define LDA(dst, b, h) for (int m = 0; m < 4; ++m) for (int k = 0; k < 2; ++k) \
    dst[m][k] = *(const __attribute__((address_space(3))) bf16x8*)(lds + SA(b, h) + aoff + m * 2048 + k * 1024)
#define LDB(dst, b, h) for (int n = 0; n < 2; ++n) for (int k = 0; k < 2; ++k) \
    dst[n][k] = *(const __attribute__((address_space(3))) bf16x8*)(lds + SB(b, h) + boff + n * 2048 + k * 1024)
#define MMA(ai, bj, At, Bt_) do { __builtin_amdgcn_s_setprio(1); \
    for (int m = 0; m < 4; ++m) for (int n = 0; n < 2; ++n) for (int k = 0; k < 2; ++k) \
      acc[ai][bj][m][n] = __builtin_amdgcn_mfma_f32_16x16x32_bf16(At[m][k], Bt_[n][k], acc[ai][bj][m][n], 0, 0, 0); \
    __builtin_amdgcn_s_setprio(0); } while (0)
#define WAIT_V(n) asm volatile("s_waitcnt vmcnt(" #n ")" ::: "memory")
#define WAIT_L(n) asm volatile("s_waitcnt lgkmcnt(" #n ")" ::: "memory")
#define BAR __builtin_amdgcn_s_barrier()
#define SCHED __builtin_amdgcn_sched_barrier(0)
  const int tid = TIDX, wid = __builtin_amdgcn_readfirstlane(tid >> 6), lane = tid & 63, wr = wid >> 2, wc = wid & 3, fr = lane & 15, fq = lane >> 4;
  unsigned va0, va1, vb0, vb1;
  { int r_, c_; stage_rc(tid * 16, r_, c_); va0 = (unsigned)((r_ * lda + c_) * 2); vb0 = (unsigned)((r_ * ldb + c_) * 2);
    stage_rc(tid * 16 + 8192, r_, c_); va1 = (unsigned)((r_ * lda + c_) * 2); vb1 = (unsigned)((r_ * ldb + c_) * 2); }
  const unsigned ldsw = (unsigned)wid * 1024u;
  const int aoff = lds_byte(wr * 64 + fr, fq * 8), boff = lds_byte(wc * 32 + fr, fq * 8);
  const char* cA0 = (const char*)(A + brow * lda); const char* cA1 = cA0 + (size_t)HALF * lda * 2;
  const char* cB0 = (const char*)(Bt + bcol * ldb); const char* cB1 = cB0 + (size_t)HALF * ldb * 2;
#pragma unroll
  for (int a = 0; a < 2; ++a)
#pragma unroll
    for (int b = 0; b < 2; ++b)
#pragma unroll
      for (int m = 0; m < 4; ++m)
#pragma unroll
        for (int n = 0; n < 2; ++n) acc[a][b][m][n] = (f32x4){0.f, 0.f, 0.f, 0.f};
  bf16x8 At[4][2], B0[2][2], B1[2][2];
  const int nt = K / BK;
  STAGE(SB(0, 0), cB0, vb, 0); STAGE(SA(0, 0), cA0, va, 0);
  STAGE(SB(0, 1), cB1, vb, 0); STAGE(SA(0, 1), cA1, va, 0);
  if (wr == 1) BAR;
  WAIT_V(4); BAR;
  STAGE(SB(1, 0), cB0, vb, 1); STAGE(SA(1, 0), cA0, va, 1); STAGE(SB(1, 1), cB1, vb, 1);
  WAIT_V(6); BAR;
  for (int t = 0; t < nt - 2; t += 2) {
    LDB(B0, 0, 0); SCHED; LDA(At, 0, 0); STAGE(SA(1, 1), cA1, va, t + 1);
    WAIT_L(8); BAR; WAIT_L(0); MMA(0, 0, At, B0); BAR; SCHED;
    LDB(B1, 0, 1); STAGE(SB(0, 0), cB0, vb, t + 2);
    BAR; WAIT_L(0); MMA(0, 1, At, B1); BAR;
    LDA(At, 0, 1); STAGE(SA(0, 0), cA0, va, t + 2);
    BAR; WAIT_L(0); MMA(1, 0, At, B0); BAR; SCHED;
    STAGE(SB(0, 1), cB1, vb, t + 2);
    WAIT_V(6); BAR; MMA(1, 1, At, B1); BAR;
    LDB(B0, 1, 0); SCHED; LDA(At, 1, 0); STAGE(SA(0, 1), cA1, va, t + 2);
    WAIT_L(8); BAR; WAIT_L(0); MMA(0, 0, At, B0); BAR; SCHED;
    LDB(B1, 1, 1); STAGE(SB(1, 0), cB0, vb, t + 3);
    BAR; WAIT_L(0); MMA(0, 1, At, B1); BAR;
    LDA(At, 1, 1); STAGE(SA(1, 0), cA0, va, t + 3);
    BAR; WAIT_L(0); MMA(1, 0, At, B0); BAR; SCHED;
    STAGE(SB(1, 1), cB1, vb, t + 3);
    WAIT_V(6); BAR; MMA(1, 1, At, B1); BAR;
  }
  { LDB(B0, 0, 0); LDA(At, 0, 0); STAGE(SA(1, 1), cA1, va, nt - 1);
    BAR; WAIT_L(0); MMA(0, 0, At, B0); BAR;
    LDB(B1, 0, 1); BAR; WAIT_L(0); MMA(0, 1, At, B1); BAR;
    LDA(At, 0, 1); WAIT_V(4); BAR; WAIT_L(0); MMA(1, 0, At, B0); MMA(1, 1, At, B1); BAR; }
  { LDB(B0, 1, 0); LDA(At, 1, 0); WAIT_V(2); BAR; WAIT_L(0); MMA(0, 0, At, B0); BAR;
    LDB(B1, 1, 1); WAIT_V(0); BAR; WAIT_L(0); MMA(0, 1, At, B1); BAR;
    LDA(At, 1, 1); BAR; WAIT_L(0); MMA(1, 0, At, B0); MMA(1, 1, At, B1); BAR; }
  if (wr == 0) BAR;
}
DEV void dump_half(const f32x4 (&acc)[2][2][4][2], int ai, int tid) {
  float* T = (float*)g_shm;
  const int wid = tid >> 6, lane = tid & 63, wr = wid >> 2, wc = wid & 3, fr = lane & 15, fq = lane >> 4;
#pragma unroll
  for (int bj = 0; bj < 2; ++bj)
#pragma unroll
    for (int m = 0; m < 4; ++m)
#pragma unroll
      for (int n = 0; n < 2; ++n)
#pragma unroll
        for (int jj = 0; jj < 4; ++jj) {
          const int r = wr * 64 + m * 16 + fq * 4 + jj, c = bj * 128 + wc * 32 + n * 16 + fr;
          T[r * 256 + (c ^ (fq << 4))] = (ai == 0) ? acc[0][bj][m][n][jj] : acc[1][bj][m][n][jj];
        }
}
DEV float4 tile_ld4(int r, int c4) { return *(const float4*)((const float*)g_shm + r * 256 + (c4 ^ (((r >> 2) & 3) << 4))); }
DEV float tile_ld(int r, int c) { return ((const float*)g_shm)[r * 256 + (c ^ (((r >> 2) & 3) << 4))]; }

DEV int vblock() { return (blockIdx.x & 7) * (gridDim.x >> 3) + (blockIdx.x >> 3); }

DEV void tile_pmpn(int tile, int nM, int nN, int& pm, int& pn) {
  const int nig = 8 * nN, gid = tile / nig, fm = gid * 8, gsz = (nM - fm) < 8 ? (nM - fm) : 8;
  pm = fm + ((tile % nig) % gsz); pn = (tile % nig) / gsz;
}
DEV void phase_gemm_res(const Params& p, const bf16_t* A, long lda, const bf16_t* Bt, int K, int mtiles, long xrow0) {
  float* X = kx();
  for (int tile = vblock(); tile < mtiles * 4; tile += gridDim.x) {
    int pm, pn; tile_pmpn(tile, mtiles, 4, pm, pn);
    f32x4 acc[2][2][4][2];
    gemm_big(A, lda, Bt, K, K, (long)pm * 256, (long)pn * 256, acc);
    const int tid = opaque_tid();
#pragma unroll
    for (int ai = 0; ai < 2; ++ai) {
      LBAR2();
      dump_half(acc, ai, tid);
      LBAR2();
      for (int e = tid; e < 128 * 64; e += 512) {
        const int r = e >> 6, c4 = (e & 63) * 4;
        const float4 v = tile_ld4(r, c4);
        float4* q = (float4*)(X + (xrow0 + pm * 256 + ai * 128 + r) * 1024 + pn * 256 + c4);
        float4 o = *q; o.x += v.x; o.y += v.y; o.z += v.z; o.w += v.w; *q = o;
      }
    }
    LBAR2();
  }
}

DEV void phase_sgu_in(const Params& p, int j, int slab) {
  const bf16_t* A = (const bf16_t*)(kws() + OFF_H0) + (size_t)slab * SLAB * 1024;
  const bf16_t* Bt = (const bf16_t*)(kws() + OFF_W + W_SG_IN);
  const float* bin = kin(6) + (size_t)j * 4096;
  bf16_t* Z = (bf16_t*)(kws() + OFF_U);
  float* SSQ = (float*)(kws() + OFF_SSQ);
  for (int tile = vblock(); tile < 64 * 16; tile += gridDim.x) {
    int pm, pn; tile_pmpn(tile, 64, 16, pm, pn);
    f32x4 acc[2][2][4][2];
    gemm_big(A, 1024, Bt, 1024, 1024, (long)pm * 256, (long)pn * 256, acc);
    const int tid = opaque_tid(), wid = tid >> 6, lane = tid & 63;
    const float4 b4 = *(const float4*)(bin + pn * 256 + lane * 4);
#pragma unroll
    for (int ai = 0; ai < 2; ++ai) {
      LBAR2();
      dump_half(acc, ai, tid);
      LBAR2();
      for (int rr = 0; rr < 16; ++rr) {
        const int r = wid * 16 + rr;
        const float4 v = tile_ld4(r, lane * 4);
        const f32x2 za = gelu_pk((f32x2){v.x + b4.x, v.y + b4.y}), zb = gelu_pk((f32x2){v.z + b4.z, v.w + b4.w});
        const float z0 = za.x, z1 = za.y, z2 = zb.x, z3 = zb.y;
        const int row = pm * 256 + ai * 128 + r;
        uint2 o; o.x = pack2(z0, z1); o.y = pack2(z2, z3);
        *(uint2*)(Z + (size_t)row * 4096 + pn * 256 + lane * 4) = o;
        if (pn >= 8) {
          const float ss = wave_sum(z0 * z0 + z1 * z1 + z2 * z2 + z3 * z3);
          if (lane == 0) SSQ[(size_t)row * 8 + (pn - 8)] = ss;
        }
      }
    }
    LBAR2();
  }
}

DEV void phase_tm_proj(const Params& p) {
  const bf16_t* MIX = (const bf16_t*)(kws() + OFF_MIX);
  const bf16_t* Bt = (const bf16_t*)(kws() + OFF_W + W_TM_P);
  for (int tile = vblock(); tile < 64 * 15; tile += gridDim.x) {
    int pm, pn; tile_pmpn(tile, 64, 15, pm, pn);
    const int msel = pn < 4 ? 0 : (pn < 8 ? 2 : (pn < 12 ? 3 : (pn == 12 ? 1 : (pn == 13 ? 4 : 5))));
    f32x4 acc[2][2][4][2];
    gemm_big(MIX + (size_t)msel * SLAB * 1024, 1024, Bt, 1024, 1024, (long)pm * 256, (long)pn * 256, acc);
    const int tid = opaque_tid(), wid = tid >> 6, lane = tid & 63;
    bf16_t* O; int ld, cb;
    if (pn < 12) { O = (bf16_t*)(kws() + (pn < 4 ? OFF_R : (pn < 8 ? OFF_K : OFF_V))); ld = 1024; cb = (pn & 3) * 256; }
    else { O = (bf16_t*)(kws() + OFF_HL); ld = 512; cb = pn == 12 ? 0 : (pn == 13 ? 128 : 256); }
    const int act = pn == 12 ? 1 : (pn == 14 ? 2 : 0);
    const bool live = pn < 12 || pn == 14 || lane < 32;
#pragma unroll
    for (int ai = 0; ai < 2; ++ai) {
      LBAR2();
      dump_half(acc, ai, tid);
      LBAR2();
      for (int rr = 0; rr < 16; ++rr) {
        const int r = wid * 16 + rr;
        float4 v = tile_ld4(r, lane * 4);
        if (act == 1) { v.x = tanhf(v.x); v.y = tanhf(v.y); v.z = tanhf(v.z); v.w = tanhf(v.w); }
        else if (act == 2) { v.x = sigmoidf_(v.x); v.y = sigmoidf_(v.y); v.z = sigmoidf_(v.z); v.w = sigmoidf_(v.w); }
        uint2 o; o.x = pack2(v.x, v.y); o.y = pack2(v.z, v.w);
        if (live) *(uint2*)(O + (size_t)(pm * 256 + ai * 128 + r) * ld + cb + lane * 4) = o;
      }
    }
    LBAR2();
  }
}

DEV void phase_ffn_a(const Params& p, int layer) {
  const bf16_t* A = (const bf16_t*)(kws() + OFF_H0);
  const bf16_t* Bt = (const bf16_t*)(kws() + OFF_W + W_FF_A);
  bf16_t* HM = (bf16_t*)(kws() + OFF_HMID);
  const float* cw = kin(31) + (size_t)layer * 3 * 2816;
  const float* cb = kin(32) + (size_t)layer * 2816;
  float* UP = (float*)g_shm;
  bf16_t* gl = (bf16_t*)(g_shm + 65536);
  for (int tile = vblock(); tile < 202 * 22; tile += gridDim.x) {
    int mi, pn; tile_pmpn(tile, 202, 22, mi, pn);
    int base, L, i;
    if (mi < 130) { base = (mi / 65) * 16384; L = 16384; i = mi % 65; }
    else { const int m2 = mi - 130; base = 32768 + (m2 / 9) * 2048; L = 2048; i = m2 % 9; }
    const int s0 = 254 * i - 1;
    f32x4 acc[2][2][4][2];
    gemm_big(A, 1024, Bt, 1024, 1024, (long)base + s0, (long)pn * 256, acc);
    const int tid = opaque_tid(), wid = tid >> 6, lane = tid & 63, wr = wid >> 2, wc = wid & 3, fr = lane & 15, fq = lane >> 4;
    LBAR2();
#pragma unroll
    for (int ai = 0; ai < 2; ++ai)
#pragma unroll
      for (int m = 0; m < 4; ++m)
#pragma unroll
        for (int n = 0; n < 2; ++n)
#pragma unroll
          for (int jj = 0; jj < 4; ++jj) {
            const int r = ai * 128 + wr * 64 + m * 16 + fq * 4 + jj, c = wc * 32 + n * 16 + fr;
            const int s = s0 + r;
            gl[r * 136 + c] = (s >= 0 && s < L) ? f2bf(acc[ai][0][m][n][jj]) : (bf16_t)0;
          }
    const int c4 = (lane & 31) * 4, f = pn * 128 + c4;
    const float4 w0 = *(const float4*)(cw + f), w1 = *(const float4*)(cw + 2816 + f), w2 = *(const float4*)(cw + 2 * 2816 + f), bb = *(const float4*)(cb + f);
#pragma unroll
    for (int ai = 0; ai < 2; ++ai) {
      LBAR2();
#pragma unroll
      for (int m = 0; m < 4; ++m)
#pragma unroll
        for (int n = 0; n < 2; ++n)
#pragma unroll
          for (int jj = 0; jj < 4; ++jj) {
            const int r = wr * 64 + m * 16 + fq * 4 + jj, c = wc * 32 + n * 16 + fr;
            UP[r * 128 + (c ^ (fq << 4))] = (ai == 0) ? acc[0][1][m][n][jj] : acc[1][1][m][n][jj];
          }
      LBAR2();
      for (int e = tid; e < 128 * 32; e += 512) {
        const int rl = e >> 5, r = ai * 128 + rl, s = s0 + r;
        if (r >= 1 && r <= 254 && s < L) {
          const float4 u = *(const float4*)(UP + rl * 128 + (c4 ^ (((rl >> 2) & 3) << 4)));
          const uint2 g0 = *(const uint2*)(gl + (r - 1) * 136 + c4), g1 = *(const uint2*)(gl + r * 136 + c4), g2 = *(const uint2*)(gl + (r + 1) * 136 + c4);
          const float c0 = w0.x * __uint_as_float(g0.x << 16) + w1.x * __uint_as_float(g1.x << 16) + w2.x * __uint_as_float(g2.x << 16) + bb.x;
          const float c1 = w0.y * __uint_as_float(g0.x & 0xffff0000u) + w1.y * __uint_as_float(g1.x & 0xffff0000u) + w2.y * __uint_as_float(g2.x & 0xffff0000u) + bb.y;
          const float c2 = w0.z * __uint_as_float(g0.y << 16) + w1.z * __uint_as_float(g1.y << 16) + w2.z * __uint_as_float(g2.y << 16) + bb.z;
          const float c3 = w0.w * __uint_as_float(g0.y & 0xffff0000u) + w1.w * __uint_as_float(g1.y & 0xffff0000u) + w2.w * __uint_as_float(g2.y & 0xffff0000u) + bb.w;
          const f32x2 ga = gelu_pk((f32x2){c0, c1}), gb = gelu_pk((f32x2){c2, c3});
          uint2 o; o.x = pack2(ga.x * u.x, ga.y * u.y); o.y = pack2(gb.x * u.z, gb.y * u.w);
          *(uint2*)(HM + (size_t)(base + s) * 2816 + f) = o;
        }
      }
    }
    LBAR2();
  }
}

template <int KP>
DEV void small_mma(f32x4 (&acc)[4][4]) {
  const int TIDX = opaque_tid();
  constexpr int LD = KP + 8;
  const bf16_t* sA = (const bf16_t*)g_shm;
  const bf16_t* sB = sA + 128 * LD;
  const int wid = TIDX >> 6, lane = TIDX & 63, wr = wid >> 2, wc = wid & 3, fr = lane & 15, fq = lane >> 4;
#pragma unroll
  for (int m = 0; m < 4; ++m)
#pragma unroll
    for (int n = 0; n < 4; ++n) acc[m][n] = (f32x4){0.f, 0.f, 0.f, 0.f};
#pragma unroll
  for (int kk = 0; kk < KP / 32; ++kk) {
    bf16x8 a[4], b[4];
#pragma unroll
    for (int m = 0; m < 4; ++m) a[m] = *(const bf16x8*)(sA + (wr * 64 + m * 16 + fr) * LD + kk * 32 + fq * 8);
#pragma unroll
    for (int n = 0; n < 4; ++n) b[n] = *(const bf16x8*)(sB + (wc * 64 + n * 16 + fr) * LD + kk * 32 + fq * 8);
#pragma unroll
    for (int m = 0; m < 4; ++m)
#pragma unroll
      for (int n = 0; n < 4; ++n) acc[m][n] = __builtin_amdgcn_mfma_f32_16x16x32_bf16(b[n], a[m], acc[m][n], 0, 0, 0);
  }
}
template <int KP>
DEV void small_load_ab(bf16_t* sA, const bf16_t* gA, long lda, bf16_t* sB, const bf16_t* gB, long ldb, int tid) {
  constexpr int LD = KP + 8, CPR = KP / 8, TA = 128 * CPR, TB = 256 * CPR, IA = TA / 512, IB = TB / 512;
  static_assert(TA % 512 == 0 && TB % 512 == 0, "panel sizes must be multiples of the block");
  uint4 va[IA], vb[IB];
#pragma unroll
  for (int it = 0; it < IA; ++it) { const int c = tid + it * 512; va[it] = *(const uint4*)(gA + (long)(c / CPR) * lda + (c % CPR) * 8); }
#pragma unroll
  for (int it = 0; it < IB; ++it) { const int c = tid + it * 512; vb[it] = *(const uint4*)(gB + (long)(c / CPR) * ldb + (c % CPR) * 8); }
#pragma unroll
  for (int it = 0; it < IA; ++it) { const int c = tid + it * 512; *(uint4*)(sA + (c / CPR) * LD + (c % CPR) * 8) = va[it]; }
#pragma unroll
  for (int it = 0; it < IB; ++it) { const int c = tid + it * 512; *(uint4*)(sB + (c / CPR) * LD + (c % CPR) * 8) = vb[it]; }
}

DEV void phase_sgu_mix(const Params& p, int j) {
  const int TIDX = opaque_tid();
  constexpr int KP = 128, LD = KP + 8;
  const int wid = TIDX >> 6, lane = TIDX & 63, wr = wid >> 2, wc = wid & 3, fr = lane & 15, fq = lane >> 4;
  bf16_t* sA = (bf16_t*)g_shm;
  bf16_t* sB = sA + 128 * LD;
  float* rsv = (float*)(g_shm + (128 + 256) * LD * 2);
  bf16_t* Z = (bf16_t*)(kws() + OFF_U);
  const float* SSQ = (const float*)(kws() + OFF_SSQ);
  const float* ws_ = kin(8) + (size_t)j * 8 * 128 * 128;
  const float* bs = kin(9) + (size_t)j * 8 * 128;
  const float* ng = kin(7) + (size_t)j * 2048;
  for (int unit = blockIdx.x; unit < 128 * 8; unit += gridDim.x) {
    const int chunk = unit >> 3, g = unit & 7;
    __syncthreads();
    uint4 vb[8]; float4 wa[4][2];
#pragma unroll
    for (int it = 0; it < 8; ++it) {
      const int e = TIDX + it * 512, pp = e & 127, c8 = (e >> 7) * 8;
      vb[it] = *(const uint4*)(Z + (size_t)(chunk * 128 + pp) * 4096 + 2048 + g * 256 + c8);
    }
#pragma unroll
    for (int it = 0; it < 4; ++it) {
      const int c = TIDX + it * 512, q = c >> 4, p8 = (c & 15) * 8;
      const float4* wp = (const float4*)(ws_ + ((size_t)g * 128 + q) * 128 + p8);
      wa[it][0] = wp[0]; wa[it][1] = wp[1];
    }
    if (TIDX < 128) {
      const float4* sp = (const float4*)(SSQ + (size_t)(chunk * 128 + TIDX) * 8);
      const float4 s0 = sp[0], s1 = sp[1];
      const float sm = ((s0.x + s0.y) + (s0.z + s0.w)) + ((s1.x + s1.y) + (s1.z + s1.w));
      rsv[TIDX] = rsqrtf(sm * (1.0f / 2048.f) + 1e-6f);
    }
#pragma unroll
    for (int it = 0; it < 8; ++it) {
      const int e = TIDX + it * 512, pp = e & 127, c8 = (e >> 7) * 8;
      const uint4 v = vb[it];
      sB[(c8 + 0) * LD + pp] = (bf16_t)(v.x & 0xffff); sB[(c8 + 1) * LD + pp] = (bf16_t)(v.x >> 16);
      sB[(c8 + 2) * LD + pp] = (bf16_t)(v.y & 0xffff); sB[(c8 + 3) * LD + pp] = (bf16_t)(v.y >> 16);
      sB[(c8 + 4) * LD + pp] = (bf16_t)(v.z & 0xffff); sB[(c8 + 5) * LD + pp] = (bf16_t)(v.z >> 16);
      sB[(c8 + 6) * LD + pp] = (bf16_t)(v.w & 0xffff); sB[(c8 + 7) * LD + pp] = (bf16_t)(v.w >> 16);
    }
    __syncthreads();
#pragma unroll
    for (int it = 0; it < 4; ++it) {
      const int c = TIDX + it * 512, q = c >> 4, p8 = (c & 15) * 8;
      const float4 w0 = wa[it][0], w1 = wa[it][1];
      uint4 o;
      o.x = pack2(w0.x * rsv[p8 + 0], w0.y * rsv[p8 + 1]); o.y = pack2(w0.z * rsv[p8 + 2], w0.w * rsv[p8 + 3]);
      o.z = pack2(w1.x * rsv[p8 + 4], w1.y * rsv[p8 + 5]); o.w = pack2(w1.z * rsv[p8 + 6], w1.w * rsv[p8 + 7]);
      *(uint4*)(sA + q * LD + p8) = o;
    }
    __syncthreads();
    f32x4 acc[4][4];
    small_mma<KP>(acc);
#pragma unroll
    for (int m = 0; m < 4; ++m) {
      const int q = wr * 64 + m * 16 + fr;
      const float bq = bs[g * 128 + q];
#pragma unroll
      for (int n = 0; n < 4; ++n) {
        const int c = g * 256 + wc * 64 + n * 16 + fq * 4;
        const float4 gg = *(const float4*)(ng + c);
        uint2* up = (uint2*)(Z + (size_t)(chunk * 128 + q) * 4096 + c);
        const uint2 u = *up;
        uint2 o;
        o.x = pack2(__uint_as_float(u.x << 16) * (acc[m][n][0] * gg.x + bq), __uint_as_float(u.x & 0xffff0000u) * (acc[m][n][1] * gg.y + bq));
        o.y = pack2(__uint_as_float(u.y << 16) * (acc[m][n][2] * gg.z + bq), __uint_as_float(u.y & 0xffff0000u) * (acc[m][n][3] * gg.w + bq));
        *up = o;
      }
    }
  }
  __syncthreads();
}

template <int KP>
DEV void lora_out_unit(const Params& p, int j, int kind, int mt, int ntile) {
  const int TIDX = opaque_tid();
  constexpr int LD = KP + 8;
  const int wid = TIDX >> 6, lane = TIDX & 63, wr = wid >> 2, wc = wid & 3, fr = lane & 15, fq = lane >> 4;
  bf16_t* sA = (bf16_t*)g_shm;
  bf16_t* sB = sA + 128 * LD;
  const bf16_t* HL = (const bf16_t*)(kws() + OFF_HL);
  const int koff = kind < 4 ? kind * 64 : 256;
  const bf16_t* Bt = (const bf16_t*)(kws() + OFF_W + (kind < 2 ? W_TM_W2 + (size_t)kind * 1024 * 64 * 2 : (kind < 4 ? W_TM_A2 + (size_t)(kind - 2) * 1024 * 64 * 2 : W_TM_G2)));
  bf16_t* O = (bf16_t*)(kws() + (kind == 0 ? OFF_E0 : kind == 1 ? OFF_E1 : kind == 2 ? OFF_A0 : kind == 3 ? OFF_A1 : OFF_G));
  const float* bias = kind < 2 ? kin(15) + ((size_t)j * 2 + kind) * 1024 : (kind < 4 ? kin(18) + ((size_t)j * 2 + kind - 2) * 1024 : nullptr);
  __syncthreads();
  small_load_ab<KP>(sA, HL + (size_t)mt * 128 * 512 + koff, 512, sB, Bt + (size_t)ntile * 256 * KP, KP, TIDX);
  __syncthreads();
  f32x4 acc[4][4];
  small_mma<KP>(acc);
#pragma unroll
  for (int n = 0; n < 4; ++n) {
    const int col = ntile * 256 + wc * 64 + n * 16 + fq * 4;
    const float4 b = bias ? *(const float4*)(bias + col) : make_float4(0.f, 0.f, 0.f, 0.f);
#pragma unroll
    for (int m = 0; m < 4; ++m) {
      const int row = mt * 128 + wr * 64 + m * 16 + fr;
      float v0 = acc[m][n][0] + b.x, v1 = acc[m][n][1] + b.y, v2 = acc[m][n][2] + b.z, v3 = acc[m][n][3] + b.w;
      if (kind < 4) {
        const float sc = kind < 2 ? 0.6065306597126334f : 1.0f;
        v0 = sc * sigmoidf_(v0); v1 = sc * sigmoidf_(v1); v2 = sc * sigmoidf_(v2); v3 = sc * sigmoidf_(v3);
      }
      uint2 o; o.x = pack2(v0, v1); o.y = pack2(v2, v3);
      *(uint2*)(O + (size_t)row * 1024 + col) = o;
    }
  }
}
DEV void phase_tm_lora_out(const Params& p, int j) {
  for (int unit = blockIdx.x; unit < 5 * 512; unit += gridDim.x) {
    const int kind = unit / 512, r = unit % 512, mt = r >> 2, ntile = r & 3;
    if (kind < 4) lora_out_unit<64>(p, j, kind, mt, ntile); else lora_out_unit<160>(p, j, kind, mt, ntile);
  }
  __syncthreads();
}

constexpr int LDP = 72;
constexpr int MATE = 64 * LDP;
DEV bf16_t* lbuf(int i) { return (bf16_t*)g_shm + i * MATE; }
DEV void bmm(const bf16_t* A, const bf16_t* Bt, int mb, int nh, int fr, int fq, f32x4 (&acc)[2]) {
  acc[0] = (f32x4){0.f, 0.f, 0.f, 0.f}; acc[1] = (f32x4){0.f, 0.f, 0.f, 0.f};
#pragma unroll
  for (int kk = 0; kk < 2; ++kk) {
    const bf16x8 a = *(const bf16x8*)(A + (mb * 16 + fr) * LDP + kk * 32 + fq * 8);
#pragma unroll
    for (int n = 0; n < 2; ++n) {
      const bf16x8 b = *(const bf16x8*)(Bt + (nh * 32 + n * 16 + fr) * LDP + kk * 32 + fq * 8);
      acc[n] = __builtin_amdgcn_mfma_f32_16x16x32_bf16(a, b, acc[n], 0, 0, 0);
    }
  }
}
DEV void st_rm(bf16_t* C, const f32x4 (&v)[2], int mb, int nh, int fr, int fq) {
#pragma unroll
  for (int n = 0; n < 2; ++n)
#pragma unroll
    for (int j = 0; j < 4; ++j) C[(mb * 16 + fq * 4 + j) * LDP + nh * 32 + n * 16 + fr] = f2bf(v[n][j]);
}
DEV void st_tr(bf16_t* CT, const f32x4 (&v)[2], int mb, int nh, int fr, int fq) {
#pragma unroll
  for (int n = 0; n < 2; ++n) {
    uint2 o; o.x = pack2(v[n][0], v[n][1]); o.y = pack2(v[n][2], v[n][3]);
    *(uint2*)(CT + (nh * 32 + n * 16 + fr) * LDP + mb * 16 + fq * 4) = o;
  }
}

DEV void phase_wkv_a(const Params& p, int jl, int slab) {
  const int TIDX = opaque_tid();
  const int wid = __builtin_amdgcn_readfirstlane(TIDX >> 6), lane = TIDX & 63, fr = lane & 15, fq = lane >> 4, mb = wid >> 1, nh = wid & 1;
  const bf16_t* Rb = (const bf16_t*)(kws() + OFF_R);
  const bf16_t* Kb = (const bf16_t*)(kws() + OFF_K);
  const bf16_t* Vb = (const bf16_t*)(kws() + OFF_V);
  float* PSI = (float*)(kws() + OFF_PSI);
  float* BON = (float*)(kws() + OFF_BON);
  float* segsum = (float*)(g_shm + 15 * MATE * 2);
  float* gTs = segsum + 512;
  bf16_t *mAtil = lbuf(0), *mBtil = lbuf(1), *mKtil = lbuf(2), *mRtil = lbuf(3), *mBgamT = lbuf(4), *mKgam = lbuf(5), *mAtilT = lbuf(6), *mVT = lbuf(7),
         *mMak = lbuf(10), *mMrk = lbuf(11), *mMrbT = lbuf(12);
  uint4 nr, nk, nv, na, ne;
  const int lr = TIDX >> 3, lc8 = (TIDX & 7) * 8;
  auto load_raw = [&](int u) {
    const int e2 = u & 1, h2 = (u >> 1) & 15, c2 = u >> 5;
    const bf16_t* A2 = (const bf16_t*)(kws() + (e2 ? OFF_A1 : OFF_A0));
    const bf16_t* E2 = (const bf16_t*)(kws() + (e2 ? OFF_E1 : OFF_E0));
    const size_t o = (size_t)c2 * 64 * 1024 + h2 * 64 + (size_t)lr * 1024 + lc8;
    nr = *(const uint4*)(Rb + o); nk = *(const uint4*)(Kb + o); nv = *(const uint4*)(Vb + o); na = *(const uint4*)(A2 + o); ne = *(const uint4*)(E2 + o);
  };
  if ((int)blockIdx.x < 256 * 32) load_raw(blockIdx.x);
  for (int unit = blockIdx.x; unit < 256 * 32; unit += gridDim.x) {
    const int e = unit & 1, h = (unit >> 1) & 15, c = unit >> 5;
    bf16_t* Ab = (bf16_t*)(kws() + (e ? OFF_A1 : OFF_A0));
    bf16_t* Eb = (bf16_t*)(kws() + (e ? OFF_E1 : OFF_E0));
    bf16_t* YL = (bf16_t*)(kws() + (e ? OFF_YLB : OFF_YLF));
    const size_t tile0 = (size_t)c * 64 * 1024 + h * 64;
    {
      const int jcol = lane, sg = wid;
      const float kkw = kin(23)[(size_t)jl * 1024 + h * 64 + jcol], kaw = kin(24)[(size_t)jl * 1024 + h * 64 + jcol], rkw = kin(25)[(size_t)jl * 1024 + h * 64 + jcol];
      *(uint4*)(lbuf(8) + lr * LDP + lc8) = nr; *(uint4*)(lbuf(9) + lr * LDP + lc8) = nk; *(uint4*)(lbuf(10) + lr * LDP + lc8) = nv;
      *(uint4*)(lbuf(11) + lr * LDP + lc8) = na; *(uint4*)(lbuf(12) + lr * LDP + lc8) = ne;
      LBAR2();
      if (unit + (int)gridDim.x < 256 * 32) load_raw(unit + gridDim.x);
      float rv[8], kv[8], vv[8], av[8], lw[8];
#pragma unroll
      for (int q = 0; q < 8; ++q) {
        const int tau = sg * 8 + q, tok = e ? 63 - tau : tau;
        rv[q] = bf2f(lbuf(8)[tok * LDP + jcol]); kv[q] = bf2f(lbuf(9)[tok * LDP + jcol]); vv[q] = bf2f(lbuf(10)[tok * LDP + jcol]);
        av[q] = bf2f(lbuf(11)[tok * LDP + jcol]); lw[q] = -bf2f(lbuf(12)[tok * LDP + jcol]);
      }
      float pre[8]; float run = 0.f;
#pragma unroll
      for (int q = 0; q < 8; ++q) { run += lw[q]; pre[q] = run; }
      segsum[sg * 64 + jcol] = run;
      LBAR2();
      float off = 0.f, tot = 0.f;
#pragma unroll
      for (int s2 = 0; s2 < 8; ++s2) { const float sv = segsum[s2 * 64 + jcol]; tot += sv; if (s2 < sg) off += sv; }
      if (sg == 0) gTs[jcol] = __expf(tot);
      float at[8], bg[8], vt[8];
#pragma unroll
      for (int q = 0; q < 8; ++q) {
        const int tau = sg * 8 + q, tok = e ? 63 - tau : tau;
        const float g = off + pre[q], gp = g - lw[q];
        const float kr = kv[q] * kkw;
        const float ss = wave_sum(kr * kr);
        const float kk = kr * __builtin_amdgcn_rsqf(fmaxf(ss, 1e-24f));
        const float b = kk * av[q], kd = kv[q] * (1.0f + (av[q] - 1.0f) * kaw);
        const float eg = __expf(g), eng = __expf(-g), egp = __expf(gp), egt = __expf(tot - g);
        const float atil = -kk * egp;
        mAtil[tau * LDP + jcol] = f2bf(atil);
        mBtil[tau * LDP + jcol] = f2bf(b * eng);
        mKtil[tau * LDP + jcol] = f2bf(kd * eng);
        mRtil[tau * LDP + jcol] = f2bf(rv[q] * eg);
        mKgam[tau * LDP + jcol] = f2bf(kd * egt);
        at[q] = atil; bg[q] = b * egt; vt[q] = vv[q];
        const float bon = wave_sum(rv[q] * kd * rkw);
        if (lane == 0) BON[((size_t)e * SLAB + c * 64 + tok) * 16 + h] = bon;
      }
      uint4 o;
      o.x = pack2(at[0], at[1]); o.y = pack2(at[2], at[3]); o.z = pack2(at[4], at[5]); o.w = pack2(at[6], at[7]);
      *(uint4*)(mAtilT + jcol * LDP + sg * 8) = o;
      o.x = pack2(bg[0], bg[1]); o.y = pack2(bg[2], bg[3]); o.z = pack2(bg[4], bg[5]); o.w = pack2(bg[6], bg[7]);
      *(uint4*)(mBgamT + jcol * LDP + sg * 8) = o;
      o.x = pack2(vt[0], vt[1]); o.y = pack2(vt[2], vt[3]); o.z = pack2(vt[4], vt[5]); o.w = pack2(vt[6], vt[7]);
      *(uint4*)(mVT + jcol * LDP + sg * 8) = o;
    }
    LBAR2();
    f32x4 acc[2], acc2[2];
    bmm(mBtil, mAtil, mb, nh, fr, fq, acc);
#pragma unroll
    for (int n = 0; n < 2; ++n)
#pragma unroll
      for (int j = 0; j < 4; ++j) { const int s = mb * 16 + fq * 4 + j, t = nh * 32 + n * 16 + fr; acc[n][j] = s < t ? acc[n][j] : 0.f; }
    st_rm(lbuf(8), acc, mb, nh, fr, fq); st_tr(lbuf(9), acc, mb, nh, fr, fq);
#pragma unroll
    for (int n = 0; n < 2; ++n)
#pragma unroll
      for (int j = 0; j < 4; ++j) { const int s = mb * 16 + fq * 4 + j, t = nh * 32 + n * 16 + fr; acc[n][j] += (s == t) ? 1.f : 0.f; }
    st_rm(lbuf(13), acc, mb, nh, fr, fq);
    bmm(mKtil, mAtil, mb, nh, fr, fq, acc);
#pragma unroll
    for (int n = 0; n < 2; ++n)
#pragma unroll
      for (int j = 0; j < 4; ++j) { const int s = mb * 16 + fq * 4 + j, t = nh * 32 + n * 16 + fr; acc[n][j] = s < t ? acc[n][j] : 0.f; }
    st_rm(mMak, acc, mb, nh, fr, fq);
    bmm(mKtil, mRtil, mb, nh, fr, fq, acc);
#pragma unroll
    for (int n = 0; n < 2; ++n)
#pragma unroll
      for (int j = 0; j < 4; ++j) { const int s = mb * 16 + fq * 4 + j, t = nh * 32 + n * 16 + fr; acc[n][j] = s <= t ? acc[n][j] : 0.f; }
    st_rm(mMrk, acc, mb, nh, fr, fq);
    bmm(mBtil, mRtil, mb, nh, fr, fq, acc);
#pragma unroll
    for (int n = 0; n < 2; ++n)
#pragma unroll
      for (int j = 0; j < 4; ++j) { const int s = mb * 16 + fq * 4 + j, t = nh * 32 + n * 16 + fr; acc[n][j] = s <= t ? acc[n][j] : 0.f; }
    st_tr(mMrbT, acc, mb, nh, fr, fq);
    LBAR2();
    bmm(lbuf(8), lbuf(9), mb, nh, fr, fq, acc);
    st_rm(lbuf(1), acc, mb, nh, fr, fq); st_tr(lbuf(2), acc, mb, nh, fr, fq);
    LBAR2();
#pragma unroll
    for (int k = 0; k < 4; ++k) {
      const int pc = (k & 1) ? 8 : 1, pn = (k & 1) ? 1 : 8, wc_ = (k & 1) ? 14 : 13, wn = (k & 1) ? 13 : 14;
      bmm(lbuf(wc_), lbuf(pc + 1), mb, nh, fr, fq, acc);
      bmm(lbuf(pc), lbuf(pc + 1), mb, nh, fr, fq, acc2);
#pragma unroll
      for (int n = 0; n < 2; ++n)
#pragma unroll
        for (int j = 0; j < 4; ++j) acc[n][j] += bf2f(lbuf(wc_)[(mb * 16 + fq * 4 + j) * LDP + nh * 32 + n * 16 + fr]);
      st_rm(lbuf(wn), acc, mb, nh, fr, fq);
      st_rm(lbuf(pn), acc2, mb, nh, fr, fq); st_tr(lbuf(pn + 1), acc2, mb, nh, fr, fq);
      LBAR2();
    }
    bmm(lbuf(13), lbuf(2), mb, nh, fr, fq, acc);
#pragma unroll
    for (int n = 0; n < 2; ++n)
#pragma unroll
      for (int j = 0; j < 4; ++j) acc[n][j] += bf2f(lbuf(13)[(mb * 16 + fq * 4 + j) * LDP + nh * 32 + n * 16 + fr]);
    st_rm(lbuf(14), acc, mb, nh, fr, fq);
    LBAR2();
    bmm(mMrbT, lbuf(14), mb, nh, fr, fq, acc);  st_rm(lbuf(8), acc, mb, nh, fr, fq);
    bmm(mBgamT, lbuf(14), mb, nh, fr, fq, acc); st_rm(lbuf(9), acc, mb, nh, fr, fq);
    LBAR2();
    bmm(lbuf(8), mMak, mb, nh, fr, fq, acc);
#pragma unroll
    for (int n = 0; n < 2; ++n)
#pragma unroll
      for (int j = 0; j < 4; ++j) { const int t = mb * 16 + fq * 4 + j, s = nh * 32 + n * 16 + fr; acc[n][j] += bf2f(mMrk[s * LDP + t]); }
    st_rm(lbuf(1), acc, mb, nh, fr, fq);
    bmm(lbuf(9), mMak, mb, nh, fr, fq, acc);
#pragma unroll
    for (int n = 0; n < 2; ++n)
#pragma unroll
      for (int j = 0; j < 4; ++j) { const int jj = mb * 16 + fq * 4 + j, s = nh * 32 + n * 16 + fr; acc[n][j] += bf2f(mKgam[s * LDP + jj]); }
    st_rm(lbuf(2), acc, mb, nh, fr, fq);
    bmm(mAtilT, lbuf(8), mb, nh, fr, fq, acc);
#pragma unroll
    for (int n = 0; n < 2; ++n) {
      const int j0 = mb * 16 + fq * 4, t = nh * 32 + n * 16 + fr;
      const uint2 rt = *(const uint2*)(mRtil + t * LDP + j0);
      uint2 o;
      o.x = pack2(acc[n][0] + __uint_as_float(rt.x << 16), acc[n][1] + __uint_as_float(rt.x & 0xffff0000u));
      o.y = pack2(acc[n][2] + __uint_as_float(rt.y << 16), acc[n][3] + __uint_as_float(rt.y & 0xffff0000u));
      *(uint2*)(Eb + tile0 + (size_t)t * 1024 + j0) = o;
    }
    bmm(mAtilT, lbuf(9), mb, nh, fr, fq, acc);
#pragma unroll
    for (int n = 0; n < 2; ++n) {
      const int j0 = mb * 16 + fq * 4, jp = nh * 32 + n * 16 + fr;
      uint2 o;
      o.x = pack2(acc[n][0] + (jp == j0 ? gTs[j0] : 0.f), acc[n][1] + (jp == j0 + 1 ? gTs[j0 + 1] : 0.f));
      o.y = pack2(acc[n][2] + (jp == j0 + 2 ? gTs[j0 + 2] : 0.f), acc[n][3] + (jp == j0 + 3 ? gTs[j0 + 3] : 0.f));
      *(uint2*)(Ab + tile0 + (size_t)jp * 1024 + j0) = o;
    }
    LBAR2();
    bmm(mVT, lbuf(1), mb, nh, fr, fq, acc);
#pragma unroll
    for (int n = 0; n < 2; ++n) {
      const int i0 = mb * 16 + fq * 4, t = nh * 32 + n * 16 + fr;
      uint2 o; o.x = pack2(acc[n][0], acc[n][1]); o.y = pack2(acc[n][2], acc[n][3]);
      *(uint2*)(YL + tile0 + (size_t)t * 1024 + i0) = o;
    }
    bmm(mVT, lbuf(2), mb, nh, fr, fq, acc);
    *(f32x4*)(PSI + (size_t)unit * 4096 + (size_t)(wid * 64 + lane) * 8) = acc[0];
    *(f32x4*)(PSI + (size_t)unit * 4096 + (size_t)(wid * 64 + lane) * 8 + 4) = acc[1];
  }
}

DEV void phase_wkv_b(const Params& p, int slab, int mode) {
  const int TIDX = opaque_tid();
  const int wid = __builtin_amdgcn_readfirstlane(TIDX >> 6), lane = TIDX & 63, fr = lane & 15, fq = lane >> 4, mb = wid >> 1, nh = wid & 1;
  const float* PSI = (const float*)(kws() + OFF_PSI);
  bf16_t* PHG = (bf16_t*)(kws() + OFF_PHG);
  float* PSG = (float*)(kws() + OFF_PSG);
  float* SST = (float*)(kws() + OFF_SST);
  const bool two_level = slab < 2;
  if (!two_level && mode != 3) return;
  const int nseq = two_level ? 1 : 8, cps = 256 / nseq;
  const int ngrp = two_level ? 8 : 1;
  bf16_t *Sb = lbuf(0), *PhT = lbuf(1), *OmT = lbuf(2), *Sa = lbuf(3);
  const int lr = TIDX >> 3, lc8 = (TIDX & 7) * 8;
  const size_t nat = (size_t)(wid * 64 + lane) * 8;
  if (mode == 2) {
    for (int chain = blockIdx.x; chain < 32; chain += gridDim.x) {
      f32x4 S[2];
      S[0] = (f32x4){0.f, 0.f, 0.f, 0.f}; S[1] = (f32x4){0.f, 0.f, 0.f, 0.f};
      for (int g = 0; g < 8; ++g) {
        const size_t item = (size_t)chain * 8 + g;
        *(f32x4*)(SST + item * 4096 + nat) = S[0]; *(f32x4*)(SST + item * 4096 + nat + 4) = S[1];
        const uint4 ph = *(const uint4*)(PHG + item * 4096 + lr * 64 + lc8);
        const f32x4 q0 = *(const f32x4*)(PSG + item * 4096 + nat), q1 = *(const f32x4*)(PSG + item * 4096 + nat + 4);
        st_rm(Sb, S, mb, nh, fr, fq);
        *(uint4*)(PhT + lr * LDP + lc8) = ph;
        LBAR2();
        f32x4 acc[2];
        bmm(Sb, PhT, mb, nh, fr, fq, acc);
        S[0] = acc[0] + q0; S[1] = acc[1] + q1;
        LBAR2();
      }
    }
    return;
  }
  for (int item = blockIdx.x; item < nseq * 32 * ngrp; item += gridDim.x) {
    const int chain = item / ngrp, grp = item % ngrp;
    const int e = chain & 1, h = (chain >> 1) & 15, sq = chain >> 5;
    const bf16_t* Ab = (const bf16_t*)(kws() + (e ? OFF_A1 : OFF_A0));
    const bf16_t* Eb = (const bf16_t*)(kws() + (e ? OFF_E1 : OFF_E0));
    bf16_t* YL = (bf16_t*)(kws() + (e ? OFF_YLB : OFF_YLF));
    const int sbase = grp * 32;
    f32x4 S[2], SA[2];
    if (mode == 3 && two_level) { S[0] = *(const f32x4*)(SST + (size_t)item * 4096 + nat); S[1] = *(const f32x4*)(SST + (size_t)item * 4096 + nat + 4); }
    else { S[0] = (f32x4){0.f, 0.f, 0.f, 0.f}; S[1] = (f32x4){0.f, 0.f, 0.f, 0.f}; }
#pragma unroll
    for (int n = 0; n < 2; ++n)
#pragma unroll
      for (int j = 0; j < 4; ++j) SA[n][j] = (mb * 16 + fq * 4 + j == nh * 32 + n * 16 + fr) ? 1.f : 0.f;
    uint4 ph0, ph1, ph2, ph3, om0, om1, om2, om3;
    f32x4 ps0[2], ps1[2], ps2[2], ps3[2];
    uint2 yl0[2], yl1[2], yl2[2], yl3[2];
#define WB_PREFETCH(step_, ph, om, ps, y8) do { \
      const int st_ = sbase + ((step_) < 32 ? (step_) : 31); \
      const int c_ = sq * cps + (e ? cps - 1 - st_ : st_); \
      const size_t t0_ = (size_t)c_ * 64 * 1024 + h * 64; \
      ph = *(const uint4*)(Ab + t0_ + (size_t)lr * 1024 + lc8); \
      const size_t u_ = ((size_t)c_ * 16 + h) * 2 + e; \
      ps[0] = *(const f32x4*)(PSI + u_ * 4096 + nat); ps[1] = *(const f32x4*)(PSI + u_ * 4096 + nat + 4); \
      if (mode == 3) { \
        om = *(const uint4*)(Eb + t0_ + (size_t)lr * 1024 + lc8); \
        y8[0] = *(const uint2*)(YL + t0_ + (size_t)(nh * 32 + fr) * 1024 + mb * 16 + fq * 4); \
        y8[1] = *(const uint2*)(YL + t0_ + (size_t)(nh * 32 + 16 + fr) * 1024 + mb * 16 + fq * 4); } } while (0)
#define WB_STEP(step_, ph, om, ps, y8) do { \
      const int c = sq * cps + (e ? cps - 1 - (sbase + (step_)) : (sbase + (step_))); \
      const size_t tile0 = (size_t)c * 64 * 1024 + h * 64; \
      bf16_t *Sb_ = lbuf(((step_) & 1) * 4), *PhT_ = lbuf(((step_) & 1) * 4 + 1), *OmT_ = lbuf(((step_) & 1) * 4 + 2), *Sa_ = lbuf(((step_) & 1) * 4 + 3); \
      st_rm(Sb_, S, mb, nh, fr, fq); \
      *(uint4*)(PhT_ + lr * LDP + lc8) = ph; \
      if (mode == 3) *(uint4*)(OmT_ + lr * LDP + lc8) = om; else st_rm(Sa_, SA, mb, nh, fr, fq); \
      const f32x4 psc0 = ps[0], psc1 = ps[1]; const uint2 ylc0 = y8[0], ylc1 = y8[1]; \
      LBAR2(); \
      WB_PREFETCH((step_) + 4, ph, om, ps, y8); \
      f32x4 acc[2]; \
      if (mode == 3) { \
        bmm(Sb_, OmT_, mb, nh, fr, fq, acc); \
        uint2 o; \
        o.x = pack2(acc[0][0] + __uint_as_float(ylc0.x << 16), acc[0][1] + __uint_as_float(ylc0.x & 0xffff0000u)); \
        o.y = pack2(acc[0][2] + __uint_as_float(ylc0.y << 16), acc[0][3] + __uint_as_float(ylc0.y & 0xffff0000u)); \
        *(uint2*)(YL + tile0 + (size_t)(nh * 32 + fr) * 1024 + mb * 16 + fq * 4) = o; \
        o.x = pack2(acc[1][0] + __uint_as_float(ylc1.x << 16), acc[1][1] + __uint_as_float(ylc1.x & 0xffff0000u)); \
        o.y = pack2(acc[1][2] + __uint_as_float(ylc1.y << 16), acc[1][3] + __uint_as_float(ylc1.y & 0xffff0000u)); \
        *(uint2*)(YL + tile0 + (size_t)(nh * 32 + 16 + fr) * 1024 + mb * 16 + fq * 4) = o; \
      } else { \
        bmm(Sa_, PhT_, mb, nh, fr, fq, acc); SA[0] = acc[0]; SA[1] = acc[1]; \
      } \
      bmm(Sb_, PhT_, mb, nh, fr, fq, acc); \
      S[0] = acc[0] + psc0; S[1] = acc[1] + psc1; } while (0)
    yl0[0] = yl0[1] = yl1[0] = yl1[1] = yl2[0] = yl2[1] = yl3[0] = yl3[1] = make_uint2(0u, 0u);
    om0 = om1 = om2 = om3 = make_uint4(0u, 0u, 0u, 0u);
    WB_PREFETCH(0, ph0, om0, ps0, yl0); WB_PREFETCH(1, ph1, om1, ps1, yl1); WB_PREFETCH(2, ph2, om2, ps2, yl2); WB_PREFETCH(3, ph3, om3, ps3, yl3);
    for (int step0 = 0; step0 < 32; step0 += 4) {
      WB_STEP(step0 + 0, ph0, om0, ps0, yl0);
      WB_STEP(step0 + 1, ph1, om1, ps1, yl1);
      WB_STEP(step0 + 2, ph2, om2, ps2, yl2);
      WB_STEP(step0 + 3, ph3, om3, ps3, yl3);
    }
    LBAR2();
    if (mode == 1) {
#pragma unroll
      for (int n = 0; n < 2; ++n) {
        uint2 o; o.x = pack2(SA[n][0], SA[n][1]); o.y = pack2(SA[n][2], SA[n][3]);
        *(uint2*)(PHG + (size_t)item * 4096 + (nh * 32 + n * 16 + fr) * 64 + mb * 16 + fq * 4) = o;
      }
      *(f32x4*)(PSG + (size_t)item * 4096 + nat) = S[0]; *(f32x4*)(PSG + (size_t)item * 4096 + nat + 4) = S[1];
    }
  }
}

DEV void phase_tm_post(const Params& p, int jl) {
  const int TIDX = opaque_tid();
  const int wid = TIDX >> 6, lane = TIDX & 63, hs = lane >> 4, c4 = (lane & 15) * 4;
  bf16_t* Rb = (bf16_t*)(kws() + OFF_R);
  const bf16_t* Vb = (const bf16_t*)(kws() + OFF_V);
  const bf16_t* Gb = (const bf16_t*)(kws() + OFF_G);
  const bf16_t* YF = (const bf16_t*)(kws() + OFF_YLF);
  const bf16_t* YB = (const bf16_t*)(kws() + OFF_YLB);
  const float* BON = (const float*)(kws() + OFF_BON);
  for (int item = blockIdx.x * 8 + wid; item < 2048; item += gridDim.x * 8) {
    const int hd = (item & 3) * 4 + hs, tb = (item >> 2) * 32;
    const int cch = hd * 64 + c4;
    const float4 lg = *(const float4*)(kin(26) + (size_t)jl * 1024 + cch), lb = *(const float4*)(kin(27) + (size_t)jl * 1024 + cch);
    struct PostRaw { uint2 yf, yb, v, g; float b0, b1; };
    auto load_raw = [&](int tt, PostRaw& w) {
      const int t = tb + (tt < 32 ? tt : 31);
      const size_t o = (size_t)t * 1024 + cch;
      const size_t ob = (size_t)((t & ~63) + 63 - (t & 63)) * 1024 + cch;
      w.yf = *(const uint2*)(YF + o); w.yb = *(const uint2*)(YB + ob); w.v = *(const uint2*)(Vb + o); w.g = *(const uint2*)(Gb + o);
      w.b0 = BON[(size_t)t * 16 + hd]; w.b1 = BON[((size_t)SLAB + t) * 16 + hd];
    };
    PostRaw w0, w1;
    load_raw(0, w0); load_raw(1, w1);
    for (int tt = 0; tt < 32; ++tt) {
      PostRaw w2; load_raw(tt + 2, w2);
      float y[4];
      y[0] = __uint_as_float(w0.yf.x << 16) + __uint_as_float(w0.yb.x << 16); y[1] = __uint_as_float(w0.yf.x & 0xffff0000u) + __uint_as_float(w0.yb.x & 0xffff0000u);
      y[2] = __uint_as_float(w0.yf.y << 16) + __uint_as_float(w0.yb.y << 16); y[3] = __uint_as_float(w0.yf.y & 0xffff0000u) + __uint_as_float(w0.yb.y & 0xffff0000u);
      const float mean = row_sum16((y[0] + y[1]) + (y[2] + y[3])) * (1.0f / 64.f);
      const float d0 = y[0] - mean, d1 = y[1] - mean, d2 = y[2] - mean, d3 = y[3] - mean;
      const float var = row_sum16((d0 * d0 + d1 * d1) + (d2 * d2 + d3 * d3)) * (1.0f / 64.f);
      const float rs = rsqrtf(var + 64e-5f), bon = w0.b0 + w0.b1;
      const float o0 = (d0 * rs * lg.x + lb.x + bon * __uint_as_float(w0.v.x << 16)) * __uint_as_float(w0.g.x << 16);
      const float o1 = (d1 * rs * lg.y + lb.y + bon * __uint_as_float(w0.v.x & 0xffff0000u)) * __uint_as_float(w0.g.x & 0xffff0000u);
      const float o2 = (d2 * rs * lg.z + lb.z + bon * __uint_as_float(w0.v.y << 16)) * __uint_as_float(w0.g.y << 16);
      const float o3 = (d3 * rs * lg.w + lb.w + bon * __uint_as_float(w0.v.y & 0xffff0000u)) * __uint_as_float(w0.g.y & 0xffff0000u);
      uint2 o; o.x = pack2(o0, o1); o.y = pack2(o2, o3);
      *(uint2*)(Rb + (size_t)(tb + tt) * 1024 + cch) = o;
      w0 = w1; w1 = w2;
    }
  }
}

DEV void wprep_sgu(const Params& p, int j) {
  wprep_T2((bf16_t*)(kws() + OFF_W + W_SG_IN), 1024, 0, kin(5) + (size_t)j * 1024 * 4096, 1024, 4096, nullptr, 128, 0);
  wprep_T2((bf16_t*)(kws() + OFF_W + W_SG_OUT), 2048, 0, kin(10) + (size_t)j * 2048 * 1024, 2048, 1024, nullptr, 128, 0);
}
DEV void wprep_ffn(const Params& p, int layer) {
  wprep_T2((bf16_t*)(kws() + OFF_W + W_FF_A), 1024, 0, kin(29) + (size_t)layer * 1024 * 2816, 1024, 2816, nullptr, 256, 0);
  wprep_T2((bf16_t*)(kws() + OFF_W + W_FF_A), 1024, 0, kin(30) + (size_t)layer * 1024 * 2816, 1024, 2816, nullptr, 256, 128);
  wprep_T2((bf16_t*)(kws() + OFF_W + W_FF_D), 2816, 0, kin(33) + (size_t)layer * 2816 * 1024, 2816, 1024, nullptr, 128, 0);
}
DEV void wprep_tm(const Params& p, int j) {
  const int TIDX = opaque_tid();
  bf16_t* WP = (bf16_t*)(kws() + OFF_W + W_TM_P);
  const float* srcs[3] = {kin(12) + (size_t)j * 1048576, kin(13) + (size_t)j * 1048576, kin(14) + (size_t)j * 1048576};
#pragma unroll
  for (int i = 0; i < 3; ++i) wprep_T2(WP, 1024, 0, srcs[i], 1024, 1024, nullptr, 128, i * 1024);
#pragma unroll
  for (int e = 0; e < 2; ++e) {
    wprep_T(WP, 1024, 0, kin(16) + ((size_t)j * 2 + e) * 1024 * 64, 1024, 64, nullptr, 128, 3072 + 64 * e);
    wprep_T(WP, 1024, 0, kin(19) + ((size_t)j * 2 + e) * 1024 * 64, 1024, 64, nullptr, 128, 3328 + 64 * e);
    wprep_T2((bf16_t*)(kws() + OFF_W + W_TM_W2) + (size_t)e * 1024 * 64, 64, 0, kin(17) + ((size_t)j * 2 + e) * 64 * 1024, 64, 1024, nullptr, 128, 0);
    wprep_T2((bf16_t*)(kws() + OFF_W + W_TM_A2) + (size_t)e * 1024 * 64, 64, 0, kin(20) + ((size_t)j * 2 + e) * 64 * 1024, 64, 1024, nullptr, 128, 0);
  }
  wprep_T(WP, 1024, 0, kin(21) + (size_t)j * 1024 * 160, 1024, 160, nullptr, 128, 3584);
  for (size_t i = (size_t)blockIdx.x * 512 + TIDX; i < (size_t)(128 + 128 + 96) * 512; i += (size_t)gridDim.x * 512) {
    const size_t row = i / 512, w = i % 512;
    const size_t drow = row < 128 ? 3200 + row : (row < 256 ? 3456 + (row - 128) : 3744 + (row - 256));
    ((unsigned*)(WP + drow * 1024))[w] = 0u;
  }
  wprep_T((bf16_t*)(kws() + OFF_W + W_TM_G2), 160, 0, kin(22) + (size_t)j * 160 * 1024, 160, 1024, nullptr, 128, 0);
  wprep_T2((bf16_t*)(kws() + OFF_W + W_TM_O), 1024, 0, kin(28) + (size_t)j * 1048576, 1024, 1024, nullptr, 128, 0);
}

constexpr int PH_SGU = 10, PH_FFN = 3, PH_TM = 25;
constexpr int N_PHASES = 2 * (PH_SGU + PH_FFN) + 2 * (PH_TM + PH_FFN) + 1;

DEV void run_phase(const Params& p, int ph) {
  if (ph == N_PHASES - 1) { phase_final(p); return; }
  int q = ph, layer = 0;
  for (;;) {
    const int len = (layer & 1) ? PH_TM + PH_FFN : PH_SGU + PH_FFN;
    if (q < len) break;
    q -= len; ++layer;
  }
  const int j = layer >> 1;
  bf16_t* H0 = (bf16_t*)(kws() + OFF_H0);
  const int nmix = (layer & 1) ? PH_TM : PH_SGU;
  if (q >= nmix) {
    const int f = q - nmix;
    if (f == 0) { phase_norm<false>(p, kin(3) + (size_t)layer * 1024, H0); wprep_ffn(p, layer); }
    else if (f == 1) phase_ffn_a(p, layer);
    else phase_gemm_res(p, (const bf16_t*)(kws() + OFF_HMID), 2816, (const bf16_t*)(kws() + OFF_W + W_FF_D), 2816, 192, 0);
    return;
  }
  if (!(layer & 1)) {
    if (q == 0) { if (layer == 0) phase_norm<true>(p, kin(2), H0); else phase_norm<false>(p, kin(2) + (size_t)layer * 1024, H0); wprep_sgu(p, j); return; }
    const int slab = (q - 1) / 3, s = (q - 1) % 3;
    if (s == 0) phase_sgu_in(p, j, slab);
    else if (s == 1) phase_sgu_mix(p, j);
    else phase_gemm_res(p, (const bf16_t*)(kws() + OFF_U), 4096, (const bf16_t*)(kws() + OFF_W + W_SG_OUT), 2048, 64, (long)slab * SLAB);
    return;
  }
  {
    const int slab = q < 18 ? q / 9 : 2;
    int s = q < 18 ? q % 9 : q - 18;
    if (slab == 2 && s >= 4) s += 2;
    switch (s) {
      case 0: phase_norm_tm(p, kin(2) + (size_t)layer * 1024, kin(11) + (size_t)j * 6 * 1024, (bf16_t*)(kws() + OFF_MIX), slab); if (slab == 0) wprep_tm(p, j); break;
      case 1: phase_tm_proj(p); break;
      case 2: phase_tm_lora_out(p, j); break;
      case 3: phase_wkv_a(p, j, slab); break;
      case 4: phase_wkv_b(p, slab, 1); break;
      case 5: phase_wkv_b(p, slab, 2); break;
      case 6: phase_wkv_b(p, slab, 3); break;
      case 7: phase_tm_post(p, j); break;
      default: phase_gemm_res(p, (const bf16_t*)(kws() + OFF_R), 1024, (const bf16_t*)(kws() + OFF_W + W_TM_O), 1024, 64, (long)slab * SLAB); break;
    }
  }
}

#ifndef PROBE_CAT
#define PROBE_CAT -1
#endif
DEV int phase_cat(int ph) {
  if (ph == N_PHASES - 1) return 2;
  int q = ph, layer = 0;
  for (;;) { const int len = (layer & 1) ? PH_TM + PH_FFN : PH_SGU + PH_FFN; if (q < len) break; q -= len; ++layer; }
  const int nmix = (layer & 1) ? PH_TM : PH_SGU;
  if (q >= nmix) return (q - nmix) == 0 ? 2 : ((q - nmix) == 1 ? 7 : 8);
  if (!(layer & 1)) { if (q == 0) return 2; const int s = (q - 1) % 3; return s == 1 ? 3 : 0; }
  int s = q < 18 ? q % 9 : q - 18; if (q >= 18 && s >= 4) s += 2;
  return s == 0 ? 2 : (s == 1 || s == 8) ? 0 : (s == 2 ? 4 : (s == 3 ? 1 : (s == 7 ? 6 : 5)));
}
__global__ void __launch_bounds__(512, 2) mega(Params p, int ph_lo, int ph_hi, int coop) {
#if PROBE_CAT >= 0
  if (blockIdx.x == 0 && threadIdx.x == 0) ((unsigned long long*)(kws() + 500 * MiB))[0] = wall_clock64();
#endif
  for (int ph = ph_lo; ph < ph_hi; ++ph) {
    run_phase(p, ph);
    if (coop && ph + 1 < ph_hi) cg::this_grid().sync();
#if PROBE_CAT >= 0
    if (blockIdx.x == 0 && threadIdx.x == 0) ((unsigned long long*)(kws() + 500 * MiB))[ph + 1] = wall_clock64();
#endif
  }
#if PROBE_CAT >= 0
  cg::this_grid().sync();
  if (blockIdx.x == 0 && threadIdx.x == 0) {
    const unsigned long long* ts = (const unsigned long long*)(kws() + 500 * MiB);
    unsigned long long acc = 0;
    for (int ph = 0; ph < N_PHASES; ++ph) if (PROBE_CAT == 9 || phase_cat(ph) == PROBE_CAT) acc += ts[ph + 1] - ts[ph];
    ((float*)(kws() + 500 * MiB))[1024] = (float)acc * (0.01f * 2e-5f);
  }
  __syncthreads();
  if (blockIdx.x == 0) {
    __threadfence();
    const float ev = ((volatile float*)(kws() + 500 * MiB))[1024];
    for (int i = threadIdx.x; i < 4096; i += 512) kx()[i] += ev;
    for (int i = threadIdx.x; i < 2048; i += 512) kx()[(size_t)32768 * 1024 + i] += ev;
  }
#endif
}

extern "C" void kernel_launch(void* const* d_in, const int* in_sizes, int n_in, void* d_out, int out_size, void* d_ws, size_t ws_size, hipStream_t stream) {
  static int grid = 0;
  if (!grid) {
    int dev = 0, cus = 0, per_cu = 0;
    (void)hipFuncSetAttribute((const void*)mega, hipFuncAttributeMaxDynamicSharedMemorySize, SHM_BYTES);
    (void)hipGetDevice(&dev);
    (void)hipDeviceGetAttribute(&cus, hipDeviceAttributeMultiprocessorCount, dev);
    (void)hipOccupancyMaxActiveBlocksPerMultiprocessor(&per_cu, (const void*)mega, 512, SHM_BYTES);
    if (per_cu < 1) per_cu = 1;
    grid = cus * per_cu;
    if (grid > 256) grid = 256;
    if (grid & 7) grid &= ~7;
  }
  Params p{};
  for (int i = 0; i < 34; ++i) p.in[i] = (const float*)d_in[i];
  p.x = (float*)d_out;
  p.ws = (char*)d_ws;
  int ph_lo = 0, ph_hi = N_PHASES, coop = 1;
  void* args[] = {&p, &ph_lo, &ph_hi, &coop};
  hipError_t e = hipLaunchCooperativeKernel((const void*)mega, dim3(grid), dim3(512), args, SHM_BYTES, stream);
  if (e != hipSuccess) fprintf(stderr, "cooperative launch failed: %s (grid %d)\n", hipGetErrorString(e), grid);
}
```

```cpp
#define PROBE_CAT -1
#include <hip/hip_runtime.h>
#include <hip/hip_cooperative_groups.h>
#include <cstdio>
namespace cg = cooperative_groups;

#define DEV __device__ __forceinline__
typedef unsigned short bf16_t;
typedef short bf16x8 __attribute__((ext_vector_type(8)));
typedef float f32x4 __attribute__((ext_vector_type(4)));

extern __shared__ __attribute__((aligned(16))) char g_shm[];

constexpr int NT = 49152, SLAB = 16384;
constexpr int SHM_BYTES = 147456;
constexpr size_t MiB = 1u << 20;
constexpr size_t OFF_W = 0;
constexpr size_t OFF_H = 24 * MiB;
constexpr size_t OFF_H0 = OFF_H + 256 * 2048;
constexpr size_t OFF_U = 122 * MiB, OFF_SSQ = 250 * MiB;
constexpr size_t OFF_HMID = 122 * MiB;
constexpr size_t OFF_MIX = 200 * MiB;
constexpr size_t OFF_HX = 24 * MiB, OFF_YLF = 24 * MiB, OFF_YLB = 56 * MiB, OFF_R = 88 * MiB, OFF_K = 120 * MiB, OFF_V = 152 * MiB,
                 OFF_HL = 184 * MiB, OFF_E0 = 200 * MiB, OFF_E1 = 232 * MiB, OFF_A0 = 264 * MiB, OFF_A1 = 296 * MiB, OFF_G = 328 * MiB,
                 OFF_PSI = 360 * MiB, OFF_BON = 488 * MiB, OFF_PHG = 490 * MiB, OFF_PSG = 492 * MiB, OFF_SST = 496 * MiB;
constexpr size_t W_SG_IN = 0, W_SG_OUT = 8 * MiB;
constexpr size_t W_FF_A = 0, W_FF_D = 12 * MiB;
constexpr size_t W_TM_P = 0, W_TM_O = 14 * MiB, W_TM_W2 = 16 * MiB, W_TM_A2 = 16 * MiB + 512 * 1024, W_TM_G2 = 17 * MiB;

struct Params {
  const float* in[34];
  float* x;
  char* ws;
};


typedef const __attribute__((address_space(4))) char* karg_t;
DEV int opaque0() { int z = 0; asm volatile("" : "+s"(z)); return z; }
DEV const float* kin(int i) { karg_t kp = (karg_t)__builtin_amdgcn_kernarg_segment_ptr(); return *(const float* const __attribute__((address_space(4)))*)(kp + (i + opaque0()) * 8); }
DEV float* kx() { karg_t kp = (karg_t)__builtin_amdgcn_kernarg_segment_ptr(); return *(float* const __attribute__((address_space(4)))*)(kp + (34 + opaque0()) * 8); }
DEV char* kws() { karg_t kp = (karg_t)__builtin_amdgcn_kernarg_segment_ptr(); return *(char* const __attribute__((address_space(4)))*)(kp + (35 + opaque0()) * 8); }

DEV int opaque_tid() { int z = 0; asm volatile("" : "+v"(z)); return (int)threadIdx.x + z; }
#define LBAR2() do { asm volatile("s_waitcnt lgkmcnt(0)" ::: "memory"); __builtin_amdgcn_s_barrier(); asm volatile("" ::: "memory"); } while (0)
DEV float bf2f(bf16_t u) { return __uint_as_float(((unsigned)u) << 16); }
typedef float f32x2 __attribute__((ext_vector_type(2)));
typedef __bf16 bf16x2_t __attribute__((ext_vector_type(2)));
DEV unsigned pack2(float a, float b) { f32x2 v = {a, b}; bf16x2_t h = __builtin_convertvector(v, bf16x2_t); return __builtin_bit_cast(unsigned, h); }
DEV bf16_t f2bf(float f) { return (bf16_t)(pack2(f, f) & 0xffffu); }
template <int CTRL> DEV float dppmov(float v) { return __int_as_float(__builtin_amdgcn_update_dpp(0, __float_as_int(v), CTRL, 0xf, 0xf, true)); }
DEV float row_sum16(float v) {
  v += dppmov<0xB1>(v); v += dppmov<0x4E>(v); v += dppmov<0x141>(v); v += dppmov<0x140>(v);
  return v;
}
DEV float wave_sum(float v) {
  const int r = __float_as_int(row_sum16(v));
  return (__int_as_float(__builtin_amdgcn_readlane(r, 0)) + __int_as_float(__builtin_amdgcn_readlane(r, 16))) +
         (__int_as_float(__builtin_amdgcn_readlane(r, 32)) + __int_as_float(__builtin_amdgcn_readlane(r, 48)));
}
DEV float sigmoidf_(float x) { return 1.0f / (1.0f + __expf(-x)); }
DEV f32x2 gelu_pk(f32x2 v) {
  const f32x2 av = __builtin_elementwise_abs(v), d = av * 0.2316418882f + 1.0f;
  f32x2 t; t.x = __builtin_amdgcn_rcpf(d.x); t.y = __builtin_amdgcn_rcpf(d.y);
  f32x2 q = t * 0.5307027145f + (-0.7265760135f); q = q * t + 0.7107068705f; q = q * t + (-0.142248368f); q = q * t + 0.127414796f; q = q * t;
  const f32x2 s = (v * v) * (-0.72134752044f);
  f32x2 e; e.x = __builtin_amdgcn_exp2f(s.x); e.y = __builtin_amdgcn_exp2f(s.y);
  const f32x2 m = v * (q * e), r = v - m;
  f32x2 o; o.x = v.x < 0.f ? m.x : r.x; o.y = v.y < 0.f ? m.y : r.y; return o;
}
DEV float gelu_exact(float v) {
  const float av = fabsf(v), d = av * 0.2316418882f + 1.0f;
  const float t = __builtin_amdgcn_rcpf(d);
  float q = t * 0.5307027145f + (-0.7265760135f); q = q * t + 0.7107068705f; q = q * t + (-0.142248368f); q = q * t + 0.127414796f; q = q * t;
  const float e = __builtin_amdgcn_exp2f((v * v) * (-0.72134752044f));
  const float m = v * (q * e), r = v - m;
  return v < 0.f ? m : r;
}

DEV void phase_init(const Params& p) {
  const int TIDX = opaque_tid();
  const float4* xp = (const float4*)kin(0);
  const float4* xs = (const float4*)kin(1);
  float4* x = (float4*)kx();
  const size_t n0 = (size_t)32768 * 256, n1 = (size_t)16384 * 256;
  for (size_t i = (size_t)blockIdx.x * 512 + TIDX; i < n0 + n1; i += (size_t)gridDim.x * 512) x[i] = i < n0 ? xp[i] : xs[i - n0];
}

template <bool FROM_INPUT>
DEV void phase_norm(const Params& p, const float* g, bf16_t* h0) {
  const int TIDX = opaque_tid();
  const int wid = TIDX >> 6, lane = TIDX & 63;
  float4 gv[4];
#pragma unroll
  for (int i = 0; i < 4; ++i) gv[i] = ((const float4*)g)[lane + 64 * i];
  const int tstep = gridDim.x * 8;
  auto row_ptr = [&](int t) -> const float4* {
    const int tc = t < NT ? t : NT - 1;
    return FROM_INPUT ? (const float4*)(tc < 32768 ? kin(0) + (size_t)tc * 1024 : kin(1) + (size_t)(tc - 32768) * 1024)
                      : (const float4*)(kx() + (size_t)tc * 1024);
  };
  float4 nx[4];
  { const float4* xr = row_ptr(blockIdx.x * 8 + wid);
#pragma unroll
    for (int i = 0; i < 4; ++i) nx[i] = xr[lane + 64 * i]; }
  for (int t = blockIdx.x * 8 + wid; t < NT; t += tstep) {
    float4 v[4]; float ss = 0.f;
#pragma unroll
    for (int i = 0; i < 4; ++i) { v[i] = nx[i]; ss += v[i].x * v[i].x + v[i].y * v[i].y + v[i].z * v[i].z + v[i].w * v[i].w; }
    { const float4* xr = row_ptr(t + tstep);
#pragma unroll
      for (int i = 0; i < 4; ++i) nx[i] = xr[lane + 64 * i]; }
    if (FROM_INPUT) {
      float4* xw = (float4*)(kx() + (size_t)t * 1024);
#pragma unroll
      for (int i = 0; i < 4; ++i) xw[lane + 64 * i] = v[i];
    }
    ss = wave_sum(ss);
    const float rs = rsqrtf(ss * (1.0f / 1024.f) + 1e-6f);
    uint2* hr = (uint2*)(h0 + (size_t)t * 1024);
#pragma unroll
    for (int i = 0; i < 4; ++i) {
      uint2 o; o.x = pack2(v[i].x * rs * gv[i].x, v[i].y * rs * gv[i].y); o.y = pack2(v[i].z * rs * gv[i].z, v[i].w * rs * gv[i].w);
      hr[lane + 64 * i] = o;
    }
  }
}

DEV void phase_norm_tm(const Params& p, const float* g, const float* mu, bf16_t* mixb, int slab) {
  const int TIDX = opaque_tid();
  const int wid = TIDX >> 6, lane = TIDX & 63;
  const int L = slab < 2 ? 16384 : 2048;
  float4 gv[4], muv[6][4];
#pragma unroll
  for (int i = 0; i < 4; ++i) gv[i] = ((const float4*)g)[lane + 64 * i];
#pragma unroll
  for (int m = 0; m < 6; ++m)
#pragma unroll
    for (int i = 0; i < 4; ++i) muv[m][i] = ((const float4*)(mu + m * 1024))[lane + 64 * i];
  for (int ts = blockIdx.x * 8 + wid; ts < SLAB; ts += gridDim.x * 8) {
    const int t = slab * SLAB + ts, pos = ts & (L - 1);
    float4 hv[3][4];
#pragma unroll
    for (int d = 0; d < 3; ++d) {
      const bool valid = !((d == 0 && pos == 0) || (d == 2 && pos == L - 1));
      const int tt = valid ? t + d - 1 : t;
      const float4* xr = (const float4*)(kx() + (size_t)tt * 1024);
      float ss = 0.f;
#pragma unroll
      for (int i = 0; i < 4; ++i) { float4 v = xr[lane + 64 * i]; hv[d][i] = v; ss += v.x * v.x + v.y * v.y + v.z * v.z + v.w * v.w; }
      ss = wave_sum(ss);
      const float rs = valid ? rsqrtf(ss * (1.0f / 1024.f) + 1e-6f) : 0.f;
#pragma unroll
      for (int i = 0; i < 4; ++i) { hv[d][i].x *= rs * gv[i].x; hv[d][i].y *= rs * gv[i].y; hv[d][i].z *= rs * gv[i].z; hv[d][i].w *= rs * gv[i].w; }
    }
#pragma unroll
    for (int i = 0; i < 4; ++i) {
      hv[0][i].x = 0.5f * (hv[0][i].x + hv[2][i].x) - hv[1][i].x; hv[0][i].y = 0.5f * (hv[0][i].y + hv[2][i].y) - hv[1][i].y;
      hv[0][i].z = 0.5f * (hv[0][i].z + hv[2][i].z) - hv[1][i].z; hv[0][i].w = 0.5f * (hv[0][i].w + hv[2][i].w) - hv[1][i].w;
    }
#pragma unroll
    for (int m = 0; m < 6; ++m) {
      uint2* orow = (uint2*)(mixb + ((size_t)m * SLAB + ts) * 1024);
#pragma unroll
      for (int i = 0; i < 4; ++i) {
        const float4 mv = muv[m][i];
        uint2 o;
        o.x = pack2(hv[1][i].x + hv[0][i].x * mv.x, hv[1][i].y + hv[0][i].y * mv.y);
        o.y = pack2(hv[1][i].z + hv[0][i].z * mv.z, hv[1][i].w + hv[0][i].w * mv.w);
        orow[lane + 64 * i] = o;
      }
    }
  }
}

DEV void phase_final(const Params& p) {
  const int TIDX = opaque_tid();
  const int wid = TIDX >> 6, lane = TIDX & 63;
  const float* g = kin(4);
  float4 gv[4];
#pragma unroll
  for (int i = 0; i < 4; ++i) gv[i] = ((const float4*)g)[lane + 64 * i];
  for (int t = blockIdx.x * 8 + wid; t < NT; t += gridDim.x * 8) {
    float4* xr = (float4*)(kx() + (size_t)t * 1024);
    float4 v[4]; float ss = 0.f;
#pragma unroll
    for (int i = 0; i < 4; ++i) { v[i] = xr[lane + 64 * i]; ss += v[i].x * v[i].x + v[i].y * v[i].y + v[i].z * v[i].z + v[i].w * v[i].w; }
    ss = wave_sum(ss);
    const float rs = rsqrtf(ss * (1.0f / 1024.f) + 1e-6f);
#pragma unroll
    for (int i = 0; i < 4; ++i) {
      float4 o; o.x = v[i].x * rs * gv[i].x; o.y = v[i].y * rs * gv[i].y; o.z = v[i].z * rs * gv[i].z; o.w = v[i].w * rs * gv[i].w;
      xr[lane + 64 * i] = o;
    }
  }
}

DEV void wprep_T(bf16_t* dst, int ldd, int koff, const float* src, int Ks, int Ns, const float* scale, int rs, int roff) {
  const int TIDX = opaque_tid();
  float (*tile)[33] = (float (*)[33])g_shm;
  const int tx = TIDX & 31, ty = TIDX >> 5;
  const int nkt = Ks / 32, nnt = Ns / 32;
  for (int tIdx = blockIdx.x; tIdx < nkt * nnt; tIdx += gridDim.x) {
    const int k0 = (tIdx / nnt) * 32, n0 = (tIdx % nnt) * 32;
    __syncthreads();
#pragma unroll
    for (int i = 0; i < 2; ++i) tile[ty + 16 * i][tx] = src[(size_t)(k0 + ty + 16 * i) * Ns + n0 + tx];
    __syncthreads();
    const float sc = scale ? scale[k0 + tx] : 1.0f;
#pragma unroll
    for (int i = 0; i < 2; ++i) {
      const int n = n0 + ty + 16 * i;
      const int drow = (n >> 7) * rs + (n & 127) + roff;
      dst[(size_t)drow * ldd + koff + k0 + tx] = f2bf(tile[tx][ty + 16 * i] * sc);
    }
  }
  __syncthreads();
}


DEV void wprep_T2(bf16_t* dst, int ldd, int koff, const float* src, int Ks, int Ns, const float* scale, int rs, int roff) {
  const int TIDX = opaque_tid();
  float* tile = (float*)g_shm;
  const int nkt = Ks / 64, nnt = Ns / 128;
  const int lc = TIDX & 127, lr = TIDX >> 7;
  const int wk = TIDX & 63, wn = TIDX >> 6;
  for (int tIdx = blockIdx.x; tIdx < nkt * nnt; tIdx += gridDim.x) {
    const int k0 = (tIdx / nnt) * 64, n0 = (tIdx % nnt) * 128;
    float v[16];
#pragma unroll
    for (int i = 0; i < 16; ++i) v[i] = src[(size_t)(k0 + i * 4 + lr) * Ns + n0 + lc];
    __syncthreads();
#pragma unroll
    for (int i = 0; i < 16; ++i) tile[(i * 4 + lr) * 129 + lc] = v[i];
    __syncthreads();
    const float sc = scale ? scale[k0 + wk] : 1.0f;
#pragma unroll
    for (int i = 0; i < 16; ++i) {
      const int n = n0 + i * 8 + wn;
      const int drow = (n >> 7) * rs + (n & 127) + roff;
      dst[(size_t)drow * ldd + koff + k0 + wk] = f2bf(tile[wk * 129 + i * 8 + wn] * sc);
    }
  }
  __syncthreads();
}

constexpr int BM = 256, BK = 64, HALF = 128, HT = HALF * BK;
DEV int lds_byte(int r, int c) {
  int st = (r >> 4) * 2 + (c >> 5), rr = r & 15, cc = c & 31, ob = rr * 64 + cc * 2;
  return st * 1024 + (ob ^ (((ob >> 9) & 1) << 5));
}
DEV void stage_rc(int b, int& R, int& C) {
  int st = b / 1024, sb = b % 1024, swz = sb ^ (((sb >> 9) & 1) << 5);
  R = (st >> 1) * 16 + swz / 64; C = (st & 1) * 32 + (swz % 64) / 2;
}

typedef __attribute__((address_space(3))) unsigned char lds_u8;
DEV void gemm_big(const bf16_t* A, long lda, const bf16_t* Bt, long ldb, int K, long brow, long bcol, f32x4 (&acc)[2][2][4][2]) {
  const int TIDX = opaque_tid();
  lds_u8* lds = (lds_u8*)g_shm;
  constexpr int HTB = HT * 2;
#define SA(b, h) (((b) * 2 + (h)) * HTB)
#define SB(b, h) ((4 + (b) * 2 + (h)) * HTB)
#define STAGE(bufoff, gbase, VO, kt) do { const char* _gp = (gbase) + (size_t)(kt) * (BK * 2); \
    __builtin_amdgcn_global_load_lds((const unsigned*)(_gp + VO##0), (__attribute__((address_space(3))) unsigned*)(lds + (bufoff) + ldsw), 16, 0, 0); \
    __builtin_amdgcn_global_load_lds((const unsigned*)(_gp + VO##1), (__attribute__((address_space(3))) unsigned*)(lds + (bufoff) + ldsw + 8192), 16, 0, 0); } while (0)
#define LDA(dst, b, h) for (int m = 0; m < 4; ++m) for (int k = 0; k < 2; ++k) \
    dst[m][k] = *(const __attribute__((address_space(3))) bf16x8*)(lds + SA(b, h) + aoff + m * 2048 + k * 1024)
#define LDB(dst, b, h) for (int n = 0; n < 2; ++n) for (int k = 0; k < 2; ++k) \
    dst[n][k] = *(const __attribute__((address_space(3))) bf16x8*)(lds + SB(b, h) + boff + n * 2048 + k * 1024)
#define MMA(ai, bj, At, Bt_) do { __builtin_amdgcn_s_setprio(1); \
    for (int m = 0; m < 4; ++m) for (int n = 0; n < 2; ++n) for (int k = 0; k < 2; ++k) \
      acc[ai][bj][m][n] = __builtin_amdgcn_mfma_f32_16x16x32_bf16(Bt_[n][k], At[m][k], acc[ai][bj][m][n], 0, 0, 0); \
    __builtin_amdgcn_s_setprio(0); } while (0)
#define WAIT_V(n) asm volatile("s_waitcnt vmcnt(" #n ")" ::: "memory")
#define WAIT_L(n) asm volatile("s_waitcnt lgkmcnt(" #n ")" ::: "memory")
#define BAR __builtin_amdgcn_s_barrier()
#define SCHED __builtin_amdgcn_sched_barrier(0)
  const int tid = TIDX, wid = __builtin_amdgcn_readfirstlane(tid >> 6), lane = tid & 63, wr = wid >> 2, wc = wid & 3, fr = lane & 15, fq = lane >> 4;
  unsigned va0, va1, vb0, vb1;
  { int r_, c_; stage_rc(tid * 16, r_, c_); va0 = (unsigned)((r_ * lda + c_) * 2); vb0 = (unsigned)((r_ * ldb + c_) * 2);
    stage_rc(tid * 16 + 8192, r_, c_); va1 = (unsigned)((r_ * lda + c_) * 2); vb1 = (unsigned)((r_ * ldb + c_) * 2); }
  const unsigned ldsw = (unsigned)wid * 1024u;
  const int aoff = lds_byte(wr * 64 + fr, fq * 8), boff = lds_byte(wc * 32 + fr, fq * 8);
  const char* cA0 = (const char*)(A + brow * lda); const char* cA1 = cA0 + (size_t)HALF * lda * 2;
  const char* cB0 = (const char*)(Bt + bcol * ldb); const char* cB1 = cB0 + (size_t)HALF * ldb * 2;
#pragma unroll
  for (int a = 0; a < 2; ++a)
#pragma unroll
    for (int b = 0; b < 2; ++b)
#pragma unroll
      for (int m = 0; m < 4; ++m)
#pragma unroll
        for (int n = 0; n < 2; ++n) acc[a][b][m][n] = (f32x4){0.f, 0.f, 0.f, 0.f};
  bf16x8 At[4][2], B0[2][2], B1[2][2];
  const int nt = K / BK;
  STAGE(SB(0, 0), cB0, vb, 0); STAGE(SA(0, 0), cA0, va, 0);
  STAGE(SB(0, 1), cB1, vb, 0); STAGE(SA(0, 1), cA1, va, 0);
  if (wr == 1) BAR;
  WAIT_V(4); BAR;
  STAGE(SB(1, 0), cB0, vb, 1); STAGE(SA(1, 0), cA0, va, 1); STAGE(SB(1, 1), cB1, vb, 1);
  WAIT_V(6); BAR;
  for (int t = 0; t < nt - 2; t += 2) {
    LDB(B0, 0, 0); SCHED; LDA(At, 0, 0); STAGE(SA(1, 1), cA1, va, t + 1);
    WAIT_L(8); BAR; WAIT_L(0); MMA(0, 0, At, B0); BAR; SCHED;
    LDB(B1, 0, 1); STAGE(SB(0, 0), cB0, vb, t + 2);
    BAR; WAIT_L(0); MMA(0, 1, At, B1); BAR;
    LDA(At, 0, 1); STAGE(SA(0, 0), cA0, va, t + 2);
    BAR; WAIT_L(0); MMA(1, 0, At, B0); BAR; SCHED;
    STAGE(SB(0, 1), cB1, vb, t + 2);
    WAIT_V(6); BAR; MMA(1, 1, At, B1); BAR;
    LDB(B0, 1, 0); SCHED; LDA(At, 1, 0); STAGE(SA(0, 1), cA1, va, t + 2);
    WAIT_L(8); BAR; WAIT_L(0); MMA(0, 0, At, B0); BAR; SCHED;
    LDB(B1, 1, 1); STAGE(SB(1, 0), cB0, vb, t + 3);
    BAR; WAIT_L(0); MMA(0, 1, At, B1); BAR;
    LDA(At, 1, 1); STAGE(SA(1, 0), cA0, va, t + 3);
    BAR; WAIT_L(0); MMA(1, 0, At, B0); BAR; SCHED;
    STAGE(SB(1, 1), cB1, vb, t + 3);
    WAIT_V(6); BAR; MMA(1, 1, At, B1); BAR;
  }
  { LDB(B0, 0, 0); LDA(At, 0, 0); STAGE(SA(1, 1), cA1, va, nt - 1);
    BAR; WAIT_L(0); MMA(0, 0, At, B0); BAR;
    LDB(B1, 0, 1); BAR; WAIT_L(0); MMA(0, 1, At, B1); BAR;
    LDA(At, 0, 1); WAIT_V(4); BAR; WAIT_L(0); MMA(1, 0, At, B0); MMA(1, 1, At, B1); BAR; }
  { LDB(B0, 1, 0); LDA(At, 1, 0); WAIT_V(2); BAR; WAIT_L(0); MMA(0, 0, At, B0); BAR;
    LDB(B1, 1, 1); WAIT_V(0); BAR; WAIT_L(0); MMA(0, 1, At, B1); BAR;
    LDA(At, 1, 1); BAR; WAIT_L(0); MMA(1, 0, At, B0); MMA(1, 1, At, B1); BAR; }
  if (wr == 0) BAR;
}
DEV void dump_half(const f32x4 (&acc)[2][2][4][2], int ai, int tid) {
  float* T = (float*)g_shm;
  const int wid = tid >> 6, lane = tid & 63, wr = wid >> 2, wc = wid & 3, fr = lane & 15, fq = lane >> 4;
#pragma unroll
  for (int bj = 0; bj < 2; ++bj)
#pragma unroll
    for (int m = 0; m < 4; ++m)
#pragma unroll
      for (int n = 0; n < 2; ++n) {
        const int r = wr * 64 + m * 16 + fr, c = bj * 128 + wc * 32 + n * 16 + fq * 4;
        *(f32x4*)(T + r * 260 + c) = (ai == 0) ? acc[0][bj][m][n] : acc[1][bj][m][n];
      }
}
DEV float4 tile_ld4(int r, int c4) { return *(const float4*)((const float*)g_shm + r * 260 + c4); }
DEV void dump_tile_bf16(const f32x4 (&acc)[2][2][4][2], int tid) {
  bf16_t* T = (bf16_t*)g_shm;
  const int wid = tid >> 6, lane = tid & 63, wr = wid >> 2, wc = wid & 3, fr = lane & 15, fq = lane >> 4;
#pragma unroll
  for (int ai = 0; ai < 2; ++ai)
#pragma unroll
    for (int bj = 0; bj < 2; ++bj)
#pragma unroll
      for (int m = 0; m < 4; ++m)
#pragma unroll
        for (int n = 0; n < 2; ++n) {
          const int r = ai * 128 + wr * 64 + m * 16 + fr, c = bj * 128 + wc * 32 + n * 16 + fq * 4;
          uint2 o; o.x = pack2(acc[ai][bj][m][n][0], acc[ai][bj][m][n][1]); o.y = pack2(acc[ai][bj][m][n][2], acc[ai][bj][m][n][3]);
          *(uint2*)(T + r * 264 + c) = o;
        }
}
DEV float4 tileb_ld4(int r, int c4) {
  const uint2 u = *(const uint2*)((const bf16_t*)g_shm + r * 264 + c4);
  return make_float4(__uint_as_float(u.x << 16), __uint_as_float(u.x & 0xffff0000u), __uint_as_float(u.y << 16), __uint_as_float(u.y & 0xffff0000u));
}

DEV int vblock() { return (blockIdx.x & 7) * (gridDim.x >> 3) + (blockIdx.x >> 3); }

DEV void tile_pmpn(int tile, int nM, int nN, int& pm, int& pn) {
  const int nig = 8 * nN, gid = tile / nig, fm = gid * 8, gsz = (nM - fm) < 8 ? (nM - fm) : 8;
  pm = fm + ((tile % nig) % gsz); pn = (tile % nig) / gsz;
}
DEV void phase_gemm_res(const Params& p, const bf16_t* A, long lda, const bf16_t* Bt, int K, int mtiles, long xrow0) {
  float* X = kx();
  for (int tile = vblock(); tile < mtiles * 4; tile += gridDim.x) {
    int pm, pn; tile_pmpn(tile, mtiles, 4, pm, pn);
    f32x4 acc[2][2][4][2];
    gemm_big(A, lda, Bt, K, K, (long)pm * 256, (long)pn * 256, acc);
    const int tid = opaque_tid();
#pragma unroll
    for (int ai = 0; ai < 2; ++ai) {
      LBAR2();
      dump_half(acc, ai, tid);
      LBAR2();
      for (int e = tid; e < 128 * 64; e += 512) {
        const int r = e >> 6, c4 = (e & 63) * 4;
        const float4 v = tile_ld4(r, c4);
        float4* q = (float4*)(X + (xrow0 + pm * 256 + ai * 128 + r) * 1024 + pn * 256 + c4);
        float4 o = *q; o.x += v.x; o.y += v.y; o.z += v.z; o.w += v.w; *q = o;
      }
    }
    LBAR2();
  }
}

DEV void phase_sgu_in(const Params& p, int j, int slab) {
  const bf16_t* A = (const bf16_t*)(kws() + OFF_H0) + (size_t)slab * SLAB * 1024;
  const bf16_t* Bt = (const bf16_t*)(kws() + OFF_W + W_SG_IN);
  const float* bin = kin(6) + (size_t)j * 4096;
  bf16_t* Z = (bf16_t*)(kws() + OFF_U);
  float* SSQ = (float*)(kws() + OFF_SSQ);
  for (int tile = vblock(); tile < 64 * 16; tile += gridDim.x) {
    int pm, pn; tile_pmpn(tile, 64, 16, pm, pn);
    f32x4 acc[2][2][4][2];
    gemm_big(A, 1024, Bt, 1024, 1024, (long)pm * 256, (long)pn * 256, acc);
    const int tid = opaque_tid(), wid = tid >> 6, lane = tid & 63;
    const float4 b4 = *(const float4*)(bin + pn * 256 + lane * 4);
    dump_tile_bf16(acc, tid);
    LBAR2();
    for (int rr = 0; rr < 32; ++rr) {
      const int r = wid * 32 + rr;
      const float4 v = tileb_ld4(r, lane * 4);
      const f32x2 za = gelu_pk((f32x2){v.x + b4.x, v.y + b4.y}), zb = gelu_pk((f32x2){v.z + b4.z, v.w + b4.w});
      const float z0 = za.x, z1 = za.y, z2 = zb.x, z3 = zb.y;
      const int row = pm * 256 + r;
      uint2 o; o.x = pack2(z0, z1); o.y = pack2(z2, z3);
      *(uint2*)(Z + (size_t)row * 4096 + pn * 256 + lane * 4) = o;
      if (pn >= 8) {
        const float ss = wave_sum(z0 * z0 + z1 * z1 + z2 * z2 + z3 * z3);
        if (lane == 0) SSQ[(size_t)row * 8 + (pn - 8)] = ss;
      }
    }
    LBAR2();
  }
}

DEV void phase_tm_proj(const Params& p) {
  const bf16_t* MIX = (const bf16_t*)(kws() + OFF_MIX);
  const bf16_t* Bt = (const bf16_t*)(kws() + OFF_W + W_TM_P);
  for (int tile = vblock(); tile < 64 * 15; tile += gridDim.x) {
    int pm, pn; tile_pmpn(tile, 64, 15, pm, pn);
    const int msel = pn < 4 ? 0 : (pn < 8 ? 2 : (pn < 12 ? 3 : (pn == 12 ? 1 : (pn == 13 ? 4 : 5))));
    f32x4 acc[2][2][4][2];
    gemm_big(MIX + (size_t)msel * SLAB * 1024, 1024, Bt, 1024, 1024, (long)pm * 256, (long)pn * 256, acc);
    const int tid = opaque_tid(), wid = tid >> 6, lane = tid & 63;
    bf16_t* O; int ld, cb;
    if (pn < 12) { O = (bf16_t*)(kws() + (pn < 4 ? OFF_R : (pn < 8 ? OFF_K : OFF_V))); ld = 1024; cb = (pn & 3) * 256; }
    else { O = (bf16_t*)(kws() + OFF_HL); ld = 512; cb = pn == 12 ? 0 : (pn == 13 ? 128 : 256); }
    const int act = pn == 12 ? 1 : (pn == 14 ? 2 : 0);
    const bool live = pn < 12 || pn == 14 || lane < 32;
    dump_tile_bf16(acc, tid);
    LBAR2();
    for (int rr = 0; rr < 32; ++rr) {
      const int r = wid * 32 + rr;
      float4 v = tileb_ld4(r, lane * 4);
      if (act == 1) { v.x = tanhf(v.x); v.y = tanhf(v.y); v.z = tanhf(v.z); v.w = tanhf(v.w); }
      else if (act == 2) { v.x = sigmoidf_(v.x); v.y = sigmoidf_(v.y); v.z = sigmoidf_(v.z); v.w = sigmoidf_(v.w); }
      uint2 o; o.x = pack2(v.x, v.y); o.y = pack2(v.z, v.w);
      if (live) *(uint2*)(O + (size_t)(pm * 256 + r) * ld + cb + lane * 4) = o;
    }
    LBAR2();
  }
}

DEV void phase_ffn_a(const Params& p, int layer) {
  const bf16_t* A = (const bf16_t*)(kws() + OFF_H0);
  const bf16_t* Bt = (const bf16_t*)(kws() + OFF_W + W_FF_A);
  bf16_t* HM = (bf16_t*)(kws() + OFF_HMID);
  const float* cw = kin(31) + (size_t)layer * 3 * 2816;
  const float* cb = kin(32) + (size_t)layer * 2816;
  bf16_t* gl = (bf16_t*)g_shm;
  bf16_t* ul = (bf16_t*)(g_shm + 69632);
  for (int tile = vblock(); tile < 202 * 22; tile += gridDim.x) {
    int mi, pn; tile_pmpn(tile, 202, 22, mi, pn);
    int base, L, i;
    if (mi < 130) { base = (mi / 65) * 16384; L = 16384; i = mi % 65; }
    else { const int m2 = mi - 130; base = 32768 + (m2 / 9) * 2048; L = 2048; i = m2 % 9; }
    const int s0 = 254 * i - 1;
    f32x4 acc[2][2][4][2];
    gemm_big(A, 1024, Bt, 1024, 1024, (long)base + s0, (long)pn * 256, acc);
    const int tid = opaque_tid(), wid = tid >> 6, lane = tid & 63, wr = wid >> 2, wc = wid & 3, fr = lane & 15, fq = lane >> 4;
#pragma unroll
    for (int ai = 0; ai < 2; ++ai)
#pragma unroll
      for (int m = 0; m < 4; ++m) {
        const int r = ai * 128 + wr * 64 + m * 16 + fr, sp = s0 + r;
        const bool inseq = sp >= 0 && sp < L;
#pragma unroll
        for (int n = 0; n < 2; ++n) {
          const int c = wc * 32 + n * 16 + fq * 4;
          uint2 o;
          o.x = inseq ? pack2(acc[ai][0][m][n][0], acc[ai][0][m][n][1]) : 0u; o.y = inseq ? pack2(acc[ai][0][m][n][2], acc[ai][0][m][n][3]) : 0u;
          *(uint2*)(gl + r * 136 + c) = o;
          o.x = pack2(acc[ai][1][m][n][0], acc[ai][1][m][n][1]); o.y = pack2(acc[ai][1][m][n][2], acc[ai][1][m][n][3]);
          *(uint2*)(ul + r * 136 + c) = o;
        }
      }
    const int c4 = (lane & 31) * 4, f = pn * 128 + c4;
    const float4 w0 = *(const float4*)(cw + f), w1 = *(const float4*)(cw + 2816 + f), w2 = *(const float4*)(cw + 2 * 2816 + f), bb = *(const float4*)(cb + f);
    LBAR2();
    for (int e = tid; e < 256 * 32; e += 512) {
      const int r = e >> 5, sp = s0 + r;
      if (r >= 1 && r <= 254 && sp < L) {
        const uint2 ur = *(const uint2*)(ul + r * 136 + c4);
        const uint2 g0 = *(const uint2*)(gl + (r - 1) * 136 + c4), g1 = *(const uint2*)(gl + r * 136 + c4), g2 = *(const uint2*)(gl + (r + 1) * 136 + c4);
        const float c0 = w0.x * __uint_as_float(g0.x << 16) + w1.x * __uint_as_float(g1.x << 16) + w2.x * __uint_as_float(g2.x << 16) + bb.x;
        const float c1 = w0.y * __uint_as_float(g0.x & 0xffff0000u) + w1.y * __uint_as_float(g1.x & 0xffff0000u) + w2.y * __uint_as_float(g2.x & 0xffff0000u) + bb.y;
        const float c2 = w0.z * __uint_as_float(g0.y << 16) + w1.z * __uint_as_float(g1.y << 16) + w2.z * __uint_as_float(g2.y << 16) + bb.z;
        const float c3 = w0.w * __uint_as_float(g0.y & 0xffff0000u) + w1.w * __uint_as_float(g1.y & 0xffff0000u) + w2.w * __uint_as_float(g2.y & 0xffff0000u) + bb.w;
        const f32x2 ga = gelu_pk((f32x2){c0, c1}), gb = gelu_pk((f32x2){c2, c3});
        uint2 o; o.x = pack2(ga.x * __uint_as_float(ur.x << 16), ga.y * __uint_as_float(ur.x & 0xffff0000u));
        o.y = pack2(gb.x * __uint_as_float(ur.y << 16), gb.y * __uint_as_float(ur.y & 0xffff0000u));
        *(uint2*)(HM + (size_t)(base + sp) * 2816 + f) = o;
      }
    }
    LBAR2();
  }
}

template <int KP>
DEV void small_mma(f32x4 (&acc)[4][4]) {
  const int TIDX = opaque_tid();
  constexpr int LD = KP + 8;
  const bf16_t* sA = (const bf16_t*)g_shm;
  const bf16_t* sB = sA + 128 * LD;
  const int wid = TIDX >> 6, lane = TIDX & 63, wr = wid >> 2, wc = wid & 3, fr = lane & 15, fq = lane >> 4;
#pragma unroll
  for (int m = 0; m < 4; ++m)
#pragma unroll
    for (int n = 0; n < 4; ++n) acc[m][n] = (f32x4){0.f, 0.f, 0.f, 0.f};
#pragma unroll
  for (int kk = 0; kk < KP / 32; ++kk) {
    bf16x8 a[4], b[4];
#pragma unroll
    for (int m = 0; m < 4; ++m) a[m] = *(const bf16x8*)(sA + (wr * 64 + m * 16 + fr) * LD + kk * 32 + fq * 8);
#pragma unroll
    for (int n = 0; n < 4; ++n) b[n] = *(const bf16x8*)(sB + (wc * 64 + n * 16 + fr) * LD + kk * 32 + fq * 8);
#pragma unroll
    for (int m = 0; m < 4; ++m)
#pragma unroll
      for (int n = 0; n < 4; ++n) acc[m][n] = __builtin_amdgcn_mfma_f32_16x16x32_bf16(b[n], a[m], acc[m][n], 0, 0, 0);
  }
}
template <int KP>
DEV void small_load_ab(bf16_t* sA, const bf16_t* gA, long lda, bf16_t* sB, const bf16_t* gB, long ldb, int tid) {
  constexpr int LD = KP + 8, CPR = KP / 8, TA = 128 * CPR, TB = 256 * CPR, IA = TA / 512, IB = TB / 512;
  static_assert(TA % 512 == 0 && TB % 512 == 0, "panel sizes must be multiples of the block");
  uint4 va[IA], vb[IB];
#pragma unroll
  for (int it = 0; it < IA; ++it) { const int c = tid + it * 512; va[it] = *(const uint4*)(gA + (long)(c / CPR) * lda + (c % CPR) * 8); }
#pragma unroll
  for (int it = 0; it < IB; ++it) { const int c = tid + it * 512; vb[it] = *(const uint4*)(gB + (long)(c / CPR) * ldb + (c % CPR) * 8); }
#pragma unroll
  for (int it = 0; it < IA; ++it) { const int c = tid + it * 512; *(uint4*)(sA + (c / CPR) * LD + (c % CPR) * 8) = va[it]; }
#pragma unroll
  for (int it = 0; it < IB; ++it) { const int c = tid + it * 512; *(uint4*)(sB + (c / CPR) * LD + (c % CPR) * 8) = vb[it]; }
}

DEV void phase_sgu_mix(const Params& p, int j) {
  const int TIDX = opaque_tid();
  constexpr int KP = 128, LD = KP + 8;
  const int wid = TIDX >> 6, lane = TIDX & 63, wr = wid >> 2, wc = wid & 3, fr = lane & 15, fq = lane >> 4;
  bf16_t* sA = (bf16_t*)g_shm;
  bf16_t* sB = sA + 128 * LD;
  float* rsv = (float*)(g_shm + (128 + 256) * LD * 2);
  bf16_t* Z = (bf16_t*)(kws() + OFF_U);
  const float* SSQ = (const float*)(kws() + OFF_SSQ);
  const float* ws_ = kin(8) + (size_t)j * 8 * 128 * 128;
  const float* bs = kin(9) + (size_t)j * 8 * 128;
  const float* ng = kin(7) + (size_t)j * 2048;
  for (int unit = blockIdx.x; unit < 128 * 8; unit += gridDim.x) {
    const int chunk = unit >> 3, g = unit & 7;
    __syncthreads();
    uint4 vb[8]; float4 wa[4][2];
#pragma unroll
    for (int it = 0; it < 8; ++it) {
      const int e = TIDX + it * 512, pp = e & 127, c8 = (e >> 7) * 8;
      vb[it] = *(const uint4*)(Z + (size_t)(chunk * 128 + pp) * 4096 + 2048 + g * 256 + c8);
    }
#pragma unroll
    for (int it = 0; it < 4; ++it) {
      const int c = TIDX + it * 512, q = c >> 4, p8 = (c & 15) * 8;
      const float4* wp = (const float4*)(ws_ + ((size_t)g * 128 + q) * 128 + p8);
      wa[it][0] = wp[0]; wa[it][1] = wp[1];
    }
    if (TIDX < 128) {
      const float4* sp = (const float4*)(SSQ + (size_t)(chunk * 128 + TIDX) * 8);
      const float4 s0 = sp[0], s1 = sp[1];
      const float sm = ((s0.x + s0.y) + (s0.z + s0.w)) + ((s1.x + s1.y) + (s1.z + s1.w));
      rsv[TIDX] = rsqrtf(sm * (1.0f / 2048.f) + 1e-6f);
    }
#pragma unroll
    for (int it = 0; it < 8; ++it) {
      const int e = TIDX + it * 512, pp = e & 127, c8 = (e >> 7) * 8;
      const uint4 v = vb[it];
      sB[(c8 + 0) * LD + pp] = (bf16_t)(v.x & 0xffff); sB[(c8 + 1) * LD + pp] = (bf16_t)(v.x >> 16);
      sB[(c8 + 2) * LD + pp] = (bf16_t)(v.y & 0xffff); sB[(c8 + 3) * LD + pp] = (bf16_t)(v.y >> 16);
      sB[(c8 + 4) * LD + pp] = (bf16_t)(v.z & 0xffff); sB[(c8 + 5) * LD + pp] = (bf16_t)(v.z >> 16);
      sB[(c8 + 6) * LD + pp] = (bf16_t)(v.w & 0xffff); sB[(c8 + 7) * LD + pp] = (bf16_t)(v.w >> 16);
    }
    __syncthreads();
#pragma unroll
    for (int it = 0; it < 4; ++it) {
      const int c = TIDX + it * 512, q = c >> 4, p8 = (c & 15) * 8;
      const float4 w0 = wa[it][0], w1 = wa[it][1];
      uint4 o;
      o.x = pack2(w0.x * rsv[p8 + 0], w0.y * rsv[p8 + 1]); o.y = pack2(w0.z * rsv[p8 + 2], w0.w * rsv[p8 + 3]);
      o.z = pack2(w1.x * rsv[p8 + 4], w1.y * rsv[p8 + 5]); o.w = pack2(w1.z * rsv[p8 + 6], w1.w * rsv[p8 + 7]);
      *(uint4*)(sA + q * LD + p8) = o;
    }
    __syncthreads();
    f32x4 acc[4][4];
    small_mma<KP>(acc);
#pragma unroll
    for (int m = 0; m < 4; ++m) {
      const int q = wr * 64 + m * 16 + fr;
      const float bq = bs[g * 128 + q];
#pragma unroll
      for (int n = 0; n < 4; ++n) {
        const int c = g * 256 + wc * 64 + n * 16 + fq * 4;
        const float4 gg = *(const float4*)(ng + c);
        uint2* up = (uint2*)(Z + (size_t)(chunk * 128 + q) * 4096 + c);
        const uint2 u = *up;
        uint2 o;
        o.x = pack2(__uint_as_float(u.x << 16) * (acc[m][n][0] * gg.x + bq), __uint_as_float(u.x & 0xffff0000u) * (acc[m][n][1] * gg.y + bq));
        o.y = pack2(__uint_as_float(u.y << 16) * (acc[m][n][2] * gg.z + bq), __uint_as_float(u.y & 0xffff0000u) * (acc[m][n][3] * gg.w + bq));
        *up = o;
      }
    }
  }
  __syncthreads();
}

template <int KP>
DEV void lora_out_unit(const Params& p, int j, int kind, int mt, int ntile) {
  const int TIDX = opaque_tid();
  constexpr int LD = KP + 8;
  const int wid = TIDX >> 6, lane = TIDX & 63, wr = wid >> 2, wc = wid & 3, fr = lane & 15, fq = lane >> 4;
  bf16_t* sA = (bf16_t*)g_shm;
  bf16_t* sB = sA + 128 * LD;
  const bf16_t* HL = (const bf16_t*)(kws() + OFF_HL);
  const int koff = kind < 4 ? kind * 64 : 256;
  const bf16_t* Bt = (const bf16_t*)(kws() + OFF_W + (kind < 2 ? W_TM_W2 + (size_t)kind * 1024 * 64 * 2 : (kind < 4 ? W_TM_A2 + (size_t)(kind - 2) * 1024 * 64 * 2 : W_TM_G2)));
  bf16_t* O = (bf16_t*)(kws() + (kind == 0 ? OFF_E0 : kind == 1 ? OFF_E1 : kind == 2 ? OFF_A0 : kind == 3 ? OFF_A1 : OFF_G));
  const float* bias = kind < 2 ? kin(15) + ((size_t)j * 2 + kind) * 1024 : (kind < 4 ? kin(18) + ((size_t)j * 2 + kind - 2) * 1024 : nullptr);
  __syncthreads();
  small_load_ab<KP>(sA, HL + (size_t)mt * 128 * 512 + koff, 512, sB, Bt + (size_t)ntile * 256 * KP, KP, TIDX);
  __syncthreads();
  f32x4 acc[4][4];
  small_mma<KP>(acc);
#pragma unroll
  for (int n = 0; n < 4; ++n) {
    const int col = ntile * 256 + wc * 64 + n * 16 + fq * 4;
    const float4 b = bias ? *(const float4*)(bias + col) : make_float4(0.f, 0.f, 0.f, 0.f);
#pragma unroll
    for (int m = 0; m < 4; ++m) {
      const int row = mt * 128 + wr * 64 + m * 16 + fr;
      float v0 = acc[m][n][0] + b.x, v1 = acc[m][n][1] + b.y, v2 = acc[m][n][2] + b.z, v3 = acc[m][n][3] + b.w;
      if (kind < 4) {
        const float sc = kind < 2 ? 0.6065306597126334f : 1.0f;
        v0 = sc * sigmoidf_(v0); v1 = sc * sigmoidf_(v1); v2 = sc * sigmoidf_(v2); v3 = sc * sigmoidf_(v3);
      }
      uint2 o; o.x = pack2(v0, v1); o.y = pack2(v2, v3);
      *(uint2*)(O + (size_t)row * 1024 + col) = o;
    }
  }
}
DEV void phase_tm_lora_out(const Params& p, int j) {
  for (int unit = blockIdx.x; unit < 5 * 512; unit += gridDim.x) {
    const int kind = unit / 512, r = unit % 512, mt = r >> 2, ntile = r & 3;
    if (kind < 4) lora_out_unit<64>(p, j, kind, mt, ntile); else lora_out_unit<160>(p, j, kind, mt, ntile);
  }
  __syncthreads();
}

constexpr int LDP = 72;
constexpr int MATE = 64 * LDP;
DEV bf16_t* lbuf(int i) { return (bf16_t*)g_shm + i * MATE; }
DEV void bmm(const bf16_t* A, const bf16_t* Bt, int mb, int nh, int fr, int fq, f32x4 (&acc)[2]) {
  acc[0] = (f32x4){0.f, 0.f, 0.f, 0.f}; acc[1] = (f32x4){0.f, 0.f, 0.f, 0.f};
#pragma unroll
  for (int kk = 0; kk < 2; ++kk) {
    const bf16x8 a = *(const bf16x8*)(A + (mb * 16 + fr) * LDP + kk * 32 + fq * 8);
#pragma unroll
    for (int n = 0; n < 2; ++n) {
      const bf16x8 b = *(const bf16x8*)(Bt + (nh * 32 + n * 16 + fr) * LDP + kk * 32 + fq * 8);
      acc[n] = __builtin_amdgcn_mfma_f32_16x16x32_bf16(a, b, acc[n], 0, 0, 0);
    }
  }
}
DEV void st_rm(bf16_t* C, const f32x4 (&v)[2], int mb, int nh, int fr, int fq) {
#pragma unroll
  for (int n = 0; n < 2; ++n)
#pragma unroll
    for (int j = 0; j < 4; ++j) C[(mb * 16 + fq * 4 + j) * LDP + nh * 32 + n * 16 + fr] = f2bf(v[n][j]);
}
DEV void st_tr(bf16_t* CT, const f32x4 (&v)[2], int mb, int nh, int fr, int fq) {
#pragma unroll
  for (int n = 0; n < 2; ++n) {
    uint2 o; o.x = pack2(v[n][0], v[n][1]); o.y = pack2(v[n][2], v[n][3]);
    *(uint2*)(CT + (nh * 32 + n * 16 + fr) * LDP + mb * 16 + fq * 4) = o;
  }
}

DEV void phase_wkv_a(const Params& p, int jl, int slab) {
  const int TIDX = opaque_tid();
  const int wid = __builtin_amdgcn_readfirstlane(TIDX >> 6), lane = TIDX & 63, fr = lane & 15, fq = lane >> 4, mb = wid >> 1, nh = wid & 1;
  const bf16_t* Rb = (const bf16_t*)(kws() + OFF_R);
  const bf16_t* Kb = (const bf16_t*)(kws() + OFF_K);
  const bf16_t* Vb = (const bf16_t*)(kws() + OFF_V);
  float* PSI = (float*)(kws() + OFF_PSI);
  float* BON = (float*)(kws() + OFF_BON);
  float* segsum = (float*)(g_shm + 15 * MATE * 2);
  float* gTs = segsum + 512;
  bf16_t *mAtil = lbuf(0), *mBtil = lbuf(1), *mKtil = lbuf(2), *mRtil = lbuf(3), *mBgamT = lbuf(4), *mKgam = lbuf(5), *mAtilT = lbuf(6), *mVT = lbuf(7),
         *mMak = lbuf(10), *mMrk = lbuf(11), *mMrbT = lbuf(12);
  uint4 nr, nk, nv, na, ne;
  const int lr = TIDX >> 3, lc8 = (TIDX & 7) * 8;
  auto load_raw = [&](int u) {
    const int e2 = u & 1, h2 = (u >> 1) & 15, c2 = u >> 5;
    const bf16_t* A2 = (const bf16_t*)(kws() + (e2 ? OFF_A1 : OFF_A0));
    const bf16_t* E2 = (const bf16_t*)(kws() + (e2 ? OFF_E1 : OFF_E0));
    const size_t o = (size_t)c2 * 64 * 1024 + h2 * 64 + (size_t)lr * 1024 + lc8;
    nr = *(const uint4*)(Rb + o); nk = *(const uint4*)(Kb + o); nv = *(const uint4*)(Vb + o); na = *(const uint4*)(A2 + o); ne = *(const uint4*)(E2 + o);
  };
  if ((int)blockIdx.x < 256 * 32) load_raw(blockIdx.x);
  for (int unit = blockIdx.x; unit < 256 * 32; unit += gridDim.x) {
    const int e = unit & 1, h = (unit >> 1) & 15, c = unit >> 5;
    bf16_t* Ab = (bf16_t*)(kws() + (e ? OFF_A1 : OFF_A0));
    bf16_t* Eb = (bf16_t*)(kws() + (e ? OFF_E1 : OFF_E0));
    bf16_t* YL = (bf16_t*)(kws() + (e ? OFF_YLB : OFF_YLF));
    const size_t tile0 = (size_t)c * 64 * 1024 + h * 64;
    {
      const int jcol = lane, sg = wid;
      const float kkw = kin(23)[(size_t)jl * 1024 + h * 64 + jcol], kaw = kin(24)[(size_t)jl * 1024 + h * 64 + jcol], rkw = kin(25)[(size_t)jl * 1024 + h * 64 + jcol];
      *(uint4*)(lbuf(8) + lr * LDP + lc8) = nr; *(uint4*)(lbuf(9) + lr * LDP + lc8) = nk; *(uint4*)(lbuf(10) + lr * LDP + lc8) = nv;
      *(uint4*)(lbuf(11) + lr * LDP + lc8) = na; *(uint4*)(lbuf(12) + lr * LDP + lc8) = ne;
      LBAR2();
      if (unit + (int)gridDim.x < 256 * 32) load_raw(unit + gridDim.x);
      float rv[8], kv[8], vv[8], av[8], lw[8];
#pragma unroll
      for (int q = 0; q < 8; ++q) {
        const int tau = sg * 8 + q, tok = e ? 63 - tau : tau;
        rv[q] = bf2f(lbuf(8)[tok * LDP + jcol]); kv[q] = bf2f(lbuf(9)[tok * LDP + jcol]); vv[q] = bf2f(lbuf(10)[tok * LDP + jcol]);
        av[q] = bf2f(lbuf(11)[tok * LDP + jcol]); lw[q] = -bf2f(lbuf(12)[tok * LDP + jcol]);
      }
      float pre[8]; float run = 0.f;
#pragma unroll
      for (int q = 0; q < 8; ++q) { run += lw[q]; pre[q] = run; }
      segsum[sg * 64 + jcol] = run;
      LBAR2();
      float off = 0.f, tot = 0.f;
#pragma unroll
      for (int s2 = 0; s2 < 8; ++s2) { const float sv = segsum[s2 * 64 + jcol]; tot += sv; if (s2 < sg) off += sv; }
      if (sg == 0) gTs[jcol] = __expf(tot);
      float at[8], bg[8], vt[8];
#pragma unroll
      for (int q = 0; q < 8; ++q) {
        const int tau = sg * 8 + q, tok = e ? 63 - tau : tau;
        const float g = off + pre[q], gp = g - lw[q];
        const float kr = kv[q] * kkw;
        const float ss = wave_sum(kr * kr);
        const float kk = kr * __builtin_amdgcn_rsqf(fmaxf(ss, 1e-24f));
        const float b = kk * av[q], kd = kv[q] * (1.0f + (av[q] - 1.0f) * kaw);
        const float eg = __expf(g), eng = __expf(-g), egp = __expf(gp), egt = __expf(tot - g);
        const float atil = -kk * egp;
        mAtil[tau * LDP + jcol] = f2bf(atil);
        mBtil[tau * LDP + jcol] = f2bf(b * eng);
        mKtil[tau * LDP + jcol] = f2bf(kd * eng);
        mRtil[tau * LDP + jcol] = f2bf(rv[q] * eg);
        mKgam[tau * LDP + jcol] = f2bf(kd * egt);
        at[q] = atil; bg[q] = b * egt; vt[q] = vv[q];
        const float bon = wave_sum(rv[q] * kd * rkw);
        if (lane == 0) BON[((size_t)e * SLAB + c * 64 + tok) * 16 + h] = bon;
      }
      uint4 o;
      o.x = pack2(at[0], at[1]); o.y = pack2(at[2], at[3]); o.z = pack2(at[4], at[5]); o.w = pack2(at[6], at[7]);
      *(uint4*)(mAtilT + jcol * LDP + sg * 8) = o;
      o.x = pack2(bg[0], bg[1]); o.y = pack2(bg[2], bg[3]); o.z = pack2(bg[4], bg[5]); o.w = pack2(bg[6], bg[7]);
      *(uint4*)(mBgamT + jcol * LDP + sg * 8) = o;
      o.x = pack2(vt[0], vt[1]); o.y = pack2(vt[2], vt[3]); o.z = pack2(vt[4], vt[5]); o.w = pack2(vt[6], vt[7]);
      *(uint4*)(mVT + jcol * LDP + sg * 8) = o;
    }
    LBAR2();
    f32x4 acc[2], acc2[2];
    bmm(mBtil, mAtil, mb, nh, fr, fq, acc);
#pragma unroll
    for (int n = 0; n < 2; ++n)
#pragma unroll
      for (int j = 0; j < 4; ++j) { const int s = mb * 16 + fq * 4 + j, t = nh * 32 + n * 16 + fr; acc[n][j] = s < t ? acc[n][j] : 0.f; }
    st_rm(lbuf(8), acc, mb, nh, fr, fq); st_tr(lbuf(9), acc, mb, nh, fr, fq);
#pragma unroll
    for (int n = 0; n < 2; ++n)
#pragma unroll
      for (int j = 0; j < 4; ++j) { const int s = mb * 16 + fq * 4 + j, t = nh * 32 + n * 16 + fr; acc[n][j] += (s == t) ? 1.f : 0.f; }
    st_rm(lbuf(13), acc, mb, nh, fr, fq);
    f32x4 Wp[2] = {acc[0], acc[1]};
    bmm(mKtil, mAtil, mb, nh, fr, fq, acc);
#pragma unroll
    for (int n = 0; n < 2; ++n)
#pragma unroll
      for (int j = 0; j < 4; ++j) { const int s = mb * 16 + fq * 4 + j, t = nh * 32 + n * 16 + fr; acc[n][j] = s < t ? acc[n][j] : 0.f; }
    st_rm(mMak, acc, mb, nh, fr, fq);
    bmm(mKtil, mRtil, mb, nh, fr, fq, acc);
#pragma unroll
    for (int n = 0; n < 2; ++n)
#pragma unroll
      for (int j = 0; j < 4; ++j) { const int s = mb * 16 + fq * 4 + j, t = nh * 32 + n * 16 + fr; acc[n][j] = s <= t ? acc[n][j] : 0.f; }
    st_rm(mMrk, acc, mb, nh, fr, fq);
    bmm(mBtil, mRtil, mb, nh, fr, fq, acc);
#pragma unroll
    for (int n = 0; n < 2; ++n)
#pragma unroll
      for (int j = 0; j < 4; ++j) { const int s = mb * 16 + fq * 4 + j, t = nh * 32 + n * 16 + fr; acc[n][j] = s <= t ? acc[n][j] : 0.f; }
    st_tr(mMrbT, acc, mb, nh, fr, fq);
    LBAR2();
    bmm(lbuf(8), lbuf(9), mb, nh, fr, fq, acc);
    st_rm(lbuf(1), acc, mb, nh, fr, fq); st_tr(lbuf(2), acc, mb, nh, fr, fq);
    LBAR2();
#pragma unroll
    for (int k = 0; k < 4; ++k) {
      const int pc = (k & 1) ? 8 : 1, pn = (k & 1) ? 1 : 8, wc_ = (k & 1) ? 14 : 13, wn = (k & 1) ? 13 : 14;
      bmm(lbuf(wc_), lbuf(pc + 1), mb, nh, fr, fq, acc);
      bmm(lbuf(pc), lbuf(pc + 1), mb, nh, fr, fq, acc2);
      Wp[0] += acc[0]; Wp[1] += acc[1];
      st_rm(lbuf(wn), Wp, mb, nh, fr, fq);
      st_rm(lbuf(pn), acc2, mb, nh, fr, fq); st_tr(lbuf(pn + 1), acc2, mb, nh, fr, fq);
      LBAR2();
    }
    bmm(lbuf(13), lbuf(2), mb, nh, fr, fq, acc);
    Wp[0] += acc[0]; Wp[1] += acc[1];
    st_rm(lbuf(14), Wp, mb, nh, fr, fq);
    LBAR2();
    bmm(mMrbT, lbuf(14), mb, nh, fr, fq, acc);  st_rm(lbuf(8), acc, mb, nh, fr, fq);
    bmm(mBgamT, lbuf(14), mb, nh, fr, fq, acc); st_rm(lbuf(9), acc, mb, nh, fr, fq);
    LBAR2();
    bmm(lbuf(8), mMak, mb, nh, fr, fq, acc);
#pragma unroll
    for (int n = 0; n < 2; ++n)
#pragma unroll
      for (int j = 0; j < 4; ++j) { const int t = mb * 16 + fq * 4 + j, s = nh * 32 + n * 16 + fr; acc[n][j] += bf2f(mMrk[s * LDP + t]); }
    st_rm(lbuf(1), acc, mb, nh, fr, fq);
    bmm(lbuf(9), mMak, mb, nh, fr, fq, acc);
#pragma unroll
    for (int n = 0; n < 2; ++n)
#pragma unroll
      for (int j = 0; j < 4; ++j) { const int jj = mb * 16 + fq * 4 + j, s = nh * 32 + n * 16 + fr; acc[n][j] += bf2f(mKgam[s * LDP + jj]); }
    st_rm(lbuf(2), acc, mb, nh, fr, fq);
    bmm(mAtilT, lbuf(8), mb, nh, fr, fq, acc);
#pragma unroll
    for (int n = 0; n < 2; ++n) {
      const int j0 = mb * 16 + fq * 4, t = nh * 32 + n * 16 + fr;
      const uint2 rt = *(const uint2*)(mRtil + t * LDP + j0);
      uint2 o;
      o.x = pack2(acc[n][0] + __uint_as_float(rt.x << 16), acc[n][1] + __uint_as_float(rt.x & 0xffff0000u));
      o.y = pack2(acc[n][2] + __uint_as_float(rt.y << 16), acc[n][3] + __uint_as_float(rt.y & 0xffff0000u));
      *(uint2*)(Eb + tile0 + (size_t)t * 1024 + j0) = o;
    }
    bmm(mAtilT, lbuf(9), mb, nh, fr, fq, acc);
#pragma unroll
    for (int n = 0; n < 2; ++n) {
      const int j0 = mb * 16 + fq * 4, jp = nh * 32 + n * 16 + fr;
      uint2 o;
      o.x = pack2(acc[n][0] + (jp == j0 ? gTs[j0] : 0.f), acc[n][1] + (jp == j0 + 1 ? gTs[j0 + 1] : 0.f));
      o.y = pack2(acc[n][2] + (jp == j0 + 2 ? gTs[j0 + 2] : 0.f), acc[n][3] + (jp == j0 + 3 ? gTs[j0 + 3] : 0.f));
      *(uint2*)(Ab + tile0 + (size_t)jp * 1024 + j0) = o;
    }
    LBAR2();
    bmm(mVT, lbuf(1), mb, nh, fr, fq, acc);
#pragma unroll
    for (int n = 0; n < 2; ++n) {
      const int i0 = mb * 16 + fq * 4, t = nh * 32 + n * 16 + fr;
      uint2 o; o.x = pack2(acc[n][0], acc[n][1]); o.y = pack2(acc[n][2], acc[n][3]);
      *(uint2*)(YL + tile0 + (size_t)t * 1024 + i0) = o;
    }
    bmm(mVT, lbuf(2), mb, nh, fr, fq, acc);
    *(f32x4*)(PSI + (size_t)unit * 4096 + (size_t)(wid * 64 + lane) * 8) = acc[0];
    *(f32x4*)(PSI + (size_t)unit * 4096 + (size_t)(wid * 64 + lane) * 8 + 4) = acc[1];
  }
}

DEV void phase_wkv_b(const Params& p, int slab, int mode) {
  const int TIDX = opaque_tid();
  const int wid = __builtin_amdgcn_readfirstlane(TIDX >> 6), lane = TIDX & 63, fr = lane & 15, fq = lane >> 4, mb = wid >> 1, nh = wid & 1;
  const float* PSI = (const float*)(kws() + OFF_PSI);
  bf16_t* PHG = (bf16_t*)(kws() + OFF_PHG);
  float* PSG = (float*)(kws() + OFF_PSG);
  float* SST = (float*)(kws() + OFF_SST);
  const bool two_level = slab < 2;
  if (!two_level && mode != 3) return;
  const int nseq = two_level ? 1 : 8, cps = 256 / nseq;
  const int ngrp = two_level ? 8 : 1;
  bf16_t *Sb = lbuf(0), *PhT = lbuf(1), *OmT = lbuf(2), *Sa = lbuf(3);
  const int lr = TIDX >> 3, lc8 = (TIDX & 7) * 8;
  const size_t nat = (size_t)(wid * 64 + lane) * 8;
  if (mode == 2) {
    for (int chain = blockIdx.x; chain < 32; chain += gridDim.x) {
      f32x4 S[2];
      S[0] = (f32x4){0.f, 0.f, 0.f, 0.f}; S[1] = (f32x4){0.f, 0.f, 0.f, 0.f};
      for (int g = 0; g < 8; ++g) {
        const size_t item = (size_t)chain * 8 + g;
        *(f32x4*)(SST + item * 4096 + nat) = S[0]; *(f32x4*)(SST + item * 4096 + nat + 4) = S[1];
        const uint4 ph = *(const uint4*)(PHG + item * 4096 + lr * 64 + lc8);
        const f32x4 q0 = *(const f32x4*)(PSG + item * 4096 + nat), q1 = *(const f32x4*)(PSG + item * 4096 + nat + 4);
        st_rm(Sb, S, mb, nh, fr, fq);
        *(uint4*)(PhT + lr * LDP + lc8) = ph;
        LBAR2();
        f32x4 acc[2];
        bmm(Sb, PhT, mb, nh, fr, fq, acc);
        S[0] = acc[0] + q0; S[1] = acc[1] + q1;
        LBAR2();
      }
    }
    return;
  }
  for (int item = blockIdx.x; item < nseq * 32 * ngrp; item += gridDim.x) {
    const int chain = item / ngrp, grp = item % ngrp;
    const int e = chain & 1, h = (chain >> 1) & 15, sq = chain >> 5;
    const bf16_t* Ab = (const bf16_t*)(kws() + (e ? OFF_A1 : OFF_A0));
    const bf16_t* Eb = (const bf16_t*)(kws() + (e ? OFF_E1 : OFF_E0));
    bf16_t* YL = (bf16_t*)(kws() + (e ? OFF_YLB : OFF_YLF));
    const int sbase = grp * 32;
    f32x4 S[2], SA[2];
    if (mode == 3 && two_level) { S[0] = *(const f32x4*)(SST + (size_t)item * 4096 + nat); S[1] = *(const f32x4*)(SST + (size_t)item * 4096 + nat + 4); }
    else { S[0] = (f32x4){0.f, 0.f, 0.f, 0.f}; S[1] = (f32x4){0.f, 0.f, 0.f, 0.f}; }
#pragma unroll
    for (int n = 0; n < 2; ++n)
#pragma unroll
      for (int j = 0; j < 4; ++j) SA[n][j] = (mb * 16 + fq * 4 + j == nh * 32 + n * 16 + fr) ? 1.f : 0.f;
    uint4 ph0, ph1, ph2, ph3, om0, om1, om2, om3;
    f32x4 ps0[2], ps1[2], ps2[2], ps3[2];
    uint2 yl0[2], yl1[2], yl2[2], yl3[2];
#define WB_PREFETCH(step_, ph, om, ps, y8) do { \
      const int st_ = sbase + ((step_) < 32 ? (step_) : 31); \
      const int c_ = sq * cps + (e ? cps - 1 - st_ : st_); \
      const size_t t0_ = (size_t)c_ * 64 * 1024 + h * 64; \
      ph = *(const uint4*)(Ab + t0_ + (size_t)lr * 1024 + lc8); \
      const size_t u_ = ((size_t)c_ * 16 + h) * 2 + e; \
      ps[0] = *(const f32x4*)(PSI + u_ * 4096 + nat); ps[1] = *(const f32x4*)(PSI + u_ * 4096 + nat + 4); \
      if (mode == 3) { \
        om = *(const uint4*)(Eb + t0_ + (size_t)lr * 1024 + lc8); \
        y8[0] = *(const uint2*)(YL + t0_ + (size_t)(nh * 32 + fr) * 1024 + mb * 16 + fq * 4); \
        y8[1] = *(const uint2*)(YL + t0_ + (size_t)(nh * 32 + 16 + fr) * 1024 + mb * 16 + fq * 4); } } while (0)
#define WB_STEP(step_, ph, om, ps, y8) do { \
      const int c = sq * cps + (e ? cps - 1 - (sbase + (step_)) : (sbase + (step_))); \
      const size_t tile0 = (size_t)c * 64 * 1024 + h * 64; \
      bf16_t *Sb_ = lbuf(((step_) & 1) * 4), *PhT_ = lbuf(((step_) & 1) * 4 + 1), *OmT_ = lbuf(((step_) & 1) * 4 + 2), *Sa_ = lbuf(((step_) & 1) * 4 + 3); \
      st_rm(Sb_, S, mb, nh, fr, fq); \
      *(uint4*)(PhT_ + lr * LDP + lc8) = ph; \
      if (mode == 3) *(uint4*)(OmT_ + lr * LDP + lc8) = om; else st_rm(Sa_, SA, mb, nh, fr, fq); \
      const f32x4 psc0 = ps[0], psc1 = ps[1]; const uint2 ylc0 = y8[0], ylc1 = y8[1]; \
      LBAR2(); \
      WB_PREFETCH((step_) + 4, ph, om, ps, y8); \
      f32x4 acc[2]; \
      if (mode == 3) { \
        bmm(Sb_, OmT_, mb, nh, fr, fq, acc); \
        uint2 o; \
        o.x = pack2(acc[0][0] + __uint_as_float(ylc0.x << 16), acc[0][1] + __uint_as_float(ylc0.x & 0xffff0000u)); \
        o.y = pack2(acc[0][2] + __uint_as_float(ylc0.y << 16), acc[0][3] + __uint_as_float(ylc0.y & 0xffff0000u)); \
        *(uint2*)(YL + tile0 + (size_t)(nh * 32 + fr) * 1024 + mb * 16 + fq * 4) = o; \
        o.x = pack2(acc[1][0] + __uint_as_float(ylc1.x << 16), acc[1][1] + __uint_as_float(ylc1.x & 0xffff0000u)); \
        o.y = pack2(acc[1][2] + __uint_as_float(ylc1.y << 16), acc[1][3] + __uint_as_float(ylc1.y & 0xffff0000u)); \
        *(uint2*)(YL + tile0 + (size_t)(nh * 32 + 16 + fr) * 1024 + mb * 16 + fq * 4) = o; \
      } else { \
        bmm(Sa_, PhT_, mb, nh, fr, fq, acc); SA[0] = acc[0]; SA[1] = acc[1]; \
      } \
      bmm(Sb_, PhT_, mb, nh, fr, fq, acc); \
      S[0] = acc[0] + psc0; S[1] = acc[1] + psc1; } while (0)
    yl0[0] = yl0[1] = yl1[0] = yl1[1] = yl2[0] = yl2[1] = yl3[0] = yl3[1] = make_uint2(0u, 0u);
    om0 = om1 = om2 = om3 = make_uint4(0u, 0u, 0u, 0u);
    WB_PREFETCH(0, ph0, om0, ps0, yl0); WB_PREFETCH(1, ph1, om1, ps1, yl1); WB_PREFETCH(2, ph2, om2, ps2, yl2); WB_PREFETCH(3, ph3, om3, ps3, yl3);
    for (int step0 = 0; step0 < 32; step0 += 4) {
      WB_STEP(step0 + 0, ph0, om0, ps0, yl0);
      WB_STEP(step0 + 1, ph1, om1, ps1, yl1);
      WB_STEP(step0 + 2, ph2, om2, ps2, yl2);
      WB_STEP(step0 + 3, ph3, om3, ps3, yl3);
    }
    LBAR2();
    if (mode == 1) {
#pragma unroll
      for (int n = 0; n < 2; ++n) {
        uint2 o; o.x = pack2(SA[n][0], SA[n][1]); o.y = pack2(SA[n][2], SA[n][3]);
        *(uint2*)(PHG + (size_t)item * 4096 + (nh * 32 + n * 16 + fr) * 64 + mb * 16 + fq * 4) = o;
      }
      *(f32x4*)(PSG + (size_t)item * 4096 + nat) = S[0]; *(f32x4*)(PSG + (size_t)item * 4096 + nat + 4) = S[1];
    }
  }
}

DEV void phase_tm_post(const Params& p, int jl) {
  const int TIDX = opaque_tid();
  const int wid = TIDX >> 6, lane = TIDX & 63, hs = lane >> 4, c4 = (lane & 15) * 4;
  bf16_t* Rb = (bf16_t*)(kws() + OFF_R);
  const bf16_t* Vb = (const bf16_t*)(kws() + OFF_V);
  const bf16_t* Gb = (const bf16_t*)(kws() + OFF_G);
  const bf16_t* YF = (const bf16_t*)(kws() + OFF_YLF);
  const bf16_t* YB = (const bf16_t*)(kws() + OFF_YLB);
  const float* BON = (const float*)(kws() + OFF_BON);
  for (int item = blockIdx.x * 8 + wid; item < 2048; item += gridDim.x * 8) {
    const int hd = (item & 3) * 4 + hs, tb = (item >> 2) * 32;
    const int cch = hd * 64 + c4;
    const float4 lg = *(const float4*)(kin(26) + (size_t)jl * 1024 + cch), lb = *(const float4*)(kin(27) + (size_t)jl * 1024 + cch);
    struct PostRaw { uint2 yf, yb, v, g; float b0, b1; };
    auto load_raw = [&](int tt, PostRaw& w) {
      const int t = tb + (tt < 32 ? tt : 31);
      const size_t o = (size_t)t * 1024 + cch;
      const size_t ob = (size_t)((t & ~63) + 63 - (t & 63)) * 1024 + cch;
      w.yf = *(const uint2*)(YF + o); w.yb = *(const uint2*)(YB + ob); w.v = *(const uint2*)(Vb + o); w.g = *(const uint2*)(Gb + o);
      w.b0 = BON[(size_t)t * 16 + hd]; w.b1 = BON[((size_t)SLAB + t) * 16 + hd];
    };
    PostRaw w0, w1;
    load_raw(0, w0); load_raw(1, w1);
    for (int tt = 0; tt < 32; ++tt) {
      PostRaw w2; load_raw(tt + 2, w2);
      float y[4];
      y[0] = __uint_as_float(w0.yf.x << 16) + __uint_as_float(w0.yb.x << 16); y[1] = __uint_as_float(w0.yf.x & 0xffff0000u) + __uint_as_float(w0.yb.x & 0xffff0000u);
      y[2] = __uint_as_float(w0.yf.y << 16) + __uint_as_float(w0.yb.y << 16); y[3] = __uint_as_float(w0.yf.y & 0xffff0000u) + __uint_as_float(w0.yb.y & 0xffff0000u);
      const float mean = row_sum16((y[0] + y[1]) + (y[2] + y[3])) * (1.0f / 64.f);
      const float d0 = y[0] - mean, d1 = y[1] - mean, d2 = y[2] - mean, d3 = y[3] - mean;
      const float var = row_sum16((d0 * d0 + d1 * d1) + (d2 * d2 + d3 * d3)) * (1.0f / 64.f);
      const float rs = rsqrtf(var + 64e-5f), bon = w0.b0 + w0.b1;
      const float o0 = (d0 * rs * lg.x + lb.x + bon * __uint_as_float(w0.v.x << 16)) * __uint_as_float(w0.g.x << 16);
      const float o1 = (d1 * rs * lg.y + lb.y + bon * __uint_as_float(w0.v.x & 0xffff0000u)) * __uint_as_float(w0.g.x & 0xffff0000u);
      const float o2 = (d2 * rs * lg.z + lb.z + bon * __uint_as_float(w0.v.y << 16)) * __uint_as_float(w0.g.y << 16);
      const float o3 = (d3 * rs * lg.w + lb.w + bon * __uint_as_float(w0.v.y & 0xffff0000u)) * __uint_as_float(w0.g.y & 0xffff0000u);
      uint2 o; o.x = pack2(o0, o1); o.y = pack2(o2, o3);
      *(uint2*)(Rb + (size_t)(tb + tt) * 1024 + cch) = o;
      w0 = w1; w1 = w2;
    }
  }
}

DEV void wprep_sgu(const Params& p, int j) {
  wprep_T2((bf16_t*)(kws() + OFF_W + W_SG_IN), 1024, 0, kin(5) + (size_t)j * 1024 * 4096, 1024, 4096, nullptr, 128, 0);
  wprep_T2((bf16_t*)(kws() + OFF_W + W_SG_OUT), 2048, 0, kin(10) + (size_t)j * 2048 * 1024, 2048, 1024, nullptr, 128, 0);
}
DEV void wprep_ffn(const Params& p, int layer) {
  wprep_T2((bf16_t*)(kws() + OFF_W + W_FF_A), 1024, 0, kin(29) + (size_t)layer * 1024 * 2816, 1024, 2816, nullptr, 256, 0);
  wprep_T2((bf16_t*)(kws() + OFF_W + W_FF_A), 1024, 0, kin(30) + (size_t)layer * 1024 * 2816, 1024, 2816, nullptr, 256, 128);
  wprep_T2((bf16_t*)(kws() + OFF_W + W_FF_D), 2816, 0, kin(33) + (size_t)layer * 2816 * 1024, 2816, 1024, nullptr, 128, 0);
}
DEV void wprep_tm(const Params& p, int j) {
  const int TIDX = opaque_tid();
  bf16_t* WP = (bf16_t*)(kws() + OFF_W + W_TM_P);
  const float* srcs[3] = {kin(12) + (size_t)j * 1048576, kin(13) + (size_t)j * 1048576, kin(14) + (size_t)j * 1048576};
#pragma unroll
  for (int i = 0; i < 3; ++i) wprep_T2(WP, 1024, 0, srcs[i], 1024, 1024, nullptr, 128, i * 1024);
#pragma unroll
  for (int e = 0; e < 2; ++e) {
    wprep_T(WP, 1024, 0, kin(16) + ((size_t)j * 2 + e) * 1024 * 64, 1024, 64, nullptr, 128, 3072 + 64 * e);
    wprep_T(WP, 1024, 0, kin(19) + ((size_t)j * 2 + e) * 1024 * 64, 1024, 64, nullptr, 128, 3328 + 64 * e);
    wprep_T2((bf16_t*)(kws() + OFF_W + W_TM_W2) + (size_t)e * 1024 * 64, 64, 0, kin(17) + ((size_t)j * 2 + e) * 64 * 1024, 64, 1024, nullptr, 128, 0);
    wprep_T2((bf16_t*)(kws() + OFF_W + W_TM_A2) + (size_t)e * 1024 * 64, 64, 0, kin(20) + ((size_t)j * 2 + e) * 64 * 1024, 64, 1024, nullptr, 128, 0);
  }
  wprep_T(WP, 1024, 0, kin(21) + (size_t)j * 1024 * 160, 1024, 160, nullptr, 128, 3584);
  for (size_t i = (size_t)blockIdx.x * 512 + TIDX; i < (size_t)(128 + 128 + 96) * 512; i += (size_t)gridDim.x * 512) {
    const size_t row = i / 512, w = i % 512;
    const size_t drow = row < 128 ? 3200 + row : (row < 256 ? 3456 + (row - 128) : 3744 + (row - 256));
    ((unsigned*)(WP + drow * 1024))[w] = 0u;
  }
  wprep_T((bf16_t*)(kws() + OFF_W + W_TM_G2), 160, 0, kin(22) + (size_t)j * 160 * 1024, 160, 1024, nullptr, 128, 0);
  wprep_T2((bf16_t*)(kws() + OFF_W + W_TM_O), 1024, 0, kin(28) + (size_t)j * 1048576, 1024, 1024, nullptr, 128, 0);
}

constexpr int PH_SGU = 10, PH_FFN = 3, PH_TM = 25;
constexpr int N_PHASES = 2 * (PH_SGU + PH_FFN) + 2 * (PH_TM + PH_FFN) + 1;

DEV void run_phase(const Params& p, int ph) {
  if (ph == N_PHASES - 1) { phase_final(p); return; }
  int q = ph, layer = 0;
  for (;;) {
    const int len = (layer & 1) ? PH_TM + PH_FFN : PH_SGU + PH_FFN;
    if (q < len) break;
    q -= len; ++layer;
  }
  const int j = layer >> 1;
  bf16_t* H0 = (bf16_t*)(kws() + OFF_H0);
  const int nmix = (layer & 1) ? PH_TM : PH_SGU;
  if (q >= nmix) {
    const int f = q - nmix;
    if (f == 0) { phase_norm<false>(p, kin(3) + (size_t)layer * 1024, H0); wprep_ffn(p, layer); }
    else if (f == 1) phase_ffn_a(p, layer);
    else phase_gemm_res(p, (const bf16_t*)(kws() + OFF_HMID), 2816, (const bf16_t*)(kws() + OFF_W + W_FF_D), 2816, 192, 0);
    return;
  }
  if (!(layer & 1)) {
    if (q == 0) { if (layer == 0) phase_norm<true>(p, kin(2), H0); else phase_norm<false>(p, kin(2) + (size_t)layer * 1024, H0); wprep_sgu(p, j); return; }
    const int slab = (q - 1) / 3, s = (q - 1) % 3;
    if (s == 0) phase_sgu_in(p, j, slab);
    else if (s == 1) phase_sgu_mix(p, j);
    else phase_gemm_res(p, (const bf16_t*)(kws() + OFF_U), 4096, (const bf16_t*)(kws() + OFF_W + W_SG_OUT), 2048, 64, (long)slab * SLAB);
    return;
  }
  {
    const int slab = q < 18 ? q / 9 : 2;
    int s = q < 18 ? q % 9 : q - 18;
    if (slab == 2 && s >= 4) s += 2;
    switch (s) {
      case 0: phase_norm_tm(p, kin(2) + (size_t)layer * 1024, kin(11) + (size_t)j * 6 * 1024, (bf16_t*)(kws() + OFF_MIX), slab); if (slab == 0) wprep_tm(p, j); break;
      case 1: phase_tm_proj(p); break;
      case 2: phase_tm_lora_out(p, j); break;
      case 3: phase_wkv_a(p, j, slab); break;
      case 4: phase_wkv_b(p, slab, 1); break;
      case 5: phase_wkv_b(p, slab, 2); break;
      case 6: phase_wkv_b(p, slab, 3); break;
      case 7: phase_tm_post(p, j); break;
      default: phase_gemm_res(p, (const bf16_t*)(kws() + OFF_R), 1024, (const bf16_t*)(kws() + OFF_W + W_TM_O), 1024, 64, (long)slab * SLAB); break;
    }
  }
}

#ifndef PROBE_CAT
#define PROBE_CAT -1
#endif
DEV int phase_cat(int ph) {
  if (ph == N_PHASES - 1) return 2;
  int q = ph, layer = 0;
  for (;;) { const int len = (layer & 1) ? PH_TM + PH_FFN : PH_SGU + PH_FFN; if (q < len) break; q -= len; ++layer; }
  const int nmix = (layer & 1) ? PH_TM : PH_SGU;
  if (q >= nmix) return (q - nmix) == 0 ? 2 : ((q - nmix) == 1 ? 7 : 8);
  if (!(layer & 1)) { if (q == 0) return 2; const int s = (q - 1) % 3; return s == 1 ? 3 : 0; }
  int s = q < 18 ? q % 9 : q - 18; if (q >= 18 && s >= 4) s += 2;
  return s == 0 ? 2 : (s == 1 || s == 8) ? 0 : (s == 2 ? 4 : (s == 3 ? 1 : (s == 7 ? 6 : 5)));
}
__global__ void __launch_bounds__(512, 2) mega(Params p, int ph_lo, int ph_hi, int coop) {
#if PROBE_CAT >= 0
  if (blockIdx.x == 0 && threadIdx.x == 0) ((unsigned long long*)(kws() + 500 * MiB))[0] = wall_clock64();
#endif
  for (int ph = ph_lo; ph < ph_hi; ++ph) {
    run_phase(p, ph);
    if (coop && ph + 1 < ph_hi) cg::this_grid().sync();
#if PROBE_CAT >= 0
    if (blockIdx.x == 0 && threadIdx.x == 0) ((unsigned long long*)(kws() + 500 * MiB))[ph + 1] = wall_clock64();
#endif
  }
#if PROBE_CAT >= 0
  cg::this_grid().sync();
  if (blockIdx.x == 0 && threadIdx.x == 0) {
    const unsigned long long* ts = (const unsigned long long*)(kws() + 500 * MiB);
    unsigned long long acc = 0;
    for (int ph = 0; ph < N_PHASES; ++ph) if (PROBE_CAT == 9 || phase_cat(ph) == PROBE_CAT) acc += ts[ph + 1] - ts[ph];
    ((float*)(kws() + 500 * MiB))[1024] = (float)acc * (0.01f * 2e-5f);
  }
  __syncthreads();
  if (blockIdx.x == 0) {
    __threadfence();
    const float ev = ((volatile float*)(kws() + 500 * MiB))[1024];
    for (int i = threadIdx.x; i < 4096; i += 512) kx()[i] += ev;
    for (int i = threadIdx.x; i < 2048; i += 512) kx()[(size_t)32768 * 1024 + i] += ev;
  }
#endif
}

extern "C" void kernel_launch(void* const* d_in, const int* in_sizes, int n_in, void* d_out, int out_size, void* d_ws, size_t ws_size, hipStream_t stream) {
  static int grid = 0;
  if (!grid) {
    int dev = 0, cus = 0, per_cu = 0;
    (void)hipFuncSetAttribute((const void*)mega, hipFuncAttributeMaxDynamicSharedMemorySize, SHM_BYTES);
    (void)hipGetDevice(&dev);
    (void)hipDeviceGetAttribute(&cus, hipDeviceAttributeMultiprocessorCount, dev);
    (void)hipOccupancyMaxActiveBlocksPerMultiprocessor(&per_cu, (const void*)mega, 512, SHM_BYTES);
    if (per_cu < 1) per_cu = 1;
    grid = cus * per_cu;
    if (grid > 256) grid = 256;
    if (grid & 7) grid &= ~7;
  }
  Params p{};
  for (int i = 0; i < 34; ++i) p.in[i] = (const float*)d_in[i];
  p.x = (float*)d_out;
  p.ws = (char*)d_ws;
  int ph_lo = 0, ph_hi = N_PHASES, coop = 1;
  void* args[] = {&p, &ph_lo, &ph_hi, &coop};
  hipError_t e = hipLaunchCooperativeKernel((const void*)mega, dim3(grid), dim3(512), args, SHM_BYTES, stream);
  if (e != hipSuccess) fprintf(stderr, "cooperative launch failed: %s (grid %d)\n", hipGetErrorString(e), grid);
}
```

```cpp
#define PROBE_CAT -1
#include <hip/hip_runtime.h>
#include <hip/hip_cooperative_groups.h>
#include <cstdio>
namespace cg = cooperative_groups;

#define DEV __device__ __forceinline__
typedef unsigned short bf16_t;
typedef short bf16x8 __attribute__((ext_vector_type(8)));
typedef float f32x4 __attribute__((ext_vector_type(4)));

extern __shared__ __attribute__((aligned(16))) char g_shm[];

constexpr int NT = 49152, SLAB = 16384;
constexpr int SHM_BYTES = 147456;
constexpr size_t MiB = 1u << 20;
constexpr size_t OFF_W = 0;
constexpr size_t OFF_H = 24 * MiB;
constexpr size_t OFF_H0 = OFF_H + 256 * 2048;
constexpr size_t OFF_U = 122 * MiB, OFF_SSQ = 250 * MiB;
constexpr size_t OFF_HMID = 122 * MiB;
constexpr size_t OFF_MIX = 200 * MiB;
constexpr size_t OFF_HX = 24 * MiB, OFF_YLF = 24 * MiB, OFF_YLB = 56 * MiB, OFF_R = 88 * MiB, OFF_K = 120 * MiB, OFF_V = 152 * MiB,
                 OFF_HL = 184 * MiB, OFF_E0 = 200 * MiB, OFF_E1 = 232 * MiB, OFF_A0 = 264 * MiB, OFF_A1 = 296 * MiB, OFF_G = 328 * MiB,
                 OFF_PSI = 360 * MiB, OFF_BON = 488 * MiB, OFF_PHG = 490 * MiB, OFF_PSG = 492 * MiB, OFF_SST = 496 * MiB;
constexpr size_t W_SG_IN = 0, W_SG_OUT = 8 * MiB;
constexpr size_t W_FF_A = 0, W_FF_D = 12 * MiB;
constexpr size_t W_TM_P = 0, W_TM_O = 14 * MiB, W_TM_W2 = 16 * MiB, W_TM_A2 = 16 * MiB + 512 * 1024, W_TM_G2 = 17 * MiB;

struct Params {
  const float* in[34];
  float* x;
  char* ws;
};


typedef const __attribute__((address_space(4))) char* karg_t;
DEV int opaque0() { int z = 0; asm volatile("" : "+s"(z)); return z; }
DEV const float* kin(int i) { karg_t kp = (karg_t)__builtin_amdgcn_kernarg_segment_ptr(); return *(const float* const __attribute__((address_space(4)))*)(kp + (i + opaque0()) * 8); }
DEV float* kx() { karg_t kp = (karg_t)__builtin_amdgcn_kernarg_segment_ptr(); return *(float* const __attribute__((address_space(4)))*)(kp + (34 + opaque0()) * 8); }
DEV char* kws() { karg_t kp = (karg_t)__builtin_amdgcn_kernarg_segment_ptr(); return *(char* const __attribute__((address_space(4)))*)(kp + (35 + opaque0()) * 8); }

DEV int opaque_tid() { int z = 0; asm volatile("" : "+v"(z)); return (int)threadIdx.x + z; }
#define LBAR2() do { asm volatile("s_waitcnt lgkmcnt(0)" ::: "memory"); __builtin_amdgcn_s_barrier(); asm volatile("" ::: "memory"); } while (0)
DEV float bf2f(bf16_t u) { return __uint_as_float(((unsigned)u) << 16); }
typedef float f32x2 __attribute__((ext_vector_type(2)));
typedef __bf16 bf16x2_t __attribute__((ext_vector_type(2)));
DEV unsigned pack2(float a, float b) { f32x2 v = {a, b}; bf16x2_t h = __builtin_convertvector(v, bf16x2_t); return __builtin_bit_cast(unsigned, h); }
DEV bf16_t f2bf(float f) { return (bf16_t)(pack2(f, f) & 0xffffu); }
template <int CTRL> DEV float dppmov(float v) { return __int_as_float(__builtin_amdgcn_update_dpp(0, __float_as_int(v), CTRL, 0xf, 0xf, true)); }
DEV float row_sum16(float v) {
  v += dppmov<0xB1>(v); v += dppmov<0x4E>(v); v += dppmov<0x141>(v); v += dppmov<0x140>(v);
  return v;
}
DEV float wave_sum(float v) {
  const int r = __float_as_int(row_sum16(v));
  return (__int_as_float(__builtin_amdgcn_readlane(r, 0)) + __int_as_float(__builtin_amdgcn_readlane(r, 16))) +
         (__int_as_float(__builtin_amdgcn_readlane(r, 32)) + __int_as_float(__builtin_amdgcn_readlane(r, 48)));
}
DEV float sigmoidf_(float x) { return 1.0f / (1.0f + __expf(-x)); }
DEV f32x2 gelu_pk(f32x2 v) {
  const f32x2 av = __builtin_elementwise_abs(v), d = av * 0.2316418882f + 1.0f;
  f32x2 t; t.x = __builtin_amdgcn_rcpf(d.x); t.y = __builtin_amdgcn_rcpf(d.y);
  f32x2 q = t * 0.5307027145f + (-0.7265760135f); q = q * t + 0.7107068705f; q = q * t + (-0.142248368f); q = q * t + 0.127414796f; q = q * t;
  const f32x2 s = (v * v) * (-0.72134752044f);
  f32x2 e; e.x = __builtin_amdgcn_exp2f(s.x); e.y = __builtin_amdgcn_exp2f(s.y);
  const f32x2 m = v * (q * e), r = v - m;
  f32x2 o; o.x = v.x < 0.f ? m.x : r.x; o.y = v.y < 0.f ? m.y : r.y; return o;
}
DEV float gelu_exact(float v) {
  const float av = fabsf(v), d = av * 0.2316418882f + 1.0f;
  const float t = __builtin_amdgcn_rcpf(d);
  float q = t * 0.5307027145f + (-0.7265760135f); q = q * t + 0.7107068705f; q = q * t + (-0.142248368f); q = q * t + 0.127414796f; q = q * t;
  const float e = __builtin_amdgcn_exp2f((v * v) * (-0.72134752044f));
  const float m = v * (q * e), r = v - m;
  return v < 0.f ? m : r;
}

DEV void phase_init(const Params& p) {
  const int TIDX = opaque_tid();
  const float4* xp = (const float4*)kin(0);
  const float4* xs = (const float4*)kin(1);
  float4* x = (float4*)kx();
  const size_t n0 = (size_t)32768 * 256, n1 = (size_t)16384 * 256;
  for (size_t i = (size_t)blockIdx.x * 512 + TIDX; i < n0 + n1; i += (size_t)gridDim.x * 512) x[i] = i < n0 ? xp[i] : xs[i - n0];
}

template <bool FROM_INPUT>
DEV void phase_norm(const Params& p, const float* g, bf16_t* h0) {
  const int TIDX = opaque_tid();
  const int wid = TIDX >> 6, lane = TIDX & 63;
  float4 gv[4];
#pragma unroll
  for (int i = 0; i < 4; ++i) gv[i] = ((const float4*)g)[lane + 64 * i];
  const int tstep = gridDim.x * 8;
  auto row_ptr = [&](int t) -> const float4* {
    const int tc = t < NT ? t : NT - 1;
    return FROM_INPUT ? (const float4*)(tc < 32768 ? kin(0) + (size_t)tc * 1024 : kin(1) + (size_t)(tc - 32768) * 1024)
                      : (const float4*)(kx() + (size_t)tc * 1024);
  };
  float4 nx[4];
  { const float4* xr = row_ptr(blockIdx.x * 8 + wid);
#pragma unroll
    for (int i = 0; i < 4; ++i) nx[i] = xr[lane + 64 * i]; }
  for (int t = blockIdx.x * 8 + wid; t < NT; t += tstep) {
    float4 v[4]; float ss = 0.f;
#pragma unroll
    for (int i = 0; i < 4; ++i) { v[i] = nx[i]; ss += v[i].x * v[i].x + v[i].y * v[i].y + v[i].z * v[i].z + v[i].w * v[i].w; }
    { const float4* xr = row_ptr(t + tstep);
#pragma unroll
      for (int i = 0; i < 4; ++i) nx[i] = xr[lane + 64 * i]; }
    if (FROM_INPUT) {
      float4* xw = (float4*)(kx() + (size_t)t * 1024);
#pragma unroll
      for (int i = 0; i < 4; ++i) xw[lane + 64 * i] = v[i];
    }
    ss = wave_sum(ss);
    const float rs = rsqrtf(ss * (1.0f / 1024.f) + 1e-6f);
    uint2* hr = (uint2*)(h0 + (size_t)t * 1024);
#pragma unroll
    for (int i = 0; i < 4; ++i) {
      uint2 o; o.x = pack2(v[i].x * rs * gv[i].x, v[i].y * rs * gv[i].y); o.y = pack2(v[i].z * rs * gv[i].z, v[i].w * rs * gv[i].w);
      hr[lane + 64 * i] = o;
    }
  }
}

DEV void phase_norm_tm(const Params& p, const float* g, const float* mu, bf16_t* mixb, int slab) {
  const int TIDX = opaque_tid();
  const int wid = TIDX >> 6, lane = TIDX & 63;
  const int L = slab < 2 ? 16384 : 2048;
  float4 gv[4], muv[6][4];
#pragma unroll
  for (int i = 0; i < 4; ++i) gv[i] = ((const float4*)g)[lane + 64 * i];
#pragma unroll
  for (int m = 0; m < 6; ++m)
#pragma unroll
    for (int i = 0; i < 4; ++i) muv[m][i] = ((const float4*)(mu + m * 1024))[lane + 64 * i];
  for (int ts = blockIdx.x * 8 + wid; ts < SLAB; ts += gridDim.x * 8) {
    const int t = slab * SLAB + ts, pos = ts & (L - 1);
    float4 hv[3][4];
#pragma unroll
    for (int d = 0; d < 3; ++d) {
      const bool valid = !((d == 0 && pos == 0) || (d == 2 && pos == L - 1));
      const int tt = valid ? t + d - 1 : t;
      const float4* xr = (const float4*)(kx() + (size_t)tt * 1024);
      float ss = 0.f;
#pragma unroll
      for (int i = 0; i < 4; ++i) { float4 v = xr[lane + 64 * i]; hv[d][i] = v; ss += v.x * v.x + v.y * v.y + v.z * v.z + v.w * v.w; }
      ss = wave_sum(ss);
      const float rs = valid ? rsqrtf(ss * (1.0f / 1024.f) + 1e-6f) : 0.f;
#pragma unroll
      for (int i = 0; i < 4; ++i) { hv[d][i].x *= rs * gv[i].x; hv[d][i].y *= rs * gv[i].y; hv[d][i].z *= rs * gv[i].z; hv[d][i].w *= rs * gv[i].w; }
    }
#pragma unroll
    for (int i = 0; i < 4; ++i) {
      hv[0][i].x = 0.5f * (hv[0][i].x + hv[2][i].x) - hv[1][i].x; hv[0][i].y = 0.5f * (hv[0][i].y + hv[2][i].y) - hv[1][i].y;
      hv[0][i].z = 0.5f * (hv[0][i].z + hv[2][i].z) - hv[1][i].z; hv[0][i].w = 0.5f * (hv[0][i].w + hv[2][i].w) - hv[1][i].w;
    }
#pragma unroll
    for (int m = 0; m < 6; ++m) {
      uint2* orow = (uint2*)(mixb + ((size_t)m * SLAB + ts) * 1024);
#pragma unroll
      for (int i = 0; i < 4; ++i) {
        const float4 mv = muv[m][i];
        uint2 o;
        o.x = pack2(hv[1][i].x + hv[0][i].x * mv.x, hv[1][i].y + hv[0][i].y * mv.y);
        o.y = pack2(hv[1][i].z + hv[0][i].z * mv.z, hv[1][i].w + hv[0][i].w * mv.w);
        orow[lane + 64 * i] = o;
      }
    }
  }
}

DEV void phase_final(const Params& p) {
  const int TIDX = opaque_tid();
  const int wid = TIDX >> 6, lane = TIDX & 63;
  const float* g = kin(4);
  float4 gv[4];
#pragma unroll
  for (int i = 0; i < 4; ++i) gv[i] = ((const float4*)g)[lane + 64 * i];
  for (int t = blockIdx.x * 8 + wid; t < NT; t += gridDim.x * 8) {
    float4* xr = (float4*)(kx() + (size_t)t * 1024);
    float4 v[4]; float ss = 0.f;
#pragma unroll
    for (int i = 0; i < 4; ++i) { v[i] = xr[lane + 64 * i]; ss += v[i].x * v[i].x + v[i].y * v[i].y + v[i].z * v[i].z + v[i].w * v[i].w; }
    ss = wave_sum(ss);
    const float rs = rsqrtf(ss * (1.0f / 1024.f) + 1e-6f);
#pragma unroll
    for (int i = 0; i < 4; ++i) {
      float4 o; o.x = v[i].x * rs * gv[i].x; o.y = v[i].y * rs * gv[i].y; o.z = v[i].z * rs * gv[i].z; o.w = v[i].w * rs * gv[i].w;
      xr[lane + 64 * i] = o;
    }
  }
}

DEV void wprep_T(bf16_t* dst, int ldd, int koff, const float* src, int Ks, int Ns, const float* scale, int rs, int roff) {
  const int TIDX = opaque_tid();
  float (*tile)[33] = (float (*)[33])g_shm;
  const int tx = TIDX & 31, ty = TIDX >> 5;
  const int nkt = Ks / 32, nnt = Ns / 32;
  for (int tIdx = blockIdx.x; tIdx < nkt * nnt; tIdx += gridDim.x) {
    const int k0 = (tIdx / nnt) * 32, n0 = (tIdx % nnt) * 32;
    __syncthreads();
#pragma unroll
    for (int i = 0; i < 2; ++i) tile[ty + 16 * i][tx] = src[(size_t)(k0 + ty + 16 * i) * Ns + n0 + tx];
    __syncthreads();
    const float sc = scale ? scale[k0 + tx] : 1.0f;
#pragma unroll
    for (int i = 0; i < 2; ++i) {
      const int n = n0 + ty + 16 * i;
      const int drow = (n >> 7) * rs + (n & 127) + roff;
      dst[(size_t)drow * ldd + koff + k0 + tx] = f2bf(tile[tx][ty + 16 * i] * sc);
    }
  }
  __syncthreads();
}


DEV void wprep_T2(bf16_t* dst, int ldd, int koff, const float* src, int Ks, int Ns, const float* scale, int rs, int roff) {
  const int TIDX = opaque_tid();
  float* tile = (float*)g_shm;
  const int nkt = Ks / 64, nnt = Ns / 128;
  const int lc = TIDX & 127, lr = TIDX >> 7;
  const int wk = TIDX & 63, wn = TIDX >> 6;
  for (int tIdx = blockIdx.x; tIdx < nkt * nnt; tIdx += gridDim.x) {
    const int k0 = (tIdx / nnt) * 64, n0 = (tIdx % nnt) * 128;
    float v[16];
#pragma unroll
    for (int i = 0; i < 16; ++i) v[i] = src[(size_t)(k0 + i * 4 + lr) * Ns + n0 + lc];
    __syncthreads();
#pragma unroll
    for (int i = 0; i < 16; ++i) tile[(i * 4 + lr) * 129 + lc] = v[i];
    __syncthreads();
    const float sc = scale ? scale[k0 + wk] : 1.0f;
#pragma unroll
    for (int i = 0; i < 16; ++i) {
      const int n = n0 + i * 8 + wn;
      const int drow = (n >> 7) * rs + (n & 127) + roff;
      dst[(size_t)drow * ldd + koff + k0 + wk] = f2bf(tile[wk * 129 + i * 8 + wn] * sc);
    }
  }
  __syncthreads();
}

constexpr int BM = 256, BK = 64, HALF = 128, HT = HALF * BK;
DEV int lds_byte(int r, int c) {
  int st = (r >> 4) * 2 + (c >> 5), rr = r & 15, cc = c & 31, ob = rr * 64 + cc * 2;
  return st * 1024 + (ob ^ (((ob >> 9) & 1) << 5));
}
DEV void stage_rc(int b, int& R, int& C) {
  int st = b / 1024, sb = b % 1024, swz = sb ^ (((sb >> 9) & 1) << 5);
  R = (st >> 1) * 16 + swz / 64; C = (st & 1) * 32 + (swz % 64) / 2;
}

typedef __attribute__((address_space(3))) unsigned char lds_u8;
DEV void gemm_big(const bf16_t* A, long lda, const bf16_t* Bt, long ldb, int K, long brow, long bcol, f32x4 (&acc)[2][2][4][2]) {
  const int TIDX = opaque_tid();
  lds_u8* lds = (lds_u8*)g_shm;
  constexpr int HTB = HT * 2;
#define SA(b, h) (((b) * 2 + (h)) * HTB)
#define SB(b, h) ((4 + (b) * 2 + (h)) * HTB)
#define STAGE(bufoff, gbase, VO, kt) do { const char* _gp = (gbase) + (size_t)(kt) * (BK * 2); \
    __builtin_amdgcn_global_load_lds((const unsigned*)(_gp + VO##0), (__attribute__((address_space(3))) unsigned*)(lds + (bufoff) + ldsw), 16, 0, 0); \
    __builtin_amdgcn_global_load_lds((const unsigned*)(_gp + VO##1), (__attribute__((address_space(3))) unsigned*)(lds + (bufoff) + ldsw + 8192), 16, 0, 0); } while (0)
#define LDA(dst, b, h) for (int m = 0; m < 4; ++m) for (int k = 0; k < 2; ++k) \
    dst[m][k] = *(const __attribute__((address_space(3))) bf16x8*)(lds + SA(b, h) + aoff + m * 2048 + k * 1024)
#define LDB(dst, b, h) for (int n = 0; n < 2; ++n) for (int k = 0; k < 2; ++k) \
    dst[n][k] = *(const __attribute__((address_space(3))) bf16x8*)(lds + SB(b, h) + boff + n * 2048 + k * 1024)
#define MMA(ai, bj, At, Bt_) do { __builtin_amdgcn_s_setprio(1); \
    for (int m = 0; m < 4; ++m) for (int n = 0; n < 2; ++n) for (int k = 0; k < 2; ++k) \
      acc[ai][bj][m][n] = __builtin_amdgcn_mfma_f32_16x16x32_bf16(Bt_[n][k], At[m][k], acc[ai][bj][m][n], 0, 0, 0); \
    __builtin_amdgcn_s_setprio(0); } while (0)
#define WAIT_V(n) asm volatile("s_waitcnt vmcnt(" #n ")" ::: "memory")
#define WAIT_L(n) asm volatile("s_waitcnt lgkmcnt(" #n ")" ::: "memory")
#define BAR __builtin_amdgcn_s_barrier()
#define SCHED __builtin_amdgcn_sched_barrier(0)
  const int tid = TIDX, wid = __builtin_amdgcn_readfirstlane(tid >> 6), lane = tid & 63, wr = wid >> 2, wc = wid & 3, fr = lane & 15, fq = lane >> 4;
  unsigned va0, va1, vb0, vb1;
  { int r_, c_; stage_rc(tid * 16, r_, c_); va0 = (unsigned)((r_ * lda + c_) * 2); vb0 = (unsigned)((r_ * ldb + c_) * 2);
    stage_rc(tid * 16 + 8192, r_, c_); va1 = (unsigned)((r_ * lda + c_) * 2); vb1 = (unsigned)((r_ * ldb + c_) * 2); }
  const unsigned ldsw = (unsigned)wid * 1024u;
  const int aoff = lds_byte(wr * 64 + fr, fq * 8), boff = lds_byte(wc * 32 + fr, fq * 8);
  const char* cA0 = (const char*)(A + brow * lda); const char* cA1 = cA0 + (size_t)HALF * lda * 2;
  const char* cB0 = (const char*)(Bt + bcol * ldb); const char* cB1 = cB0 + (size_t)HALF * ldb * 2;
#pragma unroll
  for (int a = 0; a < 2; ++a)
#pragma unroll
    for (int b = 0; b < 2; ++b)
#pragma unroll
      for (int m = 0; m < 4; ++m)
#pragma unroll
        for (int n = 0; n < 2; ++n) acc[a][b][m][n] = (f32x4){0.f, 0.f, 0.f, 0.f};
  bf16x8 At[4][2], B0[2][2], B1[2][2];
  const int nt = K / BK;
  STAGE(SB(0, 0), cB0, vb, 0); STAGE(SA(0, 0), cA0, va, 0);
  STAGE(SB(0, 1), cB1, vb, 0); STAGE(SA(0, 1), cA1, va, 0);
  if (wr == 1) BAR;
  WAIT_V(4); BAR;
  STAGE(SB(1, 0), cB0, vb, 1); STAGE(SA(1, 0), cA0, va, 1); STAGE(SB(1, 1), cB1, vb, 1);
  WAIT_V(6); BAR;
  for (int t = 0; t < nt - 2; t += 2) {
    LDB(B0, 0, 0); SCHED; LDA(At, 0, 0); STAGE(SA(1, 1), cA1, va, t + 1);
    WAIT_L(8); BAR; WAIT_L(0); MMA(0, 0, At, B0); BAR; SCHED;
    LDB(B1, 0, 1); STAGE(SB(0, 0), cB0, vb, t + 2);
    BAR; WAIT_L(0); MMA(0, 1, At, B1); BAR;
    LDA(At, 0, 1); STAGE(SA(0, 0), cA0, va, t + 2);
    BAR; WAIT_L(0); MMA(1, 0, At, B0); BAR; SCHED;
    STAGE(SB(0, 1), cB1, vb, t + 2);
    WAIT_V(6); BAR; MMA(1, 1, At, B1); BAR;
    LDB(B0, 1, 0); SCHED; LDA(At, 1, 0); STAGE(SA(0, 1), cA1, va, t + 2);
    WAIT_L(8); BAR; WAIT_L(0); MMA(0, 0, At, B0); BAR; SCHED;
    LDB(B1, 1, 1); STAGE(SB(1, 0), cB0, vb, t + 3);
    BAR; WAIT_L(0); MMA(0, 1, At, B1); BAR;
    LDA(At, 1, 1); STAGE(SA(1, 0), cA0, va, t + 3);
    BAR; WAIT_L(0); MMA(1, 0, At, B0); BAR; SCHED;
    STAGE(SB(1, 1), cB1, vb, t + 3);
    WAIT_V(6); BAR; MMA(1, 1, At, B1); BAR;
  }
  { LDB(B0, 0, 0); LDA(At, 0, 0); STAGE(SA(1, 1), cA1, va, nt - 1);
    BAR; WAIT_L(0); MMA(0, 0, At, B0); BAR;
    LDB(B1, 0, 1); BAR; WAIT_L(0); MMA(0, 1, At, B1); BAR;
    LDA(At, 0, 1); WAIT_V(4); BAR; WAIT_L(0); MMA(1, 0, At, B0); MMA(1, 1, At, B1); BAR; }
  { LDB(B0, 1, 0); LDA(At, 1, 0); WAIT_V(2); BAR; WAIT_L(0); MMA(0, 0, At, B0); BAR;
    LDB(B1, 1, 1); WAIT_V(0); BAR; WAIT_L(0); MMA(0, 1, At, B1); BAR;
    LDA(At, 1, 1); BAR; WAIT_L(0); MMA(1, 0, At, B0); MMA(1, 1, At, B1); BAR; }
  if (wr == 0) BAR;
}
DEV void dump_half(const f32x4 (&acc)[2][2][4][2], int ai, int tid) {
  float* T = (float*)g_shm;
  const int wid = tid >> 6, lane = tid & 63, wr = wid >> 2, wc = wid & 3, fr = lane & 15, fq = lane >> 4;
#pragma unroll
  for (int bj = 0; bj < 2; ++bj)
#pragma unroll
    for (int m = 0; m < 4; ++m)
#pragma unroll
      for (int n = 0; n < 2; ++n) {
        const int r = wr * 64 + m * 16 + fr, c = bj * 128 + wc * 32 + n * 16 + fq * 4;
        *(f32x4*)(T + r * 260 + c) = (ai == 0) ? acc[0][bj][m][n] : acc[1][bj][m][n];
      }
}
DEV float4 tile_ld4(int r, int c4) { return *(const float4*)((const float*)g_shm + r * 260 + c4); }
DEV void dump_tile_bf16(const f32x4 (&acc)[2][2][4][2], int tid) {
  bf16_t* T = (bf16_t*)g_shm;
  const int wid = tid >> 6, lane = tid & 63, wr = wid >> 2, wc = wid & 3, fr = lane & 15, fq = lane >> 4;
#pragma unroll
  for (int ai = 0; ai < 2; ++ai)
#pragma unroll
    for (int bj = 0; bj < 2; ++bj)
#pragma unroll
      for (int m = 0; m < 4; ++m)
#pragma unroll
        for (int n = 0; n < 2; ++n) {
          const int r = ai * 128 + wr * 64 + m * 16 + fr, c = bj * 128 + wc * 32 + n * 16 + fq * 4;
          uint2 o; o.x = pack2(acc[ai][bj][m][n][0], acc[ai][bj][m][n][1]); o.y = pack2(acc[ai][bj][m][n][2], acc[ai][bj][m][n][3]);
          *(uint2*)(T + r * 264 + c) = o;
        }
}
DEV float4 tileb_ld4(int r, int c4) {
  const uint2 u = *(const uint2*)((const bf16_t*)g_shm + r * 264 + c4);
  return make_float4(__uint_as_float(u.x << 16), __uint_as_float(u.x & 0xffff0000u), __uint_as_float(u.y << 16), __uint_as_float(u.y & 0xffff0000u));
}

DEV int vblock() { return (blockIdx.x & 7) * (gridDim.x >> 3) + (blockIdx.x >> 3); }

DEV void tile_pmpn(int tile, int nM, int nN, int& pm, int& pn) {
  const int nig = 8 * nN, gid = tile / nig, fm = gid * 8, gsz = (nM - fm) < 8 ? (nM - fm) : 8;
  pm = fm + ((tile % nig) % gsz); pn = (tile % nig) / gsz;
}
DEV void phase_gemm_res(const Params& p, const bf16_t* A, long lda, const bf16_t* Bt, int K, int mtiles, long xrow0) {
  float* X = kx();
  for (int tile = vblock(); tile < mtiles * 4; tile += gridDim.x) {
    int pm, pn; tile_pmpn(tile, mtiles, 4, pm, pn);
    f32x4 acc[2][2][4][2];
    gemm_big(A, lda, Bt, K, K, (long)pm * 256, (long)pn * 256, acc);
    const int tid = opaque_tid();
#pragma unroll
    for (int ai = 0; ai < 2; ++ai) {
      LBAR2();
      dump_half(acc, ai, tid);
      LBAR2();
      for (int e = tid; e < 128 * 64; e += 512) {
        const int r = e >> 6, c4 = (e & 63) * 4;
        const float4 v = tile_ld4(r, c4);
        float4* q = (float4*)(X + (xrow0 + pm * 256 + ai * 128 + r) * 1024 + pn * 256 + c4);
        float4 o = *q; o.x += v.x; o.y += v.y; o.z += v.z; o.w += v.w; *q = o;
      }
    }
    LBAR2();
  }
}

DEV void phase_sgu_in(const Params& p, int j, int slab) {
  const bf16_t* A = (const bf16_t*)(kws() + OFF_H0) + (size_t)slab * SLAB * 1024;
  const bf16_t* Bt = (const bf16_t*)(kws() + OFF_W + W_SG_IN);
  const float* bin = kin(6) + (size_t)j * 4096;
  bf16_t* Z = (bf16_t*)(kws() + OFF_U);
  float* SSQ = (float*)(kws() + OFF_SSQ);
  for (int tile = vblock(); tile < 64 * 16; tile += gridDim.x) {
    int pm, pn; tile_pmpn(tile, 64, 16, pm, pn);
    f32x4 acc[2][2][4][2];
    gemm_big(A, 1024, Bt, 1024, 1024, (long)pm * 256, (long)pn * 256, acc);
    const int tid = opaque_tid(), wid = tid >> 6, lane = tid & 63;
    const float4 b4 = *(const float4*)(bin + pn * 256 + lane * 4);
    dump_tile_bf16(acc, tid);
    LBAR2();
    for (int rr = 0; rr < 32; ++rr) {
      const int r = wid * 32 + rr;
      const float4 v = tileb_ld4(r, lane * 4);
      const f32x2 za = gelu_pk((f32x2){v.x + b4.x, v.y + b4.y}), zb = gelu_pk((f32x2){v.z + b4.z, v.w + b4.w});
      const float z0 = za.x, z1 = za.y, z2 = zb.x, z3 = zb.y;
      const int row = pm * 256 + r;
      uint2 o; o.x = pack2(z0, z1); o.y = pack2(z2, z3);
      *(uint2*)(Z + (size_t)row * 4096 + pn * 256 + lane * 4) = o;
      if (pn >= 8) {
        const float ss = wave_sum(z0 * z0 + z1 * z1 + z2 * z2 + z3 * z3);
        if (lane == 0) SSQ[(size_t)row * 8 + (pn - 8)] = ss;
      }
    }
    LBAR2();
  }
}

DEV void phase_tm_proj(const Params& p) {
  const bf16_t* MIX = (const bf16_t*)(kws() + OFF_MIX);
  const bf16_t* Bt = (const bf16_t*)(kws() + OFF_W + W_TM_P);
  for (int tile = vblock(); tile < 64 * 15; tile += gridDim.x) {
    int pm, pn; tile_pmpn(tile, 64, 15, pm, pn);
    const int msel = pn < 4 ? 0 : (pn < 8 ? 2 : (pn < 12 ? 3 : (pn == 12 ? 1 : (pn == 13 ? 4 : 5))));
    f32x4 acc[2][2][4][2];
    gemm_big(MIX + (size_t)msel * SLAB * 1024, 1024, Bt, 1024, 1024, (long)pm * 256, (long)pn * 256, acc);
    const int tid = opaque_tid(), wid = tid >> 6, lane = tid & 63;
    bf16_t* O; int ld, cb;
    if (pn < 12) { O = (bf16_t*)(kws() + (pn < 4 ? OFF_R : (pn < 8 ? OFF_K : OFF_V))); ld = 1024; cb = (pn & 3) * 256; }
    else { O = (bf16_t*)(kws() + OFF_HL); ld = 512; cb = pn == 12 ? 0 : (pn == 13 ? 128 : 256); }
    const int act = pn == 12 ? 1 : (pn == 14 ? 2 : 0);
    const bool live = pn < 12 || pn == 14 || lane < 32;
    dump_tile_bf16(acc, tid);
    LBAR2();
    for (int rr = 0; rr < 32; ++rr) {
      const int r = wid * 32 + rr;
      float4 v = tileb_ld4(r, lane * 4);
      if (act == 1) { v.x = tanhf(v.x); v.y = tanhf(v.y); v.z = tanhf(v.z); v.w = tanhf(v.w); }
      else if (act == 2) { v.x = sigmoidf_(v.x); v.y = sigmoidf_(v.y); v.z = sigmoidf_(v.z); v.w = sigmoidf_(v.w); }
      uint2 o; o.x = pack2(v.x, v.y); o.y = pack2(v.z, v.w);
      if (live) *(uint2*)(O + (size_t)(pm * 256 + r) * ld + cb + lane * 4) = o;
    }
    LBAR2();
  }
}

DEV void phase_ffn_a(const Params& p, int layer) {
  const bf16_t* A = (const bf16_t*)(kws() + OFF_H0);
  const bf16_t* Bt = (const bf16_t*)(kws() + OFF_W + W_FF_A);
  bf16_t* HM = (bf16_t*)(kws() + OFF_HMID);
  const float* cw = kin(31) + (size_t)layer * 3 * 2816;
  const float* cb = kin(32) + (size_t)layer * 2816;
  bf16_t* gl = (bf16_t*)g_shm;
  bf16_t* ul = (bf16_t*)(g_shm + 69632);
  for (int tile = vblock(); tile < 195 * 22; tile += gridDim.x) {
    int mi, pn; tile_pmpn(tile, 195, 22, mi, pn);
    const int base = (mi / 65) * 16384, L = 16384, i = mi % 65;
    const int seqmask = mi < 130 ? 16383 : 2047;
    const int s0 = 254 * i - 1;
    f32x4 acc[2][2][4][2];
    gemm_big(A, 1024, Bt, 1024, 1024, (long)base + s0, (long)pn * 256, acc);
    const int tid = opaque_tid(), wid = tid >> 6, lane = tid & 63, wr = wid >> 2, wc = wid & 3, fr = lane & 15, fq = lane >> 4;
#pragma unroll
    for (int ai = 0; ai < 2; ++ai)
#pragma unroll
      for (int m = 0; m < 4; ++m) {
        const int r = ai * 128 + wr * 64 + m * 16 + fr, sp = s0 + r;
        const bool inseq = sp >= 0 && sp < L;
#pragma unroll
        for (int n = 0; n < 2; ++n) {
          const int c = wc * 32 + n * 16 + fq * 4;
          uint2 o;
          o.x = inseq ? pack2(acc[ai][0][m][n][0], acc[ai][0][m][n][1]) : 0u; o.y = inseq ? pack2(acc[ai][0][m][n][2], acc[ai][0][m][n][3]) : 0u;
          *(uint2*)(gl + r * 136 + c) = o;
          o.x = pack2(acc[ai][1][m][n][0], acc[ai][1][m][n][1]); o.y = pack2(acc[ai][1][m][n][2], acc[ai][1][m][n][3]);
          *(uint2*)(ul + r * 136 + c) = o;
        }
      }
    const int c4 = (lane & 31) * 4, f = pn * 128 + c4;
    const float4 w0 = *(const float4*)(cw + f), w1 = *(const float4*)(cw + 2816 + f), w2 = *(const float4*)(cw + 2 * 2816 + f), bb = *(const float4*)(cb + f);
    LBAR2();
    for (int e = tid; e < 256 * 32; e += 512) {
      const int r = e >> 5, sp = s0 + r;
      if (r >= 1 && r <= 254 && sp < L) {
        const uint2 ur = *(const uint2*)(ul + r * 136 + c4);
        const int pos = sp & seqmask;
        uint2 g0 = *(const uint2*)(gl + (r - 1) * 136 + c4), g2 = *(const uint2*)(gl + (r + 1) * 136 + c4);
        const uint2 g1 = *(const uint2*)(gl + r * 136 + c4);
        if (pos == 0) g0 = make_uint2(0u, 0u);
        if (pos == seqmask) g2 = make_uint2(0u, 0u);
        const float c0 = w0.x * __uint_as_float(g0.x << 16) + w1.x * __uint_as_float(g1.x << 16) + w2.x * __uint_as_float(g2.x << 16) + bb.x;
        const float c1 = w0.y * __uint_as_float(g0.x & 0xffff0000u) + w1.y * __uint_as_float(g1.x & 0xffff0000u) + w2.y * __uint_as_float(g2.x & 0xffff0000u) + bb.y;
        const float c2 = w0.z * __uint_as_float(g0.y << 16) + w1.z * __uint_as_float(g1.y << 16) + w2.z * __uint_as_float(g2.y << 16) + bb.z;
        const float c3 = w0.w * __uint_as_float(g0.y & 0xffff0000u) + w1.w * __uint_as_float(g1.y & 0xffff0000u) + w2.w * __uint_as_float(g2.y & 0xffff0000u) + bb.w;
        const f32x2 ga = gelu_pk((f32x2){c0, c1}), gb = gelu_pk((f32x2){c2, c3});
        uint2 o; o.x = pack2(ga.x * __uint_as_float(ur.x << 16), ga.y * __uint_as_float(ur.x & 0xffff0000u));
        o.y = pack2(gb.x * __uint_as_float(ur.y << 16), gb.y * __uint_as_float(ur.y & 0xffff0000u));
        *(uint2*)(HM + (size_t)(base + sp) * 2816 + f) = o;
      }
    }
    LBAR2();
  }
}

template <int KP>
DEV void small_mma(f32x4 (&acc)[4][4]) {
  const int TIDX = opaque_tid();
  constexpr int LD = KP + 8;
  const bf16_t* sA = (const bf16_t*)g_shm;
  const bf16_t* sB = sA + 128 * LD;
  const int wid = TIDX >> 6, lane = TIDX & 63, wr = wid >> 2, wc = wid & 3, fr = lane & 15, fq = lane >> 4;
#pragma unroll
  for (int m = 0; m < 4; ++m)
#pragma unroll
    for (int n = 0; n < 4; ++n) acc[m][n] = (f32x4){0.f, 0.f, 0.f, 0.f};
#pragma unroll
  for (int kk = 0; kk < KP / 32; ++kk) {
    bf16x8 a[4], b[4];
#pragma unroll
    for (int m = 0; m < 4; ++m) a[m] = *(const bf16x8*)(sA + (wr * 64 + m * 16 + fr) * LD + kk * 32 + fq * 8);
#pragma unroll
    for (int n = 0; n < 4; ++n) b[n] = *(const bf16x8*)(sB + (wc * 64 + n * 16 + fr) * LD + kk * 32 + fq * 8);
#pragma unroll
    for (int m = 0; m < 4; ++m)
#pragma unroll
      for (int n = 0; n < 4; ++n) acc[m][n] = __builtin_amdgcn_mfma_f32_16x16x32_bf16(b[n], a[m], acc[m][n], 0, 0, 0);
  }
}
template <int KP>
DEV void small_load_ab(bf16_t* sA, const bf16_t* gA, long lda, bf16_t* sB, const bf16_t* gB, long ldb, int tid) {
  constexpr int LD = KP + 8, CPR = KP / 8, TA = 128 * CPR, TB = 256 * CPR, IA = TA / 512, IB = TB / 512;
  static_assert(TA % 512 == 0 && TB % 512 == 0, "panel sizes must be multiples of the block");
  uint4 va[IA], vb[IB];
#pragma unroll
  for (int it = 0; it < IA; ++it) { const int c = tid + it * 512; va[it] = *(const uint4*)(gA + (long)(c / CPR) * lda + (c % CPR) * 8); }
#pragma unroll
  for (int it = 0; it < IB; ++it) { const int c = tid + it * 512; vb[it] = *(const uint4*)(gB + (long)(c / CPR) * ldb + (c % CPR) * 8); }
#pragma unroll
  for (int it = 0; it < IA; ++it) { const int c = tid + it * 512; *(uint4*)(sA + (c / CPR) * LD + (c % CPR) * 8) = va[it]; }
#pragma unroll
  for (int it = 0; it < IB; ++it) { const int c = tid + it * 512; *(uint4*)(sB + (c / CPR) * LD + (c % CPR) * 8) = vb[it]; }
}

DEV void phase_sgu_mix(const Params& p, int j) {
  const int TIDX = opaque_tid();
  constexpr int KP = 128, LD = KP + 8;
  const int wid = TIDX >> 6, lane = TIDX & 63, wr = wid >> 2, wc = wid & 3, fr = lane & 15, fq = lane >> 4;
  bf16_t* sA = (bf16_t*)g_shm;
  bf16_t* sB = sA + 128 * LD;
  float* rsv = (float*)(g_shm + (128 + 256) * LD * 2);
  bf16_t* Z = (bf16_t*)(kws() + OFF_U);
  const float* SSQ = (const float*)(kws() + OFF_SSQ);
  const float* ws_ = kin(8) + (size_t)j * 8 * 128 * 128;
  const float* bs = kin(9) + (size_t)j * 8 * 128;
  const float* ng = kin(7) + (size_t)j * 2048;
  for (int unit = blockIdx.x; unit < 128 * 8; unit += gridDim.x) {
    const int chunk = unit >> 3, g = unit & 7;
    __syncthreads();
    uint4 vb[8]; float4 wa[4][2];
#pragma unroll
    for (int it = 0; it < 8; ++it) {
      const int e = TIDX + it * 512, pp = e & 127, c8 = (e >> 7) * 8;
      vb[it] = *(const uint4*)(Z + (size_t)(chunk * 128 + pp) * 4096 + 2048 + g * 256 + c8);
    }
#pragma unroll
    for (int it = 0; it < 4; ++it) {
      const int c = TIDX + it * 512, q = c >> 4, p8 = (c & 15) * 8;
      const float4* wp = (const float4*)(ws_ + ((size_t)g * 128 + q) * 128 + p8);
      wa[it][0] = wp[0]; wa[it][1] = wp[1];
    }
    if (TIDX < 128) {
      const float4* sp = (const float4*)(SSQ + (size_t)(chunk * 128 + TIDX) * 8);
      const float4 s0 = sp[0], s1 = sp[1];
      const float sm = ((s0.x + s0.y) + (s0.z + s0.w)) + ((s1.x + s1.y) + (s1.z + s1.w));
      rsv[TIDX] = rsqrtf(sm * (1.0f / 2048.f) + 1e-6f);
    }
#pragma unroll
    for (int it = 0; it < 8; ++it) {
      const int e = TIDX + it * 512, pp = e & 127, c8 = (e >> 7) * 8;
      const uint4 v = vb[it];
      sB[(c8 + 0) * LD + pp] = (bf16_t)(v.x & 0xffff); sB[(c8 + 1) * LD + pp] = (bf16_t)(v.x >> 16);
      sB[(c8 + 2) * LD + pp] = (bf16_t)(v.y & 0xffff); sB[(c8 + 3) * LD + pp] = (bf16_t)(v.y >> 16);
      sB[(c8 + 4) * LD + pp] = (bf16_t)(v.z & 0xffff); sB[(c8 + 5) * LD + pp] = (bf16_t)(v.z >> 16);
      sB[(c8 + 6) * LD + pp] = (bf16_t)(v.w & 0xffff); sB[(c8 + 7) * LD + pp] = (bf16_t)(v.w >> 16);
    }
    __syncthreads();
#pragma unroll
    for (int it = 0; it < 4; ++it) {
      const int c = TIDX + it * 512, q = c >> 4, p8 = (c & 15) * 8;
      const float4 w0 = wa[it][0], w1 = wa[it][1];
      uint4 o;
      o.x = pack2(w0.x * rsv[p8 + 0], w0.y * rsv[p8 + 1]); o.y = pack2(w0.z * rsv[p8 + 2], w0.w * rsv[p8 + 3]);
      o.z = pack2(w1.x * rsv[p8 + 4], w1.y * rsv[p8 + 5]); o.w = pack2(w1.z * rsv[p8 + 6], w1.w * rsv[p8 + 7]);
      *(uint4*)(sA + q * LD + p8) = o;
    }
    __syncthreads();
    f32x4 acc[4][4];
    small_mma<KP>(acc);
#pragma unroll
    for (int m = 0; m < 4; ++m) {
      const int q = wr * 64 + m * 16 + fr;
      const float bq = bs[g * 128 + q];
#pragma unroll
      for (int n = 0; n < 4; ++n) {
        const int c = g * 256 + wc * 64 + n * 16 + fq * 4;
        const float4 gg = *(const float4*)(ng + c);
        uint2* up = (uint2*)(Z + (size_t)(chunk * 128 + q) * 4096 + c);
        const uint2 u = *up;
        uint2 o;
        o.x = pack2(__uint_as_float(u.x << 16) * (acc[m][n][0] * gg.x + bq), __uint_as_float(u.x & 0xffff0000u) * (acc[m][n][1] * gg.y + bq));
        o.y = pack2(__uint_as_float(u.y << 16) * (acc[m][n][2] * gg.z + bq), __uint_as_float(u.y & 0xffff0000u) * (acc[m][n][3] * gg.w + bq));
        *up = o;
      }
    }
  }
  __syncthreads();
}

template <int KP>
DEV void lora_out_unit(const Params& p, int j, int kind, int mt, int ntile) {
  const int TIDX = opaque_tid();
  constexpr int LD = KP + 8;
  const int wid = TIDX >> 6, lane = TIDX & 63, wr = wid >> 2, wc = wid & 3, fr = lane & 15, fq = lane >> 4;
  bf16_t* sA = (bf16_t*)g_shm;
  bf16_t* sB = sA + 128 * LD;
  const bf16_t* HL = (const bf16_t*)(kws() + OFF_HL);
  const int koff = kind < 4 ? kind * 64 : 256;
  const bf16_t* Bt = (const bf16_t*)(kws() + OFF_W + (kind < 2 ? W_TM_W2 + (size_t)kind * 1024 * 64 * 2 : (kind < 4 ? W_TM_A2 + (size_t)(kind - 2) * 1024 * 64 * 2 : W_TM_G2)));
  bf16_t* O = (bf16_t*)(kws() + (kind == 0 ? OFF_E0 : kind == 1 ? OFF_E1 : kind == 2 ? OFF_A0 : kind == 3 ? OFF_A1 : OFF_G));
  const float* bias = kind < 2 ? kin(15) + ((size_t)j * 2 + kind) * 1024 : (kind < 4 ? kin(18) + ((size_t)j * 2 + kind - 2) * 1024 : nullptr);
  __syncthreads();
  small_load_ab<KP>(sA, HL + (size_t)mt * 128 * 512 + koff, 512, sB, Bt + (size_t)ntile * 256 * KP, KP, TIDX);
  __syncthreads();
  f32x4 acc[4][4];
  small_mma<KP>(acc);
#pragma unroll
  for (int n = 0; n < 4; ++n) {
    const int col = ntile * 256 + wc * 64 + n * 16 + fq * 4;
    const float4 b = bias ? *(const float4*)(bias + col) : make_float4(0.f, 0.f, 0.f, 0.f);
#pragma unroll
    for (int m = 0; m < 4; ++m) {
      const int row = mt * 128 + wr * 64 + m * 16 + fr;
      float v0 = acc[m][n][0] + b.x, v1 = acc[m][n][1] + b.y, v2 = acc[m][n][2] + b.z, v3 = acc[m][n][3] + b.w;
      if (kind < 4) {
        const float sc = kind < 2 ? 0.6065306597126334f : 1.0f;
        v0 = sc * sigmoidf_(v0); v1 = sc * sigmoidf_(v1); v2 = sc * sigmoidf_(v2); v3 = sc * sigmoidf_(v3);
      }
      uint2 o; o.x = pack2(v0, v1); o.y = pack2(v2, v3);
      *(uint2*)(O + (size_t)row * 1024 + col) = o;
    }
  }
}
DEV void phase_tm_lora_out(const Params& p, int j) {
  for (int unit = blockIdx.x; unit < 5 * 512; unit += gridDim.x) {
    const int kind = unit / 512, r = unit % 512, mt = r >> 2, ntile = r & 3;
    if (kind < 4) lora_out_unit<64>(p, j, kind, mt, ntile); else lora_out_unit<160>(p, j, kind, mt, ntile);
  }
  __syncthreads();
}

constexpr int LDP = 72;
constexpr int MATE = 64 * LDP;
DEV bf16_t* lbuf(int i) { return (bf16_t*)g_shm + i * MATE; }
DEV void bmm(const bf16_t* A, const bf16_t* Bt, int mb, int nh, int fr, int fq, f32x4 (&acc)[2]) {
  acc[0] = (f32x4){0.f, 0.f, 0.f, 0.f}; acc[1] = (f32x4){0.f, 0.f, 0.f, 0.f};
#pragma unroll
  for (int kk = 0; kk < 2; ++kk) {
    const bf16x8 a = *(const bf16x8*)(A + (mb * 16 + fr) * LDP + kk * 32 + fq * 8);
#pragma unroll
    for (int n = 0; n < 2; ++n) {
      const bf16x8 b = *(const bf16x8*)(Bt + (nh * 32 + n * 16 + fr) * LDP + kk * 32 + fq * 8);
      acc[n] = __builtin_amdgcn_mfma_f32_16x16x32_bf16(a, b, acc[n], 0, 0, 0);
    }
  }
}
DEV void st_rm(bf16_t* C, const f32x4 (&v)[2], int mb, int nh, int fr, int fq) {
#pragma unroll
  for (int n = 0; n < 2; ++n)
#pragma unroll
    for (int j = 0; j < 4; ++j) C[(mb * 16 + fq * 4 + j) * LDP + nh * 32 + n * 16 + fr] = f2bf(v[n][j]);
}
DEV void st_tr(bf16_t* CT, const f32x4 (&v)[2], int mb, int nh, int fr, int fq) {
#pragma unroll
  for (int n = 0; n < 2; ++n) {
    uint2 o; o.x = pack2(v[n][0], v[n][1]); o.y = pack2(v[n][2], v[n][3]);
    *(uint2*)(CT + (nh * 32 + n * 16 + fr) * LDP + mb * 16 + fq * 4) = o;
  }
}

DEV void phase_wkv_a(const Params& p, int jl, int slab) {
  const int TIDX = opaque_tid();
  const int wid = __builtin_amdgcn_readfirstlane(TIDX >> 6), lane = TIDX & 63, fr = lane & 15, fq = lane >> 4, mb = wid >> 1, nh = wid & 1;
  const bf16_t* Rb = (const bf16_t*)(kws() + OFF_R);
  const bf16_t* Kb = (const bf16_t*)(kws() + OFF_K);
  const bf16_t* Vb = (const bf16_t*)(kws() + OFF_V);
  float* PSI = (float*)(kws() + OFF_PSI);
  float* BON = (float*)(kws() + OFF_BON);
  float* segsum = (float*)(g_shm + 15 * MATE * 2);
  float* gTs = segsum + 512;
  bf16_t *mAtil = lbuf(0), *mBtil = lbuf(1), *mKtil = lbuf(2), *mRtil = lbuf(3), *mBgamT = lbuf(4), *mKgam = lbuf(5), *mAtilT = lbuf(6), *mVT = lbuf(7),
         *mMak = lbuf(10), *mMrk = lbuf(11), *mMrbT = lbuf(12);
  uint4 nr, nk, nv, na, ne;
  const int lr = TIDX >> 3, lc8 = (TIDX & 7) * 8;
  auto load_raw = [&](int u) {
    const int e2 = u & 1, h2 = (u >> 1) & 15, c2 = u >> 5;
    const bf16_t* A2 = (const bf16_t*)(kws() + (e2 ? OFF_A1 : OFF_A0));
    const bf16_t* E2 = (const bf16_t*)(kws() + (e2 ? OFF_E1 : OFF_E0));
    const size_t o = (size_t)c2 * 64 * 1024 + h2 * 64 + (size_t)lr * 1024 + lc8;
    nr = *(const uint4*)(Rb + o); nk = *(const uint4*)(Kb + o); nv = *(const uint4*)(Vb + o); na = *(const uint4*)(A2 + o); ne = *(const uint4*)(E2 + o);
  };
  if ((int)blockIdx.x < 256 * 32) load_raw(blockIdx.x);
  for (int unit = blockIdx.x; unit < 256 * 32; unit += gridDim.x) {
    const int e = unit & 1, h = (unit >> 1) & 15, c = unit >> 5;
    bf16_t* Ab = (bf16_t*)(kws() + (e ? OFF_A1 : OFF_A0));
    bf16_t* Eb = (bf16_t*)(kws() + (e ? OFF_E1 : OFF_E0));
    bf16_t* YL = (bf16_t*)(kws() + (e ? OFF_YLB : OFF_YLF));
    const size_t tile0 = (size_t)c * 64 * 1024 + h * 64;
    {
      const int jcol = lane, sg = wid;
      const float kkw = kin(23)[(size_t)jl * 1024 + h * 64 + jcol], kaw = kin(24)[(size_t)jl * 1024 + h * 64 + jcol], rkw = kin(25)[(size_t)jl * 1024 + h * 64 + jcol];
      *(uint4*)(lbuf(8) + lr * LDP + lc8) = nr; *(uint4*)(lbuf(9) + lr * LDP + lc8) = nk; *(uint4*)(lbuf(10) + lr * LDP + lc8) = nv;
      *(uint4*)(lbuf(11) + lr * LDP + lc8) = na; *(uint4*)(lbuf(12) + lr * LDP + lc8) = ne;
      LBAR2();
      if (unit + (int)gridDim.x < 256 * 32) load_raw(unit + gridDim.x);
      float rv[8], kv[8], vv[8], av[8], lw[8];
#pragma unroll
      for (int q = 0; q < 8; ++q) {
        const int tau = sg * 8 + q, tok = e ? 63 - tau : tau;
        rv[q] = bf2f(lbuf(8)[tok * LDP + jcol]); kv[q] = bf2f(lbuf(9)[tok * LDP + jcol]); vv[q] = bf2f(lbuf(10)[tok * LDP + jcol]);
        av[q] = bf2f(lbuf(11)[tok * LDP + jcol]); lw[q] = -bf2f(lbuf(12)[tok * LDP + jcol]);
      }
      float pre[8]; float run = 0.f;
#pragma unroll
      for (int q = 0; q < 8; ++q) { run += lw[q]; pre[q] = run; }
      segsum[sg * 64 + jcol] = run;
      LBAR2();
      float off = 0.f, tot = 0.f;
#pragma unroll
      for (int s2 = 0; s2 < 8; ++s2) { const float sv = segsum[s2 * 64 + jcol]; tot += sv; if (s2 < sg) off += sv; }
      if (sg == 0) gTs[jcol] = __expf(tot);
      float at[8], bg[8], vt[8];
#pragma unroll
      for (int q = 0; q < 8; ++q) {
        const int tau = sg * 8 + q, tok = e ? 63 - tau : tau;
        const float g = off + pre[q], gp = g - lw[q];
        const float kr = kv[q] * kkw;
        const float ss = wave_sum(kr * kr);
        const float kk = kr * __builtin_amdgcn_rsqf(fmaxf(ss, 1e-24f));
        const float b = kk * av[q], kd = kv[q] * (1.0f + (av[q] - 1.0f) * kaw);
        const float eg = __expf(g), eng = __expf(-g), egp = __expf(gp), egt = __expf(tot - g);
        const float atil = -kk * egp;
        mAtil[tau * LDP + jcol] = f2bf(atil);
        mBtil[tau * LDP + jcol] = f2bf(b * eng);
        mKtil[tau * LDP + jcol] = f2bf(kd * eng);
        mRtil[tau * LDP + jcol] = f2bf(rv[q] * eg);
        mKgam[tau * LDP + jcol] = f2bf(kd * egt);
        at[q] = atil; bg[q] = b * egt; vt[q] = vv[q];
        const float bon = wave_sum(rv[q] * kd * rkw);
        if (lane == 0) BON[((size_t)e * SLAB + c * 64 + tok) * 16 + h] = bon;
      }
      uint4 o;
      o.x = pack2(at[0], at[1]); o.y = pack2(at[2], at[3]); o.z = pack2(at[4], at[5]); o.w = pack2(at[6], at[7]);
      *(uint4*)(mAtilT + jcol * LDP + sg * 8) = o;
      o.x = pack2(bg[0], bg[1]); o.y = pack2(bg[2], bg[3]); o.z = pack2(bg[4], bg[5]); o.w = pack2(bg[6], bg[7]);
      *(uint4*)(mBgamT + jcol * LDP + sg * 8) = o;
      o.x = pack2(vt[0], vt[1]); o.y = pack2(vt[2], vt[3]); o.z = pack2(vt[4], vt[5]); o.w = pack2(vt[6], vt[7]);
      *(uint4*)(mVT + jcol * LDP + sg * 8) = o;
    }
    LBAR2();
    f32x4 acc[2], acc2[2];
    bmm(mBtil, mAtil, mb, nh, fr, fq, acc);
#pragma unroll
    for (int n = 0; n < 2; ++n)
#pragma unroll
      for (int j = 0; j < 4; ++j) { const int s = mb * 16 + fq * 4 + j, t = nh * 32 + n * 16 + fr; acc[n][j] = s < t ? acc[n][j] : 0.f; }
    st_rm(lbuf(8), acc, mb, nh, fr, fq); st_tr(lbuf(9), acc, mb, nh, fr, fq);
#pragma unroll
    for (int n = 0; n < 2; ++n)
#pragma unroll
      for (int j = 0; j < 4; ++j) { const int s = mb * 16 + fq * 4 + j, t = nh * 32 + n * 16 + fr; acc[n][j] += (s == t) ? 1.f : 0.f; }
    st_rm(lbuf(13), acc, mb, nh, fr, fq);
    f32x4 Wp[2] = {acc[0], acc[1]};
    bmm(mKtil, mAtil, mb, nh, fr, fq, acc);
#pragma unroll
    for (int n = 0; n < 2; ++n)
#pragma unroll
      for (int j = 0; j < 4; ++j) { const int s = mb * 16 + fq * 4 + j, t = nh * 32 + n * 16 + fr; acc[n][j] = s < t ? acc[n][j] : 0.f; }
    st_rm(mMak, acc, mb, nh, fr, fq);
    bmm(mKtil, mRtil, mb, nh, fr, fq, acc);
#pragma unroll
    for (int n = 0; n < 2; ++n)
#pragma unroll
      for (int j = 0; j < 4; ++j) { const int s = mb * 16 + fq * 4 + j, t = nh * 32 + n * 16 + fr; acc[n][j] = s <= t ? acc[n][j] : 0.f; }
    st_rm(mMrk, acc, mb, nh, fr, fq);
    bmm(mBtil, mRtil, mb, nh, fr, fq, acc);
#pragma unroll
    for (int n = 0; n < 2; ++n)
#pragma unroll
      for (int j = 0; j < 4; ++j) { const int s = mb * 16 + fq * 4 + j, t = nh * 32 + n * 16 + fr; acc[n][j] = s <= t ? acc[n][j] : 0.f; }
    st_tr(mMrbT, acc, mb, nh, fr, fq);
    LBAR2();
    bmm(lbuf(8), lbuf(9), mb, nh, fr, fq, acc);
    st_rm(lbuf(1), acc, mb, nh, fr, fq); st_tr(lbuf(2), acc, mb, nh, fr, fq);
    LBAR2();
#pragma unroll
    for (int k = 0; k < 4; ++k) {
      const int pc = (k & 1) ? 8 : 1, pn = (k & 1) ? 1 : 8, wc_ = (k & 1) ? 14 : 13, wn = (k & 1) ? 13 : 14;
      bmm(lbuf(wc_), lbuf(pc + 1), mb, nh, fr, fq, acc);
      bmm(lbuf(pc), lbuf(pc + 1), mb, nh, fr, fq, acc2);
      Wp[0] += acc[0]; Wp[1] += acc[1];
      st_rm(lbuf(wn), Wp, mb, nh, fr, fq);
      st_rm(lbuf(pn), acc2, mb, nh, fr, fq); st_tr(lbuf(pn + 1), acc2, mb, nh, fr, fq);
      LBAR2();
    }
    bmm(lbuf(13), lbuf(2), mb, nh, fr, fq, acc);
    Wp[0] += acc[0]; Wp[1] += acc[1];
    st_rm(lbuf(14), Wp, mb, nh, fr, fq);
    LBAR2();
    bmm(mMrbT, lbuf(14), mb, nh, fr, fq, acc);  st_rm(lbuf(8), acc, mb, nh, fr, fq);
    bmm(mBgamT, lbuf(14), mb, nh, fr, fq, acc); st_rm(lbuf(9), acc, mb, nh, fr, fq);
    LBAR2();
    bmm(lbuf(8), mMak, mb, nh, fr, fq, acc);
#pragma unroll
    for (int n = 0; n < 2; ++n)
#pragma unroll
      for (int j = 0; j < 4; ++j) { const int t = mb * 16 + fq * 4 + j, s = nh * 32 + n * 16 + fr; acc[n][j] += bf2f(mMrk[s * LDP + t]); }
    st_rm(lbuf(1), acc, mb, nh, fr, fq);
    bmm(lbuf(9), mMak, mb, nh, fr, fq, acc);
#pragma unroll
    for (int n = 0; n < 2; ++n)
#pragma unroll
      for (int j = 0; j < 4; ++j) { const int jj = mb * 16 + fq * 4 + j, s = nh * 32 + n * 16 + fr; acc[n][j] += bf2f(mKgam[s * LDP + jj]); }
    st_rm(lbuf(2), acc, mb, nh, fr, fq);
    bmm(mAtilT, lbuf(8), mb, nh, fr, fq, acc);
#pragma unroll
    for (int n = 0; n < 2; ++n) {
      const int j0 = mb * 16 + fq * 4, t = nh * 32 + n * 16 + fr;
      const uint2 rt = *(const uint2*)(mRtil + t * LDP + j0);
      uint2 o;
      o.x = pack2(acc[n][0] + __uint_as_float(rt.x << 16), acc[n][1] + __uint_as_float(rt.x & 0xffff0000u));
      o.y = pack2(acc[n][2] + __uint_as_float(rt.y << 16), acc[n][3] + __uint_as_float(rt.y & 0xffff0000u));
      *(uint2*)(Eb + tile0 + (size_t)t * 1024 + j0) = o;
    }
    bmm(mAtilT, lbuf(9), mb, nh, fr, fq, acc);
#pragma unroll
    for (int n = 0; n < 2; ++n) {
      const int j0 = mb * 16 + fq * 4, jp = nh * 32 + n * 16 + fr;
      uint2 o;
      o.x = pack2(acc[n][0] + (jp == j0 ? gTs[j0] : 0.f), acc[n][1] + (jp == j0 + 1 ? gTs[j0 + 1] : 0.f));
      o.y = pack2(acc[n][2] + (jp == j0 + 2 ? gTs[j0 + 2] : 0.f), acc[n][3] + (jp == j0 + 3 ? gTs[j0 + 3] : 0.f));
      *(uint2*)(Ab + tile0 + (size_t)jp * 1024 + j0) = o;
    }
    LBAR2();
    bmm(mVT, lbuf(1), mb, nh, fr, fq, acc);
#pragma unroll
    for (int n = 0; n < 2; ++n) {
      const int i0 = mb * 16 + fq * 4, t = nh * 32 + n * 16 + fr;
      uint2 o; o.x = pack2(acc[n][0], acc[n][1]); o.y = pack2(acc[n][2], acc[n][3]);
      *(uint2*)(YL + tile0 + (size_t)t * 1024 + i0) = o;
    }
    bmm(mVT, lbuf(2), mb, nh, fr, fq, acc);
    *(f32x4*)(PSI + (size_t)unit * 4096 + (size_t)(wid * 64 + lane) * 8) = acc[0];
    *(f32x4*)(PSI + (size_t)unit * 4096 + (size_t)(wid * 64 + lane) * 8 + 4) = acc[1];
  }
}

DEV void phase_wkv_b(const Params& p, int slab, int mode) {
  const int TIDX = opaque_tid();
  const int wid = __builtin_amdgcn_readfirstlane(TIDX >> 6), lane = TIDX & 63, fr = lane & 15, fq = lane >> 4, mb = wid >> 1, nh = wid & 1;
  const float* PSI = (const float*)(kws() + OFF_PSI);
  bf16_t* PHG = (bf16_t*)(kws() + OFF_PHG);
  float* PSG = (float*)(kws() + OFF_PSG);
  float* SST = (float*)(kws() + OFF_SST);
  const bool two_level = slab < 2;
  if (!two_level && mode != 3) return;
  const int nseq = two_level ? 1 : 8, cps = 256 / nseq;
  const int ngrp = two_level ? 8 : 1;
  bf16_t *Sb = lbuf(0), *PhT = lbuf(1), *OmT = lbuf(2), *Sa = lbuf(3);
  const int lr = TIDX >> 3, lc8 = (TIDX & 7) * 8;
  const size_t nat = (size_t)(wid * 64 + lane) * 8;
  if (mode == 2) {
    for (int chain = blockIdx.x; chain < 32; chain += gridDim.x) {
      f32x4 S[2];
      S[0] = (f32x4){0.f, 0.f, 0.f, 0.f}; S[1] = (f32x4){0.f, 0.f, 0.f, 0.f};
      for (int g = 0; g < 8; ++g) {
        const size_t item = (size_t)chain * 8 + g;
        *(f32x4*)(SST + item * 4096 + nat) = S[0]; *(f32x4*)(SST + item * 4096 + nat + 4) = S[1];
        const uint4 ph = *(const uint4*)(PHG + item * 4096 + lr * 64 + lc8);
        const f32x4 q0 = *(const f32x4*)(PSG + item * 4096 + nat), q1 = *(const f32x4*)(PSG + item * 4096 + nat + 4);
        st_rm(Sb, S, mb, nh, fr, fq);
        *(uint4*)(PhT + lr * LDP + lc8) = ph;
        LBAR2();
        f32x4 acc[2];
        bmm(Sb, PhT, mb, nh, fr, fq, acc);
        S[0] = acc[0] + q0; S[1] = acc[1] + q1;
        LBAR2();
      }
    }
    return;
  }
  for (int item = blockIdx.x; item < nseq * 32 * ngrp; item += gridDim.x) {
    const int chain = item / ngrp, grp = item % ngrp;
    const int e = chain & 1, h = (chain >> 1) & 15, sq = chain >> 5;
    const bf16_t* Ab = (const bf16_t*)(kws() + (e ? OFF_A1 : OFF_A0));
    const bf16_t* Eb = (const bf16_t*)(kws() + (e ? OFF_E1 : OFF_E0));
    bf16_t* YL = (bf16_t*)(kws() + (e ? OFF_YLB : OFF_YLF));
    const int sbase = grp * 32;
    f32x4 S[2], SA[2];
    if (mode == 3 && two_level) { S[0] = *(const f32x4*)(SST + (size_t)item * 4096 + nat); S[1] = *(const f32x4*)(SST + (size_t)item * 4096 + nat + 4); }
    else { S[0] = (f32x4){0.f, 0.f, 0.f, 0.f}; S[1] = (f32x4){0.f, 0.f, 0.f, 0.f}; }
#pragma unroll
    for (int n = 0; n < 2; ++n)
#pragma unroll
      for (int j = 0; j < 4; ++j) SA[n][j] = (mb * 16 + fq * 4 + j == nh * 32 + n * 16 + fr) ? 1.f : 0.f;
    uint4 ph0, ph1, ph2, ph3, om0, om1, om2, om3;
    f32x4 ps0[2], ps1[2], ps2[2], ps3[2];
    uint2 yl0[2], yl1[2], yl2[2], yl3[2];
#define WB_PREFETCH(step_, ph, om, ps, y8) do { \
      const int st_ = sbase + ((step_) < 32 ? (step_) : 31); \
      const int c_ = sq * cps + (e ? cps - 1 - st_ : st_); \
      const size_t t0_ = (size_t)c_ * 64 * 1024 + h * 64; \
      ph = *(const uint4*)(Ab + t0_ + (size_t)lr * 1024 + lc8); \
      const size_t u_ = ((size_t)c_ * 16 + h) * 2 + e; \
      ps[0] = *(const f32x4*)(PSI + u_ * 4096 + nat); ps[1] = *(const f32x4*)(PSI + u_ * 4096 + nat + 4); \
      if (mode == 3) { \
        om = *(const uint4*)(Eb + t0_ + (size_t)lr * 1024 + lc8); \
        y8[0] = *(const uint2*)(YL + t0_ + (size_t)(nh * 32 + fr) * 1024 + mb * 16 + fq * 4); \
        y8[1] = *(const uint2*)(YL + t0_ + (size_t)(nh * 32 + 16 + fr) * 1024 + mb * 16 + fq * 4); } } while (0)
#define WB_STEP(step_, ph, om, ps, y8) do { \
      const int c = sq * cps + (e ? cps - 1 - (sbase + (step_)) : (sbase + (step_))); \
      const size_t tile0 = (size_t)c * 64 * 1024 + h * 64; \
      bf16_t *Sb_ = lbuf(((step_) & 1) * 4), *PhT_ = lbuf(((step_) & 1) * 4 + 1), *OmT_ = lbuf(((step_) & 1) * 4 + 2), *Sa_ = lbuf(((step_) & 1) * 4 + 3); \
      st_rm(Sb_, S, mb, nh, fr, fq); \
      *(uint4*)(PhT_ + lr * LDP + lc8) = ph; \
      if (mode == 3) *(uint4*)(OmT_ + lr * LDP + lc8) = om; else st_rm(Sa_, SA, mb, nh, fr, fq); \
      const f32x4 psc0 = ps[0], psc1 = ps[1]; const uint2 ylc0 = y8[0], ylc1 = y8[1]; \
      LBAR2(); \
      WB_PREFETCH((step_) + 4, ph, om, ps, y8); \
      f32x4 acc[2]; \
      if (mode == 3) { \
        bmm(Sb_, OmT_, mb, nh, fr, fq, acc); \
        uint2 o; \
        o.x = pack2(acc[0][0] + __uint_as_float(ylc0.x << 16), acc[0][1] + __uint_as_float(ylc0.x & 0xffff0000u)); \
        o.y = pack2(acc[0][2] + __uint_as_float(ylc0.y << 16), acc[0][3] + __uint_as_float(ylc0.y & 0xffff0000u)); \
        *(uint2*)(YL + tile0 + (size_t)(nh * 32 + fr) * 1024 + mb * 16 + fq * 4) = o; \
        o.x = pack2(acc[1][0] + __uint_as_float(ylc1.x << 16), acc[1][1] + __uint_as_float(ylc1.x & 0xffff0000u)); \
        o.y = pack2(acc[1][2] + __uint_as_float(ylc1.y << 16), acc[1][3] + __uint_as_float(ylc1.y & 0xffff0000u)); \
        *(uint2*)(YL + tile0 + (size_t)(nh * 32 + 16 + fr) * 1024 + mb * 16 + fq * 4) = o; \
      } else { \
        bmm(Sa_, PhT_, mb, nh, fr, fq, acc); SA[0] = acc[0]; SA[1] = acc[1]; \
      } \
      bmm(Sb_, PhT_, mb, nh, fr, fq, acc); \
      S[0] = acc[0] + psc0; S[1] = acc[1] + psc1; } while (0)
    yl0[0] = yl0[1] = yl1[0] = yl1[1] = yl2[0] = yl2[1] = yl3[0] = yl3[1] = make_uint2(0u, 0u);
    om0 = om1 = om2 = om3 = make_uint4(0u, 0u, 0u, 0u);
    WB_PREFETCH(0, ph0, om0, ps0, yl0); WB_PREFETCH(1, ph1, om1, ps1, yl1); WB_PREFETCH(2, ph2, om2, ps2, yl2); WB_PREFETCH(3, ph3, om3, ps3, yl3);
    for (int step0 = 0; step0 < 32; step0 += 4) {
      WB_STEP(step0 + 0, ph0, om0, ps0, yl0);
      WB_STEP(step0 + 1, ph1, om1, ps1, yl1);
      WB_STEP(step0 + 2, ph2, om2, ps2, yl2);
      WB_STEP(step0 + 3, ph3, om3, ps3, yl3);
    }
    LBAR2();
    if (mode == 1) {
#pragma unroll
      for (int n = 0; n < 2; ++n) {
        uint2 o; o.x = pack2(SA[n][0], SA[n][1]); o.y = pack2(SA[n][2], SA[n][3]);
        *(uint2*)(PHG + (size_t)item * 4096 + (nh * 32 + n * 16 + fr) * 64 + mb * 16 + fq * 4) = o;
      }
      *(f32x4*)(PSG + (size_t)item * 4096 + nat) = S[0]; *(f32x4*)(PSG + (size_t)item * 4096 + nat + 4) = S[1];
    }
  }
}

DEV void phase_tm_post(const Params& p, int jl) {
  const int TIDX = opaque_tid();
  const int wid = TIDX >> 6, lane = TIDX & 63, hs = lane >> 4, c4 = (lane & 15) * 4;
  bf16_t* Rb = (bf16_t*)(kws() + OFF_R);
  const bf16_t* Vb = (const bf16_t*)(kws() + OFF_V);
  const bf16_t* Gb = (const bf16_t*)(kws() + OFF_G);
  const bf16_t* YF = (const bf16_t*)(kws() + OFF_YLF);
  const bf16_t* YB = (const bf16_t*)(kws() + OFF_YLB);
  const float* BON = (const float*)(kws() + OFF_BON);
  for (int item = blockIdx.x * 8 + wid; item < 2048; item += gridDim.x * 8) {
    const int hd = (item & 3) * 4 + hs, tb = (item >> 2) * 32;
    const int cch = hd * 64 + c4;
    const float4 lg = *(const float4*)(kin(26) + (size_t)jl * 1024 + cch), lb = *(const float4*)(kin(27) + (size_t)jl * 1024 + cch);
    struct PostRaw { uint2 yf, yb, v, g; float b0, b1; };
    auto load_raw = [&](int tt, PostRaw& w) {
      const int t = tb + (tt < 32 ? tt : 31);
      const size_t o = (size_t)t * 1024 + cch;
      const size_t ob = (size_t)((t & ~63) + 63 - (t & 63)) * 1024 + cch;
      w.yf = *(const uint2*)(YF + o); w.yb = *(const uint2*)(YB + ob); w.v = *(const uint2*)(Vb + o); w.g = *(const uint2*)(Gb + o);
      w.b0 = BON[(size_t)t * 16 + hd]; w.b1 = BON[((size_t)SLAB + t) * 16 + hd];
    };
    PostRaw w0, w1;
    load_raw(0, w0); load_raw(1, w1);
    for (int tt = 0; tt < 32; ++tt) {
      PostRaw w2; load_raw(tt + 2, w2);
      float y[4];
      y[0] = __uint_as_float(w0.yf.x << 16) + __uint_as_float(w0.yb.x << 16); y[1] = __uint_as_float(w0.yf.x & 0xffff0000u) + __uint_as_float(w0.yb.x & 0xffff0000u);
      y[2] = __uint_as_float(w0.yf.y << 16) + __uint_as_float(w0.yb.y << 16); y[3] = __uint_as_float(w0.yf.y & 0xffff0000u) + __uint_as_float(w0.yb.y & 0xffff0000u);
      const float mean = row_sum16((y[0] + y[1]) + (y[2] + y[3])) * (1.0f / 64.f);
      const float d0 = y[0] - mean, d1 = y[1] - mean, d2 = y[2] - mean, d3 = y[3] - mean;
      const float var = row_sum16((d0 * d0 + d1 * d1) + (d2 * d2 + d3 * d3)) * (1.0f / 64.f);
      const float rs = rsqrtf(var + 64e-5f), bon = w0.b0 + w0.b1;
      const float o0 = (d0 * rs * lg.x + lb.x + bon * __uint_as_float(w0.v.x << 16)) * __uint_as_float(w0.g.x << 16);
      const float o1 = (d1 * rs * lg.y + lb.y + bon * __uint_as_float(w0.v.x & 0xffff0000u)) * __uint_as_float(w0.g.x & 0xffff0000u);
      const float o2 = (d2 * rs * lg.z + lb.z + bon * __uint_as_float(w0.v.y << 16)) * __uint_as_float(w0.g.y << 16);
      const float o3 = (d3 * rs * lg.w + lb.w + bon * __uint_as_float(w0.v.y & 0xffff0000u)) * __uint_as_float(w0.g.y & 0xffff0000u);
      uint2 o; o.x = pack2(o0, o1); o.y = pack2(o2, o3);
      *(uint2*)(Rb + (size_t)(tb + tt) * 1024 + cch) = o;
      w0 = w1; w1 = w2;
    }
  }
}

DEV void wprep_sgu(const Params& p, int j) {
  wprep_T2((bf16_t*)(kws() + OFF_W + W_SG_IN), 1024, 0, kin(5) + (size_t)j * 1024 * 4096, 1024, 4096, nullptr, 128, 0);
  wprep_T2((bf16_t*)(kws() + OFF_W + W_SG_OUT), 2048, 0, kin(10) + (size_t)j * 2048 * 1024, 2048, 1024, nullptr, 128, 0);
}
DEV void wprep_ffn(const Params& p, int layer) {
  wprep_T2((bf16_t*)(kws() + OFF_W + W_FF_A), 1024, 0, kin(29) + (size_t)layer * 1024 * 2816, 1024, 2816, nullptr, 256, 0);
  wprep_T2((bf16_t*)(kws() + OFF_W + W_FF_A), 1024, 0, kin(30) + (size_t)layer * 1024 * 2816, 1024, 2816, nullptr, 256, 128);
  wprep_T2((bf16_t*)(kws() + OFF_W + W_FF_D), 2816, 0, kin(33) + (size_t)layer * 2816 * 1024, 2816, 1024, nullptr, 128, 0);
}
DEV void wprep_tm(const Params& p, int j) {
  const int TIDX = opaque_tid();
  bf16_t* WP = (bf16_t*)(kws() + OFF_W + W_TM_P);
  const float* srcs[3] = {kin(12) + (size_t)j * 1048576, kin(13) + (size_t)j * 1048576, kin(14) + (size_t)j * 1048576};
#pragma unroll
  for (int i = 0; i < 3; ++i) wprep_T2(WP, 1024, 0, srcs[i], 1024, 1024, nullptr, 128, i * 1024);
#pragma unroll
  for (int e = 0; e < 2; ++e) {
    wprep_T(WP, 1024, 0, kin(16) + ((size_t)j * 2 + e) * 1024 * 64, 1024, 64, nullptr, 128, 3072 + 64 * e);
    wprep_T(WP, 1024, 0, kin(19) + ((size_t)j * 2 + e) * 1024 * 64, 1024, 64, nullptr, 128, 3328 + 64 * e);
    wprep_T2((bf16_t*)(kws() + OFF_W + W_TM_W2) + (size_t)e * 1024 * 64, 64, 0, kin(17) + ((size_t)j * 2 + e) * 64 * 1024, 64, 1024, nullptr, 128, 0);
    wprep_T2((bf16_t*)(kws() + OFF_W + W_TM_A2) + (size_t)e * 1024 * 64, 64, 0, kin(20) + ((size_t)j * 2 + e) * 64 * 1024, 64, 1024, nullptr, 128, 0);
  }
  wprep_T(WP, 1024, 0, kin(21) + (size_t)j * 1024 * 160, 1024, 160, nullptr, 128, 3584);
  for (size_t i = (size_t)blockIdx.x * 512 + TIDX; i < (size_t)(128 + 128 + 96) * 512; i += (size_t)gridDim.x * 512) {
    const size_t row = i / 512, w = i % 512;
    const size_t drow = row < 128 ? 3200 + row : (row < 256 ? 3456 + (row - 128) : 3744 + (row - 256));
    ((unsigned*)(WP + drow * 1024))[w] = 0u;
  }
  wprep_T((bf16_t*)(kws() + OFF_W + W_TM_G2), 160, 0, kin(22) + (size_t)j * 160 * 1024, 160, 1024, nullptr, 128, 0);
  wprep_T2((bf16_t*)(kws() + OFF_W + W_TM_O), 1024, 0, kin(28) + (size_t)j * 1048576, 1024, 1024, nullptr, 128, 0);
}

constexpr int PH_SGU = 10, PH_FFN = 3, PH_TM = 25;
constexpr int N_PHASES = 2 * (PH_SGU + PH_FFN) + 2 * (PH_TM + PH_FFN) + 1;

DEV void run_phase(const Params& p, int ph) {
  if (ph == N_PHASES - 1) { phase_final(p); return; }
  int q = ph, layer = 0;
  for (;;) {
    const int len = (layer & 1) ? PH_TM + PH_FFN : PH_SGU + PH_FFN;
    if (q < len) break;
    q -= len; ++layer;
  }
  const int j = layer >> 1;
  bf16_t* H0 = (bf16_t*)(kws() + OFF_H0);
  const int nmix = (layer & 1) ? PH_TM : PH_SGU;
  if (q >= nmix) {
    const int f = q - nmix;
    if (f == 0) { phase_norm<false>(p, kin(3) + (size_t)layer * 1024, H0); wprep_ffn(p, layer); }
    else if (f == 1) phase_ffn_a(p, layer);
    else phase_gemm_res(p, (const bf16_t*)(kws() + OFF_HMID), 2816, (const bf16_t*)(kws() + OFF_W + W_FF_D), 2816, 192, 0);
    return;
  }
  if (!(layer & 1)) {
    if (q == 0) { if (layer == 0) phase_norm<true>(p, kin(2), H0); else phase_norm<false>(p, kin(2) + (size_t)layer * 1024, H0); wprep_sgu(p, j); return; }
    const int slab = (q - 1) / 3, s = (q - 1) % 3;
    if (s == 0) phase_sgu_in(p, j, slab);
    else if (s == 1) phase_sgu_mix(p, j);
    else phase_gemm_res(p, (const bf16_t*)(kws() + OFF_U), 4096, (const bf16_t*)(kws() + OFF_W + W_SG_OUT), 2048, 64, (long)slab * SLAB);
    return;
  }
  {
    const int slab = q < 18 ? q / 9 : 2;
    int s = q < 18 ? q % 9 : q - 18;
    if (slab == 2 && s >= 4) s += 2;
    switch (s) {
      case 0: phase_norm_tm(p, kin(2) + (size_t)layer * 1024, kin(11) + (size_t)j * 6 * 1024, (bf16_t*)(kws() + OFF_MIX), slab); if (slab == 0) wprep_tm(p, j); break;
      case 1: phase_tm_proj(p); break;
      case 2: phase_tm_lora_out(p, j); break;
      case 3: phase_wkv_a(p, j, slab); break;
      case 4: phase_wkv_b(p, slab, 1); break;
      case 5: phase_wkv_b(p, slab, 2); break;
      case 6: phase_wkv_b(p, slab, 3); break;
      case 7: phase_tm_post(p, j); break;
      default: phase_gemm_res(p, (const bf16_t*)(kws() + OFF_R), 1024, (const bf16_t*)(kws() + OFF_W + W_TM_O), 1024, 64, (long)slab * SLAB); break;
    }
  }
}

#ifndef PROBE_CAT
#define PROBE_CAT -1
#endif
DEV int phase_cat(int ph) {
  if (ph == N_PHASES - 1) return 2;
  int q = ph, layer = 0;
  for (;;) { const int len = (layer & 1) ? PH_TM + PH_FFN : PH_SGU + PH_FFN; if (q < len) break; q -= len; ++layer; }
  const int nmix = (layer & 1) ? PH_TM : PH_SGU;
  if (q >= nmix) return (q - nmix) == 0 ? 2 : ((q - nmix) == 1 ? 7 : 8);
  if (!(layer & 1)) { if (q == 0) return 2; const int s = (q - 1) % 3; return s == 1 ? 3 : 0; }
  int s = q < 18 ? q % 9 : q - 18; if (q >= 18 && s >= 4) s += 2;
  return s == 0 ? 2 : (s == 1 || s == 8) ? 0 : (s == 2 ? 4 : (s == 3 ? 1 : (s == 7 ? 6 : 5)));
}
__global__ void __launch_bounds__(512, 2) mega(Params p, int ph_lo, int ph_hi, int coop) {
#if PROBE_CAT >= 0
  if (blockIdx.x == 0 && threadIdx.x == 0) ((unsigned long long*)(kws() + 500 * MiB))[0] = wall_clock64();
#endif
  for (int ph = ph_lo; ph < ph_hi; ++ph) {
    run_phase(p, ph);
    if (coop && ph + 1 < ph_hi) cg::this_grid().sync();
#if PROBE_CAT >= 0
    if (blockIdx.x == 0 && threadIdx.x == 0) ((unsigned long long*)(kws() + 500 * MiB))[ph + 1] = wall_clock64();
#endif
  }
#if PROBE_CAT >= 0
  cg::this_grid().sync();
  if (blockIdx.x == 0 && threadIdx.x == 0) {
    const unsigned long long* ts = (const unsigned long long*)(kws() + 500 * MiB);
    unsigned long long acc = 0;
    for (int ph = 0; ph < N_PHASES; ++ph) if (PROBE_CAT == 9 || phase_cat(ph) == PROBE_CAT) acc += ts[ph + 1] - ts[ph];
    ((float*)(kws() + 500 * MiB))[1024] = (float)acc * (0.01f * 2e-5f);
  }
  __syncthreads();
  if (blockIdx.x == 0) {
    __threadfence();
    const float ev = ((volatile float*)(kws() + 500 * MiB))[1024];
    for (int i = threadIdx.x; i < 4096; i += 512) kx()[i] += ev;
    for (int i = threadIdx.x; i < 2048; i += 512) kx()[(size_t)32768 * 1024 + i] += ev;
  }
#endif
}

extern "C" void kernel_launch(void* const* d_in, const int* in_sizes, int n_in, void* d_out, int out_size, void* d_ws, size_t ws_size, hipStream_t stream) {
  static int grid = 0;
  if (!grid) {
    int dev = 0, cus = 0, per_cu = 0;
    (void)hipFuncSetAttribute((const void*)mega, hipFuncAttributeMaxDynamicSharedMemorySize, SHM_BYTES);
    (void)hipGetDevice(&dev);
    (void)hipDeviceGetAttribute(&cus, hipDeviceAttributeMultiprocessorCount, dev);
    (void)hipOccupancyMaxActiveBlocksPerMultiprocessor(&per_cu, (const void*)mega, 512, SHM_BYTES);
    if (per_cu < 1) per_cu = 1;
    grid = cus * per_cu;
    if (grid > 256) grid = 256;
    if (grid & 7) grid &= ~7;
  }
  Params p{};
  for (int i = 0; i < 34; ++i) p.in[i] = (const float*)d_in[i];
  p.x = (float*)d_out;
  p.ws = (char*)d_ws;
  int ph_lo = 0, ph_hi = N_PHASES, coop = 1;
  void* args[] = {&p, &ph_lo, &ph_hi, &coop};
  hipError_t e = hipLaunchCooperativeKernel((const void*)mega, dim3(grid), dim3(512), args, SHM_BYTES, stream);
  if (e != hipSuccess) fprintf(stderr, "cooperative launch failed: %s (grid %d)\n", hipGetErrorString(e), grid);
}
```

```cpp
#define PROBE_CAT -1
#include <hip/hip_runtime.h>
#include <hip/hip_cooperative_groups.h>
#include <cstdio>
namespace cg = cooperative_groups;

#define DEV __device__ __forceinline__
typedef unsigned short bf16_t;
typedef short bf16x8 __attribute__((ext_vector_type(8)));
typedef float f32x4 __attribute__((ext_vector_type(4)));

extern __shared__ __attribute__((aligned(16))) char g_shm[];

constexpr int NT = 49152, SLAB = 16384;
constexpr int SHM_BYTES = 147456;
constexpr size_t MiB = 1u << 20;
constexpr size_t OFF_W = 0;
constexpr size_t OFF_H = 24 * MiB;
constexpr size_t OFF_H0 = OFF_H + 256 * 2048;
constexpr size_t OFF_U = 122 * MiB, OFF_SSQ = 250 * MiB;
constexpr size_t OFF_HMID = 122 * MiB;
constexpr size_t OFF_MIX = 200 * MiB;
constexpr size_t OFF_HX = 24 * MiB, OFF_YLF = 24 * MiB, OFF_YLB = 56 * MiB, OFF_R = 88 * MiB, OFF_K = 120 * MiB, OFF_V = 152 * MiB,
                 OFF_HL = 184 * MiB, OFF_E0 = 200 * MiB, OFF_E1 = 232 * MiB, OFF_A0 = 264 * MiB, OFF_A1 = 296 * MiB, OFF_G = 328 * MiB,
                 OFF_PSI = 360 * MiB, OFF_BON = 488 * MiB, OFF_PHG = 490 * MiB, OFF_PSG = 492 * MiB, OFF_SST = 496 * MiB;
constexpr size_t W_SG_IN = 0, W_SG_OUT = 8 * MiB;
constexpr size_t W_FF_A = 0, W_FF_D = 12 * MiB;
constexpr size_t W_TM_P = 0, W_TM_O = 14 * MiB, W_TM_W2 = 16 * MiB, W_TM_A2 = 16 * MiB + 512 * 1024, W_TM_G2 = 17 * MiB;

struct Params {
  const float* in[34];
  float* x;
  char* ws;
};


typedef const __attribute__((address_space(4))) char* karg_t;
DEV int opaque0() { int z = 0; asm volatile("" : "+s"(z)); return z; }
DEV const float* kin(int i) { karg_t kp = (karg_t)__builtin_amdgcn_kernarg_segment_ptr(); return *(const float* const __attribute__((address_space(4)))*)(kp + (i + opaque0()) * 8); }
DEV float* kx() { karg_t kp = (karg_t)__builtin_amdgcn_kernarg_segment_ptr(); return *(float* const __attribute__((address_space(4)))*)(kp + (34 + opaque0()) * 8); }
DEV char* kws() { karg_t kp = (karg_t)__builtin_amdgcn_kernarg_segment_ptr(); return *(char* const __attribute__((address_space(4)))*)(kp + (35 + opaque0()) * 8); }

DEV int opaque_tid() { int z = 0; asm volatile("" : "+v"(z)); return (int)threadIdx.x + z; }
#define LBAR2() do { asm volatile("s_waitcnt lgkmcnt(0)" ::: "memory"); __builtin_amdgcn_s_barrier(); asm volatile("" ::: "memory"); } while (0)
DEV float bf2f(bf16_t u) { return __uint_as_float(((unsigned)u) << 16); }
typedef float f32x2 __attribute__((ext_vector_type(2)));
typedef __bf16 bf16x2_t __attribute__((ext_vector_type(2)));
DEV unsigned pack2(float a, float b) { f32x2 v = {a, b}; bf16x2_t h = __builtin_convertvector(v, bf16x2_t); return __builtin_bit_cast(unsigned, h); }
DEV bf16_t f2bf(float f) { return (bf16_t)(pack2(f, f) & 0xffffu); }
template <int CTRL> DEV float dppmov(float v) { return __int_as_float(__builtin_amdgcn_update_dpp(0, __float_as_int(v), CTRL, 0xf, 0xf, true)); }
DEV float row_sum16(float v) {
  v += dppmov<0xB1>(v); v += dppmov<0x4E>(v); v += dppmov<0x141>(v); v += dppmov<0x140>(v);
  return v;
}
DEV float wave_sum(float v) {
  const int r = __float_as_int(row_sum16(v));
  return (__int_as_float(__builtin_amdgcn_readlane(r, 0)) + __int_as_float(__builtin_amdgcn_readlane(r, 16))) +
         (__int_as_float(__builtin_amdgcn_readlane(r, 32)) + __int_as_float(__builtin_amdgcn_readlane(r, 48)));
}
DEV float sigmoidf_(float x) { return 1.0f / (1.0f + __expf(-x)); }
DEV f32x2 gelu_pk(f32x2 v) {
  const f32x2 av = __builtin_elementwise_abs(v), d = av * 0.2316418882f + 1.0f;
  f32x2 t; t.x = __builtin_amdgcn_rcpf(d.x); t.y = __builtin_amdgcn_rcpf(d.y);
  f32x2 q = t * 0.5307027145f + (-0.7265760135f); q = q * t + 0.7107068705f; q = q * t + (-0.142248368f); q = q * t + 0.127414796f; q = q * t;
  const f32x2 s = (v * v) * (-0.72134752044f);
  f32x2 e; e.x = __builtin_amdgcn_exp2f(s.x); e.y = __builtin_amdgcn_exp2f(s.y);
  const f32x2 m = v * (q * e), r = v - m;
  f32x2 o; o.x = v.x < 0.f ? m.x : r.x; o.y = v.y < 0.f ? m.y : r.y; return o;
}
DEV float gelu_exact(float v) {
  const float av = fabsf(v), d = av * 0.2316418882f + 1.0f;
  const float t = __builtin_amdgcn_rcpf(d);
  float q = t * 0.5307027145f + (-0.7265760135f); q = q * t + 0.7107068705f; q = q * t + (-0.142248368f); q = q * t + 0.127414796f; q = q * t;
  const float e = __builtin_amdgcn_exp2f((v * v) * (-0.72134752044f));
  const float m = v * (q * e), r = v - m;
  return v < 0.f ? m : r;
}

DEV void phase_init(const Params& p) {
  const int TIDX = opaque_tid();
  const float4* xp = (const float4*)kin(0);
  const float4* xs = (const float4*)kin(1);
  float4* x = (float4*)kx();
  const size_t n0 = (size_t)32768 * 256, n1 = (size_t)16384 * 256;
  for (size_t i = (size_t)blockIdx.x * 512 + TIDX; i < n0 + n1; i += (size_t)gridDim.x * 512) x[i] = i < n0 ? xp[i] : xs[i - n0];
}

template <bool FROM_INPUT>
DEV void phase_norm(const Params& p, const float* g, bf16_t* h0) {
  const int TIDX = opaque_tid();
  const int wid = TIDX >> 6, lane = TIDX & 63;
  float4 gv[4];
#pragma unroll
  for (int i = 0; i < 4; ++i) gv[i] = ((const float4*)g)[lane + 64 * i];
  const int tstep = gridDim.x * 8;
  auto row_ptr = [&](int t) -> const float4* {
    const int tc = t < NT ? t : NT - 1;
    return FROM_INPUT ? (const float4*)(tc < 32768 ? kin(0) + (size_t)tc * 1024 : kin(1) + (size_t)(tc - 32768) * 1024)
                      : (const float4*)(kx() + (size_t)tc * 1024);
  };
  float4 nx[4];
  { const float4* xr = row_ptr(blockIdx.x * 8 + wid);
#pragma unroll
    for (int i = 0; i < 4; ++i) nx[i] = xr[lane + 64 * i]; }
  for (int t = blockIdx.x * 8 + wid; t < NT; t += tstep) {
    float4 v[4]; float ss = 0.f;
#pragma unroll
    for (int i = 0; i < 4; ++i) { v[i] = nx[i]; ss += v[i].x * v[i].x + v[i].y * v[i].y + v[i].z * v[i].z + v[i].w * v[i].w; }
    { const float4* xr = row_ptr(t + tstep);
#pragma unroll
      for (int i = 0; i < 4; ++i) nx[i] = xr[lane + 64 * i]; }
    if (FROM_INPUT) {
      float4* xw = (float4*)(kx() + (size_t)t * 1024);
#pragma unroll
      for (int i = 0; i < 4; ++i) xw[lane + 64 * i] = v[i];
    }
    ss = wave_sum(ss);
    const float rs = rsqrtf(ss * (1.0f / 1024.f) + 1e-6f);
    uint2* hr = (uint2*)(h0 + (size_t)t * 1024);
#pragma unroll
    for (int i = 0; i < 4; ++i) {
      uint2 o; o.x = pack2(v[i].x * rs * gv[i].x, v[i].y * rs * gv[i].y); o.y = pack2(v[i].z * rs * gv[i].z, v[i].w * rs * gv[i].w);
      hr[lane + 64 * i] = o;
    }
  }
}

DEV void phase_norm_tm(const Params& p, const float* g, const float* mu, bf16_t* mixb, int slab) {
  const int TIDX = opaque_tid();
  const int wid = TIDX >> 6, lane = TIDX & 63;
  const int L = slab < 2 ? 16384 : 2048;
  float4 gv[4], muv[6][4];
#pragma unroll
  for (int i = 0; i < 4; ++i) gv[i] = ((const float4*)g)[lane + 64 * i];
#pragma unroll
  for (int m = 0; m < 6; ++m)
#pragma unroll
    for (int i = 0; i < 4; ++i) muv[m][i] = ((const float4*)(mu + m * 1024))[lane + 64 * i];
  for (int ts = blockIdx.x * 8 + wid; ts < SLAB; ts += gridDim.x * 8) {
    const int t = slab * SLAB + ts, pos = ts & (L - 1);
    float4 hv[3][4];
#pragma unroll
    for (int d = 0; d < 3; ++d) {
      const bool valid = !((d == 0 && pos == 0) || (d == 2 && pos == L - 1));
      const int tt = valid ? t + d - 1 : t;
      const float4* xr = (const float4*)(kx() + (size_t)tt * 1024);
      float ss = 0.f;
#pragma unroll
      for (int i = 0; i < 4; ++i) { float4 v = xr[lane + 64 * i]; hv[d][i] = v; ss += v.x * v.x + v.y * v.y + v.z * v.z + v.w * v.w; }
      ss = wave_sum(ss);
      const float rs = valid ? rsqrtf(ss * (1.0f / 1024.f) + 1e-6f) : 0.f;
#pragma unroll
      for (int i = 0; i < 4; ++i) { hv[d][i].x *= rs * gv[i].x; hv[d][i].y *= rs * gv[i].y; hv[d][i].z *= rs * gv[i].z; hv[d][i].w *= rs * gv[i].w; }
    }
#pragma unroll
    for (int i = 0; i < 4; ++i) {
      hv[0][i].x = 0.5f * (hv[0][i].x + hv[2][i].x) - hv[1][i].x; hv[0][i].y = 0.5f * (hv[0][i].y + hv[2][i].y) - hv[1][i].y;
      hv[0][i].z = 0.5f * (hv[0][i].z + hv[2][i].z) - hv[1][i].z; hv[0][i].w = 0.5f * (hv[0][i].w + hv[2][i].w) - hv[1][i].w;
    }
#pragma unroll
    for (int m = 0; m < 6; ++m) {
      uint2* orow = (uint2*)(mixb + ((size_t)m * SLAB + ts) * 1024);
#pragma unroll
      for (int i = 0; i < 4; ++i) {
        const float4 mv = muv[m][i];
        uint2 o;
        o.x = pack2(hv[1][i].x + hv[0][i].x * mv.x, hv[1][i].y + hv[0][i].y * mv.y);
        o.y = pack2(hv[1][i].z + hv[0][i].z * mv.z, hv[1][i].w + hv[0][i].w * mv.w);
        orow[lane + 64 * i] = o;
      }
    }
  }
}

DEV void phase_final(const Params& p) {
  const int TIDX = opaque_tid();
  const int wid = TIDX >> 6, lane = TIDX & 63;
  const float* g = kin(4);
  float4 gv[4];
#pragma unroll
  for (int i = 0; i < 4; ++i) gv[i] = ((const float4*)g)[lane + 64 * i];
  for (int t = blockIdx.x * 8 + wid; t < NT; t += gridDim.x * 8) {
    float4* xr = (float4*)(kx() + (size_t)t * 1024);
    float4 v[4]; float ss = 0.f;
#pragma unroll
    for (int i = 0; i < 4; ++i) { v[i] = xr[lane + 64 * i]; ss += v[i].x * v[i].x + v[i].y * v[i].y + v[i].z * v[i].z + v[i].w * v[i].w; }
    ss = wave_sum(ss);
    const float rs = rsqrtf(ss * (1.0f / 1024.f) + 1e-6f);
#pragma unroll
    for (int i = 0; i < 4; ++i) {
      float4 o; o.x = v[i].x * rs * gv[i].x; o.y = v[i].y * rs * gv[i].y; o.z = v[i].z * rs * gv[i].z; o.w = v[i].w * rs * gv[i].w;
      xr[lane + 64 * i] = o;
    }
  }
}

DEV void wprep_T(bf16_t* dst, int ldd, int koff, const float* src, int Ks, int Ns, const float* scale, int rs, int roff) {
  const int TIDX = opaque_tid();
  float (*tile)[33] = (float (*)[33])g_shm;
  const int tx = TIDX & 31, ty = TIDX >> 5;
  const int nkt = Ks / 32, nnt = Ns / 32;
  for (int tIdx = blockIdx.x; tIdx < nkt * nnt; tIdx += gridDim.x) {
    const int k0 = (tIdx / nnt) * 32, n0 = (tIdx % nnt) * 32;
    __syncthreads();
#pragma unroll
    for (int i = 0; i < 2; ++i) tile[ty + 16 * i][tx] = src[(size_t)(k0 + ty + 16 * i) * Ns + n0 + tx];
    __syncthreads();
    const float sc = scale ? scale[k0 + tx] : 1.0f;
#pragma unroll
    for (int i = 0; i < 2; ++i) {
      const int n = n0 + ty + 16 * i;
      const int drow = (n >> 7) * rs + (n & 127) + roff;
      dst[(size_t)drow * ldd + koff + k0 + tx] = f2bf(tile[tx][ty + 16 * i] * sc);
    }
  }
  __syncthreads();
}


DEV void wprep_T2(bf16_t* dst, int ldd, int koff, const float* src, int Ks, int Ns, const float* scale, int rs, int roff) {
  const int TIDX = opaque_tid();
  float* tile = (float*)g_shm;
  const int nkt = Ks / 64, nnt = Ns / 128;
  const int lc = TIDX & 127, lr = TIDX >> 7;
  const int wk = TIDX & 63, wn = TIDX >> 6;
  for (int tIdx = blockIdx.x; tIdx < nkt * nnt; tIdx += gridDim.x) {
    const int k0 = (tIdx / nnt) * 64, n0 = (tIdx % nnt) * 128;
    float v[16];
#pragma unroll
    for (int i = 0; i < 16; ++i) v[i] = src[(size_t)(k0 + i * 4 + lr) * Ns + n0 + lc];
    __syncthreads();
#pragma unroll
    for (int i = 0; i < 16; ++i) tile[(i * 4 + lr) * 129 + lc] = v[i];
    __syncthreads();
    const float sc = scale ? scale[k0 + wk] : 1.0f;
#pragma unroll
    for (int i = 0; i < 16; ++i) {
      const int n = n0 + i * 8 + wn;
      const int drow = (n >> 7) * rs + (n & 127) + roff;
      dst[(size_t)drow * ldd + koff + k0 + wk] = f2bf(tile[wk * 129 + i * 8 + wn] * sc);
    }
  }
  __syncthreads();
}

constexpr int BM = 256, BK = 64, HALF = 128, HT = HALF * BK;
DEV int lds_byte(int r, int c) {
  int st = (r >> 4) * 2 + (c >> 5), rr = r & 15, cc = c & 31, ob = rr * 64 + cc * 2;
  return st * 1024 + (ob ^ (((ob >> 9) & 1) << 5));
}
DEV void stage_rc(int b, int& R, int& C) {
  int st = b / 1024, sb = b % 1024, swz = sb ^ (((sb >> 9) & 1) << 5);
  R = (st >> 1) * 16 + swz / 64; C = (st & 1) * 32 + (swz % 64) / 2;
}

typedef __attribute__((address_space(3))) unsigned char lds_u8;
DEV void gemm_big(const bf16_t* A, long lda, const bf16_t* Bt, long ldb, int K, long brow, long bcol, f32x4 (&acc)[2][2][4][2]) {
  const int TIDX = opaque_tid();
  lds_u8* lds = (lds_u8*)g_shm;
  constexpr int HTB = HT * 2;
#define SA(b, h) (((b) * 2 + (h)) * HTB)
#define SB(b, h) ((4 + (b) * 2 + (h)) * HTB)
#define STAGE(bufoff, gbase, VO, kt) do { const char* _gp = (gbase) + (size_t)(kt) * (BK * 2); \
    __builtin_amdgcn_global_load_lds((const unsigned*)(_gp + VO##0), (__attribute__((address_space(3))) unsigned*)(lds + (bufoff) + ldsw), 16, 0, 0); \
    __builtin_amdgcn_global_load_lds((const unsigned*)(_gp + VO##1), (__attribute__((address_space(3))) unsigned*)(lds + (bufoff) + ldsw + 8192), 16, 0, 0); } while (0)
#define LDA(dst, b, h) for (int m = 0; m < 4; ++m) for (int k = 0; k < 2; ++k) \
    dst[m][k] = *(const __attribute__((address_space(3))) bf16x8*)(lds + SA(b, h) + aoff + m * 2048 + k * 1024)
#define LDB(dst, b, h) for (int n = 0; n < 2; ++n) for (int k = 0; k < 2; ++k) \
    dst[n][k] = *(const __attribute__((address_space(3))) bf16x8*)(lds + SB(b, h) + boff + n * 2048 + k * 1024)
#define MMA(ai, bj, At, Bt_) do { __builtin_amdgcn_s_setprio(1); \
    for (int m = 0; m < 4; ++m) for (int n = 0; n < 2; ++n) for (int k = 0; k < 2; ++k) \
      acc[ai][bj][m][n] = __builtin_amdgcn_mfma_f32_16x16x32_bf16(Bt_[n][k], At[m][k], acc[ai][bj][m][n], 0, 0, 0); \
    __builtin_amdgcn_s_setprio(0); } while (0)
#define WAIT_V(n) asm volatile("s_waitcnt vmcnt(" #n ")" ::: "memory")
#define WAIT_L(n) asm volatile("s_waitcnt lgkmcnt(" #n ")" ::: "memory")
#define BAR __builtin_amdgcn_s_barrier()
#define SCHED __builtin_amdgcn_sched_barrier(0)
  const int tid = TIDX, wid = __builtin_amdgcn_readfirstlane(tid >> 6), lane = tid & 63, wr = wid >> 2, wc = wid & 3, fr = lane & 15, fq = lane >> 4;
  unsigned va0, va1, vb0, vb1;
  { int r_, c_; stage_rc(tid * 16, r_, c_); va0 = (unsigned)((r_ * lda + c_) * 2); vb0 = (unsigned)((r_ * ldb + c_) * 2);
    stage_rc(tid * 16 + 8192, r_, c_); va1 = (unsigned)((r_ * lda + c_) * 2); vb1 = (unsigned)((r_ * ldb + c_) * 2); }
  const unsigned ldsw = (unsigned)wid * 1024u;
  const int aoff = lds_byte(wr * 64 + fr, fq * 8), boff = lds_byte(wc * 32 + fr, fq * 8);
  const char* cA0 = (const char*)(A + brow * lda); const char* cA1 = cA0 + (size_t)HALF * lda * 2;
  const char* cB0 = (const char*)(Bt + bcol * ldb); const char* cB1 = cB0 + (size_t)HALF * ldb * 2;
#pragma unroll
  for (int a = 0; a < 2; ++a)
#pragma unroll
    for (int b = 0; b < 2; ++b)
#pragma unroll
      for (int m = 0; m < 4; ++m)
#pragma unroll
        for (int n = 0; n < 2; ++n) acc[a][b][m][n] = (f32x4){0.f, 0.f, 0.f, 0.f};
  bf16x8 At[4][2], B0[2][2], B1[2][2];
  const int nt = K / BK;
  STAGE(SB(0, 0), cB0, vb, 0); STAGE(SA(0, 0), cA0, va, 0);
  STAGE(SB(0, 1), cB1, vb, 0); STAGE(SA(0, 1), cA1, va, 0);
  if (wr == 1) BAR;
  WAIT_V(4); BAR;
  STAGE(SB(1, 0), cB0, vb, 1); STAGE(SA(1, 0), cA0, va, 1); STAGE(SB(1, 1), cB1, vb, 1);
  WAIT_V(6); BAR;
  for (int t = 0; t < nt - 2; t += 2) {
    LDB(B0, 0, 0); SCHED; LDA(At, 0, 0); STAGE(SA(1, 1), cA1, va, t + 1);
    WAIT_L(8); BAR; WAIT_L(0); MMA(0, 0, At, B0); BAR; SCHED;
    LDB(B1, 0, 1); STAGE(SB(0, 0), cB0, vb, t + 2);
    BAR; WAIT_L(0); MMA(0, 1, At, B1); BAR;
    LDA(At, 0, 1); STAGE(SA(0, 0), cA0, va, t + 2);
    BAR; WAIT_L(0); MMA(1, 0, At, B0); BAR; SCHED;
    STAGE(SB(0, 1), cB1, vb, t + 2);
    WAIT_V(6); BAR; MMA(1, 1, At, B1); BAR;
    LDB(B0, 1, 0); SCHED; LDA(At, 1, 0); STAGE(SA(0, 1), cA1, va, t + 2);
    WAIT_L(8); BAR; WAIT_L(0); MMA(0, 0, At, B0); BAR; SCHED;
    LDB(B1, 1, 1); STAGE(SB(1, 0), cB0, vb, t + 3);
    BAR; WAIT_L(0); MMA(0, 1, At, B1); BAR;
    LDA(At, 1, 1); STAGE(SA(1, 0), cA0, va, t + 3);
    BAR; WAIT_L(0); MMA(1, 0, At, B0); BAR; SCHED;
    STAGE(SB(1, 1), cB1, vb, t + 3);
    WAIT_V(6); BAR; MMA(1, 1, At, B1); BAR;
  }
  { LDB(B0, 0, 0); LDA(At, 0, 0); STAGE(SA(1, 1), cA1, va, nt - 1);
    BAR; WAIT_L(0); MMA(0, 0, At, B0); BAR;
    LDB(B1, 0, 1); BAR; WAIT_L(0); MMA(0, 1, At, B1); BAR;
    LDA(At, 0, 1); WAIT_V(4); BAR; WAIT_L(0); MMA(1, 0, At, B0); MMA(1, 1, At, B1); BAR; }
  { LDB(B0, 1, 0); LDA(At, 1, 0); WAIT_V(2); BAR; WAIT_L(0); MMA(0, 0, At, B0); BAR;
    LDB(B1, 1, 1); WAIT_V(0); BAR; WAIT_L(0); MMA(0, 1, At, B1); BAR;
    LDA(At, 1, 1); BAR; WAIT_L(0); MMA(1, 0, At, B0); MMA(1, 1, At, B1); BAR; }
  if (wr == 0) BAR;
}
DEV void dump_half(const f32x4 (&acc)[2][2][4][2], int ai, int tid) {
  float* T = (float*)g_shm;
  const int wid = tid >> 6, lane = tid & 63, wr = wid >> 2, wc = wid & 3, fr = lane & 15, fq = lane >> 4;
#pragma unroll
  for (int bj = 0; bj < 2; ++bj)
#pragma unroll
    for (int m = 0; m < 4; ++m)
#pragma unroll
      for (int n = 0; n < 2; ++n) {
        const int r = wr * 64 + m * 16 + fr, c = bj * 128 + wc * 32 + n * 16 + fq * 4;
        *(f32x4*)(T + r * 260 + c) = (ai == 0) ? acc[0][bj][m][n] : acc[1][bj][m][n];
      }
}
DEV float4 tile_ld4(int r, int c4) { return *(const float4*)((const float*)g_shm + r * 260 + c4); }
DEV void dump_tile_bf16(const f32x4 (&acc)[2][2][4][2], int tid) {
  bf16_t* T = (bf16_t*)g_shm;
  const int wid = tid >> 6, lane = tid & 63, wr = wid >> 2, wc = wid & 3, fr = lane & 15, fq = lane >> 4;
#pragma unroll
  for (int ai = 0; ai < 2; ++ai)
#pragma unroll
    for (int bj = 0; bj < 2; ++bj)
#pragma unroll
      for (int m = 0; m < 4; ++m)
#pragma unroll
        for (int n = 0; n < 2; ++n) {
          const int r = ai * 128 + wr * 64 + m * 16 + fr, c = bj * 128 + wc * 32 + n * 16 + fq * 4;
          uint2 o; o.x = pack2(acc[ai][bj][m][n][0], acc[ai][bj][m][n][1]); o.y = pack2(acc[ai][bj][m][n][2], acc[ai][bj][m][n][3]);
          *(uint2*)(T + r * 264 + c) = o;
        }
}
DEV float4 tileb_ld4(int r, int c4) {
  const uint2 u = *(const uint2*)((const bf16_t*)g_shm + r * 264 + c4);
  return make_float4(__uint_as_float(u.x << 16), __uint_as_float(u.x & 0xffff0000u), __uint_as_float(u.y << 16), __uint_as_float(u.y & 0xffff0000u));
}

DEV int vblock() { return (blockIdx.x & 7) * (gridDim.x >> 3) + (blockIdx.x >> 3); }

DEV void tile_pmpn(int tile, int nM, int nN, int& pm, int& pn) {
  const int nig = 8 * nN, gid = tile / nig, fm = gid * 8, gsz = (nM - fm) < 8 ? (nM - fm) : 8;
  pm = fm + ((tile % nig) % gsz); pn = (tile % nig) / gsz;
}
DEV void phase_gemm_res(const Params& p, const bf16_t* A, long lda, const bf16_t* Bt, int K, int mtiles, long xrow0) {
  float* X = kx();
  for (int tile = vblock(); tile < mtiles * 4; tile += gridDim.x) {
    int pm, pn; tile_pmpn(tile, mtiles, 4, pm, pn);
    f32x4 acc[2][2][4][2];
    gemm_big(A, lda, Bt, K, K, (long)pm * 256, (long)pn * 256, acc);
    const int tid = opaque_tid();
#pragma unroll
    for (int ai = 0; ai < 2; ++ai) {
      LBAR2();
      dump_half(acc, ai, tid);
      LBAR2();
      for (int e = tid; e < 128 * 64; e += 512) {
        const int r = e >> 6, c4 = (e & 63) * 4;
        const float4 v = tile_ld4(r, c4);
        float4* q = (float4*)(X + (xrow0 + pm * 256 + ai * 128 + r) * 1024 + pn * 256 + c4);
        float4 o = *q; o.x += v.x; o.y += v.y; o.z += v.z; o.w += v.w; *q = o;
      }
    }
    LBAR2();
  }
}

DEV void phase_sgu_in(const Params& p, int j, int slab) {
  const bf16_t* A = (const bf16_t*)(kws() + OFF_H0) + (size_t)slab * SLAB * 1024;
  const bf16_t* Bt = (const bf16_t*)(kws() + OFF_W + W_SG_IN);
  const float* bin = kin(6) + (size_t)j * 4096;
  bf16_t* Z = (bf16_t*)(kws() + OFF_U);
  float* SSQ = (float*)(kws() + OFF_SSQ);
  for (int tile = vblock(); tile < 64 * 16; tile += gridDim.x) {
    int pm, pn; tile_pmpn(tile, 64, 16, pm, pn);
    f32x4 acc[2][2][4][2];
    gemm_big(A, 1024, Bt, 1024, 1024, (long)pm * 256, (long)pn * 256, acc);
    const int tid = opaque_tid(), wid = tid >> 6, lane = tid & 63;
    const float4 b4 = *(const float4*)(bin + pn * 256 + lane * 4);
    dump_tile_bf16(acc, tid);
    LBAR2();
    for (int rr = 0; rr < 32; ++rr) {
      const int r = wid * 32 + rr;
      const float4 v = tileb_ld4(r, lane * 4);
      const f32x2 za = gelu_pk((f32x2){v.x + b4.x, v.y + b4.y}), zb = gelu_pk((f32x2){v.z + b4.z, v.w + b4.w});
      const float z0 = za.x, z1 = za.y, z2 = zb.x, z3 = zb.y;
      const int row = pm * 256 + r;
      uint2 o; o.x = pack2(z0, z1); o.y = pack2(z2, z3);
      *(uint2*)(Z + (size_t)row * 4096 + pn * 256 + lane * 4) = o;
      if (pn >= 8) {
        const float ss = wave_sum(z0 * z0 + z1 * z1 + z2 * z2 + z3 * z3);
        if (lane == 0) SSQ[(size_t)row * 8 + (pn - 8)] = ss;
      }
    }
    LBAR2();
  }
}

DEV void phase_tm_proj(const Params& p) {
  const bf16_t* MIX = (const bf16_t*)(kws() + OFF_MIX);
  const bf16_t* Bt = (const bf16_t*)(kws() + OFF_W + W_TM_P);
  for (int tile = vblock(); tile < 64 * 15; tile += gridDim.x) {
    int pm, pn; tile_pmpn(tile, 64, 15, pm, pn);
    const int msel = pn < 4 ? 0 : (pn < 8 ? 2 : (pn < 12 ? 3 : (pn == 12 ? 1 : (pn == 13 ? 4 : 5))));
    f32x4 acc[2][2][4][2];
    gemm_big(MIX + (size_t)msel * SLAB * 1024, 1024, Bt, 1024, 1024, (long)pm * 256, (long)pn * 256, acc);
    const int tid = opaque_tid(), wid = tid >> 6, lane = tid & 63;
    bf16_t* O; int ld, cb;
    if (pn < 12) { O = (bf16_t*)(kws() + (pn < 4 ? OFF_R : (pn < 8 ? OFF_K : OFF_V))); ld = 1024; cb = (pn & 3) * 256; }
    else { O = (bf16_t*)(kws() + OFF_HL); ld = 512; cb = pn == 12 ? 0 : (pn == 13 ? 128 : 256); }
    const int act = pn == 12 ? 1 : (pn == 14 ? 2 : 0);
    const bool live = pn < 12 || pn == 14 || lane < 32;
    dump_tile_bf16(acc, tid);
    LBAR2();
    for (int rr = 0; rr < 32; ++rr) {
      const int r = wid * 32 + rr;
      float4 v = tileb_ld4(r, lane * 4);
      if (act == 1) { v.x = tanhf(v.x); v.y = tanhf(v.y); v.z = tanhf(v.z); v.w = tanhf(v.w); }
      else if (act == 2) { v.x = sigmoidf_(v.x); v.y = sigmoidf_(v.y); v.z = sigmoidf_(v.z); v.w = sigmoidf_(v.w); }
      uint2 o; o.x = pack2(v.x, v.y); o.y = pack2(v.z, v.w);
      if (live) *(uint2*)(O + (size_t)(pm * 256 + r) * ld + cb + lane * 4) = o;
    }
    LBAR2();
  }
}

DEV void phase_ffn_a(const Params& p, int layer) {
  const bf16_t* A = (const bf16_t*)(kws() + OFF_H0);
  const bf16_t* Bt = (const bf16_t*)(kws() + OFF_W + W_FF_A);
  bf16_t* HM = (bf16_t*)(kws() + OFF_HMID);
  const float* cw = kin(31) + (size_t)layer * 3 * 2816;
  const float* cb = kin(32) + (size_t)layer * 2816;
  bf16_t* gl = (bf16_t*)g_shm;
  bf16_t* ul = (bf16_t*)(g_shm + 69632);
  for (int tile = vblock(); tile < 195 * 22; tile += gridDim.x) {
    int mi, pn; tile_pmpn(tile, 195, 22, mi, pn);
    const int base = (mi / 65) * 16384, L = 16384, i = mi % 65;
    const int seqmask = mi < 130 ? 16383 : 2047;
    const int s0 = 254 * i - 1;
    f32x4 acc[2][2][4][2];
    gemm_big(A, 1024, Bt, 1024, 1024, (long)base + s0, (long)pn * 256, acc);
    const int tid = opaque_tid(), wid = tid >> 6, lane = tid & 63, wr = wid >> 2, wc = wid & 3, fr = lane & 15, fq = lane >> 4;
#pragma unroll
    for (int ai = 0; ai < 2; ++ai)
#pragma unroll
      for (int m = 0; m < 4; ++m) {
        const int r = ai * 128 + wr * 64 + m * 16 + fr, sp = s0 + r;
        const bool inseq = sp >= 0 && sp < L;
#pragma unroll
        for (int n = 0; n < 2; ++n) {
          const int c = wc * 32 + n * 16 + fq * 4;
          uint2 o;
          o.x = inseq ? pack2(acc[ai][0][m][n][0], acc[ai][0][m][n][1]) : 0u; o.y = inseq ? pack2(acc[ai][0][m][n][2], acc[ai][0][m][n][3]) : 0u;
          *(uint2*)(gl + r * 136 + c) = o;
          o.x = pack2(acc[ai][1][m][n][0], acc[ai][1][m][n][1]); o.y = pack2(acc[ai][1][m][n][2], acc[ai][1][m][n][3]);
          *(uint2*)(ul + r * 136 + c) = o;
        }
      }
    const int c4 = (lane & 31) * 4, f = pn * 128 + c4;
    const float4 w0 = *(const float4*)(cw + f), w1 = *(const float4*)(cw + 2816 + f), w2 = *(const float4*)(cw + 2 * 2816 + f), bb = *(const float4*)(cb + f);
    LBAR2();
    for (int e = tid; e < 256 * 32; e += 512) {
      const int r = e >> 5, sp = s0 + r;
      if (r >= 1 && r <= 254 && sp < L) {
        const uint2 ur = *(const uint2*)(ul + r * 136 + c4);
        const int pos = sp & seqmask;
        uint2 g0 = *(const uint2*)(gl + (r - 1) * 136 + c4), g2 = *(const uint2*)(gl + (r + 1) * 136 + c4);
        const uint2 g1 = *(const uint2*)(gl + r * 136 + c4);
        if (pos == 0) g0 = make_uint2(0u, 0u);
        if (pos == seqmask) g2 = make_uint2(0u, 0u);
        const float c0 = w0.x * __uint_as_float(g0.x << 16) + w1.x * __uint_as_float(g1.x << 16) + w2.x * __uint_as_float(g2.x << 16) + bb.x;
        const float c1 = w0.y * __uint_as_float(g0.x & 0xffff0000u) + w1.y * __uint_as_float(g1.x & 0xffff0000u) + w2.y * __uint_as_float(g2.x & 0xffff0000u) + bb.y;
        const float c2 = w0.z * __uint_as_float(g0.y << 16) + w1.z * __uint_as_float(g1.y << 16) + w2.z * __uint_as_float(g2.y << 16) + bb.z;
        const float c3 = w0.w * __uint_as_float(g0.y & 0xffff0000u) + w1.w * __uint_as_float(g1.y & 0xffff0000u) + w2.w * __uint_as_float(g2.y & 0xffff0000u) + bb.w;
        const f32x2 ga = gelu_pk((f32x2){c0, c1}), gb = gelu_pk((f32x2){c2, c3});
        uint2 o; o.x = pack2(ga.x * __uint_as_float(ur.x << 16), ga.y * __uint_as_float(ur.x & 0xffff0000u));
        o.y = pack2(gb.x * __uint_as_float(ur.y << 16), gb.y * __uint_as_float(ur.y & 0xffff0000u));
        *(uint2*)(HM + (size_t)(base + sp) * 2816 + f) = o;
      }
    }
    LBAR2();
  }
}

template <int KP>
DEV void small_mma(f32x4 (&acc)[4][4]) {
  const int TIDX = opaque_tid();
  constexpr int LD = KP + 8;
  const bf16_t* sA = (const bf16_t*)g_shm;
  const bf16_t* sB = sA + 128 * LD;
  const int wid = TIDX >> 6, lane = TIDX & 63, wr = wid >> 2, wc = wid & 3, fr = lane & 15, fq = lane >> 4;
#pragma unroll
  for (int m = 0; m < 4; ++m)
#pragma unroll
    for (int n = 0; n < 4; ++n) acc[m][n] = (f32x4){0.f, 0.f, 0.f, 0.f};
#pragma unroll
  for (int kk = 0; kk < KP / 32; ++kk) {
    bf16x8 a[4], b[4];
#pragma unroll
    for (int m = 0; m < 4; ++m) a[m] = *(const bf16x8*)(sA + (wr * 64 + m * 16 + fr) * LD + kk * 32 + fq * 8);
#pragma unroll
    for (int n = 0; n < 4; ++n) b[n] = *(const bf16x8*)(sB + (wc * 64 + n * 16 + fr) * LD + kk * 32 + fq * 8);
#pragma unroll
    for (int m = 0; m < 4; ++m)
#pragma unroll
      for (int n = 0; n < 4; ++n) acc[m][n] = __builtin_amdgcn_mfma_f32_16x16x32_bf16(b[n], a[m], acc[m][n], 0, 0, 0);
  }
}
template <int KP>
DEV void small_load_ab(bf16_t* sA, const bf16_t* gA, long lda, bf16_t* sB, const bf16_t* gB, long ldb, int tid) {
  constexpr int LD = KP + 8, CPR = KP / 8, TA = 128 * CPR, TB = 256 * CPR, IA = TA / 512, IB = TB / 512;
  static_assert(TA % 512 == 0 && TB % 512 == 0, "panel sizes must be multiples of the block");
  uint4 va[IA], vb[IB];
#pragma unroll
  for (int it = 0; it < IA; ++it) { const int c = tid + it * 512; va[it] = *(const uint4*)(gA + (long)(c / CPR) * lda + (c % CPR) * 8); }
#pragma unroll
  for (int it = 0; it < IB; ++it) { const int c = tid + it * 512; vb[it] = *(const uint4*)(gB + (long)(c / CPR) * ldb + (c % CPR) * 8); }
#pragma unroll
  for (int it = 0; it < IA; ++it) { const int c = tid + it * 512; *(uint4*)(sA + (c / CPR) * LD + (c % CPR) * 8) = va[it]; }
#pragma unroll
  for (int it = 0; it < IB; ++it) { const int c = tid + it * 512; *(uint4*)(sB + (c / CPR) * LD + (c % CPR) * 8) = vb[it]; }
}

DEV void phase_sgu_mix(const Params& p, int j) {
  const int TIDX = opaque_tid();
  constexpr int KP = 128, LD = KP + 8;
  const int wid = TIDX >> 6, lane = TIDX & 63, wr = wid >> 2, wc = wid & 3, fr = lane & 15, fq = lane >> 4;
  bf16_t* sA = (bf16_t*)g_shm;
  bf16_t* sB = sA + 128 * LD;
  float* rsv = (float*)(g_shm + (128 + 256) * LD * 2);
  bf16_t* Z = (bf16_t*)(kws() + OFF_U);
  const float* SSQ = (const float*)(kws() + OFF_SSQ);
  const float* ws_ = kin(8) + (size_t)j * 8 * 128 * 128;
  const float* bs = kin(9) + (size_t)j * 8 * 128;
  const float* ng = kin(7) + (size_t)j * 2048;
  for (int unit = blockIdx.x; unit < 128 * 8; unit += gridDim.x) {
    const int chunk = unit >> 3, g = unit & 7;
    __syncthreads();
    uint4 vb[8]; float4 wa[4][2];
#pragma unroll
    for (int it = 0; it < 8; ++it) {
      const int e = TIDX + it * 512, pp = e & 127, c8 = (e >> 7) * 8;
      vb[it] = *(const uint4*)(Z + (size_t)(chunk * 128 + pp) * 4096 + 2048 + g * 256 + c8);
    }
#pragma unroll
    for (int it = 0; it < 4; ++it) {
      const int c = TIDX + it * 512, q = c >> 4, p8 = (c & 15) * 8;
      const float4* wp = (const float4*)(ws_ + ((size_t)g * 128 + q) * 128 + p8);
      wa[it][0] = wp[0]; wa[it][1] = wp[1];
    }
    if (TIDX < 128) {
      const float4* sp = (const float4*)(SSQ + (size_t)(chunk * 128 + TIDX) * 8);
      const float4 s0 = sp[0], s1 = sp[1];
      const float sm = ((s0.x + s0.y) + (s0.z + s0.w)) + ((s1.x + s1.y) + (s1.z + s1.w));
      rsv[TIDX] = rsqrtf(sm * (1.0f / 2048.f) + 1e-6f);
    }
#pragma unroll
    for (int it = 0; it < 8; ++it) {
      const int e = TIDX + it * 512, pp = e & 127, c8 = (e >> 7) * 8;
      const uint4 v = vb[it];
      sB[(c8 + 0) * LD + pp] = (bf16_t)(v.x & 0xffff); sB[(c8 + 1) * LD + pp] = (bf16_t)(v.x >> 16);
      sB[(c8 + 2) * LD + pp] = (bf16_t)(v.y & 0xffff); sB[(c8 + 3) * LD + pp] = (bf16_t)(v.y >> 16);
      sB[(c8 + 4) * LD + pp] = (bf16_t)(v.z & 0xffff); sB[(c8 + 5) * LD + pp] = (bf16_t)(v.z >> 16);
      sB[(c8 + 6) * LD + pp] = (bf16_t)(v.w & 0xffff); sB[(c8 + 7) * LD + pp] = (bf16_t)(v.w >> 16);
    }
    __syncthreads();
#pragma unroll
    for (int it = 0; it < 4; ++it) {
      const int c = TIDX + it * 512, q = c >> 4, p8 = (c & 15) * 8;
      const float4 w0 = wa[it][0], w1 = wa[it][1];
      uint4 o;
      o.x = pack2(w0.x * rsv[p8 + 0], w0.y * rsv[p8 + 1]); o.y = pack2(w0.z * rsv[p8 + 2], w0.w * rsv[p8 + 3]);
      o.z = pack2(w1.x * rsv[p8 + 4], w1.y * rsv[p8 + 5]); o.w = pack2(w1.z * rsv[p8 + 6], w1.w * rsv[p8 + 7]);
      *(uint4*)(sA + q * LD + p8) = o;
    }
    __syncthreads();
    f32x4 acc[4][4];
    small_mma<KP>(acc);
#pragma unroll
    for (int m = 0; m < 4; ++m) {
      const int q = wr * 64 + m * 16 + fr;
      const float bq = bs[g * 128 + q];
#pragma unroll
      for (int n = 0; n < 4; ++n) {
        const int c = g * 256 + wc * 64 + n * 16 + fq * 4;
        const float4 gg = *(const float4*)(ng + c);
        uint2* up = (uint2*)(Z + (size_t)(chunk * 128 + q) * 4096 + c);
        const uint2 u = *up;
        uint2 o;
        o.x = pack2(__uint_as_float(u.x << 16) * (acc[m][n][0] * gg.x + bq), __uint_as_float(u.x & 0xffff0000u) * (acc[m][n][1] * gg.y + bq));
        o.y = pack2(__uint_as_float(u.y << 16) * (acc[m][n][2] * gg.z + bq), __uint_as_float(u.y & 0xffff0000u) * (acc[m][n][3] * gg.w + bq));
        *up = o;
      }
    }
  }
  __syncthreads();
}

template <int KP>
DEV void lora_out_unit(const Params& p, int j, int kind, int mt, int ntile) {
  const int TIDX = opaque_tid();
  constexpr int LD = KP + 8;
  const int wid = TIDX >> 6, lane = TIDX & 63, wr = wid >> 2, wc = wid & 3, fr = lane & 15, fq = lane >> 4;
  bf16_t* sA = (bf16_t*)g_shm;
  bf16_t* sB = sA + 128 * LD;
  const bf16_t* HL = (const bf16_t*)(kws() + OFF_HL);
  const int koff = kind < 4 ? kind * 64 : 256;
  const bf16_t* Bt = (const bf16_t*)(kws() + OFF_W + (kind < 2 ? W_TM_W2 + (size_t)kind * 1024 * 64 * 2 : (kind < 4 ? W_TM_A2 + (size_t)(kind - 2) * 1024 * 64 * 2 : W_TM_G2)));
  bf16_t* O = (bf16_t*)(kws() + (kind == 0 ? OFF_E0 : kind == 1 ? OFF_E1 : kind == 2 ? OFF_A0 : kind == 3 ? OFF_A1 : OFF_G));
  const float* bias = kind < 2 ? kin(15) + ((size_t)j * 2 + kind) * 1024 : (kind < 4 ? kin(18) + ((size_t)j * 2 + kind - 2) * 1024 : nullptr);
  __syncthreads();
  small_load_ab<KP>(sA, HL + (size_t)mt * 128 * 512 + koff, 512, sB, Bt + (size_t)ntile * 256 * KP, KP, TIDX);
  __syncthreads();
  f32x4 acc[4][4];
  small_mma<KP>(acc);
#pragma unroll
  for (int n = 0; n < 4; ++n) {
    const int col = ntile * 256 + wc * 64 + n * 16 + fq * 4;
    const float4 b = bias ? *(const float4*)(bias + col) : make_float4(0.f, 0.f, 0.f, 0.f);
#pragma unroll
    for (int m = 0; m < 4; ++m) {
      const int row = mt * 128 + wr * 64 + m * 16 + fr;
      float v0 = acc[m][n][0] + b.x, v1 = acc[m][n][1] + b.y, v2 = acc[m][n][2] + b.z, v3 = acc[m][n][3] + b.w;
      if (kind < 4) {
        const float sc = kind < 2 ? 0.6065306597126334f : 1.0f;
        v0 = sc * sigmoidf_(v0); v1 = sc * sigmoidf_(v1); v2 = sc * sigmoidf_(v2); v3 = sc * sigmoidf_(v3);
      }
      uint2 o; o.x = pack2(v0, v1); o.y = pack2(v2, v3);
      *(uint2*)(O + (size_t)row * 1024 + col) = o;
    }
  }
}
DEV void phase_tm_lora_out(const Params& p, int j) {
  for (int unit = blockIdx.x; unit < 5 * 512; unit += gridDim.x) {
    const int kind = unit / 512, r = unit % 512, mt = r >> 2, ntile = r & 3;
    if (kind < 4) lora_out_unit<64>(p, j, kind, mt, ntile); else lora_out_unit<160>(p, j, kind, mt, ntile);
  }
  __syncthreads();
}

constexpr int LDP = 72;
constexpr int MATE = 64 * LDP;
DEV bf16_t* lbuf(int i) { return (bf16_t*)g_shm + i * MATE; }
DEV void bmm(const bf16_t* A, const bf16_t* Bt, int mb, int nh, int fr, int fq, f32x4 (&acc)[2]) {
  acc[0] = (f32x4){0.f, 0.f, 0.f, 0.f}; acc[1] = (f32x4){0.f, 0.f, 0.f, 0.f};
#pragma unroll
  for (int kk = 0; kk < 2; ++kk) {
    const bf16x8 a = *(const bf16x8*)(A + (mb * 16 + fr) * LDP + kk * 32 + fq * 8);
#pragma unroll
    for (int n = 0; n < 2; ++n) {
      const bf16x8 b = *(const bf16x8*)(Bt + (nh * 32 + n * 16 + fr) * LDP + kk * 32 + fq * 8);
      acc[n] = __builtin_amdgcn_mfma_f32_16x16x32_bf16(a, b, acc[n], 0, 0, 0);
    }
  }
}
DEV void st_rm(bf16_t* C, const f32x4 (&v)[2], int mb, int nh, int fr, int fq) {
#pragma unroll
  for (int n = 0; n < 2; ++n)
#pragma unroll
    for (int j = 0; j < 4; ++j) C[(mb * 16 + fq * 4 + j) * LDP + nh * 32 + n * 16 + fr] = f2bf(v[n][j]);
}
DEV void st_tr(bf16_t* CT, const f32x4 (&v)[2], int mb, int nh, int fr, int fq) {
#pragma unroll
  for (int n = 0; n < 2; ++n) {
    uint2 o; o.x = pack2(v[n][0], v[n][1]); o.y = pack2(v[n][2], v[n][3]);
    *(uint2*)(CT + (nh * 32 + n * 16 + fr) * LDP + mb * 16 + fq * 4) = o;
  }
}

DEV void phase_wkv_a(const Params& p, int jl, int slab) {
  const int TIDX = opaque_tid();
  const int wid = __builtin_amdgcn_readfirstlane(TIDX >> 6), lane = TIDX & 63, fr = lane & 15, fq = lane >> 4, mb = wid >> 1, nh = wid & 1;
  const bf16_t* Rb = (const bf16_t*)(kws() + OFF_R);
  const bf16_t* Kb = (const bf16_t*)(kws() + OFF_K);
  const bf16_t* Vb = (const bf16_t*)(kws() + OFF_V);
  float* PSI = (float*)(kws() + OFF_PSI);
  float* BON = (float*)(kws() + OFF_BON);
  float* segsum = (float*)(g_shm + 15 * MATE * 2);
  float* gTs = segsum + 512;
  bf16_t *mAtil = lbuf(0), *mBtil = lbuf(1), *mKtil = lbuf(2), *mRtil = lbuf(3), *mBgamT = lbuf(4), *mKgam = lbuf(5), *mAtilT = lbuf(6), *mVT = lbuf(7),
         *mMak = lbuf(10), *mMrk = lbuf(11), *mMrbT = lbuf(12);
  uint4 nr, nk, nv, na, ne;
  const int lr = TIDX >> 3, lc8 = (TIDX & 7) * 8;
  auto load_raw = [&](int u) {
    const int e2 = u & 1, h2 = (u >> 1) & 15, c2 = u >> 5;
    const bf16_t* A2 = (const bf16_t*)(kws() + (e2 ? OFF_A1 : OFF_A0));
    const bf16_t* E2 = (const bf16_t*)(kws() + (e2 ? OFF_E1 : OFF_E0));
    const size_t o = (size_t)c2 * 64 * 1024 + h2 * 64 + (size_t)lr * 1024 + lc8;
    nr = *(const uint4*)(Rb + o); nk = *(const uint4*)(Kb + o); nv = *(const uint4*)(Vb + o); na = *(const uint4*)(A2 + o); ne = *(const uint4*)(E2 + o);
  };
  if ((int)blockIdx.x < 256 * 32) load_raw(blockIdx.x);
  for (int unit = blockIdx.x; unit < 256 * 32; unit += gridDim.x) {
    const int e = unit & 1, h = (unit >> 1) & 15, c = unit >> 5;
    bf16_t* Ab = (bf16_t*)(kws() + (e ? OFF_A1 : OFF_A0));
    bf16_t* Eb = (bf16_t*)(kws() + (e ? OFF_E1 : OFF_E0));
    bf16_t* YL = (bf16_t*)(kws() + (e ? OFF_YLB : OFF_YLF));
    const size_t tile0 = (size_t)c * 64 * 1024 + h * 64;
    {
      const int jcol = lane, sg = wid;
      const float kkw = kin(23)[(size_t)jl * 1024 + h * 64 + jcol], kaw = kin(24)[(size_t)jl * 1024 + h * 64 + jcol], rkw = kin(25)[(size_t)jl * 1024 + h * 64 + jcol];
      *(uint4*)(lbuf(8) + lr * LDP + lc8) = nr; *(uint4*)(lbuf(9) + lr * LDP + lc8) = nk; *(uint4*)(lbuf(10) + lr * LDP + lc8) = nv;
      *(uint4*)(lbuf(11) + lr * LDP + lc8) = na; *(uint4*)(lbuf(12) + lr * LDP + lc8) = ne;
      LBAR2();
      if (unit + (int)gridDim.x < 256 * 32) load_raw(unit + gridDim.x);
      float rv[8], kv[8], vv[8], av[8], lw[8];
#pragma unroll
      for (int q = 0; q < 8; ++q) {
        const int tau = sg * 8 + q, tok = e ? 63 - tau : tau;
        rv[q] = bf2f(lbuf(8)[tok * LDP + jcol]); kv[q] = bf2f(lbuf(9)[tok * LDP + jcol]); vv[q] = bf2f(lbuf(10)[tok * LDP + jcol]);
        av[q] = bf2f(lbuf(11)[tok * LDP + jcol]); lw[q] = -bf2f(lbuf(12)[tok * LDP + jcol]);
      }
      float pre[8]; float run = 0.f;
#pragma unroll
      for (int q = 0; q < 8; ++q) { run += lw[q]; pre[q] = run; }
      segsum[sg * 64 + jcol] = run;
      LBAR2();
      float off = 0.f, tot = 0.f;
#pragma unroll
      for (int s2 = 0; s2 < 8; ++s2) { const float sv = segsum[s2 * 64 + jcol]; tot += sv; if (s2 < sg) off += sv; }
      if (sg == 0) gTs[jcol] = __expf(tot);
      float at[8], bg[8], vt[8];
#pragma unroll
      for (int q = 0; q < 8; ++q) {
        const int tau = sg * 8 + q, tok = e ? 63 - tau : tau;
        const float g = off + pre[q], gp = g - lw[q];
        const float kr = kv[q] * kkw;
        const float ss = wave_sum(kr * kr);
        const float kk = kr * __builtin_amdgcn_rsqf(fmaxf(ss, 1e-24f));
        const float b = kk * av[q], kd = kv[q] * (1.0f + (av[q] - 1.0f) * kaw);
        const float eg = __expf(g), eng = __expf(-g), egp = __expf(gp), egt = __expf(tot - g);
        const float atil = -kk * egp;
        mAtil[tau * LDP + jcol] = f2bf(atil);
        mBtil[tau * LDP + jcol] = f2bf(b * eng);
        mKtil[tau * LDP + jcol] = f2bf(kd * eng);
        mRtil[tau * LDP + jcol] = f2bf(rv[q] * eg);
        mKgam[tau * LDP + jcol] = f2bf(kd * egt);
        at[q] = atil; bg[q] = b * egt; vt[q] = vv[q];
        const float bon = wave_sum(rv[q] * kd * rkw);
        if (lane == 0) BON[((size_t)e * SLAB + c * 64 + tok) * 16 + h] = bon;
      }
      uint4 o;
      o.x = pack2(at[0], at[1]); o.y = pack2(at[2], at[3]); o.z = pack2(at[4], at[5]); o.w = pack2(at[6], at[7]);
      *(uint4*)(mAtilT + jcol * LDP + sg * 8) = o;
      o.x = pack2(bg[0], bg[1]); o.y = pack2(bg[2], bg[3]); o.z = pack2(bg[4], bg[5]); o.w = pack2(bg[6], bg[7]);
      *(uint4*)(mBgamT + jcol * LDP + sg * 8) = o;
      o.x = pack2(vt[0], vt[1]); o.y = pack2(vt[2], vt[3]); o.z = pack2(vt[4], vt[5]); o.w = pack2(vt[6], vt[7]);
      *(uint4*)(mVT + jcol * LDP + sg * 8) = o;
    }
    LBAR2();
    f32x4 acc[2], acc2[2];
    bmm(mBtil, mAtil, mb, nh, fr, fq, acc);
#pragma unroll
    for (int n = 0; n < 2; ++n)
#pragma unroll
      for (int j = 0; j < 4; ++j) { const int s = mb * 16 + fq * 4 + j, t = nh * 32 + n * 16 + fr; acc[n][j] = s < t ? acc[n][j] : 0.f; }
    st_rm(lbuf(8), acc, mb, nh, fr, fq); st_tr(lbuf(9), acc, mb, nh, fr, fq);
#pragma unroll
    for (int n = 0; n < 2; ++n)
#pragma unroll
      for (int j = 0; j < 4; ++j) { const int s = mb * 16 + fq * 4 + j, t = nh * 32 + n * 16 + fr; acc[n][j] += (s == t) ? 1.f : 0.f; }
    st_rm(lbuf(13), acc, mb, nh, fr, fq);
    f32x4 Wp[2] = {acc[0], acc[1]};
    bmm(mKtil, mAtil, mb, nh, fr, fq, acc);
#pragma unroll
    for (int n = 0; n < 2; ++n)
#pragma unroll
      for (int j = 0; j < 4; ++j) { const int s = mb * 16 + fq * 4 + j, t = nh * 32 + n * 16 + fr; acc[n][j] = s < t ? acc[n][j] : 0.f; }
    st_rm(mMak, acc, mb, nh, fr, fq);
    bmm(mKtil, mRtil, mb, nh, fr, fq, acc);
#pragma unroll
    for (int n = 0; n < 2; ++n)
#pragma unroll
      for (int j = 0; j < 4; ++j) { const int s = mb * 16 + fq * 4 + j, t = nh * 32 + n * 16 + fr; acc[n][j] = s <= t ? acc[n][j] : 0.f; }
    st_rm(mMrk, acc, mb, nh, fr, fq);
    bmm(mBtil, mRtil, mb, nh, fr, fq, acc);
#pragma unroll
    for (int n = 0; n < 2; ++n)
#pragma unroll
      for (int j = 0; j < 4; ++j) { const int s = mb * 16 + fq * 4 + j, t = nh * 32 + n * 16 + fr; acc[n][j] = s <= t ? acc[n][j] : 0.f; }
    st_tr(mMrbT, acc, mb, nh, fr, fq);
    LBAR2();
    bmm(lbuf(8), lbuf(9), mb, nh, fr, fq, acc);
    st_rm(lbuf(1), acc, mb, nh, fr, fq); st_tr(lbuf(2), acc, mb, nh, fr, fq);
    LBAR2();
#pragma unroll
    for (int k = 0; k < 4; ++k) {
      const int pc = (k & 1) ? 8 : 1, pn = (k & 1) ? 1 : 8, wc_ = (k & 1) ? 14 : 13, wn = (k & 1) ? 13 : 14;
      bmm(lbuf(wc_), lbuf(pc + 1), mb, nh, fr, fq, acc);
      bmm(lbuf(pc), lbuf(pc + 1), mb, nh, fr, fq, acc2);
      Wp[0] += acc[0]; Wp[1] += acc[1];
      st_rm(lbuf(wn), Wp, mb, nh, fr, fq);
      st_rm(lbuf(pn), acc2, mb, nh, fr, fq); st_tr(lbuf(pn + 1), acc2, mb, nh, fr, fq);
      LBAR2();
    }
    bmm(lbuf(13), lbuf(2), mb, nh, fr, fq, acc);
    Wp[0] += acc[0]; Wp[1] += acc[1];
    st_rm(lbuf(14), Wp, mb, nh, fr, fq);
    LBAR2();
    bmm(mMrbT, lbuf(14), mb, nh, fr, fq, acc);  st_rm(lbuf(8), acc, mb, nh, fr, fq);
    bmm(mBgamT, lbuf(14), mb, nh, fr, fq, acc); st_rm(lbuf(9), acc, mb, nh, fr, fq);
    LBAR2();
    bmm(lbuf(8), mMak, mb, nh, fr, fq, acc);
#pragma unroll
    for (int n = 0; n < 2; ++n)
#pragma unroll
      for (int j = 0; j < 4; ++j) { const int t = mb * 16 + fq * 4 + j, s = nh * 32 + n * 16 + fr; acc[n][j] += bf2f(mMrk[s * LDP + t]); }
    st_rm(lbuf(1), acc, mb, nh, fr, fq);
    bmm(lbuf(9), mMak, mb, nh, fr, fq, acc);
#pragma unroll
    for (int n = 0; n < 2; ++n)
#pragma unroll
      for (int j = 0; j < 4; ++j) { const int jj = mb * 16 + fq * 4 + j, s = nh * 32 + n * 16 + fr; acc[n][j] += bf2f(mKgam[s * LDP + jj]); }
    st_rm(lbuf(2), acc, mb, nh, fr, fq);
    bmm(mAtilT, lbuf(8), mb, nh, fr, fq, acc);
#pragma unroll
    for (int n = 0; n < 2; ++n) {
      const int j0 = mb * 16 + fq * 4, t = nh * 32 + n * 16 + fr;
      const uint2 rt = *(const uint2*)(mRtil + t * LDP + j0);
      uint2 o;
      o.x = pack2(acc[n][0] + __uint_as_float(rt.x << 16), acc[n][1] + __uint_as_float(rt.x & 0xffff0000u));
      o.y = pack2(acc[n][2] + __uint_as_float(rt.y << 16), acc[n][3] + __uint_as_float(rt.y & 0xffff0000u));
      *(uint2*)(Eb + tile0 + (size_t)t * 1024 + j0) = o;
    }
    bmm(mAtilT, lbuf(9), mb, nh, fr, fq, acc);
#pragma unroll
    for (int n = 0; n < 2; ++n) {
      const int j0 = mb * 16 + fq * 4, jp = nh * 32 + n * 16 + fr;
      uint2 o;
      o.x = pack2(acc[n][0] + (jp == j0 ? gTs[j0] : 0.f), acc[n][1] + (jp == j0 + 1 ? gTs[j0 + 1] : 0.f));
      o.y = pack2(acc[n][2] + (jp == j0 + 2 ? gTs[j0 + 2] : 0.f), acc[n][3] + (jp == j0 + 3 ? gTs[j0 + 3] : 0.f));
      *(uint2*)(Ab + tile0 + (size_t)jp * 1024 + j0) = o;
    }
    LBAR2();
    bmm(mVT, lbuf(1), mb, nh, fr, fq, acc);
#pragma unroll
    for (int n = 0; n < 2; ++n) {
      const int i0 = mb * 16 + fq * 4, t = nh * 32 + n * 16 + fr;
      uint2 o; o.x = pack2(acc[n][0], acc[n][1]); o.y = pack2(acc[n][2], acc[n][3]);
      *(uint2*)(YL + tile0 + (size_t)t * 1024 + i0) = o;
    }
    bmm(mVT, lbuf(2), mb, nh, fr, fq, acc);
    *(f32x4*)(PSI + (size_t)unit * 4096 + (size_t)(wid * 64 + lane) * 8) = acc[0];
    *(f32x4*)(PSI + (size_t)unit * 4096 + (size_t)(wid * 64 + lane) * 8 + 4) = acc[1];
  }
}

DEV void phase_wkv_b(const Params& p, int slab, int mode) {
  const int TIDX = opaque_tid();
  const int wid = __builtin_amdgcn_readfirstlane(TIDX >> 6), lane = TIDX & 63, fr = lane & 15, fq = lane >> 4, mb = wid >> 1, nh = wid & 1;
  const float* PSI = (const float*)(kws() + OFF_PSI);
  bf16_t* PHG = (bf16_t*)(kws() + OFF_PHG);
  float* PSG = (float*)(kws() + OFF_PSG);
  float* SST = (float*)(kws() + OFF_SST);
  const bool two_level = slab < 2;
  if (!two_level && mode != 3) return;
  const int nseq = two_level ? 1 : 8, cps = 256 / nseq;
  const int ngrp = two_level ? 8 : 1;
  bf16_t *Sb = lbuf(0), *PhT = lbuf(1), *OmT = lbuf(2), *Sa = lbuf(3);
  const int lr = TIDX >> 3, lc8 = (TIDX & 7) * 8;
  const size_t nat = (size_t)(wid * 64 + lane) * 8;
  if (mode == 2) {
    for (int chain = blockIdx.x; chain < 32; chain += gridDim.x) {
      f32x4 S[2];
      S[0] = (f32x4){0.f, 0.f, 0.f, 0.f}; S[1] = (f32x4){0.f, 0.f, 0.f, 0.f};
      for (int g = 0; g < 8; ++g) {
        const size_t item = (size_t)chain * 8 + g;
        *(f32x4*)(SST + item * 4096 + nat) = S[0]; *(f32x4*)(SST + item * 4096 + nat + 4) = S[1];
        const uint4 ph = *(const uint4*)(PHG + item * 4096 + lr * 64 + lc8);
        const f32x4 q0 = *(const f32x4*)(PSG + item * 4096 + nat), q1 = *(const f32x4*)(PSG + item * 4096 + nat + 4);
        st_rm(Sb, S, mb, nh, fr, fq);
        *(uint4*)(PhT + lr * LDP + lc8) = ph;
        LBAR2();
        f32x4 acc[2];
        bmm(Sb, PhT, mb, nh, fr, fq, acc);
        S[0] = acc[0] + q0; S[1] = acc[1] + q1;
        LBAR2();
      }
    }
    return;
  }
  for (int item = blockIdx.x; item < nseq * 32 * ngrp; item += gridDim.x) {
    const int chain = item / ngrp, grp = item % ngrp;
    const int e = chain & 1, h = (chain >> 1) & 15, sq = chain >> 5;
    const bf16_t* Ab = (const bf16_t*)(kws() + (e ? OFF_A1 : OFF_A0));
    const bf16_t* Eb = (const bf16_t*)(kws() + (e ? OFF_E1 : OFF_E0));
    bf16_t* YL = (bf16_t*)(kws() + (e ? OFF_YLB : OFF_YLF));
    const int sbase = grp * 32;
    f32x4 S[2], SA[2];
    if (mode == 3 && two_level) { S[0] = *(const f32x4*)(SST + (size_t)item * 4096 + nat); S[1] = *(const f32x4*)(SST + (size_t)item * 4096 + nat + 4); }
    else { S[0] = (f32x4){0.f, 0.f, 0.f, 0.f}; S[1] = (f32x4){0.f, 0.f, 0.f, 0.f}; }
#pragma unroll
    for (int n = 0; n < 2; ++n)
#pragma unroll
      for (int j = 0; j < 4; ++j) SA[n][j] = (mb * 16 + fq * 4 + j == nh * 32 + n * 16 + fr) ? 1.f : 0.f;
    uint4 ph0, ph1, ph2, ph3, om0, om1, om2, om3;
    f32x4 ps0[2], ps1[2], ps2[2], ps3[2];
    uint2 yl0[2], yl1[2], yl2[2], yl3[2];
#define WB_PREFETCH(step_, ph, om, ps, y8) do { \
      const int st_ = sbase + ((step_) < 32 ? (step_) : 31); \
      const int c_ = sq * cps + (e ? cps - 1 - st_ : st_); \
      const size_t t0_ = (size_t)c_ * 64 * 1024 + h * 64; \
      ph = *(const uint4*)(Ab + t0_ + (size_t)lr * 1024 + lc8); \
      const size_t u_ = ((size_t)c_ * 16 + h) * 2 + e; \
      ps[0] = *(const f32x4*)(PSI + u_ * 4096 + nat); ps[1] = *(const f32x4*)(PSI + u_ * 4096 + nat + 4); \
      if (mode == 3) { \
        om = *(const uint4*)(Eb + t0_ + (size_t)lr * 1024 + lc8); \
        y8[0] = *(const uint2*)(YL + t0_ + (size_t)(nh * 32 + fr) * 1024 + mb * 16 + fq * 4); \
        y8[1] = *(const uint2*)(YL + t0_ + (size_t)(nh * 32 + 16 + fr) * 1024 + mb * 16 + fq * 4); } } while (0)
#define WB_STEP(step_, ph, om, ps, y8) do { \
      const int c = sq * cps + (e ? cps - 1 - (sbase + (step_)) : (sbase + (step_))); \
      const size_t tile0 = (size_t)c * 64 * 1024 + h * 64; \
      bf16_t *Sb_ = lbuf(((step_) & 1) * 4), *PhT_ = lbuf(((step_) & 1) * 4 + 1), *OmT_ = lbuf(((step_) & 1) * 4 + 2), *Sa_ = lbuf(((step_) & 1) * 4 + 3); \
      st_rm(Sb_, S, mb, nh, fr, fq); \
      *(uint4*)(PhT_ + lr * LDP + lc8) = ph; \
      if (mode == 3) *(uint4*)(OmT_ + lr * LDP + lc8) = om; else st_rm(Sa_, SA, mb, nh, fr, fq); \
      const f32x4 psc0 = ps[0], psc1 = ps[1]; const uint2 ylc0 = y8[0], ylc1 = y8[1]; \
      LBAR2(); \
      WB_PREFETCH((step_) + 4, ph, om, ps, y8); \
      f32x4 acc[2]; \
      if (mode == 3) { \
        bmm(Sb_, OmT_, mb, nh, fr, fq, acc); \
        uint2 o; \
        o.x = pack2(acc[0][0] + __uint_as_float(ylc0.x << 16), acc[0][1] + __uint_as_float(ylc0.x & 0xffff0000u)); \
        o.y = pack2(acc[0][2] + __uint_as_float(ylc0.y << 16), acc[0][3] + __uint_as_float(ylc0.y & 0xffff0000u)); \
        *(uint2*)(YL + tile0 + (size_t)(nh * 32 + fr) * 1024 + mb * 16 + fq * 4) = o; \
        o.x = pack2(acc[1][0] + __uint_as_float(ylc1.x << 16), acc[1][1] + __uint_as_float(ylc1.x & 0xffff0000u)); \
        o.y = pack2(acc[1][2] + __uint_as_float(ylc1.y << 16), acc[1][3] + __uint_as_float(ylc1.y & 0xffff0000u)); \
        *(uint2*)(YL + tile0 + (size_t)(nh * 32 + 16 + fr) * 1024 + mb * 16 + fq * 4) = o; \
      } else { \
        bmm(Sa_, PhT_, mb, nh, fr, fq, acc); SA[0] = acc[0]; SA[1] = acc[1]; \
      } \
      bmm(Sb_, PhT_, mb, nh, fr, fq, acc); \
      S[0] = acc[0] + psc0; S[1] = acc[1] + psc1; } while (0)
    yl0[0] = yl0[1] = yl1[0] = yl1[1] = yl2[0] = yl2[1] = yl3[0] = yl3[1] = make_uint2(0u, 0u);
    om0 = om1 = om2 = om3 = make_uint4(0u, 0u, 0u, 0u);
    WB_PREFETCH(0, ph0, om0, ps0, yl0); WB_PREFETCH(1, ph1, om1, ps1, yl1); WB_PREFETCH(2, ph2, om2, ps2, yl2); WB_PREFETCH(3, ph3, om3, ps3, yl3);
    for (int step0 = 0; step0 < 32; step0 += 4) {
      WB_STEP(step0 + 0, ph0, om0, ps0, yl0);
      WB_STEP(step0 + 1, ph1, om1, ps1, yl1);
      WB_STEP(step0 + 2, ph2, om2, ps2, yl2);
      WB_STEP(step0 + 3, ph3, om3, ps3, yl3);
    }
    LBAR2();
    if (mode == 1) {
#pragma unroll
      for (int n = 0; n < 2; ++n) {
        uint2 o; o.x = pack2(SA[n][0], SA[n][1]); o.y = pack2(SA[n][2], SA[n][3]);
        *(uint2*)(PHG + (size_t)item * 4096 + (nh * 32 + n * 16 + fr) * 64 + mb * 16 + fq * 4) = o;
      }
      *(f32x4*)(PSG + (size_t)item * 4096 + nat) = S[0]; *(f32x4*)(PSG + (size_t)item * 4096 + nat + 4) = S[1];
    }
  }
}

DEV void phase_tm_post(const Params& p, int jl) {
  const int TIDX = opaque_tid();
  const int wid = TIDX >> 6, lane = TIDX & 63, hs = lane >> 4, c4 = (lane & 15) * 4;
  bf16_t* Rb = (bf16_t*)(kws() + OFF_R);
  const bf16_t* Vb = (const bf16_t*)(kws() + OFF_V);
  const bf16_t* Gb = (const bf16_t*)(kws() + OFF_G);
  const bf16_t* YF = (const bf16_t*)(kws() + OFF_YLF);
  const bf16_t* YB = (const bf16_t*)(kws() + OFF_YLB);
  const float* BON = (const float*)(kws() + OFF_BON);
  for (int item = blockIdx.x * 8 + wid; item < 2048; item += gridDim.x * 8) {
    const int hd = (item & 3) * 4 + hs, tb = (item >> 2) * 32;
    const int cch = hd * 64 + c4;
    const float4 lg = *(const float4*)(kin(26) + (size_t)jl * 1024 + cch), lb = *(const float4*)(kin(27) + (size_t)jl * 1024 + cch);
    struct PostRaw { uint2 yf, yb, v, g; float b0, b1; };
    auto load_raw = [&](int tt, PostRaw& w) {
      const int t = tb + (tt < 32 ? tt : 31);
      const size_t o = (size_t)t * 1024 + cch;
      const size_t ob = (size_t)((t & ~63) + 63 - (t & 63)) * 1024 + cch;
      w.yf = *(const uint2*)(YF + o); w.yb = *(const uint2*)(YB + ob); w.v = *(const uint2*)(Vb + o); w.g = *(const uint2*)(Gb + o);
      w.b0 = BON[(size_t)t * 16 + hd]; w.b1 = BON[((size_t)SLAB + t) * 16 + hd];
    };
    PostRaw w0, w1;
    load_raw(0, w0); load_raw(1, w1);
    for (int tt = 0; tt < 32; ++tt) {
      PostRaw w2; load_raw(tt + 2, w2);
      float y[4];
      y[0] = __uint_as_float(w0.yf.x << 16) + __uint_as_float(w0.yb.x << 16); y[1] = __uint_as_float(w0.yf.x & 0xffff0000u) + __uint_as_float(w0.yb.x & 0xffff0000u);
      y[2] = __uint_as_float(w0.yf.y << 16) + __uint_as_float(w0.yb.y << 16); y[3] = __uint_as_float(w0.yf.y & 0xffff0000u) + __uint_as_float(w0.yb.y & 0xffff0000u);
      const float mean = row_sum16((y[0] + y[1]) + (y[2] + y[3])) * (1.0f / 64.f);
      const float d0 = y[0] - mean, d1 = y[1] - mean, d2 = y[2] - mean, d3 = y[3] - mean;
      const float var = row_sum16((d0 * d0 + d1 * d1) + (d2 * d2 + d3 * d3)) * (1.0f / 64.f);
      const float rs = rsqrtf(var + 64e-5f), bon = w0.b0 + w0.b1;
      const float o0 = (d0 * rs * lg.x + lb.x + bon * __uint_as_float(w0.v.x << 16)) * __uint_as_float(w0.g.x << 16);
      const float o1 = (d1 * rs * lg.y + lb.y + bon * __uint_as_float(w0.v.x & 0xffff0000u)) * __uint_as_float(w0.g.x & 0xffff0000u);
      const float o2 = (d2 * rs * lg.z + lb.z + bon * __uint_as_float(w0.v.y << 16)) * __uint_as_float(w0.g.y << 16);
      const float o3 = (d3 * rs * lg.w + lb.w + bon * __uint_as_float(w0.v.y & 0xffff0000u)) * __uint_as_float(w0.g.y & 0xffff0000u);
      uint2 o; o.x = pack2(o0, o1); o.y = pack2(o2, o3);
      *(uint2*)(Rb + (size_t)(tb + tt) * 1024 + cch) = o;
      w0 = w1; w1 = w2;
    }
  }
}

DEV void wprep_sgu(const Params& p, int j) {
  wprep_T2((bf16_t*)(kws() + OFF_W + W_SG_IN), 1024, 0, kin(5) + (size_t)j * 1024 * 4096, 1024, 4096, nullptr, 128, 0);
  wprep_T2((bf16_t*)(kws() + OFF_W + W_SG_OUT), 2048, 0, kin(10) + (size_t)j * 2048 * 1024, 2048, 1024, nullptr, 128, 0);
}
DEV void wprep_ffn(const Params& p, int layer) {
  wprep_T2((bf16_t*)(kws() + OFF_W + W_FF_A), 1024, 0, kin(29) + (size_t)layer * 1024 * 2816, 1024, 2816, nullptr, 256, 0);
  wprep_T2((bf16_t*)(kws() + OFF_W + W_FF_A), 1024, 0, kin(30) + (size_t)layer * 1024 * 2816, 1024, 2816, nullptr, 256, 128);
  wprep_T2((bf16_t*)(kws() + OFF_W + W_FF_D), 2816, 0, kin(33) + (size_t)layer * 2816 * 1024, 2816, 1024, nullptr, 128, 0);
}
DEV void wprep_tm(const Params& p, int j) {
  const int TIDX = opaque_tid();
  bf16_t* WP = (bf16_t*)(kws() + OFF_W + W_TM_P);
  const float* srcs[3] = {kin(12) + (size_t)j * 1048576, kin(13) + (size_t)j * 1048576, kin(14) + (size_t)j * 1048576};
#pragma unroll
  for (int i = 0; i < 3; ++i) wprep_T2(WP, 1024, 0, srcs[i], 1024, 1024, nullptr, 128, i * 1024);
#pragma unroll
  for (int e = 0; e < 2; ++e) {
    wprep_T(WP, 1024, 0, kin(16) + ((size_t)j * 2 + e) * 1024 * 64, 1024, 64, nullptr, 128, 3072 + 64 * e);
    wprep_T(WP, 1024, 0, kin(19) + ((size_t)j * 2 + e) * 1024 * 64, 1024, 64, nullptr, 128, 3328 + 64 * e);
    wprep_T2((bf16_t*)(kws() + OFF_W + W_TM_W2) + (size_t)e * 1024 * 64, 64, 0, kin(17) + ((size_t)j * 2 + e) * 64 * 1024, 64, 1024, nullptr, 128, 0);
    wprep_T2((bf16_t*)(kws() + OFF_W + W_TM_A2) + (size_t)e * 1024 * 64, 64, 0, kin(20) + ((size_t)j * 2 + e) * 64 * 1024, 64, 1024, nullptr, 128, 0);
  }
  wprep_T(WP, 1024, 0, kin(21) + (size_t)j * 1024 * 160, 1024, 160, nullptr, 128, 3584);
  for (size_t i = (size_t)blockIdx.x * 512 + TIDX; i < (size_t)(128 + 128 + 96) * 512; i += (size_t)gridDim.x * 512) {
    const size_t row = i / 512, w = i % 512;
    const size_t drow = row < 128 ? 3200 + row : (row < 256 ? 3456 + (row - 128) : 3744 + (row - 256));
    ((unsigned*)(WP + drow * 1024))[w] = 0u;
  }
  wprep_T((bf16_t*)(kws() + OFF_W + W_TM_G2), 160, 0, kin(22) + (size_t)j * 160 * 1024, 160, 1024, nullptr, 128, 0);
  wprep_T2((bf16_t*)(kws() + OFF_W + W_TM_O), 1024, 0, kin(28) + (size_t)j * 1048576, 1024, 1024, nullptr, 128, 0);
}

constexpr int PH_SGU = 10, PH_FFN = 3, PH_TM = 25;
constexpr int N_PHASES = 2 * (PH_SGU + PH_FFN) + 2 * (PH_TM + PH_FFN) + 1;

DEV void run_phase(const Params& p, int ph) {
  if (ph == N_PHASES - 1) { phase_final(p); return; }
  int q = ph, layer = 0;
  for (;;) {
    const int len = (layer & 1) ? PH_TM + PH_FFN : PH_SGU + PH_FFN;
    if (q < len) break;
    q -= len; ++layer;
  }
  const int j = layer >> 1;
  bf16_t* H0 = (bf16_t*)(kws() + OFF_H0);
  const int nmix = (layer & 1) ? PH_TM : PH_SGU;
  if (q >= nmix) {
    const int f = q - nmix;
    if (f == 0) { phase_norm<false>(p, kin(3) + (size_t)layer * 1024, H0); wprep_ffn(p, layer); }
    else if (f == 1) phase_ffn_a(p, layer);
    else phase_gemm_res(p, (const bf16_t*)(kws() + OFF_HMID), 2816, (const bf16_t*)(kws() + OFF_W + W_FF_D), 2816, 192, 0);
    return;
  }
  if (!(layer & 1)) {
    if (q == 0) { if (layer == 0) phase_norm<true>(p, kin(2), H0); else phase_norm<false>(p, kin(2) + (size_t)layer * 1024, H0); wprep_sgu(p, j); return; }
    const int slab = (q - 1) / 3, s = (q - 1) % 3;
    if (s == 0) phase_sgu_in(p, j, slab);
    else if (s == 1) phase_sgu_mix(p, j);
    else phase_gemm_res(p, (const bf16_t*)(kws() + OFF_U), 4096, (const bf16_t*)(kws() + OFF_W + W_SG_OUT), 2048, 64, (long)slab * SLAB);
    return;
  }
  {
    const int slab = q < 18 ? q / 9 : 2;
    int s = q < 18 ? q % 9 : q - 18;
    if (slab == 2 && s >= 4) s += 2;
    switch (s) {
      case 0: phase_norm_tm(p, kin(2) + (size_t)layer * 1024, kin(11) + (size_t)j * 6 * 1024, (bf16_t*)(kws() + OFF_MIX), slab); if (slab == 0) wprep_tm(p, j); break;
      case 1: phase_tm_proj(p); break;
      case 2: phase_tm_lora_out(p, j); break;
      case 3: phase_wkv_a(p, j, slab); break;
      case 4: phase_wkv_b(p, slab, 1); break;
      case 5: phase_wkv_b(p, slab, 2); break;
      case 6: phase_wkv_b(p, slab, 3); break;
      case 7: phase_tm_post(p, j); break;
      default: phase_gemm_res(p, (const bf16_t*)(kws() + OFF_R), 1024, (const bf16_t*)(kws() + OFF_W + W_TM_O), 1024, 64, (long)slab * SLAB); break;
    }
  }
}

#ifndef PROBE_CAT
#define PROBE_CAT -1
#endif
DEV int phase_cat(int ph) {
  if (ph == N_PHASES - 1) return 2;
  int q = ph, layer = 0;
  for (;;) { const int len = (layer & 1) ? PH_TM + PH_FFN : PH_SGU + PH_FFN; if (q < len) break; q -= len; ++layer; }
  const int nmix = (layer & 1) ? PH_TM : PH_SGU;
  if (q >= nmix) return (q - nmix) == 0 ? 2 : ((q - nmix) == 1 ? 7 : 8);
  if (!(layer & 1)) { if (q == 0) return 2; const int s = (q - 1) % 3; return s == 1 ? 3 : 0; }
  int s = q < 18 ? q % 9 : q - 18; if (q >= 18 && s >= 4) s += 2;
  return s == 0 ? 2 : (s == 1 || s == 8) ? 0 : (s == 2 ? 4 : (s == 3 ? 1 : (s == 7 ? 6 : 5)));
}

#define XB_TMO      128
#define XB_XCNT(j)  (256  + 64 * (j))
#define XB_XSUB(j)  (1280 + 64 * (j))
#define XB_XGEN(j)  (2304 + 64 * (j))
#define XB_TOP      3328
#define XB_TOPGEN   3392
#define XCD_BAR_WORDS 3456
#define XB_SPIN_CAP (1u << 18)
#define XLAS __attribute__((address_space(3)))
DEV unsigned xb_ld(unsigned* p)              { return __hip_atomic_load(p, __ATOMIC_RELAXED, __HIP_MEMORY_SCOPE_AGENT); }
DEV unsigned xb_add(unsigned* p, unsigned v) { return __hip_atomic_fetch_add(p, v, __ATOMIC_RELAXED, __HIP_MEMORY_SCOPE_AGENT); }
DEV unsigned xb_xcc_id() { return (unsigned)__builtin_amdgcn_s_getreg((3 << 11) | 20) & 0xFu; }
#define XB_SPIN(cond, bar) do { unsigned _sp = 0; while (cond) { __builtin_amdgcn_s_sleep(1); \
    if ((++_sp & 255u) == 0u) { if (xb_ld(&(bar)[XB_TMO])) break; if (_sp > XB_SPIN_CAP) { atomicAdd(&(bar)[XB_TMO], 1u); break; } } } } while (0)
DEV void xcd_barrier_complete(unsigned* bar, unsigned x, unsigned& nloc, unsigned& nx) {
  const unsigned G = gridDim.x * gridDim.y * gridDim.z;
  unsigned sum, cnt, mine, sp = 0u;
  for (;;) {
    sum = 0u; cnt = 0u; mine = 0u;
#pragma unroll
    for (unsigned j = 0; j < 16; ++j) { const unsigned c = xb_ld(&bar[XB_XCNT(j)]); sum += c; cnt += (c > 0u) ? 1u : 0u; mine = (j == x) ? c : mine; }
    if (sum == G) break;
    __builtin_amdgcn_s_sleep(1);
    if ((++sp & 255u) == 0u) { if (xb_ld(&bar[XB_TMO])) break; if (sp > XB_SPIN_CAP) { atomicAdd(&bar[XB_TMO], 1u); break; } }
  }
  nloc = mine > 0u ? mine : 1u; nx = cnt > 0u ? cnt : 1u;
}
DEV void xcd_barrier(unsigned* bar, volatile XLAS unsigned* st) {
  asm volatile("s_waitcnt vmcnt(0)" ::: "memory");
  __syncthreads();
  if (threadIdx.x == 0) {
    const unsigned x = xb_xcc_id();
    __builtin_amdgcn_s_waitcnt(0);
    unsigned nloc = st[0], nx = st[1];
    if (nloc == 0u) { xcd_barrier_complete(bar, x, nloc, nx); st[0] = nloc; st[1] = nx; }
    const unsigned old = xb_add(&bar[XB_XSUB(x)], 1u);
    const unsigned gen = old / nloc;
    if (old + 1u == (gen + 1u) * nloc) {
      __builtin_amdgcn_fence(__ATOMIC_RELEASE, "agent");
      asm volatile("s_waitcnt vmcnt(0)" ::: "memory");
      const unsigned og = xb_add(&bar[XB_TOP], 1u);
      const unsigned tg = og / nx;
      if (og + 1u == (tg + 1u) * nx) xb_add(&bar[XB_TOPGEN], 1u);
      else XB_SPIN(xb_ld(&bar[XB_TOPGEN]) == tg, bar);
      __builtin_amdgcn_fence(__ATOMIC_ACQUIRE, "agent");
      xb_add(&bar[XB_XGEN(x)], 1u);
      asm volatile("s_waitcnt vmcnt(0)" ::: "memory");
    } else {
      XB_SPIN(xb_ld(&bar[XB_XGEN(x)]) == gen, bar);
      __builtin_amdgcn_fence(__ATOMIC_ACQUIRE, "agent");
      asm volatile("s_waitcnt vmcnt(0)" ::: "memory");
    }
  }
  __syncthreads();
}
constexpr size_t OFF_BAR = 504 * MiB;

__global__ void __launch_bounds__(512, 2) mega(Params p, int ph_lo, int ph_hi, int coop) {
#if PROBE_CAT >= 0
  if (blockIdx.x == 0 && threadIdx.x == 0) ((unsigned long long*)(kws() + 500 * MiB))[0] = wall_clock64();
#endif
  __shared__ uint4 xb_words;
  if (threadIdx.x == 0) {
    xb_words = make_uint4(0u, 0u, 0u, 0u);
    if (coop) (void)xb_add(&((unsigned*)(kws() + OFF_BAR))[XB_XCNT(xb_xcc_id())], 1u);
  }
  __syncthreads();
  for (int ph = ph_lo; ph < ph_hi; ++ph) {
    run_phase(p, ph);
    if (coop && ph + 1 < ph_hi) {
      if (ph == ph_lo) cg::this_grid().sync();
      else xcd_barrier((unsigned*)(kws() + OFF_BAR), (volatile XLAS unsigned*)&xb_words);
    }
#if PROBE_CAT >= 0
    if (blockIdx.x == 0 && threadIdx.x == 0) ((unsigned long long*)(kws() + 500 * MiB))[ph + 1] = wall_clock64();
#endif
  }
#if PROBE_CAT >= 0
  cg::this_grid().sync();
  if (blockIdx.x == 0 && threadIdx.x == 0) {
    const unsigned long long* ts = (const unsigned long long*)(kws() + 500 * MiB);
    unsigned long long acc = 0;
    for (int ph = 0; ph < N_PHASES; ++ph) if (PROBE_CAT == 9 || phase_cat(ph) == PROBE_CAT) acc += ts[ph + 1] - ts[ph];
    ((float*)(kws() + 500 * MiB))[1024] = (float)acc * (0.01f * 2e-5f);
  }
  __syncthreads();
  if (blockIdx.x == 0) {
    __threadfence();
    const float ev = ((volatile float*)(kws() + 500 * MiB))[1024];
    for (int i = threadIdx.x; i < 4096; i += 512) kx()[i] += ev;
    for (int i = threadIdx.x; i < 2048; i += 512) kx()[(size_t)32768 * 1024 + i] += ev;
  }
#endif
}

extern "C" void kernel_launch(void* const* d_in, const int* in_sizes, int n_in, void* d_out, int out_size, void* d_ws, size_t ws_size, hipStream_t stream) {
  static int grid = 0;
  if (!grid) {
    int dev = 0, cus = 0, per_cu = 0;
    (void)hipFuncSetAttribute((const void*)mega, hipFuncAttributeMaxDynamicSharedMemorySize, SHM_BYTES);
    (void)hipGetDevice(&dev);
    (void)hipDeviceGetAttribute(&cus, hipDeviceAttributeMultiprocessorCount, dev);
    (void)hipOccupancyMaxActiveBlocksPerMultiprocessor(&per_cu, (const void*)mega, 512, SHM_BYTES);
    if (per_cu < 1) per_cu = 1;
    grid = cus * per_cu;
    if (grid > 256) grid = 256;
    if (grid & 7) grid &= ~7;
  }
  Params p{};
  for (int i = 0; i < 34; ++i) p.in[i] = (const float*)d_in[i];
  p.x = (float*)d_out;
  p.ws = (char*)d_ws;
  (void)hipMemsetAsync((char*)d_ws + OFF_BAR, 0, XCD_BAR_WORDS * sizeof(unsigned), stream);
  int ph_lo = 0, ph_hi = N_PHASES, coop = 1;
  void* args[] = {&p, &ph_lo, &ph_hi, &coop};
  hipError_t e = hipLaunchCooperativeKernel((const void*)mega, dim3(grid), dim3(512), args, SHM_BYTES, stream);
  if (e != hipSuccess) fprintf(stderr, "cooperative launch failed: %s (grid %d)\n", hipGetErrorString(e), grid);
}
```
